# Optimizing an MI355X kernel written in HIP

```python
import math
import jax
import jax.numpy as jnp
from jax import lax
import numpy as np

D_MODEL = 2048
BATCH = 2
SEQ = 8192
DEPTH = 4

HEAD_DIM = 128
N_HEADS = 4
BRANCH_WIDTH = N_HEADS * HEAD_DIM
N_BRANCHES = 4
DIFF_DIM = HEAD_DIM // 2
IDX_HEADS = 16
IDX_DIM = 64
TOPK_MAX = 256
DILATED_CONFIGS = ((128, 1), (512, 4), (2048, 16))
N_BUCKETS = 32
MAX_DISTANCE = 2048
BLOCK_Q = 128
RMS_EPS = 1e-6
N_BIAS_HEADS = 3 * N_HEADS
QKV_COLS = 3 * BRANCH_WIDTH
IN_SIZES = (N_BRANCHES * BRANCH_WIDTH, N_BRANCHES * D_MODEL, QKV_COLS, IDX_HEADS * IDX_DIM,
            IDX_DIM, IDX_HEADS, QKV_COLS, N_HEADS, QKV_COLS, QKV_COLS)
IN_OFFSETS = tuple(int(o) for o in np.cumsum(IN_SIZES)[:-1])
N_IN = int(sum(IN_SIZES))

kernel_name = 'hybrid_dsa_fox_diff_dilated_gated'


def rms_norm(x, w):
    xf = x.astype(jnp.float32)
    y = xf * lax.rsqrt(jnp.mean(xf * xf, axis=-1, keepdims=True) + RMS_EPS)
    return (y * w.astype(jnp.float32)).astype(x.dtype)


def t5_bucket(dist):
    dist = jnp.maximum(dist, 0)
    max_exact = N_BUCKETS // 2
    d = jnp.maximum(dist, max_exact).astype(jnp.float32)
    large = max_exact + (jnp.log(d / max_exact) / math.log(MAX_DISTANCE / max_exact)
                         * (N_BUCKETS - max_exact)).astype(jnp.int32)
    large = jnp.minimum(large, N_BUCKETS - 1)
    return jnp.where(dist < max_exact, dist, large)


def sweep_blocks(block_fn, seq):
    out = lax.map(block_fn, jnp.arange(seq // BLOCK_Q))
    n, b, q, h, d = out.shape
    return out.transpose(1, 0, 2, 3, 4).reshape(b, n * q, h, d)


def dsa_attention(q, k, v, q_idx, k_idx, w_idx, bias_table):
    seq = q.shape[1]
    topk = min(TOPK_MAX, seq // 4)
    key_pos = jnp.arange(seq)
    gather = jax.vmap(lambda a, i: a[i])
    k_idx_f = k_idx.astype(jnp.float32)

    def block(i):
        t0 = i * BLOCK_Q
        tq = t0 + jnp.arange(BLOCK_Q)
        qi = lax.dynamic_slice_in_dim(q_idx, t0, BLOCK_Q, axis=1).astype(jnp.float32)
        wi = lax.dynamic_slice_in_dim(w_idx, t0, BLOCK_Q, axis=1).astype(jnp.float32) * IDX_HEADS ** -0.5
        rel = jax.nn.relu(jnp.einsum('bqhd,bsd->bqhs', qi, k_idx_f) * IDX_DIM ** -0.5)
        score = jnp.einsum('bqh,bqhs->bqs', wi, rel)
        causal = key_pos[None, :] <= tq[:, None]
        score = jnp.where(causal, score, -jnp.inf)
        _, sel = lax.top_k(score, topk)
        valid = sel <= tq[None, :, None]
        kg = gather(k, sel)
        vg = gather(v, sel)
        qb = lax.dynamic_slice_in_dim(q, t0, BLOCK_Q, axis=1)
        logits = jnp.einsum('bqhd,bqkhd->bhqk', qb, kg).astype(jnp.float32) * HEAD_DIM ** -0.5
        bias = bias_table[t5_bucket(tq[None, :, None] - sel)].transpose(0, 3, 1, 2)
        logits = jnp.where(valid[:, None], logits + bias, -jnp.inf)
        probs = jax.nn.softmax(logits, axis=-1)
        return jnp.einsum('bhqk,bqkhd->bqhd', probs, vg)

    return sweep_blocks(block, seq)


def forgetting_attention(q, k, v, f_logit):
    seq = q.shape[1]
    key_pos = jnp.arange(seq)
    cum = lax.cumsum(jax.nn.log_sigmoid(f_logit.astype(jnp.float32)), axis=1).transpose(0, 2, 1)

    def block(i):
        t0 = i * BLOCK_Q
        tq = t0 + jnp.arange(BLOCK_Q)
        qb = lax.dynamic_slice_in_dim(q, t0, BLOCK_Q, axis=1)
        cq = lax.dynamic_slice_in_dim(cum, t0, BLOCK_Q, axis=2)
        logits = (jnp.einsum('bqhd,bshd->bhqs', qb, k).astype(jnp.float32) * HEAD_DIM ** -0.5
                  + cq[..., None] - cum[:, :, None, :])
        causal = key_pos[None, :] <= tq[:, None]
        probs = jax.nn.softmax(jnp.where(causal, logits, -jnp.inf), axis=-1)
        return jnp.einsum('bhqs,bshd->bqhd', probs, v)

    return sweep_blocks(block, seq)


def differential_attention(q, k, v, lam, subln_w, bias_table, lambda_init):
    seq = q.shape[1]
    key_pos = jnp.arange(seq)

    def block(i):
        t0 = i * BLOCK_Q
        tq = t0 + jnp.arange(BLOCK_Q)
        qb = lax.dynamic_slice_in_dim(q, t0, BLOCK_Q, axis=1)
        logits = jnp.einsum('bqhcd,bshcd->bhcqs', qb, k).astype(jnp.float32) * DIFF_DIM ** -0.5
        bias = bias_table[t5_bucket(tq[:, None] - key_pos[None, :])].transpose(2, 0, 1)
        causal = key_pos[None, :] <= tq[:, None]
        logits = jnp.where(causal, logits + bias[None, :, None], -jnp.inf)
        probs = jax.nn.softmax(logits, axis=-1)
        attn = probs[:, :, 0] - lam * probs[:, :, 1]
        return jnp.einsum('bhqs,bshd->bqhd', attn, v)

    out = sweep_blocks(block, seq)
    return rms_norm(out, subln_w) * (1.0 - lambda_init)


def dilated_attention(q, k, v, bias_table):
    seq = q.shape[1]

    def block(i):
        t0 = i * BLOCK_Q
        tq = t0 + jnp.arange(BLOCK_Q)
        qb = lax.dynamic_slice_in_dim(q, t0, BLOCK_Q, axis=1)
        outs, lses = [], []
        for window, dilation in DILATED_CONFIGS:
            dist = dilation * jnp.arange(window // dilation + 1)
            idx = tq[:, None] - dist[None, :]
            valid = idx >= 0
            idx = jnp.maximum(idx, 0)
            kg = k[:, idx]
            vg = v[:, idx]
            logits = (jnp.einsum('bqhd,bqkhd->bhqk', qb, kg).astype(jnp.float32) * HEAD_DIM ** -0.5
                      + bias_table[t5_bucket(dist)].T[None, :, None, :])
            logits = jnp.where(valid, logits, -jnp.inf)
            m = jnp.max(logits, axis=-1, keepdims=True)
            e = jnp.exp(logits - m)
            s = jnp.sum(e, axis=-1, keepdims=True)
            outs.append(jnp.einsum('bhqk,bqkhd->bqhd', e / s, vg))
            lses.append(m + jnp.log(s))
        wts = jax.nn.softmax(jnp.stack(lses), axis=0).transpose(0, 1, 3, 2, 4)
        return jnp.sum(wts * jnp.stack(outs), axis=0)

    return sweep_blocks(block, seq)


def hybrid_layer(x, layer, norm_w, w_in, fox_b_f, lq1, lk1, lq2, lk2, subln_w, w_branch, w_out, rel_bias):
    bsz, seq, _ = x.shape
    h = rms_norm(x, norm_w)
    p = h @ w_in
    (z, gate, dsa_qkv, idx_q, idx_k, idx_w, fox_qkv, fox_f, diff_qkv, dil_qkv) = jnp.split(p, IN_OFFSETS, axis=-1)

    def heads3(t):
        return [a.reshape(bsz, seq, N_HEADS, HEAD_DIM) for a in jnp.split(t, 3, axis=-1)]

    bias_dsa, bias_diff, bias_dil = jnp.split(rel_bias, 3, axis=-1)

    q, k, v = heads3(dsa_qkv)
    o_dsa = dsa_attention(q, k, v, idx_q.reshape(bsz, seq, IDX_HEADS, IDX_DIM), idx_k, idx_w, bias_dsa)

    q, k, v = heads3(fox_qkv)
    o_fox = forgetting_attention(q, k, v, fox_f + fox_b_f)

    q, k, v = heads3(diff_qkv)
    q = q.reshape(bsz, seq, N_HEADS, 2, DIFF_DIM)
    k = k.reshape(bsz, seq, N_HEADS, 2, DIFF_DIM)
    lambda_init = 0.8 - 0.6 * math.exp(-0.3 * layer)
    lam = (jnp.exp(jnp.sum((lq1 * lk1).astype(jnp.float32)))
           - jnp.exp(jnp.sum((lq2 * lk2).astype(jnp.float32))) + lambda_init)
    o_diff = differential_attention(q, k, v, lam, subln_w, bias_diff, lambda_init)

    q, k, v = heads3(dil_qkv)
    o_dil = dilated_attention(q, k, v, bias_dil)

    branches = (o_dsa, o_fox, o_diff, o_dil)
    z_parts = jnp.split(z, N_BRANCHES, axis=-1)
    g_parts = jnp.split(gate, N_BRANCHES, axis=-1)
    merged = None
    for b in range(N_BRANCHES):
        y = branches[b].reshape(bsz, seq, BRANCH_WIDTH).astype(x.dtype) * jax.nn.silu(z_parts[b])
        term = jax.nn.sigmoid(g_parts[b]) * (y @ w_branch[b])
        merged = term if merged is None else merged + term
    return (x + merged @ w_out).astype(x.dtype)


def setup_inputs(seed: int = 0) -> dict:
    key = jax.random.key(seed)
    ks = jax.random.split(key, 13)

    def nrm(k, shape, scale):
        return scale * jax.random.normal(k, shape, jnp.float32)

    return {
        'x': nrm(ks[0], (BATCH, SEQ, D_MODEL), 1.0),
        'norm_w': 1.0 + nrm(ks[1], (DEPTH, D_MODEL), 0.05),
        'w_in': nrm(ks[2], (DEPTH, D_MODEL, N_IN), D_MODEL ** -0.5),
        'fox_b_f': 4.0 + nrm(ks[3], (DEPTH, N_HEADS), 1.0),
        'diff_lq1': nrm(ks[4], (DEPTH, DIFF_DIM), 0.1),
        'diff_lk1': nrm(ks[5], (DEPTH, DIFF_DIM), 0.1),
        'diff_lq2': nrm(ks[6], (DEPTH, DIFF_DIM), 0.1),
        'diff_lk2': nrm(ks[7], (DEPTH, DIFF_DIM), 0.1),
        'diff_subln_w': 1.0 + nrm(ks[8], (DEPTH, HEAD_DIM), 0.05),
        'w_branch': nrm(ks[9], (DEPTH, N_BRANCHES, BRANCH_WIDTH, D_MODEL), BRANCH_WIDTH ** -0.5),
        'w_out': nrm(ks[10], (DEPTH, D_MODEL, D_MODEL), D_MODEL ** -0.5),
        'rel_bias': nrm(ks[11], (N_BUCKETS, N_BIAS_HEADS), 0.5),
        'final_norm_w': 1.0 + nrm(ks[12], (D_MODEL,), 0.05),
    }


def reference(x, norm_w, w_in, fox_b_f, diff_lq1, diff_lk1, diff_lq2, diff_lk2, diff_subln_w,
              w_branch, w_out, rel_bias, final_norm_w):
    for layer in range(DEPTH):
        x = hybrid_layer(x, layer, norm_w[layer], w_in[layer], fox_b_f[layer],
                         diff_lq1[layer], diff_lk1[layer], diff_lq2[layer], diff_lk2[layer],
                         diff_subln_w[layer], w_branch[layer], w_out[layer], rel_bias)
    return rms_norm(x, final_norm_w)
```

```cpp
#include <hip/hip_runtime.h>
#include <stdint.h>
#include <stdio.h>

#ifndef MK_LAUNCHES
#define MK_LAUNCHES 1
#endif

#define LAS __attribute__((address_space(3)))
typedef unsigned short bf16_t;
typedef short bf16x8 __attribute__((ext_vector_type(8)));
typedef float f32x4 __attribute__((ext_vector_type(4)));
typedef float f32x16 __attribute__((ext_vector_type(16)));
typedef unsigned u32x4 __attribute__((ext_vector_type(4)));
typedef unsigned u32x2 __attribute__((ext_vector_type(2)));
typedef unsigned long long u64;

constexpr int DM = 2048, NB = 2, SEQ = 8192, DEPTH = 4, MT = NB * SEQ;
constexpr int NIN = 17492, NINP = 17664;
constexpr int NPH = 26;
constexpr float LOG2E = 1.4426950408889634f;
constexpr float QSC128 = 0.08838834764831845f * 1.4426950408889634f;
constexpr float QSC64 = 0.125f * 1.4426950408889634f;
constexpr float RMS_EPS = 1e-6f;
constexpr size_t QS = (size_t)NB * 4 * SEQ * 128;

constexpr size_t al256(size_t x) { return (x + 255) & ~(size_t)255; }
constexpr size_t WS_CTL = 0, CTL_BYTES = 65536;
constexpr size_t WS_WIN = WS_CTL + CTL_BYTES;
constexpr size_t WS_WBR = WS_WIN + (size_t)DEPTH * NINP * DM * 2;
constexpr size_t WS_WOUT = WS_WBR + (size_t)DEPTH * DM * DM * 2;
constexpr size_t WS_XRES = WS_WOUT + (size_t)DEPTH * DM * DM * 2;
constexpr size_t WS_XB = WS_XRES + (size_t)MT * DM * 4;
constexpr size_t WS_SSQ = WS_XB + (size_t)MT * DM * 2;
constexpr size_t WS_ZS = WS_SSQ + (size_t)MT * 32 * 4;
constexpr size_t WS_G = WS_ZS + (size_t)MT * DM * 2;
constexpr size_t WS_QKV = WS_G + (size_t)MT * 8192 * 2;
constexpr size_t WS_IQ = WS_QKV + 12 * QS * 2;
constexpr size_t WS_IK = WS_IQ + (size_t)MT * 1024 * 2;
constexpr size_t WS_IW = WS_IK + (size_t)MT * 64 * 2;
constexpr size_t WS_FF = WS_IW + (size_t)MT * 16 * 4;
constexpr size_t WS_CUM = WS_FF + (size_t)MT * 4 * 4;
constexpr size_t WS_TB = WS_CUM + (size_t)NB * 4 * SEQ * 4;
constexpr size_t WS_SC = WS_TB + (size_t)12 * SEQ * 4;
constexpr size_t WS_MASK = WS_SC + (size_t)NB * SEQ * SEQ * 4;
constexpr size_t WS_Y = WS_MASK + (size_t)NB * SEQ * 128 * 8;
constexpr size_t WS_MG = WS_Y + (size_t)MT * DM * 2;
constexpr size_t WS_END = WS_MG + (size_t)MT * DM * 2;

constexpr int CW_BAR = 0;
constexpr int CW_Q = 4096;

constexpr int LDS_STAGE = 131072;
constexpr int LDS_MISC = 131072;
constexpr int LDS_BYTES = 147456;

__device__ __forceinline__ unsigned cvt_pk_bf16(float lo, float hi) { unsigned r; asm volatile("v_cvt_pk_bf16_f32 %0, %1, %2" : "=v"(r) : "v"(lo), "v"(hi)); return r; }
__device__ __forceinline__ float bf_lo(unsigned w) { return __uint_as_float(w << 16); }
__device__ __forceinline__ float bf_hi(unsigned w) { return __uint_as_float(w & 0xffff0000u); }
__device__ __forceinline__ float bf2f(bf16_t b) { return __uint_as_float(((unsigned)b) << 16); }
__device__ __forceinline__ float ex2(float x) { return __builtin_amdgcn_exp2f(x); }
__device__ __forceinline__ float sigmoidf_(float x) { return __builtin_amdgcn_rcpf(1.0f + ex2(-x * LOG2E)); }
__device__ __forceinline__ int tid_l() { int t = threadIdx.x; asm volatile("" : "+v"(t)); return t; }
__device__ __forceinline__ float wave_sum(float v) {
#pragma unroll
    for (int o = 32; o > 0; o >>= 1) v += __shfl_xor(v, o);
    return v;
}

#define XB_TMO      128
#define XB_XCNT(j)  (256  + 64 * (j))
#define XB_XSUB(j)  (1280 + 64 * (j))
#define XB_XGEN(j)  (2304 + 64 * (j))
#define XB_TOP      3328
#define XB_TOPGEN   3392
#define XCD_BAR_WORDS 3456
#define XB_SPIN_CAP (1u << 18)

__device__ __forceinline__ unsigned xb_ld(unsigned* p)              { return __hip_atomic_load(p, __ATOMIC_RELAXED, __HIP_MEMORY_SCOPE_AGENT); }
__device__ __forceinline__ unsigned xb_add(unsigned* p, unsigned v) { return __hip_atomic_fetch_add(p, v, __ATOMIC_RELAXED, __HIP_MEMORY_SCOPE_AGENT); }
__device__ __forceinline__ unsigned xb_xcc_id() { return (unsigned)__builtin_amdgcn_s_getreg((3 << 11) | 20) & 0xFu; }
#define XB_SPIN(cond, bar) do { unsigned _sp = 0; while (cond) { __builtin_amdgcn_s_sleep(1); \
    if ((++_sp & 255u) == 0u) { if (xb_ld(&(bar)[XB_TMO])) break; if (_sp > XB_SPIN_CAP) { atomicAdd(&(bar)[XB_TMO], 1u); break; } } } } while (0)

struct XcdBarrier { unsigned* bar; unsigned x; volatile LAS unsigned* st; };

__device__ __forceinline__ XcdBarrier xcd_barrier_post(unsigned* bar, volatile LAS unsigned* st) {
    XcdBarrier b; b.bar = bar; b.x = xb_xcc_id(); b.st = st;
    if (threadIdx.x == 0) (void)xb_add(&bar[XB_XCNT(b.x)], 1u);
    return b;
}
__device__ __forceinline__ void xcd_barrier_complete(unsigned* bar, unsigned x, unsigned& nloc, unsigned& nx) {
    const unsigned G = gridDim.x * gridDim.y * gridDim.z;
    unsigned sum, cnt, mine, sp = 0u;
    for (;;) {
        sum = 0u; cnt = 0u; mine = 0u;
#pragma unroll
        for (unsigned j = 0; j < 16; ++j) { const unsigned c = xb_ld(&bar[XB_XCNT(j)]); sum += c; cnt += (c > 0u) ? 1u : 0u; mine = (j == x) ? c : mine; }
        if (sum == G) break;
        __builtin_amdgcn_s_sleep(1);
        if ((++sp & 255u) == 0u) { if (xb_ld(&bar[XB_TMO])) break; if (sp > XB_SPIN_CAP) { atomicAdd(&bar[XB_TMO], 1u); break; } }
    }
    nloc = mine > 0u ? mine : 1u; nx = cnt > 0u ? cnt : 1u;
}
__device__ __forceinline__ void xcd_barrier(const XcdBarrier& b) {
    asm volatile("s_waitcnt vmcnt(0)" ::: "memory");
    __syncthreads();
    if (threadIdx.x == 0) {
        unsigned* bar = b.bar;
        __builtin_amdgcn_s_waitcnt(0);
        unsigned nloc = b.st[0], nx = b.st[1];
        if (nloc == 0u) { xcd_barrier_complete(bar, b.x, nloc, nx); b.st[0] = nloc; b.st[1] = nx; }
        const unsigned old = xb_add(&bar[XB_XSUB(b.x)], 1u);
        const unsigned gen = old / nloc;
        if (old + 1u == (gen + 1u) * nloc) {
            __builtin_amdgcn_fence(__ATOMIC_RELEASE, "agent");
            asm volatile("s_waitcnt vmcnt(0)" ::: "memory");
            const unsigned og = xb_add(&bar[XB_TOP], 1u);
            const unsigned tg = og / nx;
            if (og + 1u == (tg + 1u) * nx) xb_add(&bar[XB_TOPGEN], 1u);
            else XB_SPIN(xb_ld(&bar[XB_TOPGEN]) == tg, bar);
            __builtin_amdgcn_fence(__ATOMIC_ACQUIRE, "agent");
            xb_add(&bar[XB_XGEN(b.x)], 1u);
            asm volatile("s_waitcnt vmcnt(0)" ::: "memory");
        } else {
            XB_SPIN(xb_ld(&bar[XB_XGEN(b.x)]) == gen, bar);
            __builtin_amdgcn_fence(__ATOMIC_ACQUIRE, "agent");
            asm volatile("s_waitcnt vmcnt(0)" ::: "memory");
        }
    }
    __syncthreads();
}

namespace pg8 {
constexpr int BM = 256, BK = 64, HALF = 128, HTB = HALF * BK * 2, STAGE_BYTES = 8 * HTB, NXCD = 8, WGM = 8;
__host__ __device__ __forceinline__ int lds_byte(int r, int c) { const int st = (r >> 4) * 2 + (c >> 5), rr = r & 15, cc = c & 31, ob = rr * 64 + cc * 2; return st * 1024 + (ob ^ (((ob >> 9) & 1) << 5)); }
__host__ __device__ __forceinline__ void stage_rc(int b, int& R, int& C) { const int st = b / 1024, sb = b % 1024, swz = sb ^ (((sb >> 9) & 1) << 5); R = (st >> 1) * 16 + swz / 64; C = (st & 1) * 32 + (swz % 64) / 2; }
__host__ __device__ __forceinline__ int perm32(int rho) { const int n = rho >> 4, i = rho & 15; return 8 * (i >> 2) + 4 * n + (i & 3); }
struct Unit { int pm, pn; };
struct Gemm { const bf16_t* A; const bf16_t* Bt; int M, N, K; };
struct StaticOrder {
    int nM, nN, nwg, G, c;
    __host__ __device__ void init(int M, int N, int G_, int c_) { nM = M / BM; nN = N / BM; nwg = nM * nN; G = G_; c = c_; }
    __host__ __device__ bool next(int i, Unit& u) const {
        const long L = (long)i * G + c; if (L >= nwg) return false;
        int wgid = (int)L; { const int q = nwg / NXCD, r = nwg % NXCD, xcd = wgid % NXCD, off = wgid / NXCD; wgid = (xcd < r ? xcd * (q + 1) : r * (q + 1) + (xcd - r) * q) + off; }
        const int nig = WGM * nN, gid = wgid / nig, fm = gid * WGM, gsz = (nM - fm) < WGM ? (nM - fm) : WGM;
        u.pm = fm + ((wgid % nig) % gsz); u.pn = (wgid % nig) / gsz; return true;
    }
    __device__ __forceinline__ void a_ready(const Unit&) const {}
    __device__ __forceinline__ void done(const Unit&) const {}
};

template <class Epi, class Sched>
__device__ __forceinline__ void gemm_phase(LAS unsigned char* lds, const Gemm g, const Sched& S, const Epi& E) {
    const int tid = tid_l(), wid = __builtin_amdgcn_readfirstlane(tid >> 6), lane = tid & 63, wr = wid >> 2, wc = wid & 3, fr = lane & 15, fq = lane >> 4;
    const int K = g.K, nt = K / BK;
    unsigned voffA[2], voffB[2];
#pragma unroll
    for (int i = 0; i < 2; ++i) { int R, C; stage_rc(tid * 16 + i * 8192, R, C); const int Rb = Epi::PERM ? ((R & ~31) + perm32(R & 31)) : R;
        voffA[i] = (unsigned)(R * K + C) * 2u; voffB[i] = (unsigned)(Rb * K + C) * 2u; }
    const size_t kstep = (size_t)(BK * 2);
    const size_t hstep = (size_t)HALF * K * 2;
    const size_t tstep = 2 * hstep;
    const unsigned ldsw = (unsigned)wid * 1024u;
    const int aoff = lds_byte(wr * 64 + fr, fq * 8), boff = lds_byte(wc * 32 + fr, fq * 8);
#define PG8_SA(b, h) (((b) * 2 + (h)) * HTB)
#define PG8_SB(b, h) ((4 + (b) * 2 + (h)) * HTB)
#define PG8_STAGE(bufoff, gbase, voff) do { _Pragma("unroll") for (int _i = 0; _i < 2; ++_i) \
        __builtin_amdgcn_global_load_lds((const unsigned*)((const char*)(gbase) + (voff)[_i]), (LAS unsigned*)(lds + (bufoff) + ldsw + _i * 8192), 16, 0, 0); } while (0)
#define PG8_LDA(dst, b, h) do { _Pragma("unroll") for (int m = 0; m < 4; ++m) _Pragma("unroll") for (int k = 0; k < 2; ++k) dst[m][k] = *(const LAS bf16x8*)(lds + PG8_SA(b, h) + aoff + m * 2048 + k * 1024); } while (0)
#define PG8_LDB(dst, b, h) do { _Pragma("unroll") for (int n = 0; n < 2; ++n) _Pragma("unroll") for (int k = 0; k < 2; ++k) dst[n][k] = *(const LAS bf16x8*)(lds + PG8_SB(b, h) + boff + n * 2048 + k * 1024); } while (0)
#define PG8_MMA(ai, bj, At, Bt) do { __builtin_amdgcn_s_setprio(1); _Pragma("unroll") for (int m = 0; m < 4; ++m) _Pragma("unroll") for (int n = 0; n < 2; ++n) _Pragma("unroll") for (int k = 0; k < 2; ++k) \
        acc[ai][bj][m][n] = __builtin_amdgcn_mfma_f32_16x16x32_bf16(Bt[n][k], At[m][k], acc[ai][bj][m][n], 0, 0, 0); __builtin_amdgcn_s_setprio(0); } while (0)
#define PG8_WAIT_V(n) asm volatile("s_waitcnt vmcnt(" #n ")" ::: "memory")
#define PG8_WAIT_L(n) asm volatile("s_waitcnt lgkmcnt(" #n ")" ::: "memory")
#define PG8_BAR __builtin_amdgcn_s_barrier()
#define PG8_SCHED __builtin_amdgcn_sched_barrier(0)
    Unit cur, nxt; int ui = 0;
    if (!S.next(0, cur)) return;
    f32x4 acc[2][2][4][2];
#pragma unroll
    for (int a = 0; a < 2; ++a)
#pragma unroll
        for (int b = 0; b < 2; ++b)
#pragma unroll
            for (int m = 0; m < 4; ++m)
#pragma unroll
                for (int n = 0; n < 2; ++n) acc[a][b][m][n] = (f32x4){0.f, 0.f, 0.f, 0.f};
    bf16x8 At[4][2], B0[2][2], B1[2][2];
    const char* cA = (const char*)g.A + (size_t)cur.pm * tstep; const char* cB = (const char*)g.Bt + (size_t)cur.pn * tstep;
    S.a_ready(cur);
    PG8_STAGE(PG8_SB(0, 0), cB, voffB); PG8_STAGE(PG8_SA(0, 0), cA, voffA); PG8_STAGE(PG8_SB(0, 1), cB + hstep, voffB); PG8_STAGE(PG8_SA(0, 1), cA + hstep, voffA);
    if (wr == 1) PG8_BAR;
    PG8_WAIT_V(4); PG8_BAR;
    PG8_STAGE(PG8_SB(1, 0), cB + kstep, voffB); PG8_STAGE(PG8_SA(1, 0), cA + kstep, voffA); PG8_STAGE(PG8_SB(1, 1), cB + hstep + kstep, voffB);
    PG8_WAIT_V(6); PG8_BAR;
    for (;;) {
        const bool has_next = S.next(ui + 1, nxt);
        const char* nA = has_next ? (const char*)g.A + (size_t)nxt.pm * tstep : cA; const char* nB = has_next ? (const char*)g.Bt + (size_t)nxt.pn * tstep : cB;
        for (int t = 0; t < nt; t += 2) {
            const bool last = (t == nt - 2);
            const char* a1 = cA + (size_t)(t + 1) * kstep;
            const char* a2 = last ? nA : cA + (size_t)(t + 2) * kstep; const char* b2 = last ? nB : cB + (size_t)(t + 2) * kstep;
            const char* a3 = a2 + kstep; const char* b3 = b2 + kstep;
            if (last && has_next) S.a_ready(nxt);
            if constexpr (Epi::MIDK) { if (t > 0 && (t & 7) == 0) E.mid(acc, cur, t >> 3, wr, wc, fr, fq); }
            PG8_LDB(B0, 0, 0); PG8_SCHED; PG8_LDA(At, 0, 0); PG8_STAGE(PG8_SA(1, 1), a1 + hstep, voffA);
            PG8_WAIT_L(8); PG8_BAR; PG8_WAIT_L(0); PG8_MMA(0, 0, At, B0); PG8_BAR; PG8_SCHED;
            PG8_LDB(B1, 0, 1); PG8_STAGE(PG8_SB(0, 0), b2, voffB);
            PG8_BAR; PG8_WAIT_L(0); PG8_MMA(0, 1, At, B1); PG8_BAR;
            PG8_LDA(At, 0, 1); PG8_STAGE(PG8_SA(0, 0), a2, voffA);
            PG8_BAR; PG8_WAIT_L(0); PG8_MMA(1, 0, At, B0); PG8_BAR; PG8_SCHED;
            PG8_STAGE(PG8_SB(0, 1), b2 + hstep, voffB);
            PG8_WAIT_V(6); PG8_BAR; PG8_MMA(1, 1, At, B1); PG8_BAR;
            PG8_LDB(B0, 1, 0); PG8_SCHED; PG8_LDA(At, 1, 0); PG8_STAGE(PG8_SA(0, 1), a2 + hstep, voffA);
            PG8_WAIT_L(8); PG8_BAR; PG8_WAIT_L(0); PG8_MMA(0, 0, At, B0); PG8_BAR; PG8_SCHED;
            PG8_LDB(B1, 1, 1); PG8_STAGE(PG8_SB(1, 0), b3, voffB);
            PG8_BAR; PG8_WAIT_L(0); PG8_MMA(0, 1, At, B1); PG8_BAR;
            PG8_LDA(At, 1, 1); PG8_STAGE(PG8_SA(1, 0), a3, voffA);
            PG8_BAR; PG8_WAIT_L(0); PG8_MMA(1, 0, At, B0); PG8_BAR; PG8_SCHED;
            PG8_STAGE(PG8_SB(1, 1), b3 + hstep, voffB);
            PG8_WAIT_V(6); PG8_BAR; PG8_MMA(1, 1, At, B1); PG8_BAR;
        }
        E(acc, cur, wr, wc, fr, fq); S.done(cur);
        if (!has_next) break;
#pragma unroll
        for (int a = 0; a < 2; ++a)
#pragma unroll
            for (int b = 0; b < 2; ++b)
#pragma unroll
                for (int m = 0; m < 4; ++m)
#pragma unroll
                    for (int n = 0; n < 2; ++n) acc[a][b][m][n] = (f32x4){0.f, 0.f, 0.f, 0.f};
        cur = nxt; cA = nA; cB = nB; ++ui;
    }
    PG8_WAIT_V(0);
    if (wr == 0) PG8_BAR;
    PG8_BAR;
#undef PG8_SA
#undef PG8_SB
#undef PG8_STAGE
#undef PG8_LDA
#undef PG8_LDB
#undef PG8_MMA
#undef PG8_WAIT_V
#undef PG8_WAIT_L
#undef PG8_BAR
#undef PG8_SCHED
}
}

struct Args { const float* in[13]; float* out; unsigned char* ws; int ph_lo, ph_hi; };
struct Frame {
    const float* x; const float* norm_w; const float* w_in; const float* fox_b; const float* lq1; const float* lk1; const float* lq2; const float* lk2;
    const float* subln; const float* w_branch; const float* w_out; const float* rel_bias; const float* final_w; float* out;
    unsigned* ctl; bf16_t* WinT; bf16_t* WbrT; bf16_t* WoutT; float* xres; bf16_t* xb; float* ssq; bf16_t* Zs; bf16_t* G; bf16_t* QKV; bf16_t* IQ; bf16_t* IK;
    float* IW; float* FF; float* cum; float* tb; float* sc; u64* mask; bf16_t* Y; bf16_t* MG;
    unsigned char* lds; volatile unsigned* misc;
};

__device__ __forceinline__ int q_next(unsigned* ctr, volatile unsigned* lw) {
    __syncthreads();
    if (threadIdx.x == 0) *lw = atomicAdd(ctr, 1u);
    __syncthreads();
    return (int)*lw;
}

__device__ __forceinline__ int win_src_col(int n) {
    if (n < 12800) return n;
    if (n < 14336) return n - 12800 + 12880;
    if (n < 15872) return n - 14336 + 14420;
    if (n < 17408) return n - 15872 + 15956;
    if (n < 17472) return n - 17408 + 12800;
    if (n < 17488) return n - 17472 + 12864;
    if (n < 17492) return n - 17488 + 14416;
    return -1;
}
__device__ __forceinline__ void transpose_tile(const float* src, int ld, int srccol, const float* ksc, bf16_t* dst, int k0, int n0, float* tile) {
    const int tid = tid_l(), tk = tid >> 6, tn = tid & 63;
#pragma unroll
    for (int i = 0; i < 8; ++i) { const int kk = tk + 8 * i; float v = 0.f;
        if (srccol >= 0) { v = src[(size_t)(k0 + kk) * ld + srccol]; if (ksc) v *= ksc[k0 + kk]; }
        tile[kk * 65 + tn] = v; }
    __syncthreads();
    const int wn = tid >> 3, wk = tid & 7;
    float f[8];
#pragma unroll
    for (int j = 0; j < 8; ++j) f[j] = tile[(wk * 8 + j) * 65 + wn];
    u32x4 w = {cvt_pk_bf16(f[0], f[1]), cvt_pk_bf16(f[2], f[3]), cvt_pk_bf16(f[4], f[5]), cvt_pk_bf16(f[6], f[7])};
    *(u32x4*)(dst + (size_t)(n0 + wn) * DM + k0 + wk * 8) = w;
    __syncthreads();
}
__device__ __forceinline__ int t5_bucket(int d) {
    if (d < 16) return d;
    const int th[15] = {22, 30, 40, 54, 73, 99, 134, 182, 246, 332, 450, 609, 825, 1117, 1513};
    int b = 16;
#pragma unroll
    for (int i = 0; i < 15; ++i) b += (d >= th[i]) ? 1 : 0;
    return b;
}
__device__ __forceinline__ void p0_prologue(const Frame& F) {
    const int tid = tid_l(), lane = tid & 63, wave = tid >> 6, G = gridDim.x, bid = blockIdx.x;
    float* tile = (float*)F.lds;
    constexpr int TW = 32 * 276, TB_ = 32 * 32, TL = TW + 2 * TB_;
    for (int j = bid; j < DEPTH * TL; j += G) {
        const int l = j / TL, r = j % TL;
        if (r < TW) { const int nt = r % 276, kt = r / 276; const int n = nt * 64 + (tid & 63);
            transpose_tile(F.w_in + (size_t)l * DM * NIN, NIN, win_src_col(n), F.norm_w + l * DM, F.WinT + (size_t)l * NINP * DM, kt * 64, nt * 64, tile); }
        else if (r < TW + TB_) { const int q = r - TW, nt = q % 32, kt = q / 32;
            transpose_tile(F.w_branch + (size_t)l * DM * DM, DM, nt * 64 + (tid & 63), nullptr, F.WbrT + (size_t)l * DM * DM, kt * 64, nt * 64, tile); }
        else { const int q = r - TW - TB_, nt = q % 32, kt = q / 32;
            transpose_tile(F.w_out + (size_t)l * DM * DM, DM, nt * 64 + (tid & 63), nullptr, F.WoutT + (size_t)l * DM * DM, kt * 64, nt * 64, tile); }
    }
    for (int row = bid * 8 + wave; row < MT; row += G * 8) {
        const float* xr = F.x + (size_t)row * DM; float ss = 0.f;
#pragma unroll
        for (int i = 0; i < 8; ++i) { const int c = (i * 64 + lane) * 4; const f32x4 v = *(const f32x4*)(xr + c);
            *(f32x4*)(F.xres + (size_t)row * DM + c) = v; ss += v[0] * v[0] + v[1] * v[1] + v[2] * v[2] + v[3] * v[3];
            u32x2 w = {cvt_pk_bf16(v[0], v[1]), cvt_pk_bf16(v[2], v[3])}; *(u32x2*)(F.xb + (size_t)row * DM + c) = w; }
        ss = wave_sum(ss);
        if (lane < 32) F.ssq[(size_t)row * 32 + lane] = (lane == 0) ? ss : 0.f;
    }
    for (int i = bid * 512 + tid; i < 12 * SEQ; i += G * 512) { const int hd = i / SEQ, d = i % SEQ; F.tb[i] = F.rel_bias[t5_bucket(d) * 12 + hd] * LOG2E; }
}

struct EpiIn {
    static constexpr bool PERM = true, AFTER_DRAIN = false, MIDK = false;
    unsigned char* ws;
    template <int KIND>
    __device__ __forceinline__ void body(const f32x4 (&acc)[2][2][4][2], int row0, int cl, int fq, bf16_t* base, int ldc, float qscale, int headbase) const {
        const float* ssq = (const float*)(ws + WS_SSQ);
#pragma unroll
        for (int ai = 0; ai < 2; ++ai)
#pragma unroll
            for (int m = 0; m < 4; ++m) {
                const int r = row0 + ai * 128 + m * 16;
                const float* sp = ssq + (size_t)r * 32 + fq * 8;
                const f32x4 s4 = *(const f32x4*)sp + *(const f32x4*)(sp + 4);
                float ssum = (s4[0] + s4[1]) + (s4[2] + s4[3]);
                ssum += __shfl_xor(ssum, 16); ssum += __shfl_xor(ssum, 32);
                const float sc = __builtin_amdgcn_rsqf(ssum * (1.0f / DM) + RMS_EPS) * qscale;
#pragma unroll
                for (int bj = 0; bj < 2; ++bj) {
                    f32x4 v0 = acc[ai][bj][m][0] * sc, v1 = acc[ai][bj][m][1] * sc;
                    if (KIND == 0) {
#pragma unroll
                        for (int j = 0; j < 4; ++j) { v0[j] = v0[j] * sigmoidf_(v0[j]); v1[j] = v1[j] * sigmoidf_(v1[j]); }
                    } else if (KIND == 1) {
#pragma unroll
                        for (int j = 0; j < 4; ++j) { v0[j] = fmaxf(sigmoidf_(v0[j]), 1e-9f); v1[j] = fmaxf(sigmoidf_(v1[j]), 1e-9f); }
                    }
                    if (KIND == 4) {
                        if (bj == 0) {
                            if (cl < 64) { u32x4 w = {cvt_pk_bf16(v0[0], v0[1]), cvt_pk_bf16(v0[2], v0[3]), cvt_pk_bf16(v1[0], v1[1]), cvt_pk_bf16(v1[2], v1[3])};
                                *(u32x4*)((bf16_t*)(ws + WS_IK) + (size_t)r * 64 + cl) = w; }
                            else if (cl < 80) { float* iw = (float*)(ws + WS_IW) + (size_t)r * 16 + (cl - 64); *(f32x4*)iw = v0; *(f32x4*)(iw + 4) = v1; }
                            else if (cl == 80) { *(f32x4*)((float*)(ws + WS_FF) + (size_t)r * 4) = v0; }
                        }
                    } else {
                        bf16_t* dst;
                        if (KIND == 2) { const int b = r >> 13, s = r & (SEQ - 1); dst = base + ((size_t)(b * 4 + headbase + bj) * SEQ + s) * 128 + cl; }
                        else dst = base + (size_t)r * ldc + bj * 128 + cl;
                        u32x4 w = {cvt_pk_bf16(v0[0], v0[1]), cvt_pk_bf16(v0[2], v0[3]), cvt_pk_bf16(v1[0], v1[1]), cvt_pk_bf16(v1[2], v1[3])};
                        *(u32x4*)dst = w;
                    }
                }
            }
    }
    __device__ __forceinline__ void operator()(const f32x4 (&acc)[2][2][4][2], const pg8::Unit& u, int wr, int wc, int fr, int fq) const {
        const int row0 = u.pm * 256 + wr * 64 + fr, pn = u.pn, cl = wc * 32 + 8 * fq;
        if (pn < 8) body<0>(acc, row0, cl, fq, (bf16_t*)(ws + WS_ZS) + pn * 256, DM, 1.f, 0);
        else if (pn < 40) body<1>(acc, row0, cl, fq, (bf16_t*)(ws + WS_G) + (pn - 8) * 256, 8192, 1.f, 0);
        else if (pn >= 46 && pn < 50) body<3>(acc, row0, cl, fq, (bf16_t*)(ws + WS_IQ) + (pn - 46) * 256, 1024, 1.f, 0);
        else if (pn < 68) {
            int mixer, t6;
            if (pn < 46) { mixer = 0; t6 = pn - 40; } else if (pn < 56) { mixer = 1; t6 = pn - 50; } else if (pn < 62) { mixer = 2; t6 = pn - 56; } else { mixer = 3; t6 = pn - 62; }
            const int which = t6 >> 1;
            const float qscale = (which == 0) ? ((mixer == 2) ? QSC64 : QSC128) : 1.f;
            body<2>(acc, row0, cl, fq, (bf16_t*)(ws + WS_QKV) + (size_t)(mixer * 3 + which) * QS, 0, qscale, (t6 & 1) * 2);
        }
        else body<4>(acc, row0, cl, fq, nullptr, 0, 1.f, 0);
    }
};

__device__ __forceinline__ void fox_scan(const Frame& F, int layer, int seqid) {
    const int tid = tid_l(), lane = tid & 63, wave = tid >> 6, b = seqid >> 2, h = seqid & 3;
    float* sm = (float*)F.lds;
    const float bias = F.fox_b[layer * 4 + h];
    float v[16]; float run = 0.f;
#pragma unroll
    for (int i = 0; i < 16; ++i) { const int s = tid * 16 + i; const float x = F.FF[(size_t)(b * SEQ + s) * 4 + h] + bias;
        const float ls = fminf(x, 0.f) - log1pf(expf(-fabsf(x))); run += ls; v[i] = run; }
    float incl = run;
#pragma unroll
    for (int o = 1; o < 64; o <<= 1) { const float t = __shfl_up(incl, o); if (lane >= o) incl += t; }
    if (lane == 63) sm[wave] = incl;
    __syncthreads();
    float woff = 0.f;
    for (int w = 0; w < wave; ++w) woff += sm[w];
    const float excl = woff + incl - run;
#pragma unroll
    for (int i = 0; i < 16; ++i) F.cum[(size_t)(b * 4 + h) * SEQ + tid * 16 + i] = (excl + v[i]) * LOG2E;
    __syncthreads();
}
__device__ __forceinline__ void idx_unit(const Frame& F, int unit) {
    const int b = unit / 576; int id = unit % 576; int g = 0;
    while (8 * (g + 1) * (g + 2) <= id) ++g;
    const int rem = id - 8 * g * (g + 1), qb = 16 * g + rem / (g + 1), kc = rem % (g + 1);
    const int tid = tid_l(), lane = tid & 63, wave = __builtin_amdgcn_readfirstlane(tid >> 6), n32 = lane & 31, hi = lane >> 5;
    const int tq0 = qb * 64 + wave * 8;
    const int qa = (n32 >> 2) & 1, ha = (n32 & 3) + 4 * (n32 >> 3);
    bf16x8 Af[4][4]; float wr_[4][16];
#pragma unroll
    for (int p = 0; p < 4; ++p) {
        const bf16_t* qp = F.IQ + (size_t)(b * SEQ + tq0 + 2 * p + qa) * 1024 + ha * 64 + hi * 8;
#pragma unroll
        for (int ks = 0; ks < 4; ++ks) Af[p][ks] = *(const bf16x8*)(qp + ks * 16);
        const float* wp = F.IW + (size_t)(b * SEQ + tq0 + 2 * p + hi) * 16;
#pragma unroll
        for (int q4 = 0; q4 < 4; ++q4) { const f32x4 w4 = *(const f32x4*)(wp + 4 * q4); wr_[p][4 * q4] = w4[0]; wr_[p][4 * q4 + 1] = w4[1]; wr_[p][4 * q4 + 2] = w4[2]; wr_[p][4 * q4 + 3] = w4[3]; }
    }
    const int smax = tq0 + 7;
    for (int j = 0; j < 32; ++j) {
        const int s0 = kc * 1024 + j * 32;
        if (s0 > smax) break;
        const bf16_t* kp = F.IK + (size_t)(b * SEQ + s0 + n32) * 64 + hi * 8;
        bf16x8 Bf[4];
#pragma unroll
        for (int ks = 0; ks < 4; ++ks) Bf[ks] = *(const bf16x8*)(kp + ks * 16);
#pragma unroll
        for (int p = 0; p < 4; ++p) {
            f32x16 c = {};
#pragma unroll
            for (int ks = 0; ks < 4; ++ks) c = __builtin_amdgcn_mfma_f32_32x32x16_bf16(Af[p][ks], Bf[ks], c, 0, 0, 0);
            float sc = 0.f;
#pragma unroll
            for (int r = 0; r < 16; ++r) sc = fmaf(wr_[p][r], fmaxf(c[r], 0.f), sc);
            F.sc[((size_t)(b * SEQ + tq0 + 2 * p + hi)) * SEQ + s0 + n32] = sc;
        }
    }
}

__device__ __forceinline__ unsigned sel_key(float f) { const unsigned u = __float_as_uint(f == 0.f ? 0.f : f); return (u >> 31) ? ~u : (u | 0x80000000u); }
__device__ __forceinline__ int wave_sum_i(int v) {
#pragma unroll
    for (int o = 32; o > 0; o >>= 1) v += __shfl_xor(v, o);
    return v;
}
__device__ __forceinline__ void select_row(const Frame& F, int row) {
    const int lane = tid_l() & 63, t = row & (SEQ - 1);
    u64* mrow = F.mask + (size_t)row * 128;
    if (t < 256) {
#pragma unroll
        for (int half = 0; half < 2; ++half) { const int j = half * 64 + lane; const int lo = j * 64; u64 w = 0ull;
            if (t >= lo + 63) w = ~0ull; else if (t >= lo) w = (~0ull) >> (63 - (t - lo));
            mrow[j] = w; }
        return;
    }
    const float* srow = F.sc + (size_t)row * SEQ + lane;
    const int nj = (t >> 6) + 1;
    unsigned key[128];
#pragma unroll
    for (int jj = 0; jj < 4; ++jj) {
        if (jj * 32 < nj) {
#pragma unroll
            for (int j = jj * 32; j < jj * 32 + 32; ++j) { const float v = srow[j * 64]; key[j] = (j * 64 + lane <= t) ? sel_key(v) : 0u; }
        } else {
#pragma unroll
            for (int j = jj * 32; j < jj * 32 + 32; ++j) key[j] = 0u;
        }
    }
    unsigned prefix = 0u; int cge = 1 << 30;
    for (int bit = 31; bit >= 0; --bit) {
        const unsigned cand = prefix | (1u << bit); int c = 0;
#pragma unroll
        for (int jj = 0; jj < 4; ++jj) {
            if (jj * 32 < nj) {
#pragma unroll
                for (int j = jj * 32; j < jj * 32 + 32; ++j) c += (key[j] >= cand) ? 1 : 0;
            }
        }
        c = wave_sum_i(c);
        if (c >= 256) { prefix = cand; cge = c; }
    }
    if (cge == 256) {
        for (int j = 0; j < nj; ++j) { const int s = j * 64 + lane; const float v_ = srow[j * 64]; const unsigned k = (s <= t) ? sel_key(v_) : 0u;
            const u64 word = __ballot(k >= prefix); if (lane == 0) mrow[j] = word; }
    } else {
        int cgt = 0;
        for (int j = 0; j < nj; ++j) { const int s = j * 64 + lane; const float v_ = srow[j * 64]; const unsigned k = (s <= t) ? sel_key(v_) : 0u; cgt += __popcll(__ballot(k > prefix)); }
        int need = 256 - cgt;
        for (int j = 0; j < nj; ++j) { const int s = j * 64 + lane; const float v_ = srow[j * 64]; const unsigned k = (s <= t) ? sel_key(v_) : 0u;
            u64 word = __ballot(k > prefix); u64 tm = __ballot(k == prefix);
            if (tm != 0ull && need > 0) { const int c = __popcll(tm);
                if (c <= need) { word |= tm; need -= c; }
                else { u64 selb = 0ull; for (int i = 0; i < need; ++i) { const u64 low = tm & (~tm + 1ull); selb |= low; tm ^= low; } word |= selb; need = 0; } }
            if (lane == 0) mrow[j] = word; }
    }
    for (int j = nj + lane; j < 128; j += 64) mrow[j] = 0ull;
}

__device__ __forceinline__ void attn_naive_unit(const Frame& F, int layer, int unit) {
    const int mixer = unit & 3, h = (unit >> 2) & 3, b = (unit >> 4) & 1, tblk = 63 - (unit >> 5);
    const int tid = tid_l(), lane = tid & 63, wave = tid >> 6, qi = lane >> 2, part = lane & 3;
    const int t = tblk * 128 + wave * 16 + qi, tmaxw = tblk * 128 + wave * 16 + 15;
    const bf16_t* Qp = F.QKV + (size_t)(mixer * 3 + 0) * QS + ((size_t)(b * 4 + h) * SEQ) * 128;
    const bf16_t* Kp = F.QKV + (size_t)(mixer * 3 + 1) * QS + ((size_t)(b * 4 + h) * SEQ) * 128;
    const bf16_t* Vp = F.QKV + (size_t)(mixer * 3 + 2) * QS + ((size_t)(b * 4 + h) * SEQ) * 128;
    float q[32];
    { const u32x4* p = (const u32x4*)(Qp + (size_t)t * 128 + part * 32);
#pragma unroll
      for (int i = 0; i < 4; ++i) { const u32x4 w = p[i];
#pragma unroll
          for (int j = 0; j < 4; ++j) { q[i * 8 + 2 * j] = bf_lo(w[j]); q[i * 8 + 2 * j + 1] = bf_hi(w[j]); } } }
    float o0[32], o1[32]; float m0 = -1e30f, l0 = 0.f, m1 = -1e30f, l1 = 0.f;
#pragma unroll
    for (int i = 0; i < 32; ++i) { o0[i] = 0.f; o1[i] = 0.f; }
    const float* tbh = F.tb + (size_t)((mixer == 0 ? 0 : (mixer == 2 ? 4 : 8)) + h) * SEQ;
    const float* cumh = F.cum + (size_t)(b * 4 + h) * SEQ;
    const u64* mrow = F.mask + (size_t)(b * SEQ + t) * 128;
    const int nkeys = (mixer == 3) ? 3 * 129 : tmaxw + 1;
    for (int it = 0; it < nkeys; ++it) {
        int s, dist; bool valid;
        if (mixer == 3) { const int cfg = it / 129, j = it % 129, dl = (cfg == 0) ? 1 : (cfg == 1 ? 4 : 16); dist = dl * j; s = t - dist; valid = s >= 0; if (s < 0) s = 0; }
        else { s = it; dist = t - s; valid = s <= t; if (dist < 0) dist = 0; }
        float kf[32];
        { const u32x4* p = (const u32x4*)(Kp + (size_t)s * 128 + part * 32);
#pragma unroll
          for (int i = 0; i < 4; ++i) { const u32x4 w = p[i];
#pragma unroll
              for (int j = 0; j < 4; ++j) { kf[i * 8 + 2 * j] = bf_lo(w[j]); kf[i * 8 + 2 * j + 1] = bf_hi(w[j]); } } }
        float d = 0.f;
#pragma unroll
        for (int i = 0; i < 32; ++i) d = fmaf(q[i], kf[i], d);
        d += __shfl_xor(d, 1);
        float x0, x1 = 0.f;
        if (mixer == 2) { x0 = __shfl(d, lane & ~3); x1 = __shfl(d, (lane & ~3) + 2); const float bb = tbh[dist]; x0 += bb; x1 += bb; }
        else { d += __shfl_xor(d, 2); x0 = d;
            if (mixer == 0) { x0 += tbh[dist]; valid = valid && ((mrow[s >> 6] >> (s & 63)) & 1ull); }
            else if (mixer == 1) { x0 -= cumh[s]; }
            else { x0 += tbh[dist]; } }
        float vf[32];
        { const u32x4* p = (const u32x4*)(Vp + (size_t)s * 128 + part * 32);
#pragma unroll
          for (int i = 0; i < 4; ++i) { const u32x4 w = p[i];
#pragma unroll
              for (int j = 0; j < 4; ++j) { vf[i * 8 + 2 * j] = bf_lo(w[j]); vf[i * 8 + 2 * j + 1] = bf_hi(w[j]); } } }
        if (valid) {
            { const float mn = fmaxf(m0, x0), al = ex2(m0 - mn), p = ex2(x0 - mn); l0 = l0 * al + p; m0 = mn;
#pragma unroll
              for (int i = 0; i < 32; ++i) o0[i] = fmaf(o0[i], al, p * vf[i]); }
            if (mixer == 2) { const float mn = fmaxf(m1, x1), al = ex2(m1 - mn), p = ex2(x1 - mn); l1 = l1 * al + p; m1 = mn;
#pragma unroll
              for (int i = 0; i < 32; ++i) o1[i] = fmaf(o1[i], al, p * vf[i]); }
        }
    }
    const float il0 = 1.0f / l0;
#pragma unroll
    for (int i = 0; i < 32; ++i) o0[i] *= il0;
    if (mixer == 2) {
        float s1 = 0.f, s2 = 0.f;
        for (int i = 0; i < 64; ++i) { s1 = fmaf(F.lq1[layer * 64 + i], F.lk1[layer * 64 + i], s1); s2 = fmaf(F.lq2[layer * 64 + i], F.lk2[layer * 64 + i], s2); }
        const float lam_init = 0.8f - 0.6f * expf(-0.3f * (float)layer);
        const float lam = expf(s1) - expf(s2) + lam_init;
        const float il1 = 1.0f / l1; float ss = 0.f;
#pragma unroll
        for (int i = 0; i < 32; ++i) { o0[i] = o0[i] - lam * (o1[i] * il1); ss = fmaf(o0[i], o0[i], ss); }
        ss += __shfl_xor(ss, 1); ss += __shfl_xor(ss, 2);
        const float rn = rsqrtf(ss * (1.0f / 128.0f) + RMS_EPS) * (1.0f - lam_init);
#pragma unroll
        for (int i = 0; i < 32; ++i) o0[i] = o0[i] * rn * F.subln[layer * 128 + part * 32 + i];
    }
    const size_t orow = (size_t)(b * SEQ + t) * DM + mixer * 512 + h * 128 + part * 32;
#pragma unroll
    for (int i = 0; i < 4; ++i) { const u32x4 zw = *(const u32x4*)(F.Zs + orow + i * 8); u32x4 w;
#pragma unroll
        for (int j = 0; j < 4; ++j) w[j] = cvt_pk_bf16(o0[i * 8 + 2 * j] * bf_lo(zw[j]), o0[i * 8 + 2 * j + 1] * bf_hi(zw[j]));
        *(u32x4*)(F.Y + orow + i * 8) = w; }
}

struct EpiMerged {
    static constexpr bool PERM = true, AFTER_DRAIN = false, MIDK = true;
    const bf16_t* G; bf16_t* MG;
    __device__ __forceinline__ void mid(f32x4 (&acc)[2][2][4][2], const pg8::Unit& u, int bnext, int wr, int wc, int fr, int fq) const {
        const int row0 = u.pm * 256 + wr * 64 + fr, c0 = u.pn * 256 + wc * 32 + 8 * fq;
#pragma unroll
        for (int ai = 0; ai < 2; ++ai)
#pragma unroll
            for (int m = 0; m < 4; ++m) { const bf16_t* gp = G + (size_t)(row0 + ai * 128 + m * 16) * 8192 + c0;
#pragma unroll
                for (int bj = 0; bj < 2; ++bj) {
                    const u32x4 num = *(const u32x4*)(gp + (bnext - 1) * DM + bj * 128), den = *(const u32x4*)(gp + bnext * DM + bj * 128);
#pragma unroll
                    for (int j = 0; j < 2; ++j) {
                        acc[ai][bj][m][0][2 * j]     *= bf_lo(num[j]) * __builtin_amdgcn_rcpf(bf_lo(den[j]));
                        acc[ai][bj][m][0][2 * j + 1] *= bf_hi(num[j]) * __builtin_amdgcn_rcpf(bf_hi(den[j]));
                        acc[ai][bj][m][1][2 * j]     *= bf_lo(num[2 + j]) * __builtin_amdgcn_rcpf(bf_lo(den[2 + j]));
                        acc[ai][bj][m][1][2 * j + 1] *= bf_hi(num[2 + j]) * __builtin_amdgcn_rcpf(bf_hi(den[2 + j])); } } }
    }
    __device__ __forceinline__ void operator()(const f32x4 (&acc)[2][2][4][2], const pg8::Unit& u, int wr, int wc, int fr, int fq) const {
        const int row0 = u.pm * 256 + wr * 64 + fr, c0 = u.pn * 256 + wc * 32 + 8 * fq;
#pragma unroll
        for (int ai = 0; ai < 2; ++ai)
#pragma unroll
            for (int m = 0; m < 4; ++m) { const int r = row0 + ai * 128 + m * 16;
#pragma unroll
                for (int bj = 0; bj < 2; ++bj) { const u32x4 g3 = *(const u32x4*)(G + (size_t)r * 8192 + 3 * DM + c0 + bj * 128);
                    const f32x4 v0 = acc[ai][bj][m][0], v1 = acc[ai][bj][m][1];
                    u32x4 w = {cvt_pk_bf16(v0[0] * bf_lo(g3[0]), v0[1] * bf_hi(g3[0])), cvt_pk_bf16(v0[2] * bf_lo(g3[1]), v0[3] * bf_hi(g3[1])),
                               cvt_pk_bf16(v1[0] * bf_lo(g3[2]), v1[1] * bf_hi(g3[2])), cvt_pk_bf16(v1[2] * bf_lo(g3[3]), v1[3] * bf_hi(g3[3]))};
                    *(u32x4*)(MG + (size_t)r * DM + c0 + bj * 128) = w; } }
    }
};

struct EpiOut {
    static constexpr bool PERM = false, AFTER_DRAIN = false, MIDK = false;
    float* xres; bf16_t* xb; float* ssq;
    __device__ __forceinline__ void operator()(const f32x4 (&acc)[2][2][4][2], const pg8::Unit& u, int wr, int wc, int fr, int fq) const {
        const int row0 = u.pm * 256 + wr * 64 + fr, col0 = u.pn * 256 + wc * 32 + 4 * fq;
#pragma unroll
        for (int ai = 0; ai < 2; ++ai)
#pragma unroll
            for (int m = 0; m < 4; ++m) { const int r = row0 + ai * 128 + m * 16; float ss = 0.f;
#pragma unroll
                for (int bj = 0; bj < 2; ++bj)
#pragma unroll
                    for (int n = 0; n < 2; ++n) { const size_t off = (size_t)r * DM + col0 + bj * 128 + n * 16;
                        f32x4 v = *(const f32x4*)(xres + off) + acc[ai][bj][m][n];
                        *(f32x4*)(xres + off) = v; ss += v[0] * v[0] + v[1] * v[1] + v[2] * v[2] + v[3] * v[3];
                        u32x2 w = {cvt_pk_bf16(v[0], v[1]), cvt_pk_bf16(v[2], v[3])}; *(u32x2*)(xb + off) = w; }
                ss += __shfl_xor(ss, 16); ss += __shfl_xor(ss, 32);
                if (fq == 0) ssq[(size_t)r * 32 + u.pn * 4 + wc] = ss; }
    }
};

__device__ __forceinline__ void final_norm(const Frame& F) {
    const int tid = tid_l(), lane = tid & 63, wave = tid >> 6, G = gridDim.x, bid = blockIdx.x;
    for (int row = bid * 8 + wave; row < MT; row += G * 8) {
        float ss = (lane < 32) ? F.ssq[(size_t)row * 32 + lane] : 0.f; ss = wave_sum(ss);
        const float rs = rsqrtf(ss * (1.0f / DM) + RMS_EPS);
#pragma unroll
        for (int i = 0; i < 8; ++i) { const int c = (i * 64 + lane) * 4; const f32x4 v = *(const f32x4*)(F.xres + (size_t)row * DM + c), w = *(const f32x4*)(F.final_w + c);
            *(f32x4*)(F.out + (size_t)row * DM + c) = v * rs * w; }
    }
}

__device__ __forceinline__ Frame mkframe(const Args& args, unsigned char* ws, unsigned char* lds) {
    Frame F;
    F.x = args.in[0]; F.norm_w = args.in[1]; F.w_in = args.in[2]; F.fox_b = args.in[3]; F.lq1 = args.in[4]; F.lk1 = args.in[5]; F.lq2 = args.in[6]; F.lk2 = args.in[7];
    F.subln = args.in[8]; F.w_branch = args.in[9]; F.w_out = args.in[10]; F.rel_bias = args.in[11]; F.final_w = args.in[12]; F.out = args.out;
    F.ctl = (unsigned*)(ws + WS_CTL); F.WinT = (bf16_t*)(ws + WS_WIN); F.WbrT = (bf16_t*)(ws + WS_WBR); F.WoutT = (bf16_t*)(ws + WS_WOUT);
    F.xres = (float*)(ws + WS_XRES); F.xb = (bf16_t*)(ws + WS_XB); F.ssq = (float*)(ws + WS_SSQ); F.Zs = (bf16_t*)(ws + WS_ZS); F.G = (bf16_t*)(ws + WS_G);
    F.QKV = (bf16_t*)(ws + WS_QKV); F.IQ = (bf16_t*)(ws + WS_IQ); F.IK = (bf16_t*)(ws + WS_IK); F.IW = (float*)(ws + WS_IW); F.FF = (float*)(ws + WS_FF);
    F.cum = (float*)(ws + WS_CUM); F.tb = (float*)(ws + WS_TB); F.sc = (float*)(ws + WS_SC); F.mask = (u64*)(ws + WS_MASK); F.Y = (bf16_t*)(ws + WS_Y); F.MG = (bf16_t*)(ws + WS_MG);
    F.lds = lds; F.misc = (volatile unsigned*)(lds + LDS_MISC);
    return F;
}
__device__ __forceinline__ unsigned char* launder(unsigned char* p) { asm volatile("" : "+s"(p)); return p; }

__global__ void __launch_bounds__(512, 2) fwd(Args args) {
    extern __shared__ __attribute__((aligned(16))) unsigned char lds[];
    LAS unsigned char* ldsl = (LAS unsigned char*)lds;
    if (threadIdx.x < 64) ((volatile LAS unsigned*)(ldsl + LDS_MISC))[threadIdx.x] = 0u;
    __syncthreads();
    const int lo = args.ph_lo, hi = args.ph_hi;
    const bool fused = (hi - lo) > 1;
    XcdBarrier bar; bar.bar = (unsigned*)(args.ws + WS_CTL) + CW_BAR; bar.x = 0; bar.st = (volatile LAS unsigned*)(ldsl + LDS_MISC);
    if (fused) bar = xcd_barrier_post((unsigned*)(args.ws + WS_CTL) + CW_BAR, (volatile LAS unsigned*)(ldsl + LDS_MISC));
#ifndef PH_EN
#define PH_EN 0xff
#endif
#define IN(k) (lo <= (k) && (k) < hi)
#define SEAM(k) do { if (IN((k) + 1)) xcd_barrier(bar); } while (0)
    const int G = gridDim.x, bid = blockIdx.x;

    if ((PH_EN & 1) && IN(0)) { const Frame F = mkframe(args, launder(args.ws), lds); p0_prologue(F); SEAM(0); }

    for (int layer = 0; layer < DEPTH; ++layer) {
        const int pb = 1 + 6 * layer;
        if ((PH_EN & 2) && IN(pb)) {
            unsigned char* ws = launder(args.ws);
            pg8::Gemm g{(const bf16_t*)(ws + WS_XB), (const bf16_t*)(ws + WS_WIN) + (size_t)layer * NINP * DM, MT, NINP, DM}; pg8::StaticOrder S; S.init(MT, NINP, G, bid);
            EpiIn E{ws};
            pg8::gemm_phase<EpiIn, pg8::StaticOrder>(ldsl, g, S, E);
            SEAM(pb);
        }
        if ((PH_EN & 4) && IN(pb + 1)) {
            const Frame F = mkframe(args, launder(args.ws), lds);
            if (bid < 8) fox_scan(F, layer, bid);
            unsigned* ctr = F.ctl + CW_Q + 64 * (layer * 4 + 0);
            for (int u = q_next(ctr, F.misc + 4); u < 2 * 576; u = q_next(ctr, F.misc + 4)) idx_unit(F, 2 * 576 - 1 - u);
            SEAM(pb + 1);
        }
        if ((PH_EN & 8) && IN(pb + 2)) {
            const Frame F = mkframe(args, launder(args.ws), lds);
            const int wave = tid_l() >> 6;
            for (int r = bid * 8 + wave; r < MT; r += G * 8) {
                const int rr = (r & 1) ? (MT - 1 - (r >> 1)) : (r >> 1);
                select_row(F, rr);
            }
            SEAM(pb + 2);
        }
        if ((PH_EN & 16) && IN(pb + 3)) {
            const Frame F = mkframe(args, launder(args.ws), lds);
            unsigned* ctr = F.ctl + CW_Q + 64 * (layer * 4 + 1);
            for (int u = q_next(ctr, F.misc + 4); u < 2048; u = q_next(ctr, F.misc + 4)) attn_naive_unit(F, layer, u);
            SEAM(pb + 3);
        }
        if ((PH_EN & 32) && IN(pb + 4)) {
            unsigned char* ws = launder(args.ws);
            pg8::Gemm g{(const bf16_t*)(ws + WS_Y), (const bf16_t*)(ws + WS_WBR) + (size_t)layer * DM * DM, MT, DM, DM}; pg8::StaticOrder S; S.init(MT, DM, G, bid);
            EpiMerged E{(const bf16_t*)(ws + WS_G), (bf16_t*)(ws + WS_MG)};
            pg8::gemm_phase<EpiMerged, pg8::StaticOrder>(ldsl, g, S, E);
            SEAM(pb + 4);
        }
        if ((PH_EN & 64) && IN(pb + 5)) {
            unsigned char* ws = launder(args.ws);
            pg8::Gemm g{(const bf16_t*)(ws + WS_MG), (const bf16_t*)(ws + WS_WOUT) + (size_t)layer * DM * DM, MT, DM, DM}; pg8::StaticOrder S; S.init(MT, DM, G, bid);
            EpiOut E{(float*)(ws + WS_XRES), (bf16_t*)(ws + WS_XB), (float*)(ws + WS_SSQ)};
            pg8::gemm_phase<EpiOut, pg8::StaticOrder>(ldsl, g, S, E);
            SEAM(pb + 5);
        }
    }
    if ((PH_EN & 128) && IN(25)) { const Frame F = mkframe(args, launder(args.ws), lds); final_norm(F); }
#undef IN
#undef SEAM
}

extern "C" void kernel_launch(void* const* d_in, const int* in_sizes, int n_in, void* d_out, int out_size, void* d_ws, size_t ws_size, hipStream_t stream) {
    static int grid = 0;
    if (grid == 0) {
        if (n_in != 13 || in_sizes[0] != MT * DM || out_size != MT * DM || ws_size < WS_END) {
            fprintf(stderr, "kernel_launch: unexpected shapes (n_in %d, in0 %d, out %d, ws %zu, need %zu)\n", n_in, n_in > 0 ? in_sizes[0] : -1, out_size, ws_size, (size_t)WS_END); grid = -1; return; }
        int dev = 0, cus = 0, per_cu = 0;
        if (hipGetDevice(&dev) != hipSuccess || hipDeviceGetAttribute(&cus, hipDeviceAttributeMultiprocessorCount, dev) != hipSuccess) { grid = -1; return; }
        if (hipFuncSetAttribute((const void*)fwd, hipFuncAttributeMaxDynamicSharedMemorySize, LDS_BYTES) != hipSuccess) { fprintf(stderr, "kernel_launch: hipFuncSetAttribute failed\n"); grid = -1; return; }
        if (hipOccupancyMaxActiveBlocksPerMultiprocessor(&per_cu, (const void*)fwd, 512, LDS_BYTES) != hipSuccess || per_cu < 1) fprintf(stderr, "kernel_launch: occupancy query reports %d\n", per_cu);
        (void)hipGetLastError();
        grid = cus;
    }
    if (grid < 0) return;
    if (hipMemsetAsync((char*)d_ws + WS_CTL, 0, CTL_BYTES, stream) != hipSuccess) return;
    Args a{};
    for (int i = 0; i < 13; ++i) a.in[i] = (const float*)d_in[i];
    a.out = (float*)d_out; a.ws = (unsigned char*)d_ws;
#if MK_LAUNCHES == 1
    a.ph_lo = 0; a.ph_hi = NPH;
    hipLaunchKernelGGL(fwd, dim3(grid), dim3(512), LDS_BYTES, stream, a);
#else
    for (int p = 0; p < NPH; ++p) { a.ph_lo = p; a.ph_hi = p + 1; hipLaunchKernelGGL(fwd, dim3(grid), dim3(512), LDS_BYTES, stream, a); }
#endif
}
```

```cpp
#include <hip/hip_runtime.h>
#include <stdint.h>
#include <stdio.h>

#ifndef MK_LAUNCHES
#define MK_LAUNCHES 1
#endif

#define LAS __attribute__((address_space(3)))
#define GA __attribute__((address_space(1)))
typedef unsigned short bf16_t;
typedef short bf16x8 __attribute__((ext_vector_type(8)));
typedef float f32x4 __attribute__((ext_vector_type(4)));
typedef float f32x16 __attribute__((ext_vector_type(16)));
typedef unsigned u32x4 __attribute__((ext_vector_type(4)));
typedef unsigned u32x2 __attribute__((ext_vector_type(2)));
typedef unsigned long long u64;

constexpr int DM = 2048, NB = 2, SEQ = 8192, DEPTH = 4, MT = NB * SEQ;
constexpr int NIN = 17492, NINP = 17664;
constexpr int NPH = 26;
constexpr float LOG2E = 1.4426950408889634f;
constexpr float QSC128 = 0.08838834764831845f * 1.4426950408889634f;
constexpr float QSC64 = 0.125f * 1.4426950408889634f;
constexpr float RMS_EPS = 1e-6f;
constexpr size_t QS = (size_t)NB * 4 * SEQ * 128;

constexpr size_t al256(size_t x) { return (x + 255) & ~(size_t)255; }
constexpr size_t WS_CTL = 0, CTL_BYTES = 65536;
constexpr size_t WS_WIN = WS_CTL + CTL_BYTES;
constexpr size_t WS_WBR = WS_WIN + (size_t)DEPTH * NINP * DM * 2;
constexpr size_t WS_WOUT = WS_WBR + (size_t)DEPTH * DM * DM * 2;
constexpr size_t WS_XRES = WS_WOUT + (size_t)DEPTH * DM * DM * 2;
constexpr size_t WS_XB = WS_XRES + (size_t)MT * DM * 4;
constexpr size_t WS_SSQ = WS_XB + (size_t)MT * DM * 2;
constexpr size_t WS_ZS = WS_SSQ + (size_t)MT * 32 * 4;
constexpr size_t WS_G = WS_ZS + (size_t)MT * DM * 2;
constexpr size_t WS_QKV = WS_G + (size_t)MT * 8192 * 2;
constexpr size_t WS_IQ = WS_QKV + 12 * QS * 2;
constexpr size_t WS_IK = WS_IQ + (size_t)MT * 1024 * 2;
constexpr size_t WS_IW = WS_IK + (size_t)MT * 64 * 2;
constexpr size_t WS_FF = WS_IW + (size_t)MT * 16 * 4;
constexpr size_t WS_CUM = WS_FF + (size_t)MT * 4 * 4;
constexpr size_t WS_TB = WS_CUM + (size_t)NB * 4 * SEQ * 4;
constexpr size_t WS_SC = WS_TB + (size_t)12 * SEQ * 4;
constexpr size_t WS_MASK = WS_SC + (size_t)NB * SEQ * SEQ * 4;
constexpr size_t WS_Y = WS_MASK + (size_t)NB * SEQ * 128 * 8;
constexpr size_t WS_MG = WS_Y + (size_t)MT * DM * 2;
constexpr size_t WS_O1 = WS_MG + (size_t)MT * DM * 2;
constexpr size_t WS_OD = WS_O1 + (size_t)256 * 64 * 512 * 4;
constexpr size_t WS_LSE = WS_OD + (size_t)3 * MT * 512 * 4;
constexpr size_t WS_DP = WS_LSE + (size_t)3 * MT * 4 * 4;
constexpr size_t WS_END = WS_DP + 4 * 256 * 4;

constexpr int CW_BAR = 0;
constexpr int CW_Q = 4096;

constexpr int LDS_STAGE = 131072;
constexpr int LDS_MISC = 131072;
constexpr int LDS_BYTES = 147456;

__device__ __forceinline__ unsigned cvt_pk_bf16(float lo, float hi) { unsigned r; asm volatile("v_cvt_pk_bf16_f32 %0, %1, %2" : "=v"(r) : "v"(lo), "v"(hi)); return r; }
__device__ __forceinline__ float bf_lo(unsigned w) { return __uint_as_float(w << 16); }
__device__ __forceinline__ float bf_hi(unsigned w) { return __uint_as_float(w & 0xffff0000u); }
__device__ __forceinline__ float bf2f(bf16_t b) { return __uint_as_float(((unsigned)b) << 16); }
__device__ __forceinline__ float ex2(float x) { return __builtin_amdgcn_exp2f(x); }
__device__ __forceinline__ float sigmoidf_(float x) { return __builtin_amdgcn_rcpf(1.0f + ex2(-x * LOG2E)); }
__device__ __forceinline__ int tid_l() { int t = threadIdx.x; asm volatile("" : "+v"(t)); return t; }
__device__ __forceinline__ GA unsigned char* launder(unsigned char* p) { asm volatile("" : "+s"(p)); return (GA unsigned char*)p; }
__device__ __forceinline__ GA unsigned char* launder(GA unsigned char* p) { asm volatile("" : "+s"(p)); return p; }
__device__ __forceinline__ float wave_sum(float v) {
#pragma unroll
    for (int o = 32; o > 0; o >>= 1) v += __shfl_xor(v, o);
    return v;
}

#define XB_TMO      128
#define XB_XCNT(j)  (256  + 64 * (j))
#define XB_XSUB(j)  (1280 + 64 * (j))
#define XB_XGEN(j)  (2304 + 64 * (j))
#define XB_TOP      3328
#define XB_TOPGEN   3392
#define XCD_BAR_WORDS 3456
#define XB_SPIN_CAP (1u << 18)

__device__ __forceinline__ unsigned xb_ld(unsigned* p)              { return __hip_atomic_load(p, __ATOMIC_RELAXED, __HIP_MEMORY_SCOPE_AGENT); }
__device__ __forceinline__ unsigned xb_add(unsigned* p, unsigned v) { return __hip_atomic_fetch_add(p, v, __ATOMIC_RELAXED, __HIP_MEMORY_SCOPE_AGENT); }
__device__ __forceinline__ unsigned xb_xcc_id() { return (unsigned)__builtin_amdgcn_s_getreg((3 << 11) | 20) & 0xFu; }
#define XB_SPIN(cond, bar) do { unsigned _sp = 0; while (cond) { __builtin_amdgcn_s_sleep(1); \
    if ((++_sp & 255u) == 0u) { if (xb_ld(&(bar)[XB_TMO])) break; if (_sp > XB_SPIN_CAP) { atomicAdd(&(bar)[XB_TMO], 1u); break; } } } } while (0)

struct XcdBarrier { unsigned* bar; unsigned x; volatile LAS unsigned* st; };

__device__ __forceinline__ XcdBarrier xcd_barrier_post(unsigned* bar, volatile LAS unsigned* st) {
    XcdBarrier b; b.bar = bar; b.x = xb_xcc_id(); b.st = st;
    if (threadIdx.x == 0) (void)xb_add(&bar[XB_XCNT(b.x)], 1u);
    return b;
}
__device__ __forceinline__ void xcd_barrier_complete(unsigned* bar, unsigned x, unsigned& nloc, unsigned& nx) {
    const unsigned G = gridDim.x * gridDim.y * gridDim.z;
    unsigned sum, cnt, mine, sp = 0u;
    for (;;) {
        sum = 0u; cnt = 0u; mine = 0u;
#pragma unroll
        for (unsigned j = 0; j < 16; ++j) { const unsigned c = xb_ld(&bar[XB_XCNT(j)]); sum += c; cnt += (c > 0u) ? 1u : 0u; mine = (j == x) ? c : mine; }
        if (sum == G) break;
        __builtin_amdgcn_s_sleep(1);
        if ((++sp & 255u) == 0u) { if (xb_ld(&bar[XB_TMO])) break; if (sp > XB_SPIN_CAP) { atomicAdd(&bar[XB_TMO], 1u); break; } }
    }
    nloc = mine > 0u ? mine : 1u; nx = cnt > 0u ? cnt : 1u;
}
__device__ __forceinline__ void xcd_barrier(const XcdBarrier& b) {
    asm volatile("s_waitcnt vmcnt(0)" ::: "memory");
    __syncthreads();
    if (threadIdx.x == 0) {
        unsigned* bar = b.bar;
        __builtin_amdgcn_s_waitcnt(0);
        unsigned nloc = b.st[0], nx = b.st[1];
        if (nloc == 0u) { xcd_barrier_complete(bar, b.x, nloc, nx); b.st[0] = nloc; b.st[1] = nx; }
        const unsigned old = xb_add(&bar[XB_XSUB(b.x)], 1u);
        const unsigned gen = old / nloc;
        if (old + 1u == (gen + 1u) * nloc) {
            __builtin_amdgcn_fence(__ATOMIC_RELEASE, "agent");
            asm volatile("s_waitcnt vmcnt(0)" ::: "memory");
            const unsigned og = xb_add(&bar[XB_TOP], 1u);
            const unsigned tg = og / nx;
            if (og + 1u == (tg + 1u) * nx) xb_add(&bar[XB_TOPGEN], 1u);
            else XB_SPIN(xb_ld(&bar[XB_TOPGEN]) == tg, bar);
            __builtin_amdgcn_fence(__ATOMIC_ACQUIRE, "agent");
            xb_add(&bar[XB_XGEN(b.x)], 1u);
            asm volatile("s_waitcnt vmcnt(0)" ::: "memory");
        } else {
            XB_SPIN(xb_ld(&bar[XB_XGEN(b.x)]) == gen, bar);
            __builtin_amdgcn_fence(__ATOMIC_ACQUIRE, "agent");
            asm volatile("s_waitcnt vmcnt(0)" ::: "memory");
        }
    }
    __syncthreads();
}

namespace pg8 {
constexpr int BM = 256, BK = 64, HALF = 128, HTB = HALF * BK * 2, STAGE_BYTES = 8 * HTB, NXCD = 8, WGM = 8;
__host__ __device__ __forceinline__ int lds_byte(int r, int c) { const int st = (r >> 4) * 2 + (c >> 5), rr = r & 15, cc = c & 31, ob = rr * 64 + cc * 2; return st * 1024 + (ob ^ (((ob >> 9) & 1) << 5)); }
__host__ __device__ __forceinline__ void stage_rc(int b, int& R, int& C) { const int st = b / 1024, sb = b % 1024, swz = sb ^ (((sb >> 9) & 1) << 5); R = (st >> 1) * 16 + swz / 64; C = (st & 1) * 32 + (swz % 64) / 2; }
__host__ __device__ __forceinline__ int perm32(int rho) { const int n = rho >> 4, i = rho & 15; return 8 * (i >> 2) + 4 * n + (i & 3); }
struct Unit { int pm, pn; };
struct Gemm { const GA bf16_t* A; const GA bf16_t* Bt; int M, N, K; };
struct StaticOrder {
    int nM, nN, nwg, G, c;
    __host__ __device__ void init(int M, int N, int G_, int c_) { nM = M / BM; nN = N / BM; nwg = nM * nN; G = G_; c = c_; }
    __host__ __device__ bool next(int i, Unit& u) const {
        const long L = (long)i * G + c; if (L >= nwg) return false;
        int wgid = (int)L; { const int q = nwg / NXCD, r = nwg % NXCD, xcd = wgid % NXCD, off = wgid / NXCD; wgid = (xcd < r ? xcd * (q + 1) : r * (q + 1) + (xcd - r) * q) + off; }
        const int nig = WGM * nN, gid = wgid / nig, fm = gid * WGM, gsz = (nM - fm) < WGM ? (nM - fm) : WGM;
        u.pm = fm + ((wgid % nig) % gsz); u.pn = (wgid % nig) / gsz; return true;
    }
    __device__ __forceinline__ void a_ready(const Unit&) const {}
    __device__ __forceinline__ void done(const Unit&) const {}
};

template <class Epi, class Sched>
__device__ __forceinline__ void gemm_phase(LAS unsigned char* lds, const Gemm g, const Sched& S, const Epi& E) {
    const int tid = tid_l(), wid = __builtin_amdgcn_readfirstlane(tid >> 6), lane = tid & 63, wr = wid >> 2, wc = wid & 3, fr = lane & 15, fq = lane >> 4;
    const int K = g.K, nt = K / BK;
    unsigned voffA[2], voffB[2];
#pragma unroll
    for (int i = 0; i < 2; ++i) { int R, C; stage_rc(tid * 16 + i * 8192, R, C); const int Rb = Epi::PERM ? ((R & ~31) + perm32(R & 31)) : R;
        voffA[i] = (unsigned)(R * K + C) * 2u; voffB[i] = (unsigned)(Rb * K + C) * 2u; }
    const size_t kstep = (size_t)(BK * 2);
    const size_t hstep = (size_t)HALF * K * 2;
    const size_t tstep = 2 * hstep;
    const unsigned ldsw = (unsigned)wid * 1024u;
    const int aoff = lds_byte(wr * 64 + fr, fq * 8), boff = lds_byte(wc * 32 + fr, fq * 8);
#define PG8_SA(b, h) (((b) * 2 + (h)) * HTB)
#define PG8_SB(b, h) ((4 + (b) * 2 + (h)) * HTB)
#define PG8_STAGE(bufoff, gbase, voff) do { _Pragma("unroll") for (int _i = 0; _i < 2; ++_i) \
        __builtin_amdgcn_global_load_lds((const GA unsigned*)((const GA char*)(gbase) + (voff)[_i]), (LAS unsigned*)(lds + (bufoff) + ldsw + _i * 8192), 16, 0, 0); } while (0)
#define PG8_LDA(dst, b, h) do { _Pragma("unroll") for (int m = 0; m < 4; ++m) _Pragma("unroll") for (int k = 0; k < 2; ++k) dst[m][k] = *(const LAS bf16x8*)(lds + PG8_SA(b, h) + aoff + m * 2048 + k * 1024); } while (0)
#define PG8_LDB(dst, b, h) do { _Pragma("unroll") for (int n = 0; n < 2; ++n) _Pragma("unroll") for (int k = 0; k < 2; ++k) dst[n][k] = *(const LAS bf16x8*)(lds + PG8_SB(b, h) + boff + n * 2048 + k * 1024); } while (0)
#define PG8_MMA(ai, bj, At, Bt) do { __builtin_amdgcn_s_setprio(1); _Pragma("unroll") for (int m = 0; m < 4; ++m) _Pragma("unroll") for (int n = 0; n < 2; ++n) _Pragma("unroll") for (int k = 0; k < 2; ++k) \
        acc[ai][bj][m][n] = __builtin_amdgcn_mfma_f32_16x16x32_bf16(Bt[n][k], At[m][k], acc[ai][bj][m][n], 0, 0, 0); __builtin_amdgcn_s_setprio(0); } while (0)
#define PG8_WAIT_V(n) asm volatile("s_waitcnt vmcnt(" #n ")" ::: "memory")
#define PG8_WAIT_L(n) asm volatile("s_waitcnt lgkmcnt(" #n ")" ::: "memory")
#define PG8_BAR __builtin_amdgcn_s_barrier()
#define PG8_SCHED __builtin_amdgcn_sched_barrier(0)
    Unit cur, nxt; int ui = 0;
    if (!S.next(0, cur)) return;
    f32x4 acc[2][2][4][2];
#pragma unroll
    for (int a = 0; a < 2; ++a)
#pragma unroll
        for (int b = 0; b < 2; ++b)
#pragma unroll
            for (int m = 0; m < 4; ++m)
#pragma unroll
                for (int n = 0; n < 2; ++n) acc[a][b][m][n] = (f32x4){0.f, 0.f, 0.f, 0.f};
    bf16x8 At[4][2], B0[2][2], B1[2][2];
    const GA char* cA = (const GA char*)g.A + (size_t)cur.pm * tstep; const GA char* cB = (const GA char*)g.Bt + (size_t)cur.pn * tstep;
    S.a_ready(cur);
    PG8_STAGE(PG8_SB(0, 0), cB, voffB); PG8_STAGE(PG8_SA(0, 0), cA, voffA); PG8_STAGE(PG8_SB(0, 1), cB + hstep, voffB); PG8_STAGE(PG8_SA(0, 1), cA + hstep, voffA);
    if (wr == 1) PG8_BAR;
    PG8_WAIT_V(4); PG8_BAR;
    PG8_STAGE(PG8_SB(1, 0), cB + kstep, voffB); PG8_STAGE(PG8_SA(1, 0), cA + kstep, voffA); PG8_STAGE(PG8_SB(1, 1), cB + hstep + kstep, voffB);
    PG8_WAIT_V(6); PG8_BAR;
    for (;;) {
        const bool has_next = S.next(ui + 1, nxt);
        const GA char* nA = has_next ? (const GA char*)g.A + (size_t)nxt.pm * tstep : cA; const GA char* nB = has_next ? (const GA char*)g.Bt + (size_t)nxt.pn * tstep : cB;
        for (int t = 0; t < nt; t += 2) {
            const bool last = (t == nt - 2);
            const GA char* a1 = cA + (size_t)(t + 1) * kstep;
            const GA char* a2 = last ? nA : cA + (size_t)(t + 2) * kstep; const GA char* b2 = last ? nB : cB + (size_t)(t + 2) * kstep;
            const GA char* a3 = a2 + kstep; const GA char* b3 = b2 + kstep;
            if (last && has_next) S.a_ready(nxt);
            if constexpr (Epi::MIDK) { if (t > 0 && (t & 7) == 0) E.mid(acc, cur, t >> 3, wr, wc, fr, fq); }
            PG8_LDB(B0, 0, 0); PG8_SCHED; PG8_LDA(At, 0, 0); PG8_STAGE(PG8_SA(1, 1), a1 + hstep, voffA);
            PG8_WAIT_L(8); PG8_BAR; PG8_WAIT_L(0); PG8_MMA(0, 0, At, B0); PG8_BAR; PG8_SCHED;
            PG8_LDB(B1, 0, 1); PG8_STAGE(PG8_SB(0, 0), b2, voffB);
            PG8_BAR; PG8_WAIT_L(0); PG8_MMA(0, 1, At, B1); PG8_BAR;
            PG8_LDA(At, 0, 1); PG8_STAGE(PG8_SA(0, 0), a2, voffA);
            PG8_BAR; PG8_WAIT_L(0); PG8_MMA(1, 0, At, B0); PG8_BAR; PG8_SCHED;
            PG8_STAGE(PG8_SB(0, 1), b2 + hstep, voffB);
            PG8_WAIT_V(6); PG8_BAR; PG8_MMA(1, 1, At, B1); PG8_BAR;
            PG8_LDB(B0, 1, 0); PG8_SCHED; PG8_LDA(At, 1, 0); PG8_STAGE(PG8_SA(0, 1), a2 + hstep, voffA);
            PG8_WAIT_L(8); PG8_BAR; PG8_WAIT_L(0); PG8_MMA(0, 0, At, B0); PG8_BAR; PG8_SCHED;
            PG8_LDB(B1, 1, 1); PG8_STAGE(PG8_SB(1, 0), b3, voffB);
            PG8_BAR; PG8_WAIT_L(0); PG8_MMA(0, 1, At, B1); PG8_BAR;
            PG8_LDA(At, 1, 1); PG8_STAGE(PG8_SA(1, 0), a3, voffA);
            PG8_BAR; PG8_WAIT_L(0); PG8_MMA(1, 0, At, B0); PG8_BAR; PG8_SCHED;
            PG8_STAGE(PG8_SB(1, 1), b3 + hstep, voffB);
            PG8_WAIT_V(6); PG8_BAR; PG8_MMA(1, 1, At, B1); PG8_BAR;
        }
        E(acc, cur, wr, wc, fr, fq); S.done(cur);
        if (!has_next) break;
#pragma unroll
        for (int a = 0; a < 2; ++a)
#pragma unroll
            for (int b = 0; b < 2; ++b)
#pragma unroll
                for (int m = 0; m < 4; ++m)
#pragma unroll
                    for (int n = 0; n < 2; ++n) acc[a][b][m][n] = (f32x4){0.f, 0.f, 0.f, 0.f};
        cur = nxt; cA = nA; cB = nB; ++ui;
    }
    PG8_WAIT_V(0);
    if (wr == 0) PG8_BAR;
    PG8_BAR;
#undef PG8_SA
#undef PG8_SB
#undef PG8_STAGE
#undef PG8_LDA
#undef PG8_LDB
#undef PG8_MMA
#undef PG8_WAIT_V
#undef PG8_WAIT_L
#undef PG8_BAR
#undef PG8_SCHED
}
}

struct Args { const float* in[13]; float* out; unsigned char* ws; int ph_lo, ph_hi; };
struct Frame {
    const GA float* x; const GA float* norm_w; const GA float* w_in; const GA float* fox_b; const GA float* lq1; const GA float* lk1; const GA float* lq2; const GA float* lk2;
    const GA float* subln; const GA float* w_branch; const GA float* w_out; const GA float* rel_bias; const GA float* final_w; GA float* out;
    GA unsigned* ctl; GA bf16_t* WinT; GA bf16_t* WbrT; GA bf16_t* WoutT; GA float* xres; GA bf16_t* xb; GA float* ssq; GA bf16_t* Zs; GA bf16_t* G; GA bf16_t* QKV; GA bf16_t* IQ; GA bf16_t* IK;
    GA float* IW; GA float* FF; GA float* cum; GA float* tb; GA float* sc; GA u64* mask; GA bf16_t* Y; GA bf16_t* MG; GA float* O1; GA float* OD; GA float* LSE; GA float* DP; GA unsigned char* ws;
    LAS unsigned char* lds; volatile LAS unsigned* misc;
};

__device__ __forceinline__ int q_next(GA unsigned* ctr, volatile LAS unsigned* lw) {
    __syncthreads();
    if (threadIdx.x == 0) *lw = __hip_atomic_fetch_add(ctr, 1u, __ATOMIC_RELAXED, __HIP_MEMORY_SCOPE_AGENT);
    __syncthreads();
    return (int)*lw;
}

__device__ __forceinline__ int win_src_col(int n) {
    if (n < 12800) return n;
    if (n < 14336) return n - 12800 + 12880;
    if (n < 15872) return n - 14336 + 14420;
    if (n < 17408) return n - 15872 + 15956;
    if (n < 17472) return n - 17408 + 12800;
    if (n < 17488) return n - 17472 + 12864;
    if (n < 17492) return n - 17488 + 14416;
    return -1;
}
__device__ __forceinline__ void transpose_tile(const GA float* src, int ld, int srccol, const GA float* ksc, GA bf16_t* dst, int k0, int n0, LAS float* tile) {
    const int tid = tid_l(), tk = tid >> 6, tn = tid & 63;
#pragma unroll
    for (int i = 0; i < 8; ++i) { const int kk = tk + 8 * i; float v = 0.f;
        if (srccol >= 0) { v = src[(size_t)(k0 + kk) * ld + srccol]; if (ksc) v *= ksc[k0 + kk]; }
        tile[kk * 65 + tn] = v; }
    __syncthreads();
    const int wn = tid >> 3, wk = tid & 7;
    float f[8];
#pragma unroll
    for (int j = 0; j < 8; ++j) f[j] = tile[(wk * 8 + j) * 65 + wn];
    u32x4 w = {cvt_pk_bf16(f[0], f[1]), cvt_pk_bf16(f[2], f[3]), cvt_pk_bf16(f[4], f[5]), cvt_pk_bf16(f[6], f[7])};
    *(GA u32x4*)(dst + (size_t)(n0 + wn) * DM + k0 + wk * 8) = w;
    __syncthreads();
}
__device__ __forceinline__ int t5_bucket(int d) {
    if (d < 16) return d;
    const int th[15] = {22, 30, 40, 54, 73, 99, 134, 182, 246, 332, 450, 609, 825, 1117, 1513};
    int b = 16;
#pragma unroll
    for (int i = 0; i < 15; ++i) b += (d >= th[i]) ? 1 : 0;
    return b;
}
__device__ __forceinline__ void p0_prologue(const Frame& F) {
    const int tid = tid_l(), lane = tid & 63, wave = tid >> 6, G = gridDim.x, bid = blockIdx.x;
    LAS float* tile = (LAS float*)F.lds;
    constexpr int TW = 32 * 276, TB_ = 32 * 32, TL = TW + 2 * TB_;
    for (int j = bid; j < DEPTH * TL; j += G) {
        const int l = j / TL, r = j % TL;
        if (r < TW) { const int nt = r % 276, kt = r / 276; const int n = nt * 64 + (tid & 63);
            transpose_tile(F.w_in + (size_t)l * DM * NIN, NIN, win_src_col(n), F.norm_w + l * DM, F.WinT + (size_t)l * NINP * DM, kt * 64, nt * 64, tile); }
        else if (r < TW + TB_) { const int q = r - TW, nt = q % 32, kt = q / 32;
            transpose_tile(F.w_branch + (size_t)l * DM * DM, DM, nt * 64 + (tid & 63), (const GA float*)nullptr, F.WbrT + (size_t)l * DM * DM, kt * 64, nt * 64, tile); }
        else { const int q = r - TW - TB_, nt = q % 32, kt = q / 32;
            transpose_tile(F.w_out + (size_t)l * DM * DM, DM, nt * 64 + (tid & 63), (const GA float*)nullptr, F.WoutT + (size_t)l * DM * DM, kt * 64, nt * 64, tile); }
    }
    for (int row = bid * 8 + wave; row < MT; row += G * 8) {
        const GA float* xr = F.x + (size_t)row * DM; float ss = 0.f;
#pragma unroll
        for (int i = 0; i < 8; ++i) { const int c = (i * 64 + lane) * 4; const f32x4 v = *(const GA f32x4*)(xr + c);
            *(GA f32x4*)(F.xres + (size_t)row * DM + c) = v; ss += v[0] * v[0] + v[1] * v[1] + v[2] * v[2] + v[3] * v[3];
            u32x2 w = {cvt_pk_bf16(v[0], v[1]), cvt_pk_bf16(v[2], v[3])}; *(GA u32x2*)(F.xb + (size_t)row * DM + c) = w; }
        ss = wave_sum(ss);
        if (lane < 32) F.ssq[(size_t)row * 32 + lane] = (lane == 0) ? ss : 0.f;
    }
    if (bid == 0 && tid < DEPTH * 128) { const int l = tid >> 7, i = tid & 127;
        const float lam_init = 0.8f - 0.6f * expf(-0.3f * (float)l);
        F.DP[l * 256 + 128 + i] = F.subln[l * 128 + i] * (1.0f - lam_init);
        if (i == 0) { float s1 = 0.f, s2 = 0.f;
            for (int k = 0; k < 64; ++k) { s1 = fmaf(F.lq1[l * 64 + k], F.lk1[l * 64 + k], s1); s2 = fmaf(F.lq2[l * 64 + k], F.lk2[l * 64 + k], s2); }
            F.DP[l * 256] = expf(s1) - expf(s2) + lam_init; F.DP[l * 256 + 1] = 1.0f - lam_init; } }
    for (int i = bid * 512 + tid; i < 12 * SEQ; i += G * 512) { const int hd = i / SEQ, d = i % SEQ; F.tb[i] = F.rel_bias[t5_bucket(d) * 12 + hd] * LOG2E; }
}

struct EpiIn {
    static constexpr bool PERM = true, AFTER_DRAIN = false, MIDK = false;
    GA unsigned char* ws;
    template <int KIND>
    __device__ __forceinline__ void body(const f32x4 (&acc)[2][2][4][2], int row0, int cl, int fq, GA bf16_t* base, int ldc, float qscale, int headbase) const {
        const GA float* ssq = (const GA float*)(ws + WS_SSQ);
#pragma unroll
        for (int ai = 0; ai < 2; ++ai)
#pragma unroll
            for (int m = 0; m < 4; ++m) {
                const int r = row0 + ai * 128 + m * 16;
                const GA float* sp = ssq + (size_t)r * 32 + fq * 8;
                const f32x4 s4 = *(const GA f32x4*)sp + *(const GA f32x4*)(sp + 4);
                float ssum = (s4[0] + s4[1]) + (s4[2] + s4[3]);
                ssum += __shfl_xor(ssum, 16); ssum += __shfl_xor(ssum, 32);
                const float sc = __builtin_amdgcn_rsqf(ssum * (1.0f / DM) + RMS_EPS) * qscale;
#pragma unroll
                for (int bj = 0; bj < 2; ++bj) {
                    f32x4 v0 = acc[ai][bj][m][0] * sc, v1 = acc[ai][bj][m][1] * sc;
                    if (KIND == 0) {
#pragma unroll
                        for (int j = 0; j < 4; ++j) { v0[j] = v0[j] * sigmoidf_(v0[j]); v1[j] = v1[j] * sigmoidf_(v1[j]); }
                    } else if (KIND == 1) {
#pragma unroll
                        for (int j = 0; j < 4; ++j) { v0[j] = fmaxf(sigmoidf_(v0[j]), 1e-9f); v1[j] = fmaxf(sigmoidf_(v1[j]), 1e-9f); }
                    }
                    if (KIND == 4) {
                        if (bj == 0) {
                            if (cl < 64) { u32x4 w = {cvt_pk_bf16(v0[0], v0[1]), cvt_pk_bf16(v0[2], v0[3]), cvt_pk_bf16(v1[0], v1[1]), cvt_pk_bf16(v1[2], v1[3])};
                                *(GA u32x4*)((GA bf16_t*)(ws + WS_IK) + (size_t)r * 64 + cl) = w; }
                            else if (cl < 80) { GA float* iw = (GA float*)(ws + WS_IW) + (size_t)r * 16 + (cl - 64); *(GA f32x4*)iw = v0; *(GA f32x4*)(iw + 4) = v1; }
                            else if (cl == 80) { *(GA f32x4*)((GA float*)(ws + WS_FF) + (size_t)r * 4) = v0; }
                        }
                    } else {
                        GA bf16_t* dst;
                        if (KIND == 2) { const int b = r >> 13, s = r & (SEQ - 1); dst = base + ((size_t)(b * 4 + headbase + bj) * SEQ + s) * 128 + cl; }
                        else dst = base + (size_t)r * ldc + bj * 128 + cl;
                        u32x4 w = {cvt_pk_bf16(v0[0], v0[1]), cvt_pk_bf16(v0[2], v0[3]), cvt_pk_bf16(v1[0], v1[1]), cvt_pk_bf16(v1[2], v1[3])};
                        *(GA u32x4*)dst = w;
                    }
                }
            }
    }
    __device__ __forceinline__ void operator()(const f32x4 (&acc)[2][2][4][2], const pg8::Unit& u, int wr, int wc, int fr, int fq) const {
        const int row0 = u.pm * 256 + wr * 64 + fr, pn = u.pn, cl = wc * 32 + 8 * fq;
        if (pn < 8) body<0>(acc, row0, cl, fq, (GA bf16_t*)(ws + WS_ZS) + pn * 256, DM, 1.f, 0);
        else if (pn < 40) body<1>(acc, row0, cl, fq, (GA bf16_t*)(ws + WS_G) + (pn - 8) * 256, 8192, 1.f, 0);
        else if (pn >= 46 && pn < 50) body<3>(acc, row0, cl, fq, (GA bf16_t*)(ws + WS_IQ) + (pn - 46) * 256, 1024, 1.f, 0);
        else if (pn < 68) {
            int mixer, t6;
            if (pn < 46) { mixer = 0; t6 = pn - 40; } else if (pn < 56) { mixer = 1; t6 = pn - 50; } else if (pn < 62) { mixer = 2; t6 = pn - 56; } else { mixer = 3; t6 = pn - 62; }
            const int which = t6 >> 1;
            const float qscale = (which == 0) ? ((mixer == 2) ? QSC64 : QSC128) : 1.f;
            body<2>(acc, row0, cl, fq, (GA bf16_t*)(ws + WS_QKV) + (size_t)(mixer * 3 + which) * QS, 0, qscale, (t6 & 1) * 2);
        }
        else body<4>(acc, row0, cl, fq, (GA bf16_t*)nullptr, 0, 1.f, 0);
    }
};

__device__ __forceinline__ void fox_scan(const Frame& F, int layer, int seqid) {
    const int tid = tid_l(), lane = tid & 63, wave = tid >> 6, b = seqid >> 2, h = seqid & 3;
    LAS float* sm = (LAS float*)F.lds;
    const float bias = F.fox_b[layer * 4 + h];
    float v[16]; float run = 0.f;
#pragma unroll
    for (int i = 0; i < 16; ++i) { const int s = tid * 16 + i; const float x = F.FF[(size_t)(b * SEQ + s) * 4 + h] + bias;
        const float ls = fminf(x, 0.f) - log1pf(expf(-fabsf(x))); run += ls; v[i] = run; }
    float incl = run;
#pragma unroll
    for (int o = 1; o < 64; o <<= 1) { const float t = __shfl_up(incl, o); if (lane >= o) incl += t; }
    if (lane == 63) sm[wave] = incl;
    __syncthreads();
    float woff = 0.f;
    for (int w = 0; w < wave; ++w) woff += sm[w];
    const float excl = woff + incl - run;
#pragma unroll
    for (int i = 0; i < 16; ++i) F.cum[(size_t)(b * 4 + h) * SEQ + tid * 16 + i] = (excl + v[i]) * LOG2E;
    __syncthreads();
}
__device__ __forceinline__ void idx_unit(const Frame& F, int unit) {
    const int b = unit / 576; int id = unit % 576; int g = 0;
    while (8 * (g + 1) * (g + 2) <= id) ++g;
    const int rem = id - 8 * g * (g + 1), qb = 16 * g + rem / (g + 1), kc = rem % (g + 1);
    const int tid = tid_l(), lane = tid & 63, wave = __builtin_amdgcn_readfirstlane(tid >> 6), n32 = lane & 31, hi = lane >> 5;
    const int tq0 = qb * 64 + wave * 8;
    const int qa = (n32 >> 2) & 1, ha = (n32 & 3) + 4 * (n32 >> 3);
    bf16x8 Af[4][4]; float wr_[4][16];
#pragma unroll
    for (int p = 0; p < 4; ++p) {
        const GA bf16_t* qp = F.IQ + (size_t)(b * SEQ + tq0 + 2 * p + qa) * 1024 + ha * 64 + hi * 8;
#pragma unroll
        for (int ks = 0; ks < 4; ++ks) Af[p][ks] = *(const GA bf16x8*)(qp + ks * 16);
        const GA float* wp = F.IW + (size_t)(b * SEQ + tq0 + 2 * p + hi) * 16;
#pragma unroll
        for (int q4 = 0; q4 < 4; ++q4) { const f32x4 w4 = *(const GA f32x4*)(wp + 4 * q4); wr_[p][4 * q4] = w4[0]; wr_[p][4 * q4 + 1] = w4[1]; wr_[p][4 * q4 + 2] = w4[2]; wr_[p][4 * q4 + 3] = w4[3]; }
    }
    const int smax = tq0 + 7;
    for (int j = 0; j < 32; ++j) {
        const int s0 = kc * 1024 + j * 32;
        if (s0 > smax) break;
        const GA bf16_t* kp = F.IK + (size_t)(b * SEQ + s0 + n32) * 64 + hi * 8;
        bf16x8 Bf[4];
#pragma unroll
        for (int ks = 0; ks < 4; ++ks) Bf[ks] = *(const GA bf16x8*)(kp + ks * 16);
#pragma unroll
        for (int p = 0; p < 4; ++p) {
            f32x16 c = {};
#pragma unroll
            for (int ks = 0; ks < 4; ++ks) c = __builtin_amdgcn_mfma_f32_32x32x16_bf16(Af[p][ks], Bf[ks], c, 0, 0, 0);
            float sc = 0.f;
#pragma unroll
            for (int r = 0; r < 16; ++r) sc = fmaf(wr_[p][r], fmaxf(c[r], 0.f), sc);
            F.sc[((size_t)(b * SEQ + tq0 + 2 * p + hi)) * SEQ + s0 + n32] = sc;
        }
    }
}

__device__ __forceinline__ unsigned sel_key(float f) { const unsigned u = __float_as_uint(f == 0.f ? 0.f : f); return (u >> 31) ? ~u : (u | 0x80000000u); }
__device__ __forceinline__ int wave_sum_i(int v) {
#pragma unroll
    for (int o = 32; o > 0; o >>= 1) v += __shfl_xor(v, o);
    return v;
}
__device__ __forceinline__ void select_row(const Frame& F, int row) {
    const int lane = tid_l() & 63, t = row & (SEQ - 1);
    GA u64* mrow = F.mask + (size_t)row * 128;
    if (t < 256) {
#pragma unroll
        for (int half = 0; half < 2; ++half) { const int j = half * 64 + lane; const int lo = j * 64; u64 w = 0ull;
            if (t >= lo + 63) w = ~0ull; else if (t >= lo) w = (~0ull) >> (63 - (t - lo));
            mrow[j] = w; }
        return;
    }
    const GA float* srow = F.sc + (size_t)row * SEQ + lane;
    const int nj = (t >> 6) + 1;
    unsigned key[128];
#pragma unroll
    for (int jj = 0; jj < 4; ++jj) {
        if (jj * 32 < nj) {
#pragma unroll
            for (int j = jj * 32; j < jj * 32 + 32; ++j) { const float v = srow[j * 64]; key[j] = (j * 64 + lane <= t) ? sel_key(v) : 0u; }
        } else {
#pragma unroll
            for (int j = jj * 32; j < jj * 32 + 32; ++j) key[j] = 0u;
        }
    }
    unsigned prefix = 0u; int cge = 1 << 30;
    for (int bit = 31; bit >= 0; --bit) {
        const unsigned cand = prefix | (1u << bit); int c = 0;
#pragma unroll
        for (int jj = 0; jj < 4; ++jj) {
            if (jj * 32 < nj) {
#pragma unroll
                for (int j = jj * 32; j < jj * 32 + 32; ++j) c += (key[j] >= cand) ? 1 : 0;
            }
        }
        c = wave_sum_i(c);
        if (c >= 256) { prefix = cand; cge = c; }
    }
    if (cge == 256) {
        for (int j = 0; j < nj; ++j) { const int s = j * 64 + lane; const float v_ = srow[j * 64]; const unsigned k = (s <= t) ? sel_key(v_) : 0u;
            const u64 word = __ballot(k >= prefix); if (lane == 0) mrow[j] = word; }
    } else {
        int cgt = 0;
        for (int j = 0; j < nj; ++j) { const int s = j * 64 + lane; const float v_ = srow[j * 64]; const unsigned k = (s <= t) ? sel_key(v_) : 0u; cgt += __popcll(__ballot(k > prefix)); }
        int need = 256 - cgt;
        for (int j = 0; j < nj; ++j) { const int s = j * 64 + lane; const float v_ = srow[j * 64]; const unsigned k = (s <= t) ? sel_key(v_) : 0u;
            u64 word = __ballot(k > prefix); u64 tm = __ballot(k == prefix);
            if (tm != 0ull && need > 0) { const int c = __popcll(tm);
                if (c <= need) { word |= tm; need -= c; }
                else { u64 selb = 0ull; for (int i = 0; i < need; ++i) { const u64 low = tm & (~tm + 1ull); selb |= low; tm ^= low; } word |= selb; need = 0; } }
            if (lane == 0) mrow[j] = word; }
    }
    for (int j = nj + lane; j < 128; j += 64) mrow[j] = 0ull;
}

namespace att {
typedef short s16x4 __attribute__((ext_vector_type(4)));
constexpr int D = 128, NW = 8, QBLK = 32, KVBLK = 64, QB = NW * QBLK;
constexpr int SHM_V = KVBLK * D * 2, SHM_K = KVBLK * D * 2;
constexpr int L_WS = 2 * SHM_V + 2 * SHM_K;
constexpr int L_AUX = L_WS + NW * 64 * 4;
constexpr int TB_PAD = 320, TB_N = TB_PAD + 1984;
constexpr int L_END = L_AUX + 8192 * 4;
constexpr float THR2 = 11.5f;
constexpr int FAR_DIST = 1513;

#define KSWZ(row, colB) ((row) * 256 + ((colB) ^ (((row) & 7) << 4)))
#define SBAR() __builtin_amdgcn_sched_barrier(0)
__device__ __forceinline__ int v_st(int k, int c) { const int kk = (k & ~0xC) | ((k & 4) << 1) | ((k & 8) >> 1); return ((kk >> 3) * 4 + (c >> 5)) * 512 + ((kk & 7) * 32 + (c & 31)) * 2; }
__device__ __forceinline__ int v_rd_base(int lane) { return ((lane & 3) << 3) | (((lane >> 2) & 3) << 6) | (((lane >> 4) & 1) << 5) | (((lane >> 5) & 1) << 8); }
constexpr int v_rd_off(int d0, int ks, int half) { return d0 * 512 + ks * 4096 + half * 2048; }
__device__ __forceinline__ int crow(int r, int hi) { return (r & 3) + 8 * (r >> 2) + 4 * hi; }
__device__ __forceinline__ bf16x8 load8(const GA bf16_t* p) { return *(const GA bf16x8*)p; }

__device__ __forceinline__ void mask_tile(f32x16& p0, f32x16& p1, int dq, unsigned W) {
    const float NEG = -__builtin_inff();
#pragma unroll
    for (int r = 0; r < 16; ++r) {
        const int c = (r & 3) + 8 * (r >> 2);
        if ((unsigned)(dq - c) >= W) p0[r] = NEG;
        if ((unsigned)(dq - c - 32) >= W) p1[r] = NEG;
    }
}
__device__ __forceinline__ void mask_bits(f32x16& p0, f32x16& p1, u64 w, int hi) {
    const float NEG = -__builtin_inff();
    unsigned w0 = (unsigned)w, w1 = (unsigned)(w >> 32);
    if (hi == 0) { w0 <<= 4; w1 <<= 4; }
#pragma unroll
    for (int g = 3; g >= 0; --g) {
#pragma unroll
        for (int q = 3; q >= 0; --q) {
            asm volatile("v_add_co_u32 %0, vcc, %0, %0\n\tv_cndmask_b32 %1, %2, %1, vcc" : "+v"(w0), "+v"(p0[4 * g + q]) : "v"(NEG) : "vcc");
            asm volatile("v_add_co_u32 %0, vcc, %0, %0\n\tv_cndmask_b32 %1, %2, %1, vcc" : "+v"(w1), "+v"(p1[4 * g + q]) : "v"(NEG) : "vcc");
        }
        w0 <<= 4; w1 <<= 4;
    }
}
__device__ __forceinline__ void partialSM(f32x16& p0, f32x16& p1, float& m_reg, float& mn, float& alpha) {
    float pmax = p0[0];
#pragma unroll
    for (int r = 1; r < 16; ++r) pmax = fmaxf(pmax, p0[r]);
#pragma unroll
    for (int r = 0; r < 16; ++r) pmax = fmaxf(pmax, p1[r]);
    { auto rr = __builtin_amdgcn_permlane32_swap(__float_as_uint(pmax), __float_as_uint(pmax), false, false);
      pmax = fmaxf(__uint_as_float(rr[0]), __uint_as_float(rr[1])); }
    if (__builtin_expect(__all((pmax - m_reg) <= THR2), 1)) { mn = m_reg; alpha = 1.f; }
    else { mn = fmaxf(m_reg, pmax); alpha = __builtin_amdgcn_exp2f(m_reg - mn); m_reg = mn; }
#pragma unroll
    for (int r = 0; r < 16; ++r) p0[r] = p0[r] - mn;
#pragma unroll
    for (int r = 0; r < 16; ++r) p1[r] = p1[r] - mn;
#pragma unroll
    for (int r = 0; r < 16; ++r) p0[r] = __builtin_amdgcn_exp2f(p0[r]);
}
__device__ __forceinline__ void finishSM(f32x16& p0, f32x16& p1, float alpha, float& l_reg, bf16x8& pa0, bf16x8& pa1, bf16x8& pa2, bf16x8& pa3) {
#pragma unroll
    for (int r = 0; r < 16; ++r) p1[r] = __builtin_amdgcn_exp2f(p1[r]);
    float ps = 0;
#pragma unroll
    for (int r = 0; r < 16; ++r) ps += p0[r];
#pragma unroll
    for (int r = 0; r < 16; ++r) ps += p1[r];
    { auto rr = __builtin_amdgcn_permlane32_swap(__float_as_uint(ps), __float_as_uint(ps), false, false);
      ps = __uint_as_float(rr[0]) + __uint_as_float(rr[1]); }
    l_reg = l_reg * alpha + ps;
#define PK4(P, B_, OUT) do { unsigned a0 = cvt_pk_bf16(P[B_+0], P[B_+1]), a1 = cvt_pk_bf16(P[B_+2], P[B_+3]);                          \
        unsigned b0 = cvt_pk_bf16(P[B_+4], P[B_+5]), b1 = cvt_pk_bf16(P[B_+6], P[B_+7]);                                             \
        auto r0 = __builtin_amdgcn_permlane32_swap(a0, b0, false, false); auto r1 = __builtin_amdgcn_permlane32_swap(a1, b1, false, false); \
        u32x4 w = {r0[0], r1[0], r0[1], r1[1]}; OUT = *reinterpret_cast<bf16x8*>(&w); } while (0)
    PK4(p0, 0, pa0); PK4(p0, 8, pa1); PK4(p1, 0, pa2); PK4(p1, 8, pa3);
#undef PK4
}
template <int KB, int NQ>
__device__ __forceinline__ void qkt(f32x16& p0, f32x16& p1, const LAS char* K_lds, int r32, int hi, const bf16x8* qr, int koff) {
    p0 = f32x16{}; p1 = f32x16{};
    const LAS char* kb[4];
#pragma unroll
    for (int dd = 0; dd < 4; ++dd) kb[dd] = K_lds + KB * SHM_K + KSWZ(r32, (dd * 16 + hi * 8) * 2) + koff;
#pragma unroll
    for (int d0 = 0; d0 < NQ; ++d0) { const LAS char* a = kb[d0 & 3] + (d0 >> 2) * 128;
        bf16x8 b0 = *(const LAS bf16x8*)a;
        bf16x8 b1 = *(const LAS bf16x8*)(a + 32 * 256);
        p0 = __builtin_amdgcn_mfma_f32_32x32x16_bf16(b0, qr[d0], p0, 0, 0, 0);
        p1 = __builtin_amdgcn_mfma_f32_32x32x16_bf16(b1, qr[d0], p1, 0, 0, 0); }
}
template <int VB>
__device__ __forceinline__ void pv_tile(f32x16* o, int vb0, bf16x8 pa0, bf16x8 pa1, bf16x8 pa2, bf16x8 pa3) {
#define TRRD(dst, off) asm volatile("ds_read_b64_tr_b16 %0, %1 offset:%2" : "=&v"(dst) : "v"(vb0), "i"(off) : "memory")
#define PV_D0(d0) do { s16x4 l0, l1, l2, l3, h0, h1, h2, h3; constexpr int b_ = VB * SHM_V + v_rd_off(d0, 0, 0); \
        TRRD(l0, b_); TRRD(h0, b_ + 2048); TRRD(l1, b_ + 4096); TRRD(h1, b_ + 6144); TRRD(l2, b_ + 8192); TRRD(h2, b_ + 10240); TRRD(l3, b_ + 12288); TRRD(h3, b_ + 14336); \
        asm volatile("s_waitcnt lgkmcnt(0)" ::: "memory"); SBAR();   \
        o[d0] = __builtin_amdgcn_mfma_f32_32x32x16_bf16(pa0, (bf16x8){l0[0], l0[1], l0[2], l0[3], h0[0], h0[1], h0[2], h0[3]}, o[d0], 0, 0, 0);   \
        o[d0] = __builtin_amdgcn_mfma_f32_32x32x16_bf16(pa1, (bf16x8){l1[0], l1[1], l1[2], l1[3], h1[0], h1[1], h1[2], h1[3]}, o[d0], 0, 0, 0);   \
        o[d0] = __builtin_amdgcn_mfma_f32_32x32x16_bf16(pa2, (bf16x8){l2[0], l2[1], l2[2], l2[3], h2[0], h2[1], h2[2], h2[3]}, o[d0], 0, 0, 0);   \
        o[d0] = __builtin_amdgcn_mfma_f32_32x32x16_bf16(pa3, (bf16x8){l3[0], l3[1], l3[2], l3[3], h3[0], h3[1], h3[2], h3[3]}, o[d0], 0, 0, 0); } while (0)
    PV_D0(0); PV_D0(1); PV_D0(2); PV_D0(3);
#undef PV_D0
#undef TRRD
}
__device__ __forceinline__ void bias_dist(f32x16& p0, f32x16& p1, const LAS char* tbase) {
#pragma unroll
    for (int r = 0; r < 16; ++r) { const int c = (r & 3) + 8 * (r >> 2);
        p0[r] += *(const LAS float*)(tbase + (59 - c) * 4);
        p1[r] += *(const LAS float*)(tbase + (27 - c) * 4); }
}
__device__ __forceinline__ void bias_const(f32x16& p0, f32x16& p1, float c) {
#pragma unroll
    for (int r = 0; r < 16; ++r) { p0[r] += c; p1[r] += c; }
}
__device__ __forceinline__ void bias_key(f32x16& p0, f32x16& p1, const LAS char* kbase) {
#pragma unroll
    for (int g = 0; g < 4; ++g) { const f32x4 a = *(const LAS f32x4*)(kbase + (8 * g) * 4), b = *(const LAS f32x4*)(kbase + (32 + 8 * g) * 4);
#pragma unroll
        for (int q = 0; q < 4; ++q) { p0[4 * g + q] -= a[q]; p1[4 * g + q] -= b[q]; } }
}

struct Blk { const GA bf16_t* Q; const GA bf16_t* K; const GA bf16_t* V; int P0; int rs; };
struct Aux { const GA float* tb; int dscale; const GA float* cum; const GA u64* mrow0; };

__device__ __forceinline__ int swa_jlo(int P0, int W) { const int lowk = P0 - W + 1; return lowk > 0 ? lowk / KVBLK : 0; }

template <int MODE, int NQ>
__device__ __forceinline__ void attn_block(const Blk& cur, int skv, int W, int koff, const Aux& ax, LAS char* lds, f32x16 (&o)[4], float& m_out, float& l_out) {
    const int tid = tid_l(), wid = __builtin_amdgcn_readfirstlane(tid >> 6), lane = tid & 63, r32 = lane & 31, hi = lane >> 5;
    const int rs = cur.rs;
    const int j_lo = swa_jlo(cur.P0, W);
    int j_hi = (cur.P0 + QB - 1) / KVBLK + 1; if (j_hi > skv / KVBLK) j_hi = skv / KVBLK;
    const int NT = j_hi - j_lo;
    const int qlo = cur.P0 + wid * QBLK, qm = qlo + r32 - 4 * hi;
    LAS char* V_lds = lds; LAS char* K_lds = lds + 2 * SHM_V;
    LAS float* ws = (LAS float*)(lds + L_WS) + wid * 64; LAS float* li_l = ws; LAS float* al_l = ws + 32;
    LAS float* auxl = (LAS float*)(lds + L_AUX);
    float m_reg = -1e30f, l_reg = 0;
#pragma unroll
    for (int d_ = 0; d_ < 4; ++d_) o[d_] = f32x16{};
    const int sr = tid >> 4, sc = (tid & 15) * 8, vst0 = v_st(sr, sc), vst1 = v_st(32 + sr, sc), kws = KSWZ(sr, sc * 2);
    const int vb0 = (int)(unsigned)(uintptr_t)V_lds + v_rd_base(lane);
    const GA bf16_t* Kh = cur.K; const GA bf16_t* Vh = cur.V;
    bf16x8 qr[NQ]; bf16x8 st_v0, st_v1, st_k0, st_k1;
#define ROW(p, k0, rr) ((p) + (size_t)((k0) + (rr)) * rs + sc)
#define VMW() asm volatile("s_waitcnt vmcnt(0)" ::: "memory")
#define SLOAD_H(Kp, Vp, k0) do { st_v0 = load8(ROW(Vp, k0, sr)); st_v1 = load8(ROW(Vp, k0, 32 + sr));              \
                                 st_k0 = load8(ROW(Kp, k0, sr)); st_k1 = load8(ROW(Kp, k0, 32 + sr)); } while (0)
#define SWRITE_HK(bf) do { *(LAS bf16x8*)(K_lds + (bf) * SHM_K + kws) = st_k0; *(LAS bf16x8*)(K_lds + (bf) * SHM_K + kws + 32 * 256) = st_k1; } while (0)
#define SWRITE_HV(bf) do { *(LAS bf16x8*)(V_lds + (bf) * SHM_V + vst0) = st_v0; *(LAS bf16x8*)(V_lds + (bf) * SHM_V + vst1) = st_v1; } while (0)
#define SWRITE_H(bf) do { SWRITE_HV(bf); SWRITE_HK(bf); } while (0)
#define RESC(a) do { if (__any((a) < 1.f)) { if (hi == 0) al_l[r32] = (a); asm volatile("s_waitcnt lgkmcnt(0)" ::: "memory");              \
                     for (int d_ = 0; d_ < 4; ++d_) for (int r = 0; r < 16; ++r) o[d_][r] *= al_l[crow(r, hi)]; } } while (0)
#define KBASE(t) ((j_lo + (t)) * KVBLK)
    {
        const int kb0 = j_lo * KVBLK;
#pragma unroll
        for (int d0 = 0; d0 < NQ; ++d0) qr[d0] = load8(cur.Q + (size_t)(wid * QBLK + r32) * rs + d0 * 16 + hi * 8);
        SLOAD_H(Kh, Vh, kb0);
        if (MODE == 1) { for (int i = tid; i < cur.P0 + QB; i += 512) auxl[i] = ax.cum[i]; }
        else { for (int i = tid; i < TB_N; i += 512) { int d = i - TB_PAD; d = d < 0 ? 0 : d; auxl[i] = ax.tb[d * ax.dscale]; } }
        VMW(); SWRITE_HK(0); SWRITE_HV(0);
        __syncthreads();
    }
    const float cfar = (MODE == 0 || MODE == 2) ? ax.tb[FAR_DIST] : 0.f;
#define BIASMASK(P0_, P1_, t) do { const int kb_ = KBASE(t);                                                                           \
        if (MODE == 1) { bias_key(P0_, P1_, (const LAS char*)(auxl + kb_ + 4 * hi)); }                                                       \
        else if (MODE == 3) { bias_dist(P0_, P1_, (const LAS char*)(auxl + (qm - kb_ - 59 + TB_PAD))); }                                     \
        else { if (cur.P0 - kb_ - 63 >= FAR_DIST) bias_const(P0_, P1_, cfar); else bias_dist(P0_, P1_, (const LAS char*)(auxl + (qm - kb_ - 59 + TB_PAD))); } \
        if (MODE == 0) { mask_bits(P0_, P1_, mw, hi); }                                                                                  \
        else if (kb_ + KVBLK - 1 > qlo || kb_ <= qlo + QBLK - 1 - W) mask_tile(P0_, P1_, qm - kb_, (unsigned)W); } while (0)
#define MLOAD(t) do { if (MODE == 0) mw = ax.mrow0[(size_t)(wid * QBLK + r32) * 128 + (KBASE(t) >> 6)]; } while (0)
    f32x16 pA0, pA1, pB0, pB1; float mnA, mnB, alA, alB; bf16x8 pa0, pa1, pa2, pa3; u64 mw = 0ull;
    if (NT > 1) SLOAD_H(Kh, Vh, KBASE(1));
    MLOAD(0);
    SBAR(); qkt<0, NQ>(pA0, pA1, K_lds, r32, hi, qr, koff);
    BIASMASK(pA0, pA1, 0); partialSM(pA0, pA1, m_reg, mnA, alA);
    if (NT > 1) { VMW(); SWRITE_H(1); }
    __syncthreads();
#define HALF_STEP(PX0, PX1, mnX, alX, PY0, PY1, alY, t, KB, VB, SB) do {                                                      \
        MLOAD(t);                                                                                                             \
        SBAR(); qkt<KB, NQ>(PX0, PX1, K_lds, r32, hi, qr, koff);                                                              \
        finishSM(PY0, PY1, alY, l_reg, pa0, pa1, pa2, pa3); SBAR();                                                           \
        if ((t) + 1 < NT) { SLOAD_H(Kh, Vh, KBASE((t) + 1)); SBAR(); }                                                        \
        pv_tile<VB>(o, vb0, pa0, pa1, pa2, pa3); BIASMASK(PX0, PX1, (t)); partialSM(PX0, PX1, m_reg, mnX, alX);               \
        __syncthreads();                                                                                                      \
        if ((t) + 1 < NT) { VMW(); SWRITE_H(SB); }                                                                            \
        RESC(alX); __syncthreads(); } while (0)
    for (int t = 1; t + 1 < NT; t += 2) {
        HALF_STEP(pB0, pB1, mnB, alB, pA0, pA1, alA, t, 1, 0, 0);
        HALF_STEP(pA0, pA1, mnA, alA, pB0, pB1, alB, t + 1, 0, 1, 1);
    }
    const bool even = (NT & 1) == 0;
    if (even) { MLOAD(NT - 1); SBAR(); qkt<1, NQ>(pB0, pB1, K_lds, r32, hi, qr, koff); SBAR(); }
    finishSM(pA0, pA1, alA, l_reg, pa0, pa1, pa2, pa3); SBAR();
    pv_tile<0>(o, vb0, pa0, pa1, pa2, pa3);
    if (even) { BIASMASK(pB0, pB1, NT - 1); partialSM(pB0, pB1, m_reg, mnB, alB); __syncthreads(); RESC(alB);
        finishSM(pB0, pB1, alB, l_reg, pa0, pa1, pa2, pa3); SBAR(); pv_tile<1>(o, vb0, pa0, pa1, pa2, pa3); }
    if (hi == 0) li_l[r32] = l_reg; asm volatile("s_waitcnt lgkmcnt(0)" ::: "memory");
#pragma unroll
    for (int r = 0; r < 16; ++r) { const float rl = __builtin_amdgcn_rcpf(li_l[crow(r, hi)]);
#pragma unroll
        for (int d0 = 0; d0 < 4; ++d0) o[d0][r] *= rl; }
    m_out = m_reg; l_out = l_reg;
    __syncthreads();
#undef ROW
#undef VMW
#undef SLOAD_H
#undef SWRITE_HK
#undef SWRITE_HV
#undef SWRITE_H
#undef RESC
#undef KBASE
#undef BIASMASK
#undef MLOAD
#undef HALF_STEP
}
#undef KSWZ
}

__device__ __forceinline__ void store_y(const GA bf16_t* Zs, GA bf16_t* Y, const f32x16 (&o)[4], int row0w, int colbase, int r32, int hi) {
#pragma unroll
    for (int r = 0; r < 16; ++r) { const size_t off = (size_t)(row0w + att::crow(r, hi)) * DM + colbase + r32;
#pragma unroll
        for (int d0 = 0; d0 < 4; ++d0) { const float v = o[d0][r] * bf2f(Zs[off + d0 * 32]); const float vn = __shfl_xor(v, 1);
            if ((r32 & 1) == 0) *(GA unsigned*)(Y + off + d0 * 32) = cvt_pk_bf16(v, vn); } }
}
template <int MODE>
__device__ __forceinline__ void attn_fast_unit(const Frame& F, int b, int h, int qb) {
    const int mixer = MODE;
    const size_t hb = ((size_t)(b * 4 + h) * SEQ) * 128;
    att::Blk cur{F.QKV + (size_t)(mixer * 3 + 0) * QS + hb + (size_t)qb * 256 * 128, F.QKV + (size_t)(mixer * 3 + 1) * QS + hb, F.QKV + (size_t)(mixer * 3 + 2) * QS + hb, qb * 256, 128};
    att::Aux ax{F.tb + (size_t)h * SEQ, 1, F.cum + (size_t)(b * 4 + h) * SEQ, F.mask + (size_t)(b * SEQ + qb * 256) * 128};
    f32x16 o[4]; float m_, l_;
    att::attn_block<MODE, 8>(cur, SEQ, SEQ, 0, ax, (LAS char*)F.lds, o, m_, l_);
    const int tid = tid_l(), wid = tid >> 6, lane = tid & 63;
    GA unsigned char* w2 = launder(F.ws);
    store_y((const GA bf16_t*)(w2 + WS_ZS), (GA bf16_t*)(w2 + WS_Y), o, b * SEQ + qb * 256 + wid * 32, mixer * 512 + h * 128, lane & 31, lane >> 5);
}

__device__ __forceinline__ void attn_diff_unit(const Frame& F, int layer, int b, int h, int qb) {
    const size_t hb = ((size_t)(b * 4 + h) * SEQ) * 128;
    const GA bf16_t* Qc = F.QKV + (size_t)(2 * 3 + 0) * QS + hb + (size_t)qb * 256 * 128; const GA bf16_t* Kc = F.QKV + (size_t)(2 * 3 + 1) * QS + hb; const GA bf16_t* Vc = F.QKV + (size_t)(2 * 3 + 2) * QS + hb;
    att::Aux ax{F.tb + (size_t)(4 + h) * SEQ, 1, (const GA float*)nullptr, (const GA u64*)nullptr};
    f32x16 o[4]; float m_, l_;
    for (int c = 0; c < 2; ++c) {
        att::Blk cur{Qc + c * 64, Kc, Vc, qb * 256, 128};
        att::attn_block<2, 4>(cur, SEQ, SEQ, c * 128, ax, (LAS char*)F.lds, o, m_, l_);
        if (c == 0) { GA float* stash = (GA float*)(launder(F.ws) + WS_O1) + (size_t)blockIdx.x * 64 * 512 + tid_l();
#pragma unroll
            for (int d0 = 0; d0 < 4; ++d0)
#pragma unroll
                for (int r = 0; r < 16; ++r) stash[(d0 * 16 + r) * 512] = o[d0][r]; }
    }
    const int tid = tid_l(), wid = tid >> 6, lane = tid & 63, r32 = lane & 31, hi = lane >> 5;
    GA unsigned char* w2 = launder(F.ws);
    const GA float* stash = (const GA float*)(w2 + WS_O1) + (size_t)blockIdx.x * 64 * 512 + tid;
    const GA float* dp = (const GA float*)(w2 + WS_DP) + layer * 256;
    const float lam = dp[0];
#pragma unroll
    for (int r = 0; r < 16; ++r) {
        float ss = 0.f;
#pragma unroll
        for (int d0 = 0; d0 < 4; ++d0) { const float v = stash[(d0 * 16 + r) * 512] - lam * o[d0][r]; o[d0][r] = v; ss = fmaf(v, v, ss); }
        ss += __shfl_xor(ss, 1); ss += __shfl_xor(ss, 2); ss += __shfl_xor(ss, 4); ss += __shfl_xor(ss, 8); ss += __shfl_xor(ss, 16);
        const float rn = rsqrtf(ss * (1.0f / 128.0f) + RMS_EPS);
#pragma unroll
        for (int d0 = 0; d0 < 4; ++d0) o[d0][r] = o[d0][r] * rn;
        asm volatile("" ::: "memory");
    }
#pragma unroll
    for (int d0 = 0; d0 < 4; ++d0) { const float sw = dp[128 + d0 * 32 + r32];
#pragma unroll
        for (int r = 0; r < 16; ++r) o[d0][r] *= sw; }
    store_y((const GA bf16_t*)(w2 + WS_ZS), (GA bf16_t*)(w2 + WS_Y), o, b * SEQ + qb * 256 + wid * 32, 2 * 512 + h * 128, r32, hi);
}
__device__ __forceinline__ void attn_dil_unit(const Frame& F, int u) {
    const int cfg = u >> 8, v = u & 255, b = v & 1, h = (v >> 1) & 3, x = v >> 3;
    const int dl = (cfg == 0) ? 1 : (cfg == 1 ? 4 : 16);
    const int rho = (cfg == 0) ? 0 : (cfg == 1 ? (x & 3) : (x & 15)), qb = (cfg == 0) ? x : (cfg == 1 ? (x >> 2) : (x >> 4));
    const size_t hb = ((size_t)(b * 4 + h) * SEQ) * 128;
    const GA bf16_t* Qd = F.QKV + (size_t)(3 * 3 + 0) * QS + hb; const GA bf16_t* Kd = F.QKV + (size_t)(3 * 3 + 1) * QS + hb; const GA bf16_t* Vd = F.QKV + (size_t)(3 * 3 + 2) * QS + hb;
    att::Blk cur{Qd + (size_t)(rho + dl * qb * 256) * 128, Kd + (size_t)rho * 128, Vd + (size_t)rho * 128, qb * 256, 128 * dl};
    att::Aux ax{F.tb + (size_t)(8 + h) * SEQ, dl, (const GA float*)nullptr, (const GA u64*)nullptr};
    f32x16 o[4]; float m_, l_;
    att::attn_block<3, 8>(cur, SEQ / dl, 129, 0, ax, (LAS char*)F.lds, o, m_, l_);
    const int tid = tid_l(), wid = tid >> 6, lane = tid & 63, r32 = lane & 31, hi = lane >> 5;
    GA unsigned char* w2 = launder(F.ws);
    GA float* od = (GA float*)(w2 + WS_OD) + (size_t)cfg * MT * 512;
#pragma unroll
    for (int r = 0; r < 16; ++r) { const size_t row = (size_t)b * SEQ + rho + (size_t)dl * (qb * 256 + wid * 32 + att::crow(r, hi));
#pragma unroll
        for (int d0 = 0; d0 < 4; ++d0) od[row * 512 + h * 128 + d0 * 32 + r32] = o[d0][r]; }
    if (hi == 0) { const size_t row = (size_t)b * SEQ + rho + (size_t)dl * (qb * 256 + wid * 32 + r32);
        ((GA float*)(w2 + WS_LSE))[((size_t)cfg * MT + row) * 4 + h] = m_ + __builtin_amdgcn_logf(l_); }
}
__device__ __forceinline__ void dil_merge_unit(const Frame& F, int u) {
    const int tid = tid_l(), row = u * 32 + (tid >> 4), cg = tid & 15, h = cg >> 2, col = cg * 32;
    const float l0 = F.LSE[((size_t)0 * MT + row) * 4 + h], l1 = F.LSE[((size_t)1 * MT + row) * 4 + h], l2 = F.LSE[((size_t)2 * MT + row) * 4 + h];
    const float mx = fmaxf(l0, fmaxf(l1, l2)); float w0 = ex2(l0 - mx), w1 = ex2(l1 - mx), w2 = ex2(l2 - mx); const float inv = 1.0f / (w0 + w1 + w2); w0 *= inv; w1 *= inv; w2 *= inv;
    const GA float* p0 = F.OD + ((size_t)0 * MT + row) * 512 + col; const GA float* p1 = F.OD + ((size_t)1 * MT + row) * 512 + col; const GA float* p2 = F.OD + ((size_t)2 * MT + row) * 512 + col;
    const size_t yo = (size_t)row * DM + 3 * 512 + col;
#pragma unroll
    for (int i = 0; i < 4; ++i) {
        const f32x4 a0 = *(const GA f32x4*)(p0 + 8 * i), a1 = *(const GA f32x4*)(p0 + 8 * i + 4), b0 = *(const GA f32x4*)(p1 + 8 * i), b1 = *(const GA f32x4*)(p1 + 8 * i + 4), c0 = *(const GA f32x4*)(p2 + 8 * i), c1 = *(const GA f32x4*)(p2 + 8 * i + 4);
        const u32x4 zw = *(const GA u32x4*)(F.Zs + yo + 8 * i);
        const f32x4 v0 = a0 * w0 + b0 * w1 + c0 * w2, v1 = a1 * w0 + b1 * w1 + c1 * w2;
        u32x4 w = {cvt_pk_bf16(v0[0] * bf_lo(zw[0]), v0[1] * bf_hi(zw[0])), cvt_pk_bf16(v0[2] * bf_lo(zw[1]), v0[3] * bf_hi(zw[1])),
                   cvt_pk_bf16(v1[0] * bf_lo(zw[2]), v1[1] * bf_hi(zw[2])), cvt_pk_bf16(v1[2] * bf_lo(zw[3]), v1[3] * bf_hi(zw[3]))};
        *(GA u32x4*)(F.Y + yo + 8 * i) = w; }
}

struct EpiMerged {
    static constexpr bool PERM = true, AFTER_DRAIN = false, MIDK = true;
    const GA bf16_t* G; GA bf16_t* MG;
    __device__ __forceinline__ void mid(f32x4 (&acc)[2][2][4][2], const pg8::Unit& u, int bnext, int wr, int wc, int fr, int fq) const {
        const int row0 = u.pm * 256 + wr * 64 + fr, c0 = u.pn * 256 + wc * 32 + 8 * fq;
#pragma unroll
        for (int ai = 0; ai < 2; ++ai)
#pragma unroll
            for (int m = 0; m < 4; ++m) { const GA bf16_t* gp = G + (size_t)(row0 + ai * 128 + m * 16) * 8192 + c0;
#pragma unroll
                for (int bj = 0; bj < 2; ++bj) {
                    const u32x4 num = *(const GA u32x4*)(gp + (bnext - 1) * DM + bj * 128), den = *(const GA u32x4*)(gp + bnext * DM + bj * 128);
#pragma unroll
                    for (int j = 0; j < 2; ++j) {
                        acc[ai][bj][m][0][2 * j]     *= bf_lo(num[j]) * __builtin_amdgcn_rcpf(bf_lo(den[j]));
                        acc[ai][bj][m][0][2 * j + 1] *= bf_hi(num[j]) * __builtin_amdgcn_rcpf(bf_hi(den[j]));
                        acc[ai][bj][m][1][2 * j]     *= bf_lo(num[2 + j]) * __builtin_amdgcn_rcpf(bf_lo(den[2 + j]));
                        acc[ai][bj][m][1][2 * j + 1] *= bf_hi(num[2 + j]) * __builtin_amdgcn_rcpf(bf_hi(den[2 + j])); } } }
    }
    __device__ __forceinline__ void operator()(const f32x4 (&acc)[2][2][4][2], const pg8::Unit& u, int wr, int wc, int fr, int fq) const {
        const int row0 = u.pm * 256 + wr * 64 + fr, c0 = u.pn * 256 + wc * 32 + 8 * fq;
#pragma unroll
        for (int ai = 0; ai < 2; ++ai)
#pragma unroll
            for (int m = 0; m < 4; ++m) { const int r = row0 + ai * 128 + m * 16;
#pragma unroll
                for (int bj = 0; bj < 2; ++bj) { const u32x4 g3 = *(const GA u32x4*)(G + (size_t)r * 8192 + 3 * DM + c0 + bj * 128);
                    const f32x4 v0 = acc[ai][bj][m][0], v1 = acc[ai][bj][m][1];
                    u32x4 w = {cvt_pk_bf16(v0[0] * bf_lo(g3[0]), v0[1] * bf_hi(g3[0])), cvt_pk_bf16(v0[2] * bf_lo(g3[1]), v0[3] * bf_hi(g3[1])),
                               cvt_pk_bf16(v1[0] * bf_lo(g3[2]), v1[1] * bf_hi(g3[2])), cvt_pk_bf16(v1[2] * bf_lo(g3[3]), v1[3] * bf_hi(g3[3]))};
                    *(GA u32x4*)(MG + (size_t)r * DM + c0 + bj * 128) = w; } }
    }
};

struct EpiOut {
    static constexpr bool PERM = false, AFTER_DRAIN = false, MIDK = false;
    GA float* xres; GA bf16_t* xb; GA float* ssq;
    __device__ __forceinline__ void operator()(const f32x4 (&acc)[2][2][4][2], const pg8::Unit& u, int wr, int wc, int fr, int fq) const {
        const int row0 = u.pm * 256 + wr * 64 + fr, col0 = u.pn * 256 + wc * 32 + 4 * fq;
#pragma unroll
        for (int ai = 0; ai < 2; ++ai)
#pragma unroll
            for (int m = 0; m < 4; ++m) { const int r = row0 + ai * 128 + m * 16; float ss = 0.f;
#pragma unroll
                for (int bj = 0; bj < 2; ++bj)
#pragma unroll
                    for (int n = 0; n < 2; ++n) { const size_t off = (size_t)r * DM + col0 + bj * 128 + n * 16;
                        f32x4 v = *(const GA f32x4*)(xres + off) + acc[ai][bj][m][n];
                        *(GA f32x4*)(xres + off) = v; ss += v[0] * v[0] + v[1] * v[1] + v[2] * v[2] + v[3] * v[3];
                        u32x2 w = {cvt_pk_bf16(v[0], v[1]), cvt_pk_bf16(v[2], v[3])}; *(GA u32x2*)(xb + off) = w; }
                ss += __shfl_xor(ss, 16); ss += __shfl_xor(ss, 32);
                if (fq == 0) ssq[(size_t)r * 32 + u.pn * 4 + wc] = ss; }
    }
};

__device__ __forceinline__ void final_norm(const Frame& F) {
    const int tid = tid_l(), lane = tid & 63, wave = tid >> 6, G = gridDim.x, bid = blockIdx.x;
    for (int row = bid * 8 + wave; row < MT; row += G * 8) {
        float ss = (lane < 32) ? F.ssq[(size_t)row * 32 + lane] : 0.f; ss = wave_sum(ss);
        const float rs = rsqrtf(ss * (1.0f / DM) + RMS_EPS);
#pragma unroll
        for (int i = 0; i < 8; ++i) { const int c = (i * 64 + lane) * 4; const f32x4 v = *(const GA f32x4*)(F.xres + (size_t)row * DM + c), w = *(const GA f32x4*)(F.final_w + c);
            *(GA f32x4*)(F.out + (size_t)row * DM + c) = v * rs * w; }
    }
}

__device__ __forceinline__ Frame mkframe(const Args& args, GA unsigned char* ws, LAS unsigned char* lds) {
    Frame F;
    F.x = (const GA float*)args.in[0]; F.norm_w = (const GA float*)args.in[1]; F.w_in = (const GA float*)args.in[2]; F.fox_b = (const GA float*)args.in[3];
    F.lq1 = (const GA float*)args.in[4]; F.lk1 = (const GA float*)args.in[5]; F.lq2 = (const GA float*)args.in[6]; F.lk2 = (const GA float*)args.in[7];
    F.subln = (const GA float*)args.in[8]; F.w_branch = (const GA float*)args.in[9]; F.w_out = (const GA float*)args.in[10]; F.rel_bias = (const GA float*)args.in[11];
    F.final_w = (const GA float*)args.in[12]; F.out = (GA float*)args.out;
    F.ctl = (GA unsigned*)(ws + WS_CTL); F.WinT = (GA bf16_t*)(ws + WS_WIN); F.WbrT = (GA bf16_t*)(ws + WS_WBR); F.WoutT = (GA bf16_t*)(ws + WS_WOUT);
    F.xres = (GA float*)(ws + WS_XRES); F.xb = (GA bf16_t*)(ws + WS_XB); F.ssq = (GA float*)(ws + WS_SSQ); F.Zs = (GA bf16_t*)(ws + WS_ZS); F.G = (GA bf16_t*)(ws + WS_G);
    F.QKV = (GA bf16_t*)(ws + WS_QKV); F.IQ = (GA bf16_t*)(ws + WS_IQ); F.IK = (GA bf16_t*)(ws + WS_IK); F.IW = (GA float*)(ws + WS_IW); F.FF = (GA float*)(ws + WS_FF);
    F.cum = (GA float*)(ws + WS_CUM); F.tb = (GA float*)(ws + WS_TB); F.sc = (GA float*)(ws + WS_SC); F.mask = (GA u64*)(ws + WS_MASK); F.Y = (GA bf16_t*)(ws + WS_Y); F.MG = (GA bf16_t*)(ws + WS_MG);
    F.O1 = (GA float*)(ws + WS_O1); F.OD = (GA float*)(ws + WS_OD); F.LSE = (GA float*)(ws + WS_LSE); F.DP = (GA float*)(ws + WS_DP); F.ws = ws;
    F.lds = lds; F.misc = (volatile LAS unsigned*)(lds + LDS_MISC);
    return F;
}

__global__ void __launch_bounds__(512, 2) fwd(Args args) {
    extern __shared__ __attribute__((aligned(16))) unsigned char lds[];
    LAS unsigned char* ldsl = (LAS unsigned char*)lds;
    if (threadIdx.x < 64) ((volatile LAS unsigned*)(ldsl + LDS_MISC))[threadIdx.x] = 0u;
    __syncthreads();
    const int lo = args.ph_lo, hi = args.ph_hi;
    const bool fused = (hi - lo) > 1;
    XcdBarrier bar; bar.bar = (unsigned*)(args.ws + WS_CTL) + CW_BAR; bar.x = 0; bar.st = (volatile LAS unsigned*)(ldsl + LDS_MISC);
    if (fused) bar = xcd_barrier_post((unsigned*)(args.ws + WS_CTL) + CW_BAR, (volatile LAS unsigned*)(ldsl + LDS_MISC));
#ifndef PH_EN
#define PH_EN 0xff
#endif
#define IN(k) (lo <= (k) && (k) < hi)
#define SEAM(k) do { if (IN((k) + 1)) xcd_barrier(bar); } while (0)
    const int G = gridDim.x, bid = blockIdx.x;

    if ((PH_EN & 1) && IN(0)) { const Frame F = mkframe(args, launder(args.ws), ldsl); p0_prologue(F); SEAM(0); }

    for (int layer = 0; layer < DEPTH; ++layer) {
        const int pb = 1 + 6 * layer;
        if ((PH_EN & 2) && IN(pb)) {
            GA unsigned char* ws = launder(args.ws);
            pg8::Gemm g{(const GA bf16_t*)(ws + WS_XB), (const GA bf16_t*)(ws + WS_WIN) + (size_t)layer * NINP * DM, MT, NINP, DM}; pg8::StaticOrder S; S.init(MT, NINP, G, bid);
            EpiIn E{ws};
            pg8::gemm_phase<EpiIn, pg8::StaticOrder>(ldsl, g, S, E);
            SEAM(pb);
        }
        if ((PH_EN & 4) && IN(pb + 1)) {
            const Frame F = mkframe(args, launder(args.ws), ldsl);
            if (bid < 8) fox_scan(F, layer, bid);
            GA unsigned* ctr = F.ctl + CW_Q + 64 * (layer * 4 + 0);
            for (int u = q_next(ctr, F.misc + 4); u < 2 * 576; u = q_next(ctr, F.misc + 4)) idx_unit(F, 2 * 576 - 1 - u);
            SEAM(pb + 1);
        }
        if ((PH_EN & 8) && IN(pb + 2)) {
            const Frame F = mkframe(args, launder(args.ws), ldsl);
            const int wave = tid_l() >> 6;
            GA unsigned* ctr = F.ctl + CW_Q + 64 * (layer * 4 + 2);
            for (int u = q_next(ctr, F.misc + 4); u < 768 + 2048; u = q_next(ctr, F.misc + 4)) {
                if (u < 768) attn_dil_unit(F, u);
                else { const int r = (u - 768) * 8 + wave; const int rr = (r & 1) ? (MT - 1 - (r >> 1)) : (r >> 1);
                    select_row(F, rr); }
            }
            SEAM(pb + 2);
        }
        if ((PH_EN & 16) && IN(pb + 3)) {
            const Frame F = mkframe(args, launder(args.ws), ldsl);
            GA unsigned* ctr = F.ctl + CW_Q + 64 * (layer * 4 + 1);
            for (int u = q_next(ctr, F.misc + 4); u < 256 + 512 + 512; u = q_next(ctr, F.misc + 4)) {
                if (u < 256) { const int qb = 31 - (u >> 3), r = u & 7; attn_diff_unit(F, layer, r & 1, r >> 1, qb); }
                else if (u < 768) { const int v = u - 256, qb = 31 - (v >> 4), r = v & 15, mode = r & 1, b = (r >> 1) & 1, h = r >> 2;
                    if (mode == 0) attn_fast_unit<0>(F, b, h, qb); else attn_fast_unit<1>(F, b, h, qb); }
                else dil_merge_unit(F, u - 768);
            }
            SEAM(pb + 3);
        }
        if ((PH_EN & 32) && IN(pb + 4)) {
            GA unsigned char* ws = launder(args.ws);
            pg8::Gemm g{(const GA bf16_t*)(ws + WS_Y), (const GA bf16_t*)(ws + WS_WBR) + (size_t)layer * DM * DM, MT, DM, DM}; pg8::StaticOrder S; S.init(MT, DM, G, bid);
            EpiMerged E{(const GA bf16_t*)(ws + WS_G), (GA bf16_t*)(ws + WS_MG)};
            pg8::gemm_phase<EpiMerged, pg8::StaticOrder>(ldsl, g, S, E);
            SEAM(pb + 4);
        }
        if ((PH_EN & 64) && IN(pb + 5)) {
            GA unsigned char* ws = launder(args.ws);
            pg8::Gemm g{(const GA bf16_t*)(ws + WS_MG), (const GA bf16_t*)(ws + WS_WOUT) + (size_t)layer * DM * DM, MT, DM, DM}; pg8::StaticOrder S; S.init(MT, DM, G, bid);
            EpiOut E{(GA float*)(ws + WS_XRES), (GA bf16_t*)(ws + WS_XB), (GA float*)(ws + WS_SSQ)};
            pg8::gemm_phase<EpiOut, pg8::StaticOrder>(ldsl, g, S, E);
            SEAM(pb + 5);
        }
    }
    if ((PH_EN & 128) && IN(25)) { const Frame F = mkframe(args, launder(args.ws), ldsl); final_norm(F); }
#undef IN
#undef SEAM
}

extern "C" void kernel_launch(void* const* d_in, const int* in_sizes, int n_in, void* d_out, int out_size, void* d_ws, size_t ws_size, hipStream_t stream) {
    static int grid = 0;
    if (grid == 0) {
        if (n_in != 13 || in_sizes[0] != MT * DM || out_size != MT * DM || ws_size < WS_END) {
            fprintf(stderr, "kernel_launch: unexpected shapes (n_in %d, in0 %d, out %d, ws %zu, need %zu)\n", n_in, n_in > 0 ? in_sizes[0] : -1, out_size, ws_size, (size_t)WS_END); grid = -1; return; }
        int dev = 0, cus = 0, per_cu = 0;
        if (hipGetDevice(&dev) != hipSuccess || hipDeviceGetAttribute(&cus, hipDeviceAttributeMultiprocessorCount, dev) != hipSuccess) { grid = -1; return; }
        if (hipFuncSetAttribute((const void*)fwd, hipFuncAttributeMaxDynamicSharedMemorySize, LDS_BYTES) != hipSuccess) { fprintf(stderr, "kernel_launch: hipFuncSetAttribute failed\n"); grid = -1; return; }
        if (hipOccupancyMaxActiveBlocksPerMultiprocessor(&per_cu, (const void*)fwd, 512, LDS_BYTES) != hipSuccess || per_cu < 1) fprintf(stderr, "kernel_launch: occupancy query reports %d\n", per_cu);
        (void)hipGetLastError();
        grid = cus;
    }
    if (grid < 0) return;
    if (hipMemsetAsync((char*)d_ws + WS_CTL, 0, CTL_BYTES, stream) != hipSuccess) return;
    Args a{};
    for (int i = 0; i < 13; ++i) a.in[i] = (const float*)d_in[i];
    a.out = (float*)d_out; a.ws = (unsigned char*)d_ws;
#if MK_LAUNCHES == 1
    a.ph_lo = 0; a.ph_hi = NPH;
    hipLaunchKernelGGL(fwd, dim3(grid), dim3(512), LDS_BYTES, stream, a);
#else
    for (int p = 0; p < NPH; ++p) { a.ph_lo = p; a.ph_hi = p + 1; hipLaunchKernelGGL(fwd, dim3(grid), dim3(512), LDS_BYTES, stream, a); }
#endif
}
```

```cpp
#include <hip/hip_runtime.h>
#include <stdint.h>
#include <stdio.h>

#ifndef MK_LAUNCHES
#define MK_LAUNCHES 1
#endif

#define LAS __attribute__((address_space(3)))
#define GA __attribute__((address_space(1)))
typedef unsigned short bf16_t;
typedef short bf16x8 __attribute__((ext_vector_type(8)));
typedef float f32x4 __attribute__((ext_vector_type(4)));
typedef float f32x16 __attribute__((ext_vector_type(16)));
typedef unsigned u32x4 __attribute__((ext_vector_type(4)));
typedef unsigned u32x2 __attribute__((ext_vector_type(2)));
typedef unsigned long long u64;

constexpr int DM = 2048, NB = 2, SEQ = 8192, DEPTH = 4, MT = NB * SEQ;
constexpr int NIN = 17492, NINP = 17664;
constexpr int NPH = 26;
constexpr float LOG2E = 1.4426950408889634f;
constexpr float QSC128 = 0.08838834764831845f * 1.4426950408889634f;
constexpr float QSC64 = 0.125f * 1.4426950408889634f;
constexpr float RMS_EPS = 1e-6f;
constexpr size_t QS = (size_t)NB * 4 * SEQ * 128;

constexpr size_t al256(size_t x) { return (x + 255) & ~(size_t)255; }
constexpr size_t WS_CTL = 0, CTL_BYTES = 65536;
constexpr size_t WS_WIN = WS_CTL + CTL_BYTES;
constexpr size_t WS_WBR = WS_WIN + (size_t)DEPTH * NINP * DM * 2;
constexpr size_t WS_WOUT = WS_WBR + (size_t)DEPTH * DM * DM * 2;
constexpr size_t WS_XRES = WS_WOUT + (size_t)DEPTH * DM * DM * 2;
constexpr size_t WS_XB = WS_XRES + (size_t)MT * DM * 4;
constexpr size_t WS_SSQ = WS_XB + (size_t)MT * DM * 2;
constexpr size_t WS_ZS = WS_SSQ + (size_t)MT * 32 * 4;
constexpr size_t WS_G = WS_ZS + (size_t)MT * DM * 2;
constexpr size_t WS_QKV = WS_G + (size_t)MT * 8192 * 2;
constexpr size_t WS_IQ = WS_QKV + 12 * QS * 2;
constexpr size_t WS_IK = WS_IQ + (size_t)MT * 1024 * 2;
constexpr size_t WS_IW = WS_IK + (size_t)MT * 64 * 2;
constexpr size_t WS_FF = WS_IW + (size_t)MT * 16 * 4;
constexpr size_t WS_CUM = WS_FF + (size_t)MT * 4 * 4;
constexpr size_t WS_TB = WS_CUM + (size_t)NB * 4 * SEQ * 4;
constexpr size_t WS_SC = WS_TB + (size_t)12 * SEQ * 4;
constexpr size_t WS_MASK = WS_SC + (size_t)NB * SEQ * SEQ * 4;
constexpr size_t WS_Y = WS_MASK + (size_t)NB * SEQ * 128 * 8;
constexpr size_t WS_MG = WS_Y + (size_t)MT * DM * 2;
constexpr size_t WS_O1 = WS_MG + (size_t)MT * DM * 2;
constexpr size_t WS_OD = WS_O1 + (size_t)256 * 64 * 512 * 4;
constexpr size_t WS_LSE = WS_OD + (size_t)3 * MT * 512 * 4;
constexpr size_t WS_DP = WS_LSE + (size_t)3 * MT * 4 * 4;
constexpr size_t WS_END = WS_DP + 4 * 256 * 4;

constexpr int CW_BAR = 0;
constexpr int CW_Q = 4096;

constexpr int LDS_STAGE = 131072;
constexpr int LDS_MISC = 131072;
constexpr int LDS_BYTES = 147456;

__device__ __forceinline__ unsigned cvt_pk_bf16(float lo, float hi) { unsigned r; asm volatile("v_cvt_pk_bf16_f32 %0, %1, %2" : "=v"(r) : "v"(lo), "v"(hi)); return r; }
__device__ __forceinline__ float bf_lo(unsigned w) { return __uint_as_float(w << 16); }
__device__ __forceinline__ float bf_hi(unsigned w) { return __uint_as_float(w & 0xffff0000u); }
__device__ __forceinline__ float bf2f(bf16_t b) { return __uint_as_float(((unsigned)b) << 16); }
__device__ __forceinline__ float ex2(float x) { return __builtin_amdgcn_exp2f(x); }
__device__ __forceinline__ float sigmoidf_(float x) { return __builtin_amdgcn_rcpf(1.0f + ex2(-x * LOG2E)); }
__device__ __forceinline__ int tid_l() { int t = threadIdx.x; asm volatile("" : "+v"(t)); return t; }
__device__ __forceinline__ GA unsigned char* launder(unsigned char* p) { asm volatile("" : "+s"(p)); return (GA unsigned char*)p; }
__device__ __forceinline__ GA unsigned char* launder(GA unsigned char* p) { asm volatile("" : "+s"(p)); return p; }
__device__ __forceinline__ float wave_sum(float v) {
#pragma unroll
    for (int o = 32; o > 0; o >>= 1) v += __shfl_xor(v, o);
    return v;
}

#define XB_TMO      128
#define XB_XCNT(j)  (256  + 64 * (j))
#define XB_XSUB(j)  (1280 + 64 * (j))
#define XB_XGEN(j)  (2304 + 64 * (j))
#define XB_TOP      3328
#define XB_TOPGEN   3392
#define XCD_BAR_WORDS 3456
#define XB_SPIN_CAP (1u << 18)

__device__ __forceinline__ unsigned xb_ld(unsigned* p)              { return __hip_atomic_load(p, __ATOMIC_RELAXED, __HIP_MEMORY_SCOPE_AGENT); }
__device__ __forceinline__ unsigned xb_add(unsigned* p, unsigned v) { return __hip_atomic_fetch_add(p, v, __ATOMIC_RELAXED, __HIP_MEMORY_SCOPE_AGENT); }
__device__ __forceinline__ unsigned xb_xcc_id() { return (unsigned)__builtin_amdgcn_s_getreg((3 << 11) | 20) & 0xFu; }
#define XB_SPIN(cond, bar) do { unsigned _sp = 0; while (cond) { __builtin_amdgcn_s_sleep(1); \
    if ((++_sp & 255u) == 0u) { if (xb_ld(&(bar)[XB_TMO])) break; if (_sp > XB_SPIN_CAP) { atomicAdd(&(bar)[XB_TMO], 1u); break; } } } } while (0)

struct XcdBarrier { unsigned* bar; unsigned x; volatile LAS unsigned* st; };

__device__ __forceinline__ XcdBarrier xcd_barrier_post(unsigned* bar, volatile LAS unsigned* st) {
    XcdBarrier b; b.bar = bar; b.x = xb_xcc_id(); b.st = st;
    if (threadIdx.x == 0) (void)xb_add(&bar[XB_XCNT(b.x)], 1u);
    return b;
}
__device__ __forceinline__ void xcd_barrier_complete(unsigned* bar, unsigned x, unsigned& nloc, unsigned& nx) {
    const unsigned G = gridDim.x * gridDim.y * gridDim.z;
    unsigned sum, cnt, mine, sp = 0u;
    for (;;) {
        sum = 0u; cnt = 0u; mine = 0u;
#pragma unroll
        for (unsigned j = 0; j < 16; ++j) { const unsigned c = xb_ld(&bar[XB_XCNT(j)]); sum += c; cnt += (c > 0u) ? 1u : 0u; mine = (j == x) ? c : mine; }
        if (sum == G) break;
        __builtin_amdgcn_s_sleep(1);
        if ((++sp & 255u) == 0u) { if (xb_ld(&bar[XB_TMO])) break; if (sp > XB_SPIN_CAP) { atomicAdd(&bar[XB_TMO], 1u); break; } }
    }
    nloc = mine > 0u ? mine : 1u; nx = cnt > 0u ? cnt : 1u;
}
__device__ __forceinline__ void xcd_barrier(const XcdBarrier& b) {
    asm volatile("s_waitcnt vmcnt(0)" ::: "memory");
    __syncthreads();
    if (threadIdx.x == 0) {
        unsigned* bar = b.bar;
        __builtin_amdgcn_s_waitcnt(0);
        unsigned nloc = b.st[0], nx = b.st[1];
        if (nloc == 0u) { xcd_barrier_complete(bar, b.x, nloc, nx); b.st[0] = nloc; b.st[1] = nx; }
        const unsigned old = xb_add(&bar[XB_XSUB(b.x)], 1u);
        const unsigned gen = old / nloc;
        if (old + 1u == (gen + 1u) * nloc) {
            __builtin_amdgcn_fence(__ATOMIC_RELEASE, "agent");
            asm volatile("s_waitcnt vmcnt(0)" ::: "memory");
            const unsigned og = xb_add(&bar[XB_TOP], 1u);
            const unsigned tg = og / nx;
            if (og + 1u == (tg + 1u) * nx) xb_add(&bar[XB_TOPGEN], 1u);
            else XB_SPIN(xb_ld(&bar[XB_TOPGEN]) == tg, bar);
            __builtin_amdgcn_fence(__ATOMIC_ACQUIRE, "agent");
            xb_add(&bar[XB_XGEN(b.x)], 1u);
            asm volatile("s_waitcnt vmcnt(0)" ::: "memory");
        } else {
            XB_SPIN(xb_ld(&bar[XB_XGEN(b.x)]) == gen, bar);
            __builtin_amdgcn_fence(__ATOMIC_ACQUIRE, "agent");
            asm volatile("s_waitcnt vmcnt(0)" ::: "memory");
        }
    }
    __syncthreads();
}

namespace pg8 {
constexpr int BM = 256, BK = 64, HALF = 128, HTB = HALF * BK * 2, STAGE_BYTES = 8 * HTB, NXCD = 8, WGM = 8;
__host__ __device__ __forceinline__ int lds_byte(int r, int c) { const int st = (r >> 4) * 2 + (c >> 5), rr = r & 15, cc = c & 31, ob = rr * 64 + cc * 2; return st * 1024 + (ob ^ (((ob >> 9) & 1) << 5)); }
__host__ __device__ __forceinline__ void stage_rc(int b, int& R, int& C) { const int st = b / 1024, sb = b % 1024, swz = sb ^ (((sb >> 9) & 1) << 5); R = (st >> 1) * 16 + swz / 64; C = (st & 1) * 32 + (swz % 64) / 2; }
__host__ __device__ __forceinline__ int perm32(int rho) { const int n = rho >> 4, i = rho & 15; return 8 * (i >> 2) + 4 * n + (i & 3); }
struct Unit { int pm, pn; };
struct Gemm { const GA bf16_t* A; const GA bf16_t* Bt; int M, N, K; };
struct StaticOrder {
    int nM, nN, nwg, G, c;
    __host__ __device__ void init(int M, int N, int G_, int c_) { nM = M / BM; nN = N / BM; nwg = nM * nN; G = G_; c = c_; }
    __host__ __device__ bool next(int i, Unit& u) const {
        const long L = (long)i * G + c; if (L >= nwg) return false;
        int wgid = (int)L; { const int q = nwg / NXCD, r = nwg % NXCD, xcd = wgid % NXCD, off = wgid / NXCD; wgid = (xcd < r ? xcd * (q + 1) : r * (q + 1) + (xcd - r) * q) + off; }
        const int nig = WGM * nN, gid = wgid / nig, fm = gid * WGM, gsz = (nM - fm) < WGM ? (nM - fm) : WGM;
        u.pm = fm + ((wgid % nig) % gsz); u.pn = (wgid % nig) / gsz; return true;
    }
    __device__ __forceinline__ void a_ready(const Unit&) const {}
    __device__ __forceinline__ void done(const Unit&) const {}
};

template <class Epi, class Sched>
__device__ __forceinline__ void gemm_phase(LAS unsigned char* lds, const Gemm g, const Sched& S, const Epi& E) {
    const int tid = tid_l(), wid = __builtin_amdgcn_readfirstlane(tid >> 6), lane = tid & 63, wr = wid >> 2, wc = wid & 3, fr = lane & 15, fq = lane >> 4;
    const int K = g.K, nt = K / BK;
    unsigned voffA[2], voffB[2];
#pragma unroll
    for (int i = 0; i < 2; ++i) { int R, C; stage_rc(tid * 16 + i * 8192, R, C); const int Rb = Epi::PERM ? ((R & ~31) + perm32(R & 31)) : R;
        voffA[i] = (unsigned)(R * K + C) * 2u; voffB[i] = (unsigned)(Rb * K + C) * 2u; }
    const size_t kstep = (size_t)(BK * 2);
    const size_t hstep = (size_t)HALF * K * 2;
    const size_t tstep = 2 * hstep;
    const unsigned ldsw = (unsigned)wid * 1024u;
    const int aoff = lds_byte(wr * 64 + fr, fq * 8), boff = lds_byte(wc * 32 + fr, fq * 8);
#define PG8_SA(b, h) (((b) * 2 + (h)) * HTB)
#define PG8_SB(b, h) ((4 + (b) * 2 + (h)) * HTB)
#define PG8_STAGE(bufoff, gbase, voff) do { _Pragma("unroll") for (int _i = 0; _i < 2; ++_i) \
        __builtin_amdgcn_global_load_lds((const GA unsigned*)((const GA char*)(gbase) + (voff)[_i]), (LAS unsigned*)(lds + (bufoff) + ldsw + _i * 8192), 16, 0, 0); } while (0)
#define PG8_LDA(dst, b, h) do { _Pragma("unroll") for (int m = 0; m < 4; ++m) _Pragma("unroll") for (int k = 0; k < 2; ++k) dst[m][k] = *(const LAS bf16x8*)(lds + PG8_SA(b, h) + aoff + m * 2048 + k * 1024); } while (0)
#define PG8_LDB(dst, b, h) do { _Pragma("unroll") for (int n = 0; n < 2; ++n) _Pragma("unroll") for (int k = 0; k < 2; ++k) dst[n][k] = *(const LAS bf16x8*)(lds + PG8_SB(b, h) + boff + n * 2048 + k * 1024); } while (0)
#define PG8_MMA(ai, bj, At, Bt) do { __builtin_amdgcn_s_setprio(1); _Pragma("unroll") for (int m = 0; m < 4; ++m) _Pragma("unroll") for (int n = 0; n < 2; ++n) _Pragma("unroll") for (int k = 0; k < 2; ++k) \
        acc[ai][bj][m][n] = __builtin_amdgcn_mfma_f32_16x16x32_bf16(Bt[n][k], At[m][k], acc[ai][bj][m][n], 0, 0, 0); __builtin_amdgcn_s_setprio(0); } while (0)
#define PG8_WAIT_V(n) asm volatile("s_waitcnt vmcnt(" #n ")" ::: "memory")
#define PG8_WAIT_L(n) asm volatile("s_waitcnt lgkmcnt(" #n ")" ::: "memory")
#define PG8_BAR __builtin_amdgcn_s_barrier()
#define PG8_SCHED __builtin_amdgcn_sched_barrier(0)
    Unit cur, nxt; int ui = 0;
    if (!S.next(0, cur)) return;
    f32x4 acc[2][2][4][2];
#pragma unroll
    for (int a = 0; a < 2; ++a)
#pragma unroll
        for (int b = 0; b < 2; ++b)
#pragma unroll
            for (int m = 0; m < 4; ++m)
#pragma unroll
                for (int n = 0; n < 2; ++n) acc[a][b][m][n] = (f32x4){0.f, 0.f, 0.f, 0.f};
    bf16x8 At[4][2], B0[2][2], B1[2][2];
    const GA char* cA = (const GA char*)g.A + (size_t)cur.pm * tstep; const GA char* cB = (const GA char*)g.Bt + (size_t)cur.pn * tstep;
    S.a_ready(cur);
    PG8_STAGE(PG8_SB(0, 0), cB, voffB); PG8_STAGE(PG8_SA(0, 0), cA, voffA); PG8_STAGE(PG8_SB(0, 1), cB + hstep, voffB); PG8_STAGE(PG8_SA(0, 1), cA + hstep, voffA);
    if (wr == 1) PG8_BAR;
    PG8_WAIT_V(4); PG8_BAR;
    PG8_STAGE(PG8_SB(1, 0), cB + kstep, voffB); PG8_STAGE(PG8_SA(1, 0), cA + kstep, voffA); PG8_STAGE(PG8_SB(1, 1), cB + hstep + kstep, voffB);
    PG8_WAIT_V(6); PG8_BAR;
    for (;;) {
        const bool has_next = S.next(ui + 1, nxt);
        const GA char* nA = has_next ? (const GA char*)g.A + (size_t)nxt.pm * tstep : cA; const GA char* nB = has_next ? (const GA char*)g.Bt + (size_t)nxt.pn * tstep : cB;
        for (int t = 0; t < nt; t += 2) {
            const bool last = (t == nt - 2);
            const GA char* a1 = cA + (size_t)(t + 1) * kstep;
            const GA char* a2 = last ? nA : cA + (size_t)(t + 2) * kstep; const GA char* b2 = last ? nB : cB + (size_t)(t + 2) * kstep;
            const GA char* a3 = a2 + kstep; const GA char* b3 = b2 + kstep;
            if (last && has_next) S.a_ready(nxt);
            if constexpr (Epi::MIDK) { if (t > 0 && (t & 7) == 0) E.mid(acc, cur, t >> 3, wr, wc, fr, fq); }
            PG8_LDB(B0, 0, 0); PG8_SCHED; PG8_LDA(At, 0, 0); PG8_STAGE(PG8_SA(1, 1), a1 + hstep, voffA);
            PG8_WAIT_L(8); PG8_BAR; PG8_WAIT_L(0); PG8_MMA(0, 0, At, B0); PG8_BAR; PG8_SCHED;
            PG8_LDB(B1, 0, 1); PG8_STAGE(PG8_SB(0, 0), b2, voffB);
            PG8_BAR; PG8_WAIT_L(0); PG8_MMA(0, 1, At, B1); PG8_BAR;
            PG8_LDA(At, 0, 1); PG8_STAGE(PG8_SA(0, 0), a2, voffA);
            PG8_BAR; PG8_WAIT_L(0); PG8_MMA(1, 0, At, B0); PG8_BAR; PG8_SCHED;
            PG8_STAGE(PG8_SB(0, 1), b2 + hstep, voffB);
            PG8_WAIT_V(6); PG8_BAR; PG8_MMA(1, 1, At, B1); PG8_BAR;
            PG8_LDB(B0, 1, 0); PG8_SCHED; PG8_LDA(At, 1, 0); PG8_STAGE(PG8_SA(0, 1), a2 + hstep, voffA);
            PG8_WAIT_L(8); PG8_BAR; PG8_WAIT_L(0); PG8_MMA(0, 0, At, B0); PG8_BAR; PG8_SCHED;
            PG8_LDB(B1, 1, 1); PG8_STAGE(PG8_SB(1, 0), b3, voffB);
            PG8_BAR; PG8_WAIT_L(0); PG8_MMA(0, 1, At, B1); PG8_BAR;
            PG8_LDA(At, 1, 1); PG8_STAGE(PG8_SA(1, 0), a3, voffA);
            PG8_BAR; PG8_WAIT_L(0); PG8_MMA(1, 0, At, B0); PG8_BAR; PG8_SCHED;
            PG8_STAGE(PG8_SB(1, 1), b3 + hstep, voffB);
            PG8_WAIT_V(6); PG8_BAR; PG8_MMA(1, 1, At, B1); PG8_BAR;
        }
        E(acc, cur, wr, wc, fr, fq); S.done(cur);
        if (!has_next) break;
#pragma unroll
        for (int a = 0; a < 2; ++a)
#pragma unroll
            for (int b = 0; b < 2; ++b)
#pragma unroll
                for (int m = 0; m < 4; ++m)
#pragma unroll
                    for (int n = 0; n < 2; ++n) acc[a][b][m][n] = (f32x4){0.f, 0.f, 0.f, 0.f};
        cur = nxt; cA = nA; cB = nB; ++ui;
    }
    PG8_WAIT_V(0);
    if (wr == 0) PG8_BAR;
    PG8_BAR;
#undef PG8_SA
#undef PG8_SB
#undef PG8_STAGE
#undef PG8_LDA
#undef PG8_LDB
#undef PG8_MMA
#undef PG8_WAIT_V
#undef PG8_WAIT_L
#undef PG8_BAR
#undef PG8_SCHED
}
}

struct Args { const float* in[13]; float* out; unsigned char* ws; int ph_lo, ph_hi; };
struct Frame {
    const GA float* x; const GA float* norm_w; const GA float* w_in; const GA float* fox_b; const GA float* lq1; const GA float* lk1; const GA float* lq2; const GA float* lk2;
    const GA float* subln; const GA float* w_branch; const GA float* w_out; const GA float* rel_bias; const GA float* final_w; GA float* out;
    GA unsigned* ctl; GA bf16_t* WinT; GA bf16_t* WbrT; GA bf16_t* WoutT; GA float* xres; GA bf16_t* xb; GA float* ssq; GA bf16_t* Zs; GA bf16_t* G; GA bf16_t* QKV; GA bf16_t* IQ; GA bf16_t* IK;
    GA float* IW; GA float* FF; GA float* cum; GA float* tb; GA float* sc; GA u64* mask; GA bf16_t* Y; GA bf16_t* MG; GA float* O1; GA float* OD; GA float* LSE; GA float* DP; GA unsigned char* ws;
    LAS unsigned char* lds; volatile LAS unsigned* misc;
};

__device__ __forceinline__ int q_next(GA unsigned* ctr, volatile LAS unsigned* lw) {
    __syncthreads();
    if (threadIdx.x == 0) *lw = __hip_atomic_fetch_add(ctr, 1u, __ATOMIC_RELAXED, __HIP_MEMORY_SCOPE_AGENT);
    __syncthreads();
    return (int)*lw;
}

__device__ __forceinline__ int win_src_col(int n) {
    if (n < 12800) return n;
    if (n < 14336) return n - 12800 + 12880;
    if (n < 15872) return n - 14336 + 14420;
    if (n < 17408) return n - 15872 + 15956;
    if (n < 17472) return n - 17408 + 12800;
    if (n < 17488) return n - 17472 + 12864;
    if (n < 17492) return n - 17488 + 14416;
    return -1;
}
__device__ __forceinline__ void transpose_tile(const GA float* src, int ld, int srccol, const GA float* ksc, GA bf16_t* dst, int k0, int n0, LAS float* tile) {
    const int tid = tid_l(), tk = tid >> 6, tn = tid & 63;
#pragma unroll
    for (int i = 0; i < 8; ++i) { const int kk = tk + 8 * i; float v = 0.f;
        if (srccol >= 0) { v = src[(size_t)(k0 + kk) * ld + srccol]; if (ksc) v *= ksc[k0 + kk]; }
        tile[kk * 65 + tn] = v; }
    __syncthreads();
    const int wn = tid >> 3, wk = tid & 7;
    float f[8];
#pragma unroll
    for (int j = 0; j < 8; ++j) f[j] = tile[(wk * 8 + j) * 65 + wn];
    u32x4 w = {cvt_pk_bf16(f[0], f[1]), cvt_pk_bf16(f[2], f[3]), cvt_pk_bf16(f[4], f[5]), cvt_pk_bf16(f[6], f[7])};
    *(GA u32x4*)(dst + (size_t)(n0 + wn) * DM + k0 + wk * 8) = w;
    __syncthreads();
}
__device__ __forceinline__ int t5_bucket(int d) {
    if (d < 16) return d;
    const int th[15] = {22, 30, 40, 54, 73, 99, 134, 182, 246, 332, 450, 609, 825, 1117, 1513};
    int b = 16;
#pragma unroll
    for (int i = 0; i < 15; ++i) b += (d >= th[i]) ? 1 : 0;
    return b;
}
__device__ __forceinline__ void p0_prologue(const Frame& F) {
    const int tid = tid_l(), lane = tid & 63, wave = tid >> 6, G = gridDim.x, bid = blockIdx.x;
    LAS float* tile = (LAS float*)F.lds;
    constexpr int TW = 32 * 276, TB_ = 32 * 32, TL = TW + 2 * TB_;
    for (int j = bid; j < DEPTH * TL; j += G) {
        const int l = j / TL, r = j % TL;
        if (r < TW) { const int nt = r % 276, kt = r / 276; const int n = nt * 64 + (tid & 63);
            transpose_tile(F.w_in + (size_t)l * DM * NIN, NIN, win_src_col(n), F.norm_w + l * DM, F.WinT + (size_t)l * NINP * DM, kt * 64, nt * 64, tile); }
        else if (r < TW + TB_) { const int q = r - TW, nt = q % 32, kt = q / 32;
            transpose_tile(F.w_branch + (size_t)l * DM * DM, DM, nt * 64 + (tid & 63), (const GA float*)nullptr, F.WbrT + (size_t)l * DM * DM, kt * 64, nt * 64, tile); }
        else { const int q = r - TW - TB_, nt = q % 32, kt = q / 32;
            transpose_tile(F.w_out + (size_t)l * DM * DM, DM, nt * 64 + (tid & 63), (const GA float*)nullptr, F.WoutT + (size_t)l * DM * DM, kt * 64, nt * 64, tile); }
    }
    for (int row = bid * 8 + wave; row < MT; row += G * 8) {
        const GA float* xr = F.x + (size_t)row * DM; float ss = 0.f;
#pragma unroll
        for (int i = 0; i < 8; ++i) { const int c = (i * 64 + lane) * 4; const f32x4 v = *(const GA f32x4*)(xr + c);
            *(GA f32x4*)(F.xres + (size_t)row * DM + c) = v; ss += v[0] * v[0] + v[1] * v[1] + v[2] * v[2] + v[3] * v[3];
            u32x2 w = {cvt_pk_bf16(v[0], v[1]), cvt_pk_bf16(v[2], v[3])}; *(GA u32x2*)(F.xb + (size_t)row * DM + c) = w; }
        ss = wave_sum(ss);
        if (lane < 32) F.ssq[(size_t)row * 32 + lane] = (lane == 0) ? ss : 0.f;
    }
    if (bid == 0 && tid < DEPTH * 128) { const int l = tid >> 7, i = tid & 127;
        const float lam_init = 0.8f - 0.6f * expf(-0.3f * (float)l);
        F.DP[l * 256 + 128 + i] = F.subln[l * 128 + i] * (1.0f - lam_init);
        if (i == 0) { float s1 = 0.f, s2 = 0.f;
            for (int k = 0; k < 64; ++k) { s1 = fmaf(F.lq1[l * 64 + k], F.lk1[l * 64 + k], s1); s2 = fmaf(F.lq2[l * 64 + k], F.lk2[l * 64 + k], s2); }
            F.DP[l * 256] = expf(s1) - expf(s2) + lam_init; F.DP[l * 256 + 1] = 1.0f - lam_init; } }
    for (int i = bid * 512 + tid; i < 12 * SEQ; i += G * 512) { const int hd = i / SEQ, d = i % SEQ; F.tb[i] = F.rel_bias[t5_bucket(d) * 12 + hd] * LOG2E; }
}

struct EpiIn {
    static constexpr bool PERM = true, AFTER_DRAIN = false, MIDK = false;
    GA unsigned char* ws;
    template <int KIND>
    __device__ __forceinline__ void body(const f32x4 (&acc)[2][2][4][2], int row0, int cl, int fq, GA bf16_t* base, int ldc, float qscale, int headbase) const {
        const GA float* ssq = (const GA float*)(ws + WS_SSQ);
#pragma unroll
        for (int ai = 0; ai < 2; ++ai)
#pragma unroll
            for (int m = 0; m < 4; ++m) {
                const int r = row0 + ai * 128 + m * 16;
                const GA float* sp = ssq + (size_t)r * 32 + fq * 8;
                const f32x4 s4 = *(const GA f32x4*)sp + *(const GA f32x4*)(sp + 4);
                float ssum = (s4[0] + s4[1]) + (s4[2] + s4[3]);
                ssum += __shfl_xor(ssum, 16); ssum += __shfl_xor(ssum, 32);
                const float sc = __builtin_amdgcn_rsqf(ssum * (1.0f / DM) + RMS_EPS) * qscale;
#pragma unroll
                for (int bj = 0; bj < 2; ++bj) {
                    f32x4 v0 = acc[ai][bj][m][0] * sc, v1 = acc[ai][bj][m][1] * sc;
                    if (KIND == 0) {
#pragma unroll
                        for (int j = 0; j < 4; ++j) { v0[j] = v0[j] * sigmoidf_(v0[j]); v1[j] = v1[j] * sigmoidf_(v1[j]); }
                    } else if (KIND == 1) {
#pragma unroll
                        for (int j = 0; j < 4; ++j) { v0[j] = fmaxf(sigmoidf_(v0[j]), 1e-9f); v1[j] = fmaxf(sigmoidf_(v1[j]), 1e-9f); }
                    }
                    if (KIND == 4) {
                        if (bj == 0) {
                            if (cl < 64) { u32x4 w = {cvt_pk_bf16(v0[0], v0[1]), cvt_pk_bf16(v0[2], v0[3]), cvt_pk_bf16(v1[0], v1[1]), cvt_pk_bf16(v1[2], v1[3])};
                                *(GA u32x4*)((GA bf16_t*)(ws + WS_IK) + (size_t)r * 64 + cl) = w; }
                            else if (cl < 80) { GA float* iw = (GA float*)(ws + WS_IW) + (size_t)r * 16 + (cl - 64); *(GA f32x4*)iw = v0; *(GA f32x4*)(iw + 4) = v1; }
                            else if (cl == 80) { *(GA f32x4*)((GA float*)(ws + WS_FF) + (size_t)r * 4) = v0; }
                        }
                    } else {
                        GA bf16_t* dst;
                        if (KIND == 2) { const int b = r >> 13, s = r & (SEQ - 1); dst = base + ((size_t)(b * 4 + headbase + bj) * SEQ + s) * 128 + cl; }
                        else dst = base + (size_t)r * ldc + bj * 128 + cl;
                        u32x4 w = {cvt_pk_bf16(v0[0], v0[1]), cvt_pk_bf16(v0[2], v0[3]), cvt_pk_bf16(v1[0], v1[1]), cvt_pk_bf16(v1[2], v1[3])};
                        *(GA u32x4*)dst = w;
                    }
                }
            }
    }
    __device__ __forceinline__ void operator()(const f32x4 (&acc)[2][2][4][2], const pg8::Unit& u, int wr, int wc, int fr, int fq) const {
        const int row0 = u.pm * 256 + wr * 64 + fr, pn = u.pn, cl = wc * 32 + 8 * fq;
        if (pn < 8) body<0>(acc, row0, cl, fq, (GA bf16_t*)(ws + WS_ZS) + pn * 256, DM, 1.f, 0);
        else if (pn < 40) body<1>(acc, row0, cl, fq, (GA bf16_t*)(ws + WS_G) + (pn - 8) * 256, 8192, 1.f, 0);
        else if (pn >= 46 && pn < 50) body<3>(acc, row0, cl, fq, (GA bf16_t*)(ws + WS_IQ) + (pn - 46) * 256, 1024, 1.f, 0);
        else if (pn < 68) {
            int mixer, t6;
            if (pn < 46) { mixer = 0; t6 = pn - 40; } else if (pn < 56) { mixer = 1; t6 = pn - 50; } else if (pn < 62) { mixer = 2; t6 = pn - 56; } else { mixer = 3; t6 = pn - 62; }
            const int which = t6 >> 1;
            const float qscale = (which == 0) ? ((mixer == 2) ? QSC64 : QSC128) : 1.f;
            body<2>(acc, row0, cl, fq, (GA bf16_t*)(ws + WS_QKV) + (size_t)(mixer * 3 + which) * QS, 0, qscale, (t6 & 1) * 2);
        }
        else body<4>(acc, row0, cl, fq, (GA bf16_t*)nullptr, 0, 1.f, 0);
    }
};

__device__ __forceinline__ void fox_scan(const Frame& F, int layer, int seqid) {
    const int tid = tid_l(), lane = tid & 63, wave = tid >> 6, b = seqid >> 2, h = seqid & 3;
    LAS float* sm = (LAS float*)F.lds;
    const float bias = F.fox_b[layer * 4 + h];
    float v[16]; float run = 0.f;
#pragma unroll
    for (int i = 0; i < 16; ++i) { const int s = tid * 16 + i; const float x = F.FF[(size_t)(b * SEQ + s) * 4 + h] + bias;
        const float ls = fminf(x, 0.f) - log1pf(expf(-fabsf(x))); run += ls; v[i] = run; }
    float incl = run;
#pragma unroll
    for (int o = 1; o < 64; o <<= 1) { const float t = __shfl_up(incl, o); if (lane >= o) incl += t; }
    if (lane == 63) sm[wave] = incl;
    __syncthreads();
    float woff = 0.f;
    for (int w = 0; w < wave; ++w) woff += sm[w];
    const float excl = woff + incl - run;
#pragma unroll
    for (int i = 0; i < 16; ++i) F.cum[(size_t)(b * 4 + h) * SEQ + tid * 16 + i] = (excl + v[i]) * LOG2E;
    __syncthreads();
}
__device__ __forceinline__ void idx_unit(const Frame& F, int unit) {
    const int b = unit / 576; int id = unit % 576; int g = 0;
    while (8 * (g + 1) * (g + 2) <= id) ++g;
    const int rem = id - 8 * g * (g + 1), qb = 16 * g + rem / (g + 1), kc = rem % (g + 1);
    const int tid = tid_l(), lane = tid & 63, wave = __builtin_amdgcn_readfirstlane(tid >> 6), n32 = lane & 31, hi = lane >> 5;
    const int tq0 = qb * 64 + wave * 8;
    const int qa = (n32 >> 2) & 1, ha = (n32 & 3) + 4 * (n32 >> 3);
    bf16x8 Af[4][4]; float wr_[4][16];
#pragma unroll
    for (int p = 0; p < 4; ++p) {
        const GA bf16_t* qp = F.IQ + (size_t)(b * SEQ + tq0 + 2 * p + qa) * 1024 + ha * 64 + hi * 8;
#pragma unroll
        for (int ks = 0; ks < 4; ++ks) Af[p][ks] = *(const GA bf16x8*)(qp + ks * 16);
        const GA float* wp = F.IW + (size_t)(b * SEQ + tq0 + 2 * p + hi) * 16;
#pragma unroll
        for (int q4 = 0; q4 < 4; ++q4) { const f32x4 w4 = *(const GA f32x4*)(wp + 4 * q4); wr_[p][4 * q4] = w4[0]; wr_[p][4 * q4 + 1] = w4[1]; wr_[p][4 * q4 + 2] = w4[2]; wr_[p][4 * q4 + 3] = w4[3]; }
    }
    const int smax = tq0 + 7;
    for (int j = 0; j < 32; ++j) {
        const int s0 = kc * 1024 + j * 32;
        if (s0 > smax) break;
        const GA bf16_t* kp = F.IK + (size_t)(b * SEQ + s0 + n32) * 64 + hi * 8;
        bf16x8 Bf[4];
#pragma unroll
        for (int ks = 0; ks < 4; ++ks) Bf[ks] = *(const GA bf16x8*)(kp + ks * 16);
#pragma unroll
        for (int p = 0; p < 4; ++p) {
            f32x16 c = {};
#pragma unroll
            for (int ks = 0; ks < 4; ++ks) c = __builtin_amdgcn_mfma_f32_32x32x16_bf16(Af[p][ks], Bf[ks], c, 0, 0, 0);
            float sc = 0.f;
#pragma unroll
            for (int r = 0; r < 16; ++r) sc = fmaf(wr_[p][r], fmaxf(c[r], 0.f), sc);
            F.sc[((size_t)(b * SEQ + tq0 + 2 * p + hi)) * SEQ + s0 + n32] = sc;
        }
    }
}

__device__ __forceinline__ unsigned sel_key(float f) { const unsigned u = __float_as_uint(f == 0.f ? 0.f : f); return (u >> 31) ? ~u : (u | 0x80000000u); }
__device__ __forceinline__ int wave_sum_i(int v) {
#pragma unroll
    for (int o = 32; o > 0; o >>= 1) v += __shfl_xor(v, o);
    return v;
}
__device__ __forceinline__ void select_row(const Frame& F, int row_) {
    const int row = __builtin_amdgcn_readfirstlane(row_);
    const int lane = tid_l() & 63, t = row & (SEQ - 1);
    GA u64* mrow = F.mask + (size_t)row * 128;
    if (t < 256) {
#pragma unroll
        for (int half = 0; half < 2; ++half) { const int j = half * 64 + lane; const int lo = j * 64; u64 w = 0ull;
            if (t >= lo + 63) w = ~0ull; else if (t >= lo) w = (~0ull) >> (63 - (t - lo));
            mrow[j] = w; }
        return;
    }
    const GA float* srow = F.sc + (size_t)row * SEQ + lane;
    const int nj = (t >> 6) + 1;
    unsigned key[128];
#pragma unroll
    for (int jj = 0; jj < 4; ++jj) {
        if (jj * 32 < nj) {
#pragma unroll
            for (int j = jj * 32; j < jj * 32 + 32; ++j) key[j] = __float_as_uint(srow[j * 64]);
        }
    }
#pragma unroll
    for (int jj = 0; jj < 4; ++jj) {
        if (jj * 32 < nj) {
#pragma unroll
            for (int j = jj * 32; j < jj * 32 + 32; ++j) key[j] = (j * 64 + lane <= t) ? sel_key(__uint_as_float(key[j])) : 0u;
        } else {
#pragma unroll
            for (int j = jj * 32; j < jj * 32 + 32; ++j) key[j] = 0u;
        }
    }
#define CNT8(j0) do { u64 b0 = __ballot(key[(j0)] >= cand), b1 = __ballot(key[(j0) + 1] >= cand), b2 = __ballot(key[(j0) + 2] >= cand), b3 = __ballot(key[(j0) + 3] >= cand), \
        b4 = __ballot(key[(j0) + 4] >= cand), b5 = __ballot(key[(j0) + 5] >= cand), b6 = __ballot(key[(j0) + 6] >= cand), b7 = __ballot(key[(j0) + 7] >= cand); \
        asm volatile("" : "+s"(b0), "+s"(b1), "+s"(b2), "+s"(b3), "+s"(b4), "+s"(b5), "+s"(b6), "+s"(b7)); \
        c += (__popcll(b0) + __popcll(b1)) + (__popcll(b2) + __popcll(b3)) + (__popcll(b4) + __popcll(b5)) + (__popcll(b6) + __popcll(b7)); } while (0)
#define COUNT_GE() do { c = 0; _Pragma("unroll") for (int jj = 0; jj < 4; ++jj) { if (jj * 32 < nj) { CNT8(jj * 32); CNT8(jj * 32 + 8); CNT8(jj * 32 + 16); CNT8(jj * 32 + 24); } } } while (0)
    unsigned mx = 0u;
#pragma unroll
    for (int j = 0; j < 128; ++j) mx = key[j] > mx ? key[j] : mx;
#pragma unroll
    for (int o = 32; o > 0; o >>= 1) { const unsigned t2 = (unsigned)__shfl_xor((int)mx, o); mx = t2 > mx ? t2 : mx; }
    unsigned prefix = 0u; int cge = 1 << 30, c, bit = 31;
    { const unsigned e9 = mx >> 23;
      for (unsigned k = 0; k < 6u && k <= e9; ++k) { const unsigned cand = (e9 - k) << 23; COUNT_GE();
          if (c >= 256) { prefix = cand; cge = c; bit = 22; break; } } }
    if (cge != 256) {
        for (; bit >= 0; --bit) {
            const unsigned cand = prefix | (1u << bit); COUNT_GE();
            if (c >= 256) { prefix = cand; cge = c; if (c == 256) break; }
        }
    }
#undef CNT8
#undef COUNT_GE
    if (cge == 256) {
        unsigned w0l = 0u, w0h = 0u, w1l = 0u, w1h = 0u;
#pragma unroll
        for (int j = 0; j < 64; ++j) { const u64 word = __ballot(key[j] >= prefix);
            asm volatile("s_nop 1\n\tv_writelane_b32 %0, %1, %2" : "+v"(w0l) : "s"((unsigned)word), "n"(j)); asm volatile("v_writelane_b32 %0, %1, %2" : "+v"(w0h) : "s"((unsigned)(word >> 32)), "n"(j)); }
        if (nj > 64) {
#pragma unroll
            for (int j = 64; j < 128; ++j) { const u64 word = __ballot(key[j] >= prefix);
                asm volatile("s_nop 1\n\tv_writelane_b32 %0, %1, %2" : "+v"(w1l) : "s"((unsigned)word), "n"(j - 64)); asm volatile("v_writelane_b32 %0, %1, %2" : "+v"(w1h) : "s"((unsigned)(word >> 32)), "n"(j - 64)); }
        }
        mrow[lane] = ((u64)w0h << 32) | w0l; mrow[64 + lane] = ((u64)w1h << 32) | w1l;
    } else {
        int cgt = 0;
        for (int j = 0; j < nj; ++j) { const int s = j * 64 + lane; const float v_ = srow[j * 64]; const unsigned k = (s <= t) ? sel_key(v_) : 0u; cgt += __popcll(__ballot(k > prefix)); }
        int need = 256 - cgt;
        for (int j = 0; j < nj; ++j) { const int s = j * 64 + lane; const float v_ = srow[j * 64]; const unsigned k = (s <= t) ? sel_key(v_) : 0u;
            u64 word = __ballot(k > prefix); u64 tm = __ballot(k == prefix);
            if (tm != 0ull && need > 0) { const int c = __popcll(tm);
                if (c <= need) { word |= tm; need -= c; }
                else { u64 selb = 0ull; for (int i = 0; i < need; ++i) { const u64 low = tm & (~tm + 1ull); selb |= low; tm ^= low; } word |= selb; need = 0; } }
            if (lane == 0) mrow[j] = word; }
        for (int j = nj + lane; j < 128; j += 64) mrow[j] = 0ull;
    }
}

namespace att {
typedef short s16x4 __attribute__((ext_vector_type(4)));
constexpr int D = 128, NW = 8, QBLK = 32, KVBLK = 64, QB = NW * QBLK;
constexpr int SHM_V = KVBLK * D * 2, SHM_K = KVBLK * D * 2;
constexpr int L_WS = 2 * SHM_V + 2 * SHM_K;
constexpr int L_AUX = L_WS + NW * 64 * 4;
constexpr int TB_PAD = 320, TB_N = TB_PAD + 1984;
constexpr int L_END = L_AUX + 8192 * 4;
constexpr float THR2 = 11.5f;
constexpr int FAR_DIST = 1513;

#define KSWZ(row, colB) ((row) * 256 + ((colB) ^ (((row) & 7) << 4)))
#define SBAR() __builtin_amdgcn_sched_barrier(0)
__device__ __forceinline__ int v_st(int k, int c) { const int kk = (k & ~0xC) | ((k & 4) << 1) | ((k & 8) >> 1); return ((kk >> 3) * 4 + (c >> 5)) * 512 + ((kk & 7) * 32 + (c & 31)) * 2; }
__device__ __forceinline__ int v_rd_base(int lane) { return ((lane & 3) << 3) | (((lane >> 2) & 3) << 6) | (((lane >> 4) & 1) << 5) | (((lane >> 5) & 1) << 8); }
constexpr int v_rd_off(int d0, int ks, int half) { return d0 * 512 + ks * 4096 + half * 2048; }
__device__ __forceinline__ int crow(int r, int hi) { return (r & 3) + 8 * (r >> 2) + 4 * hi; }
__device__ __forceinline__ bf16x8 load8(const GA bf16_t* p) { return *(const GA bf16x8*)p; }

__device__ __forceinline__ void mask_tile(f32x16& p0, f32x16& p1, int dq, unsigned W) {
    const float NEG = -__builtin_inff();
#pragma unroll
    for (int r = 0; r < 16; ++r) {
        const int c = (r & 3) + 8 * (r >> 2);
        if ((unsigned)(dq - c) >= W) p0[r] = NEG;
        if ((unsigned)(dq - c - 32) >= W) p1[r] = NEG;
    }
}
__device__ __forceinline__ void mask_bits(f32x16& p0, f32x16& p1, u64 w, int hi) {
    const float NEG = -__builtin_inff();
    unsigned w0 = (unsigned)w, w1 = (unsigned)(w >> 32);
    if (hi == 0) { w0 <<= 4; w1 <<= 4; }
#define MB4(W, P, g) do { u64 c0_, c1_, c2_, c3_; asm volatile(                          \
        "v_add_co_u32 %[w], %[c0], %[w], %[w]\n\tv_add_co_u32 %[w], %[c1], %[w], %[w]\n\t"                     \
        "v_add_co_u32 %[w], %[c2], %[w], %[w]\n\tv_add_co_u32 %[w], %[c3], %[w], %[w]\n\t"                     \
        "v_cndmask_b32 %[e3], %[neg], %[e3], %[c0]\n\tv_cndmask_b32 %[e2], %[neg], %[e2], %[c1]\n\t"           \
        "v_cndmask_b32 %[e1], %[neg], %[e1], %[c2]\n\tv_cndmask_b32 %[e0], %[neg], %[e0], %[c3]"               \
        : [w] "+v"(W), [e0] "+v"(P[4 * (g)]), [e1] "+v"(P[4 * (g) + 1]), [e2] "+v"(P[4 * (g) + 2]), [e3] "+v"(P[4 * (g) + 3]),         \
          [c0] "=&s"(c0_), [c1] "=&s"(c1_), [c2] "=&s"(c2_), [c3] "=&s"(c3_) : [neg] "v"(NEG)); } while (0)
    MB4(w0, p0, 3); MB4(w1, p1, 3); w0 <<= 4; w1 <<= 4;
    MB4(w0, p0, 2); MB4(w1, p1, 2); w0 <<= 4; w1 <<= 4;
    MB4(w0, p0, 1); MB4(w1, p1, 1); w0 <<= 4; w1 <<= 4;
    MB4(w0, p0, 0); MB4(w1, p1, 0);
#undef MB4
}
__device__ __forceinline__ void partialSM(f32x16& p0, f32x16& p1, float& m_reg, float& mn, float& alpha) {
    float pmax = p0[0];
#pragma unroll
    for (int r = 1; r < 16; ++r) pmax = fmaxf(pmax, p0[r]);
#pragma unroll
    for (int r = 0; r < 16; ++r) pmax = fmaxf(pmax, p1[r]);
    { auto rr = __builtin_amdgcn_permlane32_swap(__float_as_uint(pmax), __float_as_uint(pmax), false, false);
      pmax = fmaxf(__uint_as_float(rr[0]), __uint_as_float(rr[1])); }
    if (__builtin_expect(__all((pmax - m_reg) <= THR2), 1)) { mn = m_reg; alpha = 1.f; }
    else { mn = fmaxf(m_reg, pmax); alpha = __builtin_amdgcn_exp2f(m_reg - mn); m_reg = mn; }
#pragma unroll
    for (int r = 0; r < 16; ++r) p0[r] = p0[r] - mn;
#pragma unroll
    for (int r = 0; r < 16; ++r) p1[r] = p1[r] - mn;
#pragma unroll
    for (int r = 0; r < 16; ++r) p0[r] = __builtin_amdgcn_exp2f(p0[r]);
}
__device__ __forceinline__ void finishSM(f32x16& p0, f32x16& p1, float alpha, float& l_reg, bf16x8& pa0, bf16x8& pa1, bf16x8& pa2, bf16x8& pa3) {
#pragma unroll
    for (int r = 0; r < 16; ++r) p1[r] = __builtin_amdgcn_exp2f(p1[r]);
    float ps = 0;
#pragma unroll
    for (int r = 0; r < 16; ++r) ps += p0[r];
#pragma unroll
    for (int r = 0; r < 16; ++r) ps += p1[r];
    { auto rr = __builtin_amdgcn_permlane32_swap(__float_as_uint(ps), __float_as_uint(ps), false, false);
      ps = __uint_as_float(rr[0]) + __uint_as_float(rr[1]); }
    l_reg = l_reg * alpha + ps;
#define PK4(P, B_, OUT) do { unsigned a0 = cvt_pk_bf16(P[B_+0], P[B_+1]), a1 = cvt_pk_bf16(P[B_+2], P[B_+3]);                          \
        unsigned b0 = cvt_pk_bf16(P[B_+4], P[B_+5]), b1 = cvt_pk_bf16(P[B_+6], P[B_+7]);                                             \
        auto r0 = __builtin_amdgcn_permlane32_swap(a0, b0, false, false); auto r1 = __builtin_amdgcn_permlane32_swap(a1, b1, false, false); \
        u32x4 w = {r0[0], r1[0], r0[1], r1[1]}; OUT = *reinterpret_cast<bf16x8*>(&w); } while (0)
    PK4(p0, 0, pa0); PK4(p0, 8, pa1); PK4(p1, 0, pa2); PK4(p1, 8, pa3);
#undef PK4
}
template <int KB, int NQ>
__device__ __forceinline__ void qkt(f32x16& p0, f32x16& p1, const LAS char* K_lds, int r32, int hi, const bf16x8* qr, int koff) {
    p0 = f32x16{}; p1 = f32x16{};
    const LAS char* kb[4];
#pragma unroll
    for (int dd = 0; dd < 4; ++dd) kb[dd] = K_lds + KB * SHM_K + KSWZ(r32, (dd * 16 + hi * 8) * 2) + koff;
#pragma unroll
    for (int d0 = 0; d0 < NQ; ++d0) { const LAS char* a = kb[d0 & 3] + (d0 >> 2) * 128;
        bf16x8 b0 = *(const LAS bf16x8*)a;
        bf16x8 b1 = *(const LAS bf16x8*)(a + 32 * 256);
        p0 = __builtin_amdgcn_mfma_f32_32x32x16_bf16(b0, qr[d0], p0, 0, 0, 0);
        p1 = __builtin_amdgcn_mfma_f32_32x32x16_bf16(b1, qr[d0], p1, 0, 0, 0); }
}
template <int VB>
__device__ __forceinline__ void pv_tile(f32x16* o, int vb0, bf16x8 pa0, bf16x8 pa1, bf16x8 pa2, bf16x8 pa3) {
#define TRRD(dst, off) asm volatile("ds_read_b64_tr_b16 %0, %1 offset:%2" : "=&v"(dst) : "v"(vb0), "i"(off) : "memory")
#define PV_D0(d0) do { s16x4 l0, l1, l2, l3, h0, h1, h2, h3; constexpr int b_ = VB * SHM_V + v_rd_off(d0, 0, 0); \
        TRRD(l0, b_); TRRD(h0, b_ + 2048); TRRD(l1, b_ + 4096); TRRD(h1, b_ + 6144); TRRD(l2, b_ + 8192); TRRD(h2, b_ + 10240); TRRD(l3, b_ + 12288); TRRD(h3, b_ + 14336); \
        asm volatile("s_waitcnt lgkmcnt(0)" ::: "memory"); SBAR();   \
        o[d0] = __builtin_amdgcn_mfma_f32_32x32x16_bf16(pa0, (bf16x8){l0[0], l0[1], l0[2], l0[3], h0[0], h0[1], h0[2], h0[3]}, o[d0], 0, 0, 0);   \
        o[d0] = __builtin_amdgcn_mfma_f32_32x32x16_bf16(pa1, (bf16x8){l1[0], l1[1], l1[2], l1[3], h1[0], h1[1], h1[2], h1[3]}, o[d0], 0, 0, 0);   \
        o[d0] = __builtin_amdgcn_mfma_f32_32x32x16_bf16(pa2, (bf16x8){l2[0], l2[1], l2[2], l2[3], h2[0], h2[1], h2[2], h2[3]}, o[d0], 0, 0, 0);   \
        o[d0] = __builtin_amdgcn_mfma_f32_32x32x16_bf16(pa3, (bf16x8){l3[0], l3[1], l3[2], l3[3], h3[0], h3[1], h3[2], h3[3]}, o[d0], 0, 0, 0); } while (0)
    PV_D0(0); PV_D0(1); PV_D0(2); PV_D0(3);
#undef PV_D0
#undef TRRD
}
__device__ __forceinline__ void bias_dist(f32x16& p0, f32x16& p1, const LAS char* tbase) {
#pragma unroll
    for (int r = 0; r < 16; ++r) { const int c = (r & 3) + 8 * (r >> 2);
        p0[r] += *(const LAS float*)(tbase + (59 - c) * 4);
        p1[r] += *(const LAS float*)(tbase + (27 - c) * 4); }
}
__device__ __forceinline__ void bias_const(f32x16& p0, f32x16& p1, float c) {
#pragma unroll
    for (int r = 0; r < 16; ++r) { p0[r] += c; p1[r] += c; }
}
__device__ __forceinline__ void bias_key(f32x16& p0, f32x16& p1, const LAS char* kbase) {
#pragma unroll
    for (int g = 0; g < 4; ++g) { const f32x4 a = *(const LAS f32x4*)(kbase + (8 * g) * 4), b = *(const LAS f32x4*)(kbase + (32 + 8 * g) * 4);
#pragma unroll
        for (int q = 0; q < 4; ++q) { p0[4 * g + q] -= a[q]; p1[4 * g + q] -= b[q]; } }
}

struct Blk { const GA bf16_t* Q; const GA bf16_t* K; const GA bf16_t* V; int P0; int rs; };
struct Aux { const GA float* tb; int dscale; const GA float* cum; const GA u64* mrow0; };

__device__ __forceinline__ int swa_jlo(int P0, int W) { const int lowk = P0 - W + 1; return lowk > 0 ? lowk / KVBLK : 0; }

template <int MODE, int NQ>
__device__ __forceinline__ void attn_block(const Blk& cur, int skv, int W, int koff, const Aux& ax, LAS char* lds, f32x16 (&o)[4], float& m_out, float& l_out) {
    const int tid = tid_l(), wid = __builtin_amdgcn_readfirstlane(tid >> 6), lane = tid & 63, r32 = lane & 31, hi = lane >> 5;
    const int rs = cur.rs;
    const int j_lo = swa_jlo(cur.P0, W);
    int j_hi = (cur.P0 + QB - 1) / KVBLK + 1; if (j_hi > skv / KVBLK) j_hi = skv / KVBLK;
    const int NT = j_hi - j_lo;
    const int qlo = cur.P0 + wid * QBLK, qm = qlo + r32 - 4 * hi;
    LAS char* V_lds = lds; LAS char* K_lds = lds + 2 * SHM_V;
    LAS float* ws = (LAS float*)(lds + L_WS) + wid * 64; LAS float* li_l = ws; LAS float* al_l = ws + 32;
    LAS float* auxl = (LAS float*)(lds + L_AUX);
    float m_reg = -1e30f, l_reg = 0;
#pragma unroll
    for (int d_ = 0; d_ < 4; ++d_) o[d_] = f32x16{};
    const int sr = tid >> 4, sc = (tid & 15) * 8, vst0 = v_st(sr, sc), vst1 = v_st(32 + sr, sc), kws = KSWZ(sr, sc * 2);
    const int vb0 = (int)(unsigned)(uintptr_t)V_lds + v_rd_base(lane);
    const GA bf16_t* Kh = cur.K; const GA bf16_t* Vh = cur.V;
    bf16x8 qr[NQ]; bf16x8 st_v0, st_v1, st_k0, st_k1;
#define ROW(p, k0, rr) ((p) + (size_t)((k0) + (rr)) * rs + sc)
#define VMW() asm volatile("s_waitcnt vmcnt(0)" ::: "memory")
#define SLOAD_H(Kp, Vp, k0) do { st_v0 = load8(ROW(Vp, k0, sr)); st_v1 = load8(ROW(Vp, k0, 32 + sr));              \
                                 st_k0 = load8(ROW(Kp, k0, sr)); st_k1 = load8(ROW(Kp, k0, 32 + sr)); } while (0)
#define SWRITE_HK(bf) do { *(LAS bf16x8*)(K_lds + (bf) * SHM_K + kws) = st_k0; *(LAS bf16x8*)(K_lds + (bf) * SHM_K + kws + 32 * 256) = st_k1; } while (0)
#define SWRITE_HV(bf) do { *(LAS bf16x8*)(V_lds + (bf) * SHM_V + vst0) = st_v0; *(LAS bf16x8*)(V_lds + (bf) * SHM_V + vst1) = st_v1; } while (0)
#define SWRITE_H(bf) do { SWRITE_HV(bf); SWRITE_HK(bf); } while (0)
#define RESC(a) do { if (__any((a) < 1.f)) { if (hi == 0) al_l[r32] = (a); asm volatile("s_waitcnt lgkmcnt(0)" ::: "memory");              \
                     for (int d_ = 0; d_ < 4; ++d_) for (int r = 0; r < 16; ++r) o[d_][r] *= al_l[crow(r, hi)]; } } while (0)
#define KBASE(t) ((j_lo + (t)) * KVBLK)
    {
        const int kb0 = j_lo * KVBLK;
#pragma unroll
        for (int d0 = 0; d0 < NQ; ++d0) qr[d0] = load8(cur.Q + (size_t)(wid * QBLK + r32) * rs + d0 * 16 + hi * 8);
        SLOAD_H(Kh, Vh, kb0);
        if (MODE == 1) { for (int i = tid; i < cur.P0 + QB; i += 512) auxl[i] = ax.cum[i]; }
        else { for (int i = tid; i < TB_N; i += 512) { int d = i - TB_PAD; d = d < 0 ? 0 : d; auxl[i] = ax.tb[d * ax.dscale]; } }
        VMW(); SWRITE_HK(0); SWRITE_HV(0);
        __syncthreads();
    }
    const float cfar = (MODE == 0 || MODE == 2) ? ax.tb[FAR_DIST] : 0.f;
#define BIASMASK(P0_, P1_, t) do { const int kb_ = KBASE(t);                                                                           \
        if (MODE == 1) { bias_key(P0_, P1_, (const LAS char*)(auxl + kb_ + 4 * hi)); }                                                       \
        else if (MODE == 3) { bias_dist(P0_, P1_, (const LAS char*)(auxl + (qm - kb_ - 59 + TB_PAD))); }                                     \
        else { if (cur.P0 - kb_ - 63 >= FAR_DIST) bias_const(P0_, P1_, cfar); else bias_dist(P0_, P1_, (const LAS char*)(auxl + (qm - kb_ - 59 + TB_PAD))); } \
        if (MODE == 0) { mask_bits(P0_, P1_, mw, hi); }                                                                                  \
        else if (kb_ + KVBLK - 1 > qlo || kb_ <= qlo + QBLK - 1 - W) mask_tile(P0_, P1_, qm - kb_, (unsigned)W); } while (0)
#define MLOAD(t) do { if (MODE == 0) mw = ax.mrow0[(size_t)(wid * QBLK + r32) * 128 + (KBASE(t) >> 6)]; } while (0)
    f32x16 pA0, pA1, pB0, pB1; float mnA, mnB, alA, alB; bf16x8 pa0, pa1, pa2, pa3; u64 mw = 0ull;
    if (NT > 1) SLOAD_H(Kh, Vh, KBASE(1));
    MLOAD(0);
    SBAR(); qkt<0, NQ>(pA0, pA1, K_lds, r32, hi, qr, koff);
    BIASMASK(pA0, pA1, 0); partialSM(pA0, pA1, m_reg, mnA, alA);
    if (NT > 1) { VMW(); SWRITE_H(1); }
    __syncthreads();
#define HALF_STEP(PX0, PX1, mnX, alX, PY0, PY1, alY, t, KB, VB, SB) do {                                                      \
        MLOAD(t);                                                                                                             \
        SBAR(); qkt<KB, NQ>(PX0, PX1, K_lds, r32, hi, qr, koff);                                                              \
        finishSM(PY0, PY1, alY, l_reg, pa0, pa1, pa2, pa3); SBAR();                                                           \
        if ((t) + 1 < NT) { SLOAD_H(Kh, Vh, KBASE((t) + 1)); SBAR(); }                                                        \
        pv_tile<VB>(o, vb0, pa0, pa1, pa2, pa3); BIASMASK(PX0, PX1, (t)); partialSM(PX0, PX1, m_reg, mnX, alX);               \
        __syncthreads();                                                                                                      \
        if ((t) + 1 < NT) { VMW(); SWRITE_H(SB); }                                                                            \
        RESC(alX); __syncthreads(); } while (0)
    for (int t = 1; t + 1 < NT; t += 2) {
        HALF_STEP(pB0, pB1, mnB, alB, pA0, pA1, alA, t, 1, 0, 0);
        HALF_STEP(pA0, pA1, mnA, alA, pB0, pB1, alB, t + 1, 0, 1, 1);
    }
    const bool even = (NT & 1) == 0;
    if (even) { MLOAD(NT - 1); SBAR(); qkt<1, NQ>(pB0, pB1, K_lds, r32, hi, qr, koff); SBAR(); }
    finishSM(pA0, pA1, alA, l_reg, pa0, pa1, pa2, pa3); SBAR();
    pv_tile<0>(o, vb0, pa0, pa1, pa2, pa3);
    if (even) { BIASMASK(pB0, pB1, NT - 1); partialSM(pB0, pB1, m_reg, mnB, alB); __syncthreads(); RESC(alB);
        finishSM(pB0, pB1, alB, l_reg, pa0, pa1, pa2, pa3); SBAR(); pv_tile<1>(o, vb0, pa0, pa1, pa2, pa3); }
    if (hi == 0) li_l[r32] = l_reg; asm volatile("s_waitcnt lgkmcnt(0)" ::: "memory");
#pragma unroll
    for (int r = 0; r < 16; ++r) { const float rl = __builtin_amdgcn_rcpf(li_l[crow(r, hi)]);
#pragma unroll
        for (int d0 = 0; d0 < 4; ++d0) o[d0][r] *= rl; }
    m_out = m_reg; l_out = l_reg;
    __syncthreads();
#undef ROW
#undef VMW
#undef SLOAD_H
#undef SWRITE_HK
#undef SWRITE_HV
#undef SWRITE_H
#undef RESC
#undef KBASE
#undef BIASMASK
#undef MLOAD
#undef HALF_STEP
}
#undef KSWZ
}

__device__ __forceinline__ void store_y(const GA bf16_t* Zs, GA bf16_t* Y, const f32x16 (&o)[4], int row0w, int colbase, int r32, int hi) {
#pragma unroll
    for (int r = 0; r < 16; ++r) { const size_t off = (size_t)(row0w + att::crow(r, hi)) * DM + colbase + r32;
#pragma unroll
        for (int d0 = 0; d0 < 4; ++d0) { const float v = o[d0][r] * bf2f(Zs[off + d0 * 32]); const float vn = __shfl_xor(v, 1);
            if ((r32 & 1) == 0) *(GA unsigned*)(Y + off + d0 * 32) = cvt_pk_bf16(v, vn); } }
}
template <int MODE>
__device__ __forceinline__ void attn_fast_unit(const Frame& F, int b, int h, int qb) {
    const int mixer = MODE;
    const size_t hb = ((size_t)(b * 4 + h) * SEQ) * 128;
    att::Blk cur{F.QKV + (size_t)(mixer * 3 + 0) * QS + hb + (size_t)qb * 256 * 128, F.QKV + (size_t)(mixer * 3 + 1) * QS + hb, F.QKV + (size_t)(mixer * 3 + 2) * QS + hb, qb * 256, 128};
    att::Aux ax{F.tb + (size_t)h * SEQ, 1, F.cum + (size_t)(b * 4 + h) * SEQ, F.mask + (size_t)(b * SEQ + qb * 256) * 128};
    f32x16 o[4]; float m_, l_;
    att::attn_block<MODE, 8>(cur, SEQ, SEQ, 0, ax, (LAS char*)F.lds, o, m_, l_);
    const int tid = tid_l(), wid = tid >> 6, lane = tid & 63;
    GA unsigned char* w2 = launder(F.ws);
    store_y((const GA bf16_t*)(w2 + WS_ZS), (GA bf16_t*)(w2 + WS_Y), o, b * SEQ + qb * 256 + wid * 32, mixer * 512 + h * 128, lane & 31, lane >> 5);
}

__device__ __forceinline__ void attn_diff_unit(const Frame& F, int layer, int b, int h, int qb) {
    const size_t hb = ((size_t)(b * 4 + h) * SEQ) * 128;
    const GA bf16_t* Qc = F.QKV + (size_t)(2 * 3 + 0) * QS + hb + (size_t)qb * 256 * 128; const GA bf16_t* Kc = F.QKV + (size_t)(2 * 3 + 1) * QS + hb; const GA bf16_t* Vc = F.QKV + (size_t)(2 * 3 + 2) * QS + hb;
    att::Aux ax{F.tb + (size_t)(4 + h) * SEQ, 1, (const GA float*)nullptr, (const GA u64*)nullptr};
    f32x16 o[4]; float m_, l_;
    for (int c = 0; c < 2; ++c) {
        att::Blk cur{Qc + c * 64, Kc, Vc, qb * 256, 128};
        att::attn_block<2, 4>(cur, SEQ, SEQ, c * 128, ax, (LAS char*)F.lds, o, m_, l_);
        if (c == 0) { GA float* stash = (GA float*)(launder(F.ws) + WS_O1) + (size_t)blockIdx.x * 64 * 512 + tid_l();
#pragma unroll
            for (int d0 = 0; d0 < 4; ++d0)
#pragma unroll
                for (int r = 0; r < 16; ++r) stash[(d0 * 16 + r) * 512] = o[d0][r]; }
    }
    const int tid = tid_l(), wid = tid >> 6, lane = tid & 63, r32 = lane & 31, hi = lane >> 5;
    GA unsigned char* w2 = launder(F.ws);
    const GA float* stash = (const GA float*)(w2 + WS_O1) + (size_t)blockIdx.x * 64 * 512 + tid;
    const GA float* dp = (const GA float*)(w2 + WS_DP) + layer * 256;
    const float lam = dp[0];
#pragma unroll
    for (int r = 0; r < 16; ++r) {
        float ss = 0.f;
#pragma unroll
        for (int d0 = 0; d0 < 4; ++d0) { const float v = stash[(d0 * 16 + r) * 512] - lam * o[d0][r]; o[d0][r] = v; ss = fmaf(v, v, ss); }
        ss += __shfl_xor(ss, 1); ss += __shfl_xor(ss, 2); ss += __shfl_xor(ss, 4); ss += __shfl_xor(ss, 8); ss += __shfl_xor(ss, 16);
        const float rn = rsqrtf(ss * (1.0f / 128.0f) + RMS_EPS);
#pragma unroll
        for (int d0 = 0; d0 < 4; ++d0) o[d0][r] = o[d0][r] * rn;
        asm volatile("" ::: "memory");
    }
#pragma unroll
    for (int d0 = 0; d0 < 4; ++d0) { const float sw = dp[128 + d0 * 32 + r32];
#pragma unroll
        for (int r = 0; r < 16; ++r) o[d0][r] *= sw; }
    store_y((const GA bf16_t*)(w2 + WS_ZS), (GA bf16_t*)(w2 + WS_Y), o, b * SEQ + qb * 256 + wid * 32, 2 * 512 + h * 128, r32, hi);
}
__device__ __forceinline__ void attn_dil_unit(const Frame& F, int u) {
    const int cfg = u >> 8, v = u & 255, b = v & 1, h = (v >> 1) & 3, x = v >> 3;
    const int dl = (cfg == 0) ? 1 : (cfg == 1 ? 4 : 16);
    const int rho = (cfg == 0) ? 0 : (cfg == 1 ? (x & 3) : (x & 15)), qb = (cfg == 0) ? x : (cfg == 1 ? (x >> 2) : (x >> 4));
    const size_t hb = ((size_t)(b * 4 + h) * SEQ) * 128;
    const GA bf16_t* Qd = F.QKV + (size_t)(3 * 3 + 0) * QS + hb; const GA bf16_t* Kd = F.QKV + (size_t)(3 * 3 + 1) * QS + hb; const GA bf16_t* Vd = F.QKV + (size_t)(3 * 3 + 2) * QS + hb;
    att::Blk cur{Qd + (size_t)(rho + dl * qb * 256) * 128, Kd + (size_t)rho * 128, Vd + (size_t)rho * 128, qb * 256, 128 * dl};
    att::Aux ax{F.tb + (size_t)(8 + h) * SEQ, dl, (const GA float*)nullptr, (const GA u64*)nullptr};
    f32x16 o[4]; float m_, l_;
    att::attn_block<3, 8>(cur, SEQ / dl, 129, 0, ax, (LAS char*)F.lds, o, m_, l_);
    const int tid = tid_l(), wid = tid >> 6, lane = tid & 63, r32 = lane & 31, hi = lane >> 5;
    GA unsigned char* w2 = launder(F.ws);
    GA float* od = (GA float*)(w2 + WS_OD) + (size_t)cfg * MT * 512;
#pragma unroll
    for (int r = 0; r < 16; ++r) { const size_t row = (size_t)b * SEQ + rho + (size_t)dl * (qb * 256 + wid * 32 + att::crow(r, hi));
#pragma unroll
        for (int d0 = 0; d0 < 4; ++d0) od[row * 512 + h * 128 + d0 * 32 + r32] = o[d0][r]; }
    if (hi == 0) { const size_t row = (size_t)b * SEQ + rho + (size_t)dl * (qb * 256 + wid * 32 + r32);
        ((GA float*)(w2 + WS_LSE))[((size_t)cfg * MT + row) * 4 + h] = m_ + __builtin_amdgcn_logf(l_); }
}
__device__ __forceinline__ void dil_merge_unit(const Frame& F, int u) {
    const int tid = tid_l(), row = u * 32 + (tid >> 4), cg = tid & 15, h = cg >> 2, col = cg * 32;
    const float l0 = F.LSE[((size_t)0 * MT + row) * 4 + h], l1 = F.LSE[((size_t)1 * MT + row) * 4 + h], l2 = F.LSE[((size_t)2 * MT + row) * 4 + h];
    const float mx = fmaxf(l0, fmaxf(l1, l2)); float w0 = ex2(l0 - mx), w1 = ex2(l1 - mx), w2 = ex2(l2 - mx); const float inv = 1.0f / (w0 + w1 + w2); w0 *= inv; w1 *= inv; w2 *= inv;
    const GA float* p0 = F.OD + ((size_t)0 * MT + row) * 512 + col; const GA float* p1 = F.OD + ((size_t)1 * MT + row) * 512 + col; const GA float* p2 = F.OD + ((size_t)2 * MT + row) * 512 + col;
    const size_t yo = (size_t)row * DM + 3 * 512 + col;
#pragma unroll
    for (int i = 0; i < 4; ++i) {
        const f32x4 a0 = *(const GA f32x4*)(p0 + 8 * i), a1 = *(const GA f32x4*)(p0 + 8 * i + 4), b0 = *(const GA f32x4*)(p1 + 8 * i), b1 = *(const GA f32x4*)(p1 + 8 * i + 4), c0 = *(const GA f32x4*)(p2 + 8 * i), c1 = *(const GA f32x4*)(p2 + 8 * i + 4);
        const u32x4 zw = *(const GA u32x4*)(F.Zs + yo + 8 * i);
        const f32x4 v0 = a0 * w0 + b0 * w1 + c0 * w2, v1 = a1 * w0 + b1 * w1 + c1 * w2;
        u32x4 w = {cvt_pk_bf16(v0[0] * bf_lo(zw[0]), v0[1] * bf_hi(zw[0])), cvt_pk_bf16(v0[2] * bf_lo(zw[1]), v0[3] * bf_hi(zw[1])),
                   cvt_pk_bf16(v1[0] * bf_lo(zw[2]), v1[1] * bf_hi(zw[2])), cvt_pk_bf16(v1[2] * bf_lo(zw[3]), v1[3] * bf_hi(zw[3]))};
        *(GA u32x4*)(F.Y + yo + 8 * i) = w; }
}

struct EpiMerged {
    static constexpr bool PERM = true, AFTER_DRAIN = false, MIDK = true;
    const GA bf16_t* G; GA bf16_t* MG;
    __device__ __forceinline__ void mid(f32x4 (&acc)[2][2][4][2], const pg8::Unit& u, int bnext, int wr, int wc, int fr, int fq) const {
        const int row0 = u.pm * 256 + wr * 64 + fr, c0 = u.pn * 256 + wc * 32 + 8 * fq;
#pragma unroll
        for (int ai = 0; ai < 2; ++ai)
#pragma unroll
            for (int m = 0; m < 4; ++m) { const GA bf16_t* gp = G + (size_t)(row0 + ai * 128 + m * 16) * 8192 + c0;
#pragma unroll
                for (int bj = 0; bj < 2; ++bj) {
                    const u32x4 num = *(const GA u32x4*)(gp + (bnext - 1) * DM + bj * 128), den = *(const GA u32x4*)(gp + bnext * DM + bj * 128);
#pragma unroll
                    for (int j = 0; j < 2; ++j) {
                        acc[ai][bj][m][0][2 * j]     *= bf_lo(num[j]) * __builtin_amdgcn_rcpf(bf_lo(den[j]));
                        acc[ai][bj][m][0][2 * j + 1] *= bf_hi(num[j]) * __builtin_amdgcn_rcpf(bf_hi(den[j]));
                        acc[ai][bj][m][1][2 * j]     *= bf_lo(num[2 + j]) * __builtin_amdgcn_rcpf(bf_lo(den[2 + j]));
                        acc[ai][bj][m][1][2 * j + 1] *= bf_hi(num[2 + j]) * __builtin_amdgcn_rcpf(bf_hi(den[2 + j])); } } }
    }
    __device__ __forceinline__ void operator()(const f32x4 (&acc)[2][2][4][2], const pg8::Unit& u, int wr, int wc, int fr, int fq) const {
        const int row0 = u.pm * 256 + wr * 64 + fr, c0 = u.pn * 256 + wc * 32 + 8 * fq;
#pragma unroll
        for (int ai = 0; ai < 2; ++ai)
#pragma unroll
            for (int m = 0; m < 4; ++m) { const int r = row0 + ai * 128 + m * 16;
#pragma unroll
                for (int bj = 0; bj < 2; ++bj) { const u32x4 g3 = *(const GA u32x4*)(G + (size_t)r * 8192 + 3 * DM + c0 + bj * 128);
                    const f32x4 v0 = acc[ai][bj][m][0], v1 = acc[ai][bj][m][1];
                    u32x4 w = {cvt_pk_bf16(v0[0] * bf_lo(g3[0]), v0[1] * bf_hi(g3[0])), cvt_pk_bf16(v0[2] * bf_lo(g3[1]), v0[3] * bf_hi(g3[1])),
                               cvt_pk_bf16(v1[0] * bf_lo(g3[2]), v1[1] * bf_hi(g3[2])), cvt_pk_bf16(v1[2] * bf_lo(g3[3]), v1[3] * bf_hi(g3[3]))};
                    *(GA u32x4*)(MG + (size_t)r * DM + c0 + bj * 128) = w; } }
    }
};

struct EpiOut {
    static constexpr bool PERM = false, AFTER_DRAIN = false, MIDK = false;
    GA float* xres; GA bf16_t* xb; GA float* ssq;
    __device__ __forceinline__ void operator()(const f32x4 (&acc)[2][2][4][2], const pg8::Unit& u, int wr, int wc, int fr, int fq) const {
        const int row0 = u.pm * 256 + wr * 64 + fr, col0 = u.pn * 256 + wc * 32 + 4 * fq;
#pragma unroll
        for (int ai = 0; ai < 2; ++ai)
#pragma unroll
            for (int m = 0; m < 4; ++m) { const int r = row0 + ai * 128 + m * 16; float ss = 0.f;
#pragma unroll
                for (int bj = 0; bj < 2; ++bj)
#pragma unroll
                    for (int n = 0; n < 2; ++n) { const size_t off = (size_t)r * DM + col0 + bj * 128 + n * 16;
                        f32x4 v = *(const GA f32x4*)(xres + off) + acc[ai][bj][m][n];
                        *(GA f32x4*)(xres + off) = v; ss += v[0] * v[0] + v[1] * v[1] + v[2] * v[2] + v[3] * v[3];
                        u32x2 w = {cvt_pk_bf16(v[0], v[1]), cvt_pk_bf16(v[2], v[3])}; *(GA u32x2*)(xb + off) = w; }
                ss += __shfl_xor(ss, 16); ss += __shfl_xor(ss, 32);
                if (fq == 0) ssq[(size_t)r * 32 + u.pn * 4 + wc] = ss; }
    }
};

__device__ __forceinline__ void final_norm(const Frame& F) {
    const int tid = tid_l(), lane = tid & 63, wave = tid >> 6, G = gridDim.x, bid = blockIdx.x;
    for (int row = bid * 8 + wave; row < MT; row += G * 8) {
        float ss = (lane < 32) ? F.ssq[(size_t)row * 32 + lane] : 0.f; ss = wave_sum(ss);
        const float rs = rsqrtf(ss * (1.0f / DM) + RMS_EPS);
#pragma unroll
        for (int i = 0; i < 8; ++i) { const int c = (i * 64 + lane) * 4; const f32x4 v = *(const GA f32x4*)(F.xres + (size_t)row * DM + c), w = *(const GA f32x4*)(F.final_w + c);
            *(GA f32x4*)(F.out + (size_t)row * DM + c) = v * rs * w; }
    }
}

__device__ __forceinline__ Frame mkframe(const Args& args, GA unsigned char* ws, LAS unsigned char* lds) {
    Frame F;
    F.x = (const GA float*)args.in[0]; F.norm_w = (const GA float*)args.in[1]; F.w_in = (const GA float*)args.in[2]; F.fox_b = (const GA float*)args.in[3];
    F.lq1 = (const GA float*)args.in[4]; F.lk1 = (const GA float*)args.in[5]; F.lq2 = (const GA float*)args.in[6]; F.lk2 = (const GA float*)args.in[7];
    F.subln = (const GA float*)args.in[8]; F.w_branch = (const GA float*)args.in[9]; F.w_out = (const GA float*)args.in[10]; F.rel_bias = (const GA float*)args.in[11];
    F.final_w = (const GA float*)args.in[12]; F.out = (GA float*)args.out;
    F.ctl = (GA unsigned*)(ws + WS_CTL); F.WinT = (GA bf16_t*)(ws + WS_WIN); F.WbrT = (GA bf16_t*)(ws + WS_WBR); F.WoutT = (GA bf16_t*)(ws + WS_WOUT);
    F.xres = (GA float*)(ws + WS_XRES); F.xb = (GA bf16_t*)(ws + WS_XB); F.ssq = (GA float*)(ws + WS_SSQ); F.Zs = (GA bf16_t*)(ws + WS_ZS); F.G = (GA bf16_t*)(ws + WS_G);
    F.QKV = (GA bf16_t*)(ws + WS_QKV); F.IQ = (GA bf16_t*)(ws + WS_IQ); F.IK = (GA bf16_t*)(ws + WS_IK); F.IW = (GA float*)(ws + WS_IW); F.FF = (GA float*)(ws + WS_FF);
    F.cum = (GA float*)(ws + WS_CUM); F.tb = (GA float*)(ws + WS_TB); F.sc = (GA float*)(ws + WS_SC); F.mask = (GA u64*)(ws + WS_MASK); F.Y = (GA bf16_t*)(ws + WS_Y); F.MG = (GA bf16_t*)(ws + WS_MG);
    F.O1 = (GA float*)(ws + WS_O1); F.OD = (GA float*)(ws + WS_OD); F.LSE = (GA float*)(ws + WS_LSE); F.DP = (GA float*)(ws + WS_DP); F.ws = ws;
    F.lds = lds; F.misc = (volatile LAS unsigned*)(lds + LDS_MISC);
    return F;
}

__global__ void __launch_bounds__(512, 2) fwd(Args args) {
    extern __shared__ __attribute__((aligned(16))) unsigned char lds[];
    LAS unsigned char* ldsl = (LAS unsigned char*)lds;
    if (threadIdx.x < 64) ((volatile LAS unsigned*)(ldsl + LDS_MISC))[threadIdx.x] = 0u;
    __syncthreads();
    const int lo = args.ph_lo, hi = args.ph_hi;
    const bool fused = (hi - lo) > 1;
    XcdBarrier bar; bar.bar = (unsigned*)(args.ws + WS_CTL) + CW_BAR; bar.x = 0; bar.st = (volatile LAS unsigned*)(ldsl + LDS_MISC);
    if (fused) bar = xcd_barrier_post((unsigned*)(args.ws + WS_CTL) + CW_BAR, (volatile LAS unsigned*)(ldsl + LDS_MISC));
#ifndef PH_EN
#define PH_EN 0xff
#endif
#define IN(k) (lo <= (k) && (k) < hi)
#define SEAM(k) do { if (IN((k) + 1)) xcd_barrier(bar); } while (0)
    const int G = gridDim.x, bid = blockIdx.x;

    if ((PH_EN & 1) && IN(0)) { const Frame F = mkframe(args, launder(args.ws), ldsl); p0_prologue(F); SEAM(0); }

    for (int layer = 0; layer < DEPTH; ++layer) {
        const int pb = 1 + 6 * layer;
        if ((PH_EN & 2) && IN(pb)) {
            GA unsigned char* ws = launder(args.ws);
            pg8::Gemm g{(const GA bf16_t*)(ws + WS_XB), (const GA bf16_t*)(ws + WS_WIN) + (size_t)layer * NINP * DM, MT, NINP, DM}; pg8::StaticOrder S; S.init(MT, NINP, G, bid);
            EpiIn E{ws};
            pg8::gemm_phase<EpiIn, pg8::StaticOrder>(ldsl, g, S, E);
#if defined(DUP) && DUP == 0
            __syncthreads(); pg8::gemm_phase<EpiIn, pg8::StaticOrder>(ldsl, g, S, E);
#endif
            SEAM(pb);
        }
        if ((PH_EN & 4) && IN(pb + 1)) {
            const Frame F = mkframe(args, launder(args.ws), ldsl);
            if (bid < 8) fox_scan(F, layer, bid);
            GA unsigned* ctr = F.ctl + CW_Q + 64 * (layer * 4 + 0);
            for (int u = q_next(ctr, F.misc + 4); u < 2 * 576; u = q_next(ctr, F.misc + 4)) idx_unit(F, 2 * 576 - 1 - u);
#if defined(DUP) && DUP == 1
            { GA unsigned* ctr2 = F.ctl + CW_Q + 64 * (16 + layer * 4 + 0);
              for (int u = q_next(ctr2, F.misc + 4); u < 2 * 576; u = q_next(ctr2, F.misc + 4)) idx_unit(F, 2 * 576 - 1 - u); }
#endif
            SEAM(pb + 1);
        }
        if ((PH_EN & 8) && IN(pb + 2)) {
            const Frame F = mkframe(args, launder(args.ws), ldsl);
            const int wave = tid_l() >> 6;
            GA unsigned* ctr = F.ctl + CW_Q + 64 * (layer * 4 + 2);
            for (int u = q_next(ctr, F.misc + 4); u < 768; u = q_next(ctr, F.misc + 4)) attn_dil_unit(F, u);
            { const int gw = bid * 8 + wave, nW = G * 8;
              for (int i = 0; i * nW < MT; ++i) { const int k = ((i & 1) ? (nW - 1 - gw) : gw) + nW * i; if (k < MT) select_row(F, (k & 1) * SEQ + (SEQ - 1 - (k >> 1))); } }
#if defined(DUP) && DUP == 2
            { GA unsigned* ctr2 = F.ctl + CW_Q + 64 * (16 + layer * 4 + 2);
              for (int u = q_next(ctr2, F.misc + 4); u < 768; u = q_next(ctr2, F.misc + 4)) attn_dil_unit(F, u); }
#endif
#if defined(DUP) && DUP == 5
            { const int gw = bid * 8 + wave, nW = G * 8;
              for (int i = 0; i * nW < MT; ++i) { const int k = ((i & 1) ? (nW - 1 - gw) : gw) + nW * i; if (k < MT) select_row(F, (k & 1) * SEQ + (SEQ - 1 - (k >> 1))); } }
#endif
            SEAM(pb + 2);
        }
        if ((PH_EN & 16) && IN(pb + 3)) {
            const Frame F = mkframe(args, launder(args.ws), ldsl);
            GA unsigned* ctr = F.ctl + CW_Q + 64 * (layer * 4 + 1);
            for (int u = q_next(ctr, F.misc + 4); u < 256 + 512 + 512; u = q_next(ctr, F.misc + 4)) {
                if (u < 256) { const int qb = 31 - (u >> 3), r = u & 7; attn_diff_unit(F, layer, r & 1, r >> 1, qb); }
                else if (u < 768) { const int v = u - 256, qb = 31 - (v >> 4), r = v & 15, mode = r & 1, b = (r >> 1) & 1, h = r >> 2;
                    if (mode == 0) attn_fast_unit<0>(F, b, h, qb); else attn_fast_unit<1>(F, b, h, qb); }
                else dil_merge_unit(F, u - 768);
            }
#if defined(DUP) && DUP == 3
            { GA unsigned* ctr2 = F.ctl + CW_Q + 64 * (16 + layer * 4 + 1);
              for (int u = q_next(ctr2, F.misc + 4); u < 256 + 512 + 512; u = q_next(ctr2, F.misc + 4)) {
                if (u < 256) { const int qb = 31 - (u >> 3), r = u & 7; attn_diff_unit(F, layer, r & 1, r >> 1, qb); }
                else if (u < 768) { const int v = u - 256, qb = 31 - (v >> 4), r = v & 15, mode = r & 1, b = (r >> 1) & 1, h = r >> 2;
                    if (mode == 0) attn_fast_unit<0>(F, b, h, qb); else attn_fast_unit<1>(F, b, h, qb); }
                else dil_merge_unit(F, u - 768); } }
#endif
            SEAM(pb + 3);
        }
        if ((PH_EN & 32) && IN(pb + 4)) {
            GA unsigned char* ws = launder(args.ws);
            pg8::Gemm g{(const GA bf16_t*)(ws + WS_Y), (const GA bf16_t*)(ws + WS_WBR) + (size_t)layer * DM * DM, MT, DM, DM}; pg8::StaticOrder S; S.init(MT, DM, G, bid);
            EpiMerged E{(const GA bf16_t*)(ws + WS_G), (GA bf16_t*)(ws + WS_MG)};
            pg8::gemm_phase<EpiMerged, pg8::StaticOrder>(ldsl, g, S, E);
#if defined(DUP) && DUP == 4
            __syncthreads(); pg8::gemm_phase<EpiMerged, pg8::StaticOrder>(ldsl, g, S, E);
#endif
            SEAM(pb + 4);
        }
        if ((PH_EN & 64) && IN(pb + 5)) {
            GA unsigned char* ws = launder(args.ws);
            pg8::Gemm g{(const GA bf16_t*)(ws + WS_MG), (const GA bf16_t*)(ws + WS_WOUT) + (size_t)layer * DM * DM, MT, DM, DM}; pg8::StaticOrder S; S.init(MT, DM, G, bid);
            EpiOut E{(GA float*)(ws + WS_XRES), (GA bf16_t*)(ws + WS_XB), (GA float*)(ws + WS_SSQ)};
            pg8::gemm_phase<EpiOut, pg8::StaticOrder>(ldsl, g, S, E);
            SEAM(pb + 5);
        }
    }
    if ((PH_EN & 128) && IN(25)) { const Frame F = mkframe(args, launder(args.ws), ldsl); final_norm(F); }
#undef IN
#undef SEAM
}

extern "C" void kernel_launch(void* const* d_in, const int* in_sizes, int n_in, void* d_out, int out_size, void* d_ws, size_t ws_size, hipStream_t stream) {
    static int grid = 0;
    if (grid == 0) {
        if (n_in != 13 || in_sizes[0] != MT * DM || out_size != MT * DM || ws_size < WS_END) {
            fprintf(stderr, "kernel_launch: unexpected shapes (n_in %d, in0 %d, out %d, ws %zu, need %zu)\n", n_in, n_in > 0 ? in_sizes[0] : -1, out_size, ws_size, (size_t)WS_END); grid = -1; return; }
        int dev = 0, cus = 0, per_cu = 0;
        if (hipGetDevice(&dev) != hipSuccess || hipDeviceGetAttribute(&cus, hipDeviceAttributeMultiprocessorCount, dev) != hipSuccess) { grid = -1; return; }
        if (hipFuncSetAttribute((const void*)fwd, hipFuncAttributeMaxDynamicSharedMemorySize, LDS_BYTES) != hipSuccess) { fprintf(stderr, "kernel_launch: hipFuncSetAttribute failed\n"); grid = -1; return; }
        if (hipOccupancyMaxActiveBlocksPerMultiprocessor(&per_cu, (const void*)fwd, 512, LDS_BYTES) != hipSuccess || per_cu < 1) fprintf(stderr, "kernel_launch: occupancy query reports %d\n", per_cu);
        (void)hipGetLastError();
        grid = cus;
    }
    if (grid < 0) return;
    if (hipMemsetAsync((char*)d_ws + WS_CTL, 0, CTL_BYTES, stream) != hipSuccess) return;
    Args a{};
    for (int i = 0; i < 13; ++i) a.in[i] = (const float*)d_in[i];
    a.out = (float*)d_out; a.ws = (unsigned char*)d_ws;
#if MK_LAUNCHES == 1
    a.ph_lo = 0; a.ph_hi = NPH;
    hipLaunchKernelGGL(fwd, dim3(grid), dim3(512), LDS_BYTES, stream, a);
#else
    for (int p = 0; p < NPH; ++p) { a.ph_lo = p; a.ph_hi = p + 1; hipLaunchKernelGGL(fwd, dim3(grid), dim3(512), LDS_BYTES, stream, a); }
#endif
}
```

```cpp
#include <hip/hip_runtime.h>
#include <stdint.h>
#include <stdio.h>

#ifndef MK_LAUNCHES
#define MK_LAUNCHES 1
#endif

#define LAS __attribute__((address_space(3)))
#define GA __attribute__((address_space(1)))
typedef unsigned short bf16_t;
typedef short bf16x8 __attribute__((ext_vector_type(8)));
typedef float f32x4 __attribute__((ext_vector_type(4)));
typedef float f32x16 __attribute__((ext_vector_type(16)));
typedef unsigned u32x4 __attribute__((ext_vector_type(4)));
typedef unsigned u32x2 __attribute__((ext_vector_type(2)));
typedef unsigned long long u64;

constexpr int DM = 2048, NB = 2, SEQ = 8192, DEPTH = 4, MT = NB * SEQ;
constexpr int NIN = 17492, NINP = 4864, N8 = 12800;
constexpr float W8SCALE = 512.f;
constexpr int NPH = 22;
constexpr float LOG2E = 1.4426950408889634f;
constexpr float QSC128 = 0.08838834764831845f * 1.4426950408889634f;
constexpr float QSC64 = 0.125f * 1.4426950408889634f;
constexpr float RMS_EPS = 1e-6f;
constexpr size_t QS = (size_t)NB * 4 * SEQ * 128;

constexpr size_t al256(size_t x) { return (x + 255) & ~(size_t)255; }
constexpr size_t WS_CTL = 0, CTL_BYTES = 65536;
constexpr size_t WS_WIN = WS_CTL + CTL_BYTES;
constexpr size_t WS_WBR = WS_WIN + (size_t)DEPTH * NINP * DM * 2;
constexpr size_t WS_WOUT = WS_WBR + (size_t)DEPTH * DM * DM * 2;
constexpr size_t WS_XRES = WS_WOUT + (size_t)DEPTH * DM * DM * 2;
constexpr size_t WS_XB = WS_XRES + (size_t)MT * DM * 4;
constexpr size_t WS_SSQ = WS_XB + (size_t)MT * DM * 2;
constexpr size_t WS_ZS = WS_SSQ + (size_t)MT * 32 * 4;
constexpr size_t WS_G = WS_ZS + (size_t)MT * DM * 2;
constexpr size_t WS_QKV = WS_G + (size_t)MT * 8192 * 2;
constexpr size_t WS_IQ = WS_QKV + 12 * QS * 2;
constexpr size_t WS_IK = WS_IQ + (size_t)MT * 1024 * 2;
constexpr size_t WS_IW = WS_IK + (size_t)MT * 64 * 2;
constexpr size_t WS_FF = WS_IW + (size_t)MT * 16 * 4;
constexpr size_t WS_CUM = WS_FF + (size_t)MT * 4 * 4;
constexpr size_t WS_TB = WS_CUM + (size_t)NB * 4 * SEQ * 4;
constexpr size_t WS_SC = WS_TB + (size_t)12 * SEQ * 4;
constexpr size_t WS_MASK = WS_SC + (size_t)NB * SEQ * SEQ * 4;
constexpr size_t WS_Y = WS_MASK + (size_t)NB * SEQ * 128 * 8;
constexpr size_t WS_MG = WS_Y + (size_t)MT * DM * 2;
constexpr size_t WS_O1 = WS_MG + (size_t)MT * DM * 2;
constexpr size_t WS_OD = WS_O1 + (size_t)2 * 256 * 64 * 512 * 4;
constexpr size_t WS_LSE = WS_OD + (size_t)3 * MT * 512 * 4;
constexpr size_t WS_DP = WS_LSE + (size_t)3 * MT * 4 * 4;
constexpr size_t WS_WG8 = WS_DP + 4 * 256 * 4;
constexpr size_t WS_XQ = WS_WG8 + (size_t)DEPTH * N8 * DM;
constexpr size_t WS_END = WS_XQ + (size_t)MT * DM;

constexpr int CW_BAR = 0;
constexpr int CW_Q = 4096;
constexpr int CW_DC = 8192;
constexpr int CW_WQ = 13312;
constexpr int CW_KM = 12288;

constexpr int LDS_STAGE = 131072;
constexpr int LDS_MISC = 131072;
constexpr int LDS_BYTES = 147456;

__device__ __forceinline__ unsigned cvt_pk_bf16(float lo, float hi) { unsigned r; asm volatile("v_cvt_pk_bf16_f32 %0, %1, %2" : "=v"(r) : "v"(lo), "v"(hi)); return r; }
__device__ __forceinline__ float bf_lo(unsigned w) { return __uint_as_float(w << 16); }
__device__ __forceinline__ float bf_hi(unsigned w) { return __uint_as_float(w & 0xffff0000u); }
__device__ __forceinline__ float bf2f(bf16_t b) { return __uint_as_float(((unsigned)b) << 16); }
__device__ __forceinline__ float ex2(float x) { return __builtin_amdgcn_exp2f(x); }
__device__ __forceinline__ float sigmoidf_(float x) { return __builtin_amdgcn_rcpf(1.0f + ex2(-x * LOG2E)); }
__device__ __forceinline__ int tid_l() { int t = threadIdx.x; asm volatile("" : "+v"(t)); return t; }
__device__ __forceinline__ GA unsigned char* launder(unsigned char* p) { asm volatile("" : "+s"(p)); return (GA unsigned char*)p; }
__device__ __forceinline__ GA unsigned char* launder(GA unsigned char* p) { asm volatile("" : "+s"(p)); return p; }
__device__ __forceinline__ float wave_sum(float v) {
#pragma unroll
    for (int o = 32; o > 0; o >>= 1) v += __shfl_xor(v, o);
    return v;
}

#define XB_TMO      128
#define XB_XCNT(j)  (256  + 64 * (j))
#define XB_XSUB(j)  (1280 + 64 * (j))
#define XB_XGEN(j)  (2304 + 64 * (j))
#define XB_TOP      3328
#define XB_TOPGEN   3392
#define XCD_BAR_WORDS 3456
#define XB_SPIN_CAP (1u << 18)

__device__ __forceinline__ unsigned xb_ld(unsigned* p)              { return __hip_atomic_load(p, __ATOMIC_RELAXED, __HIP_MEMORY_SCOPE_AGENT); }
__device__ __forceinline__ unsigned xb_add(unsigned* p, unsigned v) { return __hip_atomic_fetch_add(p, v, __ATOMIC_RELAXED, __HIP_MEMORY_SCOPE_AGENT); }
__device__ __forceinline__ unsigned xb_xcc_id() { return (unsigned)__builtin_amdgcn_s_getreg((3 << 11) | 20) & 0xFu; }
#define XB_SPIN(cond, bar) do { unsigned _sp = 0; while (cond) { __builtin_amdgcn_s_sleep(1); \
    if ((++_sp & 255u) == 0u) { if (xb_ld(&(bar)[XB_TMO])) break; if (_sp > XB_SPIN_CAP) { atomicAdd(&(bar)[XB_TMO], 1u); break; } } } } while (0)

struct XcdBarrier { unsigned* bar; unsigned x; volatile LAS unsigned* st; };

__device__ __forceinline__ XcdBarrier xcd_barrier_post(unsigned* bar, volatile LAS unsigned* st) {
    XcdBarrier b; b.bar = bar; b.x = xb_xcc_id(); b.st = st;
    if (threadIdx.x == 0) (void)xb_add(&bar[XB_XCNT(b.x)], 1u);
    return b;
}
__device__ __forceinline__ void xcd_barrier_complete(unsigned* bar, unsigned x, unsigned& nloc, unsigned& nx) {
    const unsigned G = gridDim.x * gridDim.y * gridDim.z;
    unsigned sum, cnt, mine, sp = 0u;
    for (;;) {
        sum = 0u; cnt = 0u; mine = 0u;
#pragma unroll
        for (unsigned j = 0; j < 16; ++j) { const unsigned c = xb_ld(&bar[XB_XCNT(j)]); sum += c; cnt += (c > 0u) ? 1u : 0u; mine = (j == x) ? c : mine; }
        if (sum == G) break;
        __builtin_amdgcn_s_sleep(1);
        if ((++sp & 255u) == 0u) { if (xb_ld(&bar[XB_TMO])) break; if (sp > XB_SPIN_CAP) { atomicAdd(&bar[XB_TMO], 1u); break; } }
    }
    nloc = mine > 0u ? mine : 1u; nx = cnt > 0u ? cnt : 1u;
}
__device__ __forceinline__ void xcd_barrier(const XcdBarrier& b) {
    asm volatile("s_waitcnt vmcnt(0)" ::: "memory");
    __syncthreads();
    if (threadIdx.x == 0) {
        unsigned* bar = b.bar;
        __builtin_amdgcn_s_waitcnt(0);
        unsigned nloc = b.st[0], nx = b.st[1];
        if (nloc == 0u) { xcd_barrier_complete(bar, b.x, nloc, nx); b.st[0] = nloc; b.st[1] = nx; }
        const unsigned old = xb_add(&bar[XB_XSUB(b.x)], 1u);
        const unsigned gen = old / nloc;
        if (old + 1u == (gen + 1u) * nloc) {
            __builtin_amdgcn_fence(__ATOMIC_RELEASE, "agent");
            asm volatile("s_waitcnt vmcnt(0)" ::: "memory");
            const unsigned og = xb_add(&bar[XB_TOP], 1u);
            const unsigned tg = og / nx;
            if (og + 1u == (tg + 1u) * nx) xb_add(&bar[XB_TOPGEN], 1u);
            else XB_SPIN(xb_ld(&bar[XB_TOPGEN]) == tg, bar);
            __builtin_amdgcn_fence(__ATOMIC_ACQUIRE, "agent");
            xb_add(&bar[XB_XGEN(b.x)], 1u);
            asm volatile("s_waitcnt vmcnt(0)" ::: "memory");
        } else {
            XB_SPIN(xb_ld(&bar[XB_XGEN(b.x)]) == gen, bar);
            __builtin_amdgcn_fence(__ATOMIC_ACQUIRE, "agent");
            asm volatile("s_waitcnt vmcnt(0)" ::: "memory");
        }
    }
    __syncthreads();
}

namespace pg8 {
constexpr int BM = 256, BK = 64, HALF = 128, HTB = HALF * BK * 2, STAGE_BYTES = 8 * HTB, NXCD = 8, WGM = 4;
__host__ __device__ __forceinline__ int lds_byte(int r, int c) { const int st = (r >> 4) * 2 + (c >> 5), rr = r & 15, cc = c & 31, ob = rr * 64 + cc * 2; return st * 1024 + (ob ^ (((ob >> 9) & 1) << 5)); }
__host__ __device__ __forceinline__ void stage_rc(int b, int& R, int& C) { const int st = b / 1024, sb = b % 1024, swz = sb ^ (((sb >> 9) & 1) << 5); R = (st >> 1) * 16 + swz / 64; C = (st & 1) * 32 + (swz % 64) / 2; }
__host__ __device__ __forceinline__ int perm32(int rho) { const int n = rho >> 4, i = rho & 15; return 8 * (i >> 2) + 4 * n + (i & 3); }
struct Unit { int pm, pn; };
struct Gemm { const GA bf16_t* A; const GA bf16_t* Bt; int M, N, K; };
struct StaticOrder {
    int nM, nN, nwg, G, c, cnt;
    __host__ __device__ void init(int M, int N, int G_, int c_) { nM = M / BM; nN = N / BM; nwg = nM * nN; G = G_; c = c_; cnt = 1 << 30; }
    __host__ __device__ void init_part(int M, int N, int stride, int first, int cnt_) { nM = M / BM; nN = N / BM; nwg = nM * nN; G = stride; c = first; cnt = cnt_; }
    __host__ __device__ bool next(int i, Unit& u) const {
        const long L = (long)i * G + c; if (L >= nwg || i >= cnt) return false;
        int wgid = (int)L; { const int q = nwg / NXCD, r = nwg % NXCD, xcd = wgid % NXCD, off = wgid / NXCD; wgid = (xcd < r ? xcd * (q + 1) : r * (q + 1) + (xcd - r) * q) + off; }
        const int nig = WGM * nN, gid = wgid / nig, fm = gid * WGM, gsz = (nM - fm) < WGM ? (nM - fm) : WGM;
        u.pm = fm + ((wgid % nig) % gsz); u.pn = (wgid % nig) / gsz; return true;
    }
    __device__ __forceinline__ void a_ready(const Unit&) const {}
    __device__ __forceinline__ void done(const Unit&) const {}
};

template <class Epi, class Sched>
__device__ __forceinline__ void gemm_phase(LAS unsigned char* lds, const Gemm g, const Sched& S, const Epi& E) {
    const int tid = tid_l(), wid = __builtin_amdgcn_readfirstlane(tid >> 6), lane = tid & 63, wr = wid >> 2, wc = wid & 3, fr = lane & 15, fq = lane >> 4;
    const int K = g.K, nt = K / BK;
    unsigned voffA[2], voffB[2];
#pragma unroll
    for (int i = 0; i < 2; ++i) { int R, C; stage_rc(tid * 16 + i * 8192, R, C); const int Rb = Epi::PERM ? ((R & ~31) + perm32(R & 31)) : R;
        voffA[i] = (unsigned)(R * K + C) * 2u; voffB[i] = (unsigned)(Rb * K + C) * 2u; }
    const size_t kstep = (size_t)(BK * 2);
    const size_t hstep = (size_t)HALF * K * 2;
    const size_t tstep = 2 * hstep;
    const unsigned ldsw = (unsigned)wid * 1024u;
    const int aoff = lds_byte(wr * 64 + fr, fq * 8), boff = lds_byte(wc * 32 + fr, fq * 8);
    typedef int v8i_t __attribute__((ext_vector_type(8)));
    const int aoff8 = lds_byte(wr * 64 + fr, (fq & 1) * 16) + (fq >> 1) * 1024, boff8 = lds_byte(wc * 32 + fr, (fq & 1) * 16) + (fq >> 1) * 1024;
#define PG8_SA(b, h) (((b) * 2 + (h)) * HTB)
#define PG8_SB(b, h) ((4 + (b) * 2 + (h)) * HTB)
#define PG8_STAGE(bufoff, gbase, voff) do { _Pragma("unroll") for (int _i = 0; _i < 2; ++_i) \
        __builtin_amdgcn_global_load_lds((const GA unsigned*)((const GA char*)(gbase) + (voff)[_i]), (LAS unsigned*)(lds + (bufoff) + ldsw + _i * 8192), 16, 0, 0); } while (0)
#define PG8_LDA(dst, b, h) do { if constexpr (Epi::FP8) { _Pragma("unroll") for (int m = 0; m < 4; ++m) { typedef int v4i_t_ __attribute__((ext_vector_type(4))); const LAS char* p_ = (const LAS char*)(lds + PG8_SA(b, h) + aoff8 + m * 2048); const v4i_t_ lo_ = *(const LAS v4i_t_*)p_, hi_ = *(const LAS v4i_t_*)(p_ + 16); dst##8[m] = __builtin_shufflevector(lo_, hi_, 0, 1, 2, 3, 4, 5, 6, 7); } } \
        else { _Pragma("unroll") for (int m = 0; m < 4; ++m) _Pragma("unroll") for (int k = 0; k < 2; ++k) dst[m][k] = *(const LAS bf16x8*)(lds + PG8_SA(b, h) + aoff + m * 2048 + k * 1024); } } while (0)
#define PG8_LDB(dst, b, h) do { if constexpr (Epi::FP8) { _Pragma("unroll") for (int n = 0; n < 2; ++n) { typedef int v4i_t_ __attribute__((ext_vector_type(4))); const LAS char* p_ = (const LAS char*)(lds + PG8_SB(b, h) + boff8 + n * 2048); const v4i_t_ lo_ = *(const LAS v4i_t_*)p_, hi_ = *(const LAS v4i_t_*)(p_ + 16); dst##8[n] = __builtin_shufflevector(lo_, hi_, 0, 1, 2, 3, 4, 5, 6, 7); } } \
        else { _Pragma("unroll") for (int n = 0; n < 2; ++n) _Pragma("unroll") for (int k = 0; k < 2; ++k) dst[n][k] = *(const LAS bf16x8*)(lds + PG8_SB(b, h) + boff + n * 2048 + k * 1024); } } while (0)
#define PG8_MMA(ai, bj, At, Bt) do { __builtin_amdgcn_s_setprio(1); _Pragma("unroll") for (int m = 0; m < 4; ++m) _Pragma("unroll") for (int n = 0; n < 2; ++n) { \
        if constexpr (Epi::FP8) asm volatile("v_mfma_scale_f32_16x16x128_f8f6f4 %0, %1, %2, %0, %3, %3 op_sel_hi:[0,0,0]" : "+v"(acc[ai][bj][m][n]) : "v"(Bt##8[n]), "v"(At##8[m]), "v"(sc127)); \
        else { _Pragma("unroll") for (int k = 0; k < 2; ++k) acc[ai][bj][m][n] = __builtin_amdgcn_mfma_f32_16x16x32_bf16(Bt[n][k], At[m][k], acc[ai][bj][m][n], 0, 0, 0); } } \
        __builtin_amdgcn_s_setprio(0); } while (0)
#define PG8_WAIT_V(n) asm volatile("s_waitcnt vmcnt(" #n ")" ::: "memory")
#define PG8_WAIT_L(n) asm volatile("s_waitcnt lgkmcnt(" #n ")" ::: "memory")
#define PG8_BAR __builtin_amdgcn_s_barrier()
#define PG8_SCHED __builtin_amdgcn_sched_barrier(0)
    Unit cur, nxt; int ui = 0;
    if (!S.next(0, cur)) return;
    f32x4 acc[2][2][4][2];
#pragma unroll
    for (int a = 0; a < 2; ++a)
#pragma unroll
        for (int b = 0; b < 2; ++b)
#pragma unroll
            for (int m = 0; m < 4; ++m)
#pragma unroll
                for (int n = 0; n < 2; ++n) acc[a][b][m][n] = (f32x4){0.f, 0.f, 0.f, 0.f};
    bf16x8 At[4][2], B0[2][2], B1[2][2]; v8i_t At8[4], B08[2], B18[2]; const int sc127 = 127;
    const GA char* cA = (const GA char*)g.A + (size_t)cur.pm * tstep; const GA char* cB = (const GA char*)g.Bt + (size_t)cur.pn * tstep;
    S.a_ready(cur);
    PG8_STAGE(PG8_SB(0, 0), cB, voffB); PG8_STAGE(PG8_SA(0, 0), cA, voffA); PG8_STAGE(PG8_SB(0, 1), cB + hstep, voffB); PG8_STAGE(PG8_SA(0, 1), cA + hstep, voffA);
    if (wr == 1) PG8_BAR;
    PG8_WAIT_V(4); PG8_BAR;
    PG8_STAGE(PG8_SB(1, 0), cB + kstep, voffB); PG8_STAGE(PG8_SA(1, 0), cA + kstep, voffA); PG8_STAGE(PG8_SB(1, 1), cB + hstep + kstep, voffB);
    PG8_WAIT_V(6); PG8_BAR;
    for (;;) {
        const bool has_next = S.next(ui + 1, nxt);
        const GA char* nA = has_next ? (const GA char*)g.A + (size_t)nxt.pm * tstep : cA; const GA char* nB = has_next ? (const GA char*)g.Bt + (size_t)nxt.pn * tstep : cB;
        for (int t = 0; t < nt; t += 2) {
            const bool last = (t == nt - 2);
            const GA char* a1 = cA + (size_t)(t + 1) * kstep;
            const GA char* a2 = last ? nA : cA + (size_t)(t + 2) * kstep; const GA char* b2 = last ? nB : cB + (size_t)(t + 2) * kstep;
            const GA char* a3 = a2 + kstep; const GA char* b3 = b2 + kstep;
            if (last && has_next) S.a_ready(nxt);
            if constexpr (Epi::MIDK) { if (t > 0 && (t & 7) == 0) E.mid(acc, cur, t >> 3, wr, wc, fr, fq); }
            PG8_LDB(B0, 0, 0); PG8_SCHED; PG8_LDA(At, 0, 0); PG8_STAGE(PG8_SA(1, 1), a1 + hstep, voffA);
            PG8_WAIT_L(8); PG8_BAR; PG8_WAIT_L(0); PG8_MMA(0, 0, At, B0); PG8_BAR; PG8_SCHED;
            PG8_LDB(B1, 0, 1); PG8_STAGE(PG8_SB(0, 0), b2, voffB);
            PG8_BAR; PG8_WAIT_L(0); PG8_MMA(0, 1, At, B1); PG8_BAR;
            PG8_LDA(At, 0, 1); PG8_STAGE(PG8_SA(0, 0), a2, voffA);
            PG8_BAR; PG8_WAIT_L(0); PG8_MMA(1, 0, At, B0); PG8_BAR; PG8_SCHED;
            PG8_STAGE(PG8_SB(0, 1), b2 + hstep, voffB);
            PG8_WAIT_V(6); PG8_BAR; PG8_MMA(1, 1, At, B1); PG8_BAR;
            PG8_LDB(B0, 1, 0); PG8_SCHED; PG8_LDA(At, 1, 0); PG8_STAGE(PG8_SA(0, 1), a2 + hstep, voffA);
            PG8_WAIT_L(8); PG8_BAR; PG8_WAIT_L(0); PG8_MMA(0, 0, At, B0); PG8_BAR; PG8_SCHED;
            PG8_LDB(B1, 1, 1); PG8_STAGE(PG8_SB(1, 0), b3, voffB);
            PG8_BAR; PG8_WAIT_L(0); PG8_MMA(0, 1, At, B1); PG8_BAR;
            PG8_LDA(At, 1, 1); PG8_STAGE(PG8_SA(1, 0), a3, voffA);
            PG8_BAR; PG8_WAIT_L(0); PG8_MMA(1, 0, At, B0); PG8_BAR; PG8_SCHED;
            PG8_STAGE(PG8_SB(1, 1), b3 + hstep, voffB);
            PG8_WAIT_V(6); PG8_BAR; PG8_MMA(1, 1, At, B1); PG8_BAR;
        }
        if constexpr (Epi::FP8) asm volatile("s_nop 15\n\ts_nop 15" ::: "memory");
        E(acc, cur, wr, wc, fr, fq); S.done(cur);
#if defined(DUP) && DUP == 7
        if constexpr (!Epi::MIDK && Epi::PERM) { asm volatile("s_waitcnt vmcnt(0)" ::: "memory"); E(acc, cur, wr, wc, fr, fq); E(acc, cur, wr, wc, fr, fq); }
#endif
        if (!has_next) break;
#pragma unroll
        for (int a = 0; a < 2; ++a)
#pragma unroll
            for (int b = 0; b < 2; ++b)
#pragma unroll
                for (int m = 0; m < 4; ++m)
#pragma unroll
                    for (int n = 0; n < 2; ++n) acc[a][b][m][n] = (f32x4){0.f, 0.f, 0.f, 0.f};
        cur = nxt; cA = nA; cB = nB; ++ui;
    }
    PG8_WAIT_V(0);
    if (wr == 0) PG8_BAR;
    PG8_BAR;
#undef PG8_SA
#undef PG8_SB
#undef PG8_STAGE
#undef PG8_LDA
#undef PG8_LDB
#undef PG8_MMA
#undef PG8_WAIT_V
#undef PG8_WAIT_L
#undef PG8_BAR
#undef PG8_SCHED
}
}

struct Args { const float* in[13]; float* out; unsigned char* ws; int ph_lo, ph_hi; };
struct Frame {
    const GA float* x; const GA float* norm_w; const GA float* w_in; const GA float* fox_b; const GA float* lq1; const GA float* lk1; const GA float* lq2; const GA float* lk2;
    const GA float* subln; const GA float* w_branch; const GA float* w_out; const GA float* rel_bias; const GA float* final_w; GA float* out;
    GA unsigned* ctl; GA bf16_t* WinT; GA bf16_t* WbrT; GA bf16_t* WoutT; GA float* xres; GA bf16_t* xb; GA float* ssq; GA bf16_t* Zs; GA bf16_t* G; GA bf16_t* QKV; GA bf16_t* IQ; GA bf16_t* IK;
    GA float* IW; GA float* FF; GA float* cum; GA float* tb; GA float* sc; GA u64* mask; GA bf16_t* Y; GA bf16_t* MG; GA float* O1; GA float* OD; GA float* LSE; GA float* DP; GA unsigned char* ws;
    LAS unsigned char* lds; volatile LAS unsigned* misc;
};

__device__ __forceinline__ int q_next(GA unsigned* ctr, volatile LAS unsigned* lw) {
    __syncthreads();
    if (threadIdx.x == 0) *lw = __hip_atomic_fetch_add(ctr, 1u, __ATOMIC_RELAXED, __HIP_MEMORY_SCOPE_AGENT);
    __syncthreads();
    return (int)*lw;
}

__device__ __forceinline__ int win_src_col(int n) {
    if (n < 2048) return n;
    if (n < 3072) return n - 2048 + 11776;
    if (n < 4608) return n - 3072 + 14420;
    if (n < 4672) return n - 4608 + 12800;
    if (n < 4688) return n - 4672 + 12864;
    if (n < 4692) return n - 4688 + 14416;
    return -1;
}
__device__ __forceinline__ int win8_src_col(int n) {
    if (n < 8192) return n + 2048;
    if (n < 9728) return n - 8192 + 10240;
    if (n < 11264) return n - 9728 + 12880;
    return n - 11264 + 15956;
}
__device__ __forceinline__ void transpose_tile(const GA float* src, int ld, int srccol4, const GA float* ksc, GA bf16_t* dst, int k0, int n0, LAS float* tile) {
    const int tid = tid_l(), tk = tid >> 5, tn4 = (tid & 31) * 4;
    f32x4 v[4];
#pragma unroll
    for (int i = 0; i < 4; ++i) { const int kk = tk + 16 * i; v[i] = (f32x4){0.f, 0.f, 0.f, 0.f};
        if (srccol4 >= 0) { v[i] = *(const GA f32x4*)(src + (size_t)(k0 + kk) * ld + srccol4); if (ksc) v[i] *= ksc[k0 + kk]; } }
#pragma unroll
    for (int i = 0; i < 4; ++i) { const int kk = tk + 16 * i;
#pragma unroll
        for (int j = 0; j < 4; ++j) tile[kk * 129 + tn4 + j] = v[i][j]; }
    __syncthreads();
    const int wn = tid >> 2, wk = tid & 3;
    float f[16];
#pragma unroll
    for (int j = 0; j < 16; ++j) f[j] = tile[(wk * 16 + j) * 129 + wn];
    u32x4 w0 = {cvt_pk_bf16(f[0], f[1]), cvt_pk_bf16(f[2], f[3]), cvt_pk_bf16(f[4], f[5]), cvt_pk_bf16(f[6], f[7])};
    u32x4 w1 = {cvt_pk_bf16(f[8], f[9]), cvt_pk_bf16(f[10], f[11]), cvt_pk_bf16(f[12], f[13]), cvt_pk_bf16(f[14], f[15])};
    GA u32x4* dp = (GA u32x4*)(dst + (size_t)(n0 + wn) * DM + k0 + wk * 16);
    dp[0] = w0; dp[1] = w1;
    __syncthreads();
}
__device__ __forceinline__ unsigned cvt4_fp8(float a, float b, float c, float d) {
    unsigned w = 0u; w = __builtin_amdgcn_cvt_pk_fp8_f32(a, b, w, false); w = __builtin_amdgcn_cvt_pk_fp8_f32(c, d, w, true); return w;
}
__device__ __forceinline__ void transpose_tile8(const GA float* src, int ld, int srccol4, const GA float* ksc, GA unsigned char* dst, int k0, int n0, LAS float* tile) {
    const int tid = tid_l(), tk = tid >> 5, tn4 = (tid & 31) * 4;
    f32x4 v[4];
#pragma unroll
    for (int i = 0; i < 4; ++i) { const int kk = tk + 16 * i; v[i] = *(const GA f32x4*)(src + (size_t)(k0 + kk) * ld + srccol4) * (ksc[k0 + kk] * W8SCALE); }
#pragma unroll
    for (int i = 0; i < 4; ++i) { const int kk = tk + 16 * i;
#pragma unroll
        for (int j = 0; j < 4; ++j) tile[kk * 129 + tn4 + j] = v[i][j]; }
    __syncthreads();
    const int wn = tid >> 2, wk = tid & 3;
    float f[16];
#pragma unroll
    for (int j = 0; j < 16; ++j) f[j] = tile[(wk * 16 + j) * 129 + wn];
    u32x4 w = {cvt4_fp8(f[0], f[1], f[2], f[3]), cvt4_fp8(f[4], f[5], f[6], f[7]), cvt4_fp8(f[8], f[9], f[10], f[11]), cvt4_fp8(f[12], f[13], f[14], f[15])};
    *(GA u32x4*)(dst + (size_t)(n0 + wn) * DM + k0 + wk * 16) = w;
    __syncthreads();
}
__device__ __forceinline__ int t5_bucket(int d) {
    if (d < 16) return d;
    const int th[15] = {22, 30, 40, 54, 73, 99, 134, 182, 246, 332, 450, 609, 825, 1117, 1513};
    int b = 16;
#pragma unroll
    for (int i = 0; i < 15; ++i) b += (d >= th[i]) ? 1 : 0;
    return b;
}
constexpr int WT_TW = 32 * 38, WT_TG = 32 * 100, WT_TB = 32 * 16, WT_TL = WT_TW + WT_TG + 2 * WT_TB;
__device__ __forceinline__ void weight_tile(const Frame& F, int l, int r, LAS float* tile) {
    const int tid = tid_l();
    if (r < WT_TW) { const int nt = r % 38, kt = r / 38; const int n = nt * 128 + (tid & 31) * 4;
        transpose_tile(F.w_in + (size_t)l * DM * NIN, NIN, win_src_col(n), F.norm_w + l * DM, F.WinT + (size_t)l * NINP * DM, kt * 64, nt * 128, tile); }
    else if (r < WT_TW + WT_TG) { const int q = r - WT_TW, nt = q % 100, kt = q / 100;
        transpose_tile8(F.w_in + (size_t)l * DM * NIN, NIN, win8_src_col(nt * 128 + (tid & 31) * 4), F.norm_w + l * DM, F.ws + WS_WG8 + (size_t)l * N8 * DM, kt * 64, nt * 128, tile); }
    else if (r < WT_TW + WT_TG + WT_TB) { const int q = r - WT_TW - WT_TG, nt = q % 16, kt = q / 16;
        transpose_tile(F.w_branch + (size_t)l * DM * DM, DM, nt * 128 + (tid & 31) * 4, (const GA float*)nullptr, F.WbrT + (size_t)l * DM * DM, kt * 64, nt * 128, tile); }
    else { const int q = r - WT_TW - WT_TG - WT_TB, nt = q % 16, kt = q / 16;
        transpose_tile(F.w_out + (size_t)l * DM * DM, DM, nt * 128 + (tid & 31) * 4, (const GA float*)nullptr, F.WoutT + (size_t)l * DM * DM, kt * 64, nt * 128, tile); }
}
__device__ __forceinline__ void p0_prologue(const Frame& F) {
    const int tid = tid_l(), lane = tid & 63, wave = tid >> 6, G = gridDim.x, bid = blockIdx.x;
    LAS float* tile = (LAS float*)F.lds;
    for (int j = bid; j < WT_TW + WT_TG; j += G) weight_tile(F, 0, j, tile);
    for (int row = bid * 8 + wave; row < MT; row += G * 8) {
        const GA float* xr = F.x + (size_t)row * DM; float ss = 0.f;
#pragma unroll
        for (int i = 0; i < 8; ++i) { const int c = (i * 64 + lane) * 4; const f32x4 v = *(const GA f32x4*)(xr + c);
            ss += v[0] * v[0] + v[1] * v[1] + v[2] * v[2] + v[3] * v[3];
            u32x2 w = {cvt_pk_bf16(v[0], v[1]), cvt_pk_bf16(v[2], v[3])}; *(GA u32x2*)(F.xb + (size_t)row * DM + c) = w;
            *(GA unsigned*)(F.ws + WS_XQ + (size_t)row * DM + c) = cvt4_fp8(v[0], v[1], v[2], v[3]); }
        ss = wave_sum(ss);
        if (lane < 32) F.ssq[(size_t)row * 32 + lane] = (lane == 0) ? ss : 0.f;
    }
    if (bid == 0 && tid < DEPTH * 128) { const int l = tid >> 7, i = tid & 127;
        const float lam_init = 0.8f - 0.6f * expf(-0.3f * (float)l);
        F.DP[l * 256 + 128 + i] = F.subln[l * 128 + i] * (1.0f - lam_init);
        if (i == 0) { float s1 = 0.f, s2 = 0.f;
            for (int k = 0; k < 64; ++k) { s1 = fmaf(F.lq1[l * 64 + k], F.lk1[l * 64 + k], s1); s2 = fmaf(F.lq2[l * 64 + k], F.lk2[l * 64 + k], s2); }
            F.DP[l * 256] = expf(s1) - expf(s2) + lam_init; F.DP[l * 256 + 1] = 1.0f - lam_init; } }
    for (int i = bid * 512 + tid; i < 12 * SEQ; i += G * 512) { const int hd = i / SEQ, d = i % SEQ; F.tb[i] = F.rel_bias[t5_bucket(d) * 12 + hd] * LOG2E; }
}

struct EpiIn {
    static constexpr bool PERM = true, AFTER_DRAIN = false, MIDK = false, FP8 = false;
    GA unsigned char* ws;
    template <int KIND>
    __device__ __forceinline__ void body(const f32x4 (&acc)[2][2][4][2], int row0_, int cl_, int fq, GA bf16_t* base, int ldc, float qscale, int headbase) const {
        int row0 = row0_, cl = cl_; asm volatile("" : "+v"(row0), "+v"(cl));
        const GA float* ssq = (const GA float*)(ws + WS_SSQ);
        float scv_[2][4];
#pragma unroll
        for (int ai = 0; ai < 2; ++ai) {
            f32x4 sq_[4][2];
#pragma unroll
            for (int m = 0; m < 4; ++m) { const GA float* sp = ssq + (size_t)(row0 + ai * 128 + m * 16) * 32 + fq * 8;
                sq_[m][0] = *(const GA f32x4*)sp; sq_[m][1] = *(const GA f32x4*)(sp + 4); }
#pragma unroll
            for (int m = 0; m < 4; ++m) { const f32x4 s4 = sq_[m][0] + sq_[m][1];
                float ssum = (s4[0] + s4[1]) + (s4[2] + s4[3]);
                ssum += __shfl_xor(ssum, 16); ssum += __shfl_xor(ssum, 32);
                scv_[ai][m] = __builtin_amdgcn_rsqf(ssum * (1.0f / DM) + RMS_EPS) * qscale; }
            asm volatile("" :: "v"(scv_[ai][0]), "v"(scv_[ai][1]), "v"(scv_[ai][2]), "v"(scv_[ai][3]));
        }
#pragma unroll
        for (int ai = 0; ai < 2; ++ai)
#pragma unroll
            for (int m = 0; m < 4; ++m) {
                const int r = row0 + ai * 128 + m * 16;
                const float sc = scv_[ai][m];
#pragma unroll
                for (int bj = 0; bj < 2; ++bj) {
                    f32x4 v0 = acc[ai][bj][m][0] * sc, v1 = acc[ai][bj][m][1] * sc;
                    if (KIND == 0) {
#pragma unroll
                        for (int j = 0; j < 4; ++j) { v0[j] = v0[j] * sigmoidf_(v0[j]); v1[j] = v1[j] * sigmoidf_(v1[j]); }
                    } else if (KIND == 1) {
#pragma unroll
                        for (int j = 0; j < 4; ++j) { v0[j] = sigmoidf_(v0[j]) * 256.0f; v1[j] = sigmoidf_(v1[j]) * 256.0f; }
                    }
                    if (KIND == 4) {
                        if (bj == 0) {
                            if (cl < 64) { u32x4 w = {cvt_pk_bf16(v0[0], v0[1]), cvt_pk_bf16(v0[2], v0[3]), cvt_pk_bf16(v1[0], v1[1]), cvt_pk_bf16(v1[2], v1[3])};
                                *(GA u32x4*)((GA bf16_t*)(ws + WS_IK) + (size_t)(r >> 5) * 2048 + (cl >> 4) * 512 + (((cl >> 3) & 1) * 32 + (r & 31)) * 8) = w; }
                            else if (cl < 80) { GA float* iw = (GA float*)(ws + WS_IW) + (size_t)r * 16 + (cl - 64); *(GA f32x4*)iw = v0; *(GA f32x4*)(iw + 4) = v1; }
                            else if (cl == 80) { *(GA f32x4*)((GA float*)(ws + WS_FF) + (size_t)r * 4) = v0; }
                        }
                    } else {
                        if (KIND == 1) {
                            u32x2 w;
                            { const unsigned a = __builtin_amdgcn_cvt_pk_u8_f32(v0[0], 0, 0u), b = __builtin_amdgcn_cvt_pk_u8_f32(v0[1], 1, a), c = __builtin_amdgcn_cvt_pk_u8_f32(v0[2], 2, b); w[0] = __builtin_amdgcn_cvt_pk_u8_f32(v0[3], 3, c); }
                            { const unsigned a = __builtin_amdgcn_cvt_pk_u8_f32(v1[0], 0, 0u), b = __builtin_amdgcn_cvt_pk_u8_f32(v1[1], 1, a), c = __builtin_amdgcn_cvt_pk_u8_f32(v1[2], 2, b); w[1] = __builtin_amdgcn_cvt_pk_u8_f32(v1[3], 3, c); }
                            *(GA u32x2*)((GA unsigned char*)base + (size_t)r * ldc + bj * 128 + cl) = w;
                            continue;
                        }
                        GA bf16_t* dst;
                        if (KIND == 2) { const int b = r >> 13, s = r & (SEQ - 1); dst = base + ((size_t)(b * 4 + headbase + bj) * SEQ + s) * 128 + cl; }
                        else dst = base + (size_t)r * ldc + bj * 128 + cl;
                        u32x4 w = {cvt_pk_bf16(v0[0], v0[1]), cvt_pk_bf16(v0[2], v0[3]), cvt_pk_bf16(v1[0], v1[1]), cvt_pk_bf16(v1[2], v1[3])};
                        *(GA u32x4*)dst = w;
                    }
                }
            }
    }
    __device__ __forceinline__ void operator()(const f32x4 (&acc)[2][2][4][2], const pg8::Unit& u, int wr, int wc, int fr, int fq) const {
        const int row0 = u.pm * 256 + wr * 64 + fr, pn = u.pn, cl = wc * 32 + 8 * fq;
        if (pn < 8) body<0>(acc, row0, cl, fq, (GA bf16_t*)(ws + WS_ZS) + pn * 256, DM, 1.f, 0);
        else if (pn < 12) body<3>(acc, row0, cl, fq, (GA bf16_t*)(ws + WS_IQ) + (pn - 8) * 256, 1024, 1.f, 0);
        else if (pn < 18) { const int t6 = pn - 12, which = t6 >> 1;
            body<2>(acc, row0, cl, fq, (GA bf16_t*)(ws + WS_QKV) + (size_t)(2 * 3 + which) * QS, 0, (which == 0) ? QSC64 : 1.f, (t6 & 1) * 2); }
        else body<4>(acc, row0, cl, fq, (GA bf16_t*)nullptr, 0, 1.f, 0);
    }
};

struct EpiGate {
    static constexpr bool PERM = true, AFTER_DRAIN = false, MIDK = false, FP8 = true;
    GA unsigned char* ws;
    __device__ __forceinline__ void operator()(const f32x4 (&acc)[2][2][4][2], const pg8::Unit& u, int wr, int wc, int fr, int fq) const {
        const int row0 = u.pm * 256 + wr * 64 + fr, cl = wc * 32 + 8 * fq, pn = u.pn;
        EpiIn e{ws};
        if (pn < 32) e.body<1>(acc, row0, cl, fq, (GA bf16_t*)(ws + WS_G + pn * 256), 8192, 1.0f / W8SCALE, 0);
        else { const int q = pn - 32, mixer = (q < 6) ? 0 : (q < 12 ? 1 : 3), t6 = q % 6, which = t6 >> 1;
            e.body<2>(acc, row0, cl, fq, (GA bf16_t*)(ws + WS_QKV) + (size_t)(mixer * 3 + which) * QS, 0, ((which == 0) ? QSC128 : 1.f) * (1.0f / W8SCALE), (t6 & 1) * 2); }
    }
};

__device__ __forceinline__ void fox_scan(const Frame& F, int layer, int seqid) {
    const int tid = tid_l(), lane = tid & 63, wave = tid >> 6, b = seqid >> 2, h = seqid & 3;
    LAS float* sm = (LAS float*)F.lds;
    const float bias = F.fox_b[layer * 4 + h];
    float v[16]; float run = 0.f;
#pragma unroll
    for (int i = 0; i < 16; ++i) { const int s = tid * 16 + i; const float x = F.FF[(size_t)(b * SEQ + s) * 4 + h] + bias;
        const float ls = fminf(x, 0.f) - log1pf(expf(-fabsf(x))); run += ls; v[i] = run; }
    float incl = run;
#pragma unroll
    for (int o = 1; o < 64; o <<= 1) { const float t = __shfl_up(incl, o); if (lane >= o) incl += t; }
    if (lane == 63) sm[wave] = incl;
    __syncthreads();
    float woff = 0.f;
    for (int w = 0; w < wave; ++w) woff += sm[w];
    const float excl = woff + incl - run;
#pragma unroll
    for (int i = 0; i < 16; ++i) F.cum[(size_t)(b * 4 + h) * SEQ + tid * 16 + i] = (excl + v[i]) * LOG2E;
    __syncthreads();
}
__device__ __forceinline__ void fox_kmax(const Frame& F, int layer) {
    const int tid = tid_l(), lane = tid & 63, wave = tid >> 6, G = gridDim.x, bid = blockIdx.x;
    const GA bf16_t* Kf = F.QKV + (size_t)(1 * 3 + 1) * QS;
    LAS float* sm = (LAS float*)F.lds;
    const int bh = bid & 7, part = bid >> 3, nparts = (G + 7 - bh) / 8;
    float mx = 0.f;
    for (int r4 = part * 8 + wave; r4 < SEQ / 4; r4 += nparts * 8) {
        const u32x4 w = *(const GA u32x4*)(Kf + ((size_t)bh * SEQ + r4 * 4 + (lane >> 4)) * 128 + (lane & 15) * 8); float ss = 0.f;
#pragma unroll
        for (int j = 0; j < 4; ++j) { const float a = bf_lo(w[j]), b = bf_hi(w[j]); ss = fmaf(a, a, ss); ss = fmaf(b, b, ss); }
        ss += __shfl_xor(ss, 1); ss += __shfl_xor(ss, 2); ss += __shfl_xor(ss, 4); ss += __shfl_xor(ss, 8);
        mx = fmaxf(mx, ss); }
#pragma unroll
    for (int o = 32; o > 0; o >>= 1) mx = fmaxf(mx, __shfl_xor(mx, o));
    __syncthreads();
    if (lane == 0) sm[wave] = mx;
    __syncthreads();
    if (tid == 0) { float m8 = sm[0];
#pragma unroll
        for (int w = 1; w < 8; ++w) m8 = fmaxf(m8, sm[w]);
        __hip_atomic_fetch_max(F.ctl + CW_KM + layer * 8 + bh, __float_as_uint(m8), __ATOMIC_RELAXED, __HIP_MEMORY_SCOPE_AGENT); }
    __syncthreads();
}
__device__ __forceinline__ void idx_unit(const Frame& F, int unit) {
    const int b = unit / 576; int id = unit % 576; int g = 0;
    while (8 * (g + 1) * (g + 2) <= id) ++g;
    const int rem = id - 8 * g * (g + 1), qb = 16 * g + rem / (g + 1), kc = rem % (g + 1);
    const int tid = tid_l(), lane = tid & 63, wave = __builtin_amdgcn_readfirstlane(tid >> 6), n32 = lane & 31, hi = lane >> 5;
    const int tq0 = qb * 64 + wave * 8;
    const int qa = (n32 >> 2) & 1, ha = (n32 & 3) + 4 * (n32 >> 3);
    bf16x8 Af[4][4]; float wr_[4][16];
#pragma unroll
    for (int p = 0; p < 4; ++p) {
        const GA bf16_t* qp = F.IQ + (size_t)(b * SEQ + tq0 + 2 * p + qa) * 1024 + ha * 64 + hi * 8;
#pragma unroll
        for (int ks = 0; ks < 4; ++ks) Af[p][ks] = *(const GA bf16x8*)(qp + ks * 16);
        const GA float* wp = F.IW + (size_t)(b * SEQ + tq0 + 2 * p + hi) * 16;
#pragma unroll
        for (int q4 = 0; q4 < 4; ++q4) { const f32x4 w4 = *(const GA f32x4*)(wp + 4 * q4); wr_[p][4 * q4] = w4[0]; wr_[p][4 * q4 + 1] = w4[1]; wr_[p][4 * q4 + 2] = w4[2]; wr_[p][4 * q4 + 3] = w4[3]; }
    }
    const int smax = tq0 + 7;
    int nj = (smax - kc * 1024) / 32 + 1; nj = nj > 32 ? 32 : nj;
    const GA bf16_t* kp0 = F.IK + (size_t)(b * SEQ + kc * 1024 + n32) * 64 + hi * 8;
    GA float* sp0 = F.sc + ((size_t)(b * SEQ + tq0 + hi)) * SEQ + kc * 1024 + n32;
    bf16x8 Bn[4];
#pragma unroll
    for (int ks = 0; ks < 4; ++ks) Bn[ks] = *(const GA bf16x8*)(kp0 + ks * 16);
    for (int j = 0; j < nj; ++j) {
        bf16x8 Bf[4];
#pragma unroll
        for (int ks = 0; ks < 4; ++ks) Bf[ks] = Bn[ks];
        if (j + 1 < nj) {
#pragma unroll
            for (int ks = 0; ks < 4; ++ks) Bn[ks] = *(const GA bf16x8*)(kp0 + (size_t)(j + 1) * 32 * 64 + ks * 16);
        }
#pragma unroll
        for (int p = 0; p < 4; ++p) {
            f32x16 c = {};
#pragma unroll
            for (int ks = 0; ks < 4; ++ks) c = __builtin_amdgcn_mfma_f32_32x32x16_bf16(Af[p][ks], Bf[ks], c, 0, 0, 0);
            float sc = 0.f;
#pragma unroll
            for (int r = 0; r < 16; ++r) sc = fmaf(wr_[p][r], fmaxf(c[r], 0.f), sc);
            sp0[(size_t)(2 * p) * SEQ + j * 32] = sc;
        }
    }
}

__device__ __forceinline__ unsigned sel_key(float f) { const unsigned u = __float_as_uint(f == 0.f ? 0.f : f); return (u >> 31) ? ~u : (u | 0x80000000u); }
__device__ __forceinline__ int wave_sum_i(int v) {
#pragma unroll
    for (int o = 32; o > 0; o >>= 1) v += __shfl_xor(v, o);
    return v;
}
__device__ __forceinline__ void select_row(const Frame& F, int row_) {
    const int row = __builtin_amdgcn_readfirstlane(row_);
    const int lane = tid_l() & 63, t = row & (SEQ - 1);
    GA u64* mrow = F.mask + (size_t)row * 128;
    if (t < 256) {
#pragma unroll
        for (int half = 0; half < 2; ++half) { const int j = half * 64 + lane; const int lo = j * 64; u64 w = 0ull;
            if (t >= lo + 63) w = ~0ull; else if (t >= lo) w = (~0ull) >> (63 - (t - lo));
            mrow[j] = w; }
        return;
    }
    const GA float* srow = F.sc + (size_t)row * SEQ + lane;
    const int nj = (t >> 6) + 1;
    unsigned key[128];
#pragma unroll
    for (int jj = 0; jj < 4; ++jj) {
        if (jj * 32 < nj) {
#pragma unroll
            for (int j = jj * 32; j < jj * 32 + 32; ++j) key[j] = __float_as_uint(srow[j * 64]);
        }
    }
#pragma unroll
    for (int jj = 0; jj < 4; ++jj) {
        if (jj * 32 < nj) {
#pragma unroll
            for (int j = jj * 32; j < jj * 32 + 32; ++j) key[j] = (j * 64 + lane <= t) ? sel_key(__uint_as_float(key[j])) : 0u;
        } else {
#pragma unroll
            for (int j = jj * 32; j < jj * 32 + 32; ++j) key[j] = 0u;
        }
    }
#define CNT8(j0) do { u64 b0 = __ballot(key[(j0)] >= cand), b1 = __ballot(key[(j0) + 1] >= cand), b2 = __ballot(key[(j0) + 2] >= cand), b3 = __ballot(key[(j0) + 3] >= cand), \
        b4 = __ballot(key[(j0) + 4] >= cand), b5 = __ballot(key[(j0) + 5] >= cand), b6 = __ballot(key[(j0) + 6] >= cand), b7 = __ballot(key[(j0) + 7] >= cand); \
        asm volatile("" : "+s"(b0), "+s"(b1), "+s"(b2), "+s"(b3), "+s"(b4), "+s"(b5), "+s"(b6), "+s"(b7)); \
        c += (__popcll(b0) + __popcll(b1)) + (__popcll(b2) + __popcll(b3)) + (__popcll(b4) + __popcll(b5)) + (__popcll(b6) + __popcll(b7)); } while (0)
#define COUNT_GE() do { c = 0; _Pragma("unroll") for (int jj = 0; jj < 4; ++jj) { if (jj * 32 < nj) { CNT8(jj * 32); CNT8(jj * 32 + 8); CNT8(jj * 32 + 16); CNT8(jj * 32 + 24); } } } while (0)
    unsigned mx = 0u;
#pragma unroll
    for (int j = 0; j < 128; ++j) mx = key[j] > mx ? key[j] : mx;
#pragma unroll
    for (int o = 32; o > 0; o >>= 1) { const unsigned t2 = (unsigned)__shfl_xor((int)mx, o); mx = t2 > mx ? t2 : mx; }
    unsigned prefix = 0u; int cge = 1 << 30, c, bit = 31;
    { const unsigned e9 = mx >> 23;
      for (unsigned k = 0; k < 6u && k <= e9; ++k) { const unsigned cand = (e9 - k) << 23; COUNT_GE();
          if (c >= 256) { prefix = cand; cge = c; bit = 22; break; } } }
    if (cge != 256) {
        for (; bit >= 0; --bit) {
            const unsigned cand = prefix | (1u << bit); COUNT_GE();
            if (c >= 256) { prefix = cand; cge = c; if (c == 256) break; }
        }
    }
#undef CNT8
#undef COUNT_GE
    if (cge == 256) {
        unsigned w0l = 0u, w0h = 0u, w1l = 0u, w1h = 0u;
#pragma unroll
        for (int j = 0; j < 64; ++j) { const u64 word = __ballot(key[j] >= prefix);
            asm volatile("s_nop 1\n\tv_writelane_b32 %0, %1, %2" : "+v"(w0l) : "s"((unsigned)word), "n"(j)); asm volatile("v_writelane_b32 %0, %1, %2" : "+v"(w0h) : "s"((unsigned)(word >> 32)), "n"(j)); }
        if (nj > 64) {
#pragma unroll
            for (int j = 64; j < 128; ++j) { const u64 word = __ballot(key[j] >= prefix);
                asm volatile("s_nop 1\n\tv_writelane_b32 %0, %1, %2" : "+v"(w1l) : "s"((unsigned)word), "n"(j - 64)); asm volatile("v_writelane_b32 %0, %1, %2" : "+v"(w1h) : "s"((unsigned)(word >> 32)), "n"(j - 64)); }
        }
        mrow[lane] = ((u64)w0h << 32) | w0l; mrow[64 + lane] = ((u64)w1h << 32) | w1l;
    } else {
        int cgt = 0;
        for (int j = 0; j < nj; ++j) { const int s = j * 64 + lane; const float v_ = srow[j * 64]; const unsigned k = (s <= t) ? sel_key(v_) : 0u; cgt += __popcll(__ballot(k > prefix)); }
        int need = 256 - cgt;
        for (int j = 0; j < nj; ++j) { const int s = j * 64 + lane; const float v_ = srow[j * 64]; const unsigned k = (s <= t) ? sel_key(v_) : 0u;
            u64 word = __ballot(k > prefix); u64 tm = __ballot(k == prefix);
            if (tm != 0ull && need > 0) { const int c = __popcll(tm);
                if (c <= need) { word |= tm; need -= c; }
                else { u64 selb = 0ull; for (int i = 0; i < need; ++i) { const u64 low = tm & (~tm + 1ull); selb |= low; tm ^= low; } word |= selb; need = 0; } }
            if (lane == 0) mrow[j] = word; }
        for (int j = nj + lane; j < 128; j += 64) mrow[j] = 0ull;
    }
}

#if defined(TPROBE)
#define IS_T0(k) do { if ((k) == TPROBE) is_t0 = __builtin_amdgcn_s_memrealtime(); } while (0)
#define IS_T1(k) do { if ((k) == TPROBE) tpacc += __builtin_amdgcn_s_memrealtime() - is_t0; } while (0)
#else
#define IS_T0(k) do { } while (0)
#define IS_T1(k) do { } while (0)
#endif
__device__ __forceinline__ void idxsel_unit(const Frame& F, int unit, unsigned long long& tpacc) {
    unsigned long long is_t0 = 0ull; (void)is_t0;
    const int b = unit & 1, t0 = (SEQ / 8 - 1 - (unit >> 1)) * 8;
    const int tid = tid_l(), lane = tid & 63, wave = __builtin_amdgcn_readfirstlane(tid >> 6), n32 = lane & 31, hi = lane >> 5;
    LAS unsigned short* S = (LAS unsigned short*)F.lds;
    IS_T0(30);
    {
        const int qa = (n32 >> 2) & 1, ha = (n32 & 3) + 4 * (n32 >> 3);
        typedef float f32x2_ __attribute__((ext_vector_type(2)));
        bf16x8 Af[4][4]; f32x2_ wr2[4][8];
#pragma unroll
        for (int p = 0; p < 4; ++p) {
            const GA bf16_t* qp = F.IQ + (size_t)(b * SEQ + t0 + 2 * p + qa) * 1024 + ha * 64 + hi * 8;
#pragma unroll
            for (int ks = 0; ks < 4; ++ks) Af[p][ks] = *(const GA bf16x8*)(qp + ks * 16);
            const GA float* wp = F.IW + (size_t)(b * SEQ + t0 + 2 * p + hi) * 16;
#pragma unroll
            for (int q4 = 0; q4 < 4; ++q4) { const f32x4 w4 = *(const GA f32x4*)(wp + 4 * q4); wr2[p][2 * q4] = (f32x2_){w4[0], w4[1]}; wr2[p][2 * q4 + 1] = (f32x2_){w4[2], w4[3]}; }
        }
        asm volatile("s_waitcnt vmcnt(0)" ::: "memory"); IS_T1(30); IS_T0(31);
        const int ntile = (t0 + 7) / 32 + 1;
        const GA bf16_t* kp0 = F.IK + (size_t)b * SEQ * 64 + lane * 8;
        bf16x8 Bn[4];
        if (wave < ntile) {
#pragma unroll
            for (int ks = 0; ks < 4; ++ks) Bn[ks] = *(const GA bf16x8*)(kp0 + (size_t)wave * 2048 + ks * 512);
        }
        for (int j = wave; j < ntile; j += 8) {
            bf16x8 Bf[4];
#pragma unroll
            for (int ks = 0; ks < 4; ++ks) Bf[ks] = Bn[ks];
            if (j + 8 < ntile) {
#pragma unroll
                for (int ks = 0; ks < 4; ++ks) Bn[ks] = *(const GA bf16x8*)(kp0 + (size_t)(j + 8) * 2048 + ks * 512);
            }
            const int s = j * 32 + n32;
            LAS unsigned short* sp = S + ((s >> 7) * 64 + (s & 63)) * 2 + ((s >> 6) & 1);
#define IDX_MM(C, p) do { C = f32x16{}; _Pragma("unroll") for (int ks = 0; ks < 4; ++ks) C = __builtin_amdgcn_mfma_f32_32x32x16_bf16(Af[p][ks], Bf[ks], C, 0, 0, 0); } while (0)
#define IDX_RED(C, p) do { f32x2_ s2 = {0.f, 0.f}; _Pragma("unroll") for (int r2 = 0; r2 < 8; ++r2) { \
                    const float f0 = C[2 * r2], f1 = C[2 * r2 + 1]; const int i0 = __float_as_int(f0), i1 = __float_as_int(f1); \
                    const f32x2_ x2 = {__int_as_float(i0 > 0 ? i0 : 0), __int_as_float(i1 > 0 ? i1 : 0)}; s2 = __builtin_elementwise_fma(wr2[p][r2], x2, s2); } \
                float sc = s2[0] + s2[1]; sc = fminf(fmaxf(sc, -65504.f), 65504.f);       \
                sp[(2 * (p) + hi) * 8192] = __builtin_bit_cast(unsigned short, (_Float16)sc); } while (0)
            f32x16 c0, c1;
            IDX_MM(c0, 0); IDX_MM(c1, 1); __builtin_amdgcn_sched_barrier(0);
            IDX_RED(c0, 0); __builtin_amdgcn_sched_barrier(0); IDX_MM(c0, 2); __builtin_amdgcn_sched_barrier(0);
            IDX_RED(c1, 1); __builtin_amdgcn_sched_barrier(0); IDX_MM(c1, 3); __builtin_amdgcn_sched_barrier(0);
            IDX_RED(c0, 2); IDX_RED(c1, 3);
#undef IDX_MM
#undef IDX_RED
        }
    }
    IS_T1(31); IS_T0(32);
    __syncthreads();
    IS_T1(32);
    {
        const int t = t0 + wave;
        GA u64* mrow = F.mask + (size_t)(b * SEQ + t) * 128;
        if (t < 256) {
#pragma unroll
            for (int half = 0; half < 2; ++half) { const int jw = half * 64 + lane; const int lo = jw * 64; u64 w = 0ull;
                if (t >= lo + 63) w = ~0ull; else if (t >= lo) w = (~0ull) >> (63 - (t - lo));
                mrow[jw] = w; }
        } else {
            const LAS unsigned* row = (const LAS unsigned*)(S + wave * 8192) + lane;
            const int nj = (t >> 7) + 1;
            unsigned kw[64];
            IS_T0(33);
#pragma unroll
            for (int jj = 0; jj < 4; ++jj) {
                if (jj * 16 < nj) {
#pragma unroll
                    for (int j = jj * 16; j < jj * 16 + 16; ++j) { unsigned w = row[j * 64];
                        w = ((w & 0x7fffu) == 0u ? (w & 0xffff0000u) : w); w = ((w & 0x7fff0000u) == 0u ? (w & 0x0000ffffu) : w);
                        const unsigned sg = ((w >> 15) & 0x00010001u) * 0xffffu;
                        w ^= (sg | 0x80008000u);
                        if (128 * j + lane > t) w &= 0xffff0000u;
                        if (128 * j + 64 + lane > t) w &= 0x0000ffffu;
                        kw[j] = w; }
                } else {
#pragma unroll
                    for (int j = jj * 16; j < jj * 16 + 16; ++j) kw[j] = 0u;
                }
            }
#define CNT1(j) asm volatile("v_pk_sub_u16 %1, %2, %3 clamp\n\tv_pk_min_u16 %1, %1, %4\n\tv_pk_add_u16 %0, %0, %1" : "+v"(acc2), "=&v"(tmp2) : "v"(kw[(j)]), "v"(cm2), "v"(one2))
#define COUNT_GE16(cand) do { const unsigned cm2 = (((cand) - 1u) & 0xffffu) * 0x00010001u, one2 = 0x00010001u; unsigned acc2 = 0u, tmp2; \
            _Pragma("unroll") for (int jj = 0; jj < 4; ++jj) { if (jj * 16 < nj) { _Pragma("unroll") for (int j = jj * 16; j < jj * 16 + 16; ++j) CNT1(j); } } \
            int v_ = (int)((acc2 & 0xffffu) + (acc2 >> 16));                                                                                            \
            v_ += __builtin_amdgcn_update_dpp(0, v_, 0x111, 0xf, 0xf, true); v_ += __builtin_amdgcn_update_dpp(0, v_, 0x112, 0xf, 0xf, true);            \
            v_ += __builtin_amdgcn_update_dpp(0, v_, 0x114, 0xf, 0xf, true); v_ += __builtin_amdgcn_update_dpp(0, v_, 0x118, 0xf, 0xf, true);            \
            v_ += __builtin_amdgcn_update_dpp(0, v_, 0x142, 0xa, 0xf, true); v_ += __builtin_amdgcn_update_dpp(0, v_, 0x143, 0xc, 0xf, true);            \
            c = __builtin_amdgcn_readlane(v_, 63); } while (0)
            IS_T1(33); IS_T0(34);
            unsigned prefix = 0u; int cge = 1 << 30, c;
            unsigned lo = 0u, hi; int clo = t + 1, chi = 0;
            { unsigned mx = 0u;
#pragma unroll
              for (int j = 0; j < 64; ++j) { const unsigned a = kw[j] & 0xffffu, b2 = kw[j] >> 16; mx = a > mx ? a : mx; mx = b2 > mx ? b2 : mx; }
#pragma unroll
              for (int o = 32; o > 0; o >>= 1) { const unsigned t2 = (unsigned)__shfl_xor((int)mx, o); mx = t2 > mx ? t2 : mx; }
              const unsigned e6 = (unsigned)__builtin_amdgcn_readfirstlane((int)mx) >> 10;
              hi = (e6 + 1u) << 10;
              for (unsigned k = 0; k < 5u && k < e6; ++k) { const unsigned cand = (e6 - k) << 10; COUNT_GE16(cand);
                  if (c >= 256) { lo = cand; clo = c; break; } else { hi = cand; chi = c; } } }
            for (int it = 0; clo != 256 && hi - lo > 1u; ++it) {
                const unsigned span = hi - lo; unsigned cand;
                if (it >= 3 && (it & 1)) cand = lo + (span >> 1);
                else { const float frac = (float)(256 - chi) / (float)(clo - chi); unsigned d = (unsigned)(frac * (float)span + 0.5f); d = d < 1u ? 1u : (d > span - 1u ? span - 1u : d); cand = hi - d; }
                COUNT_GE16(cand);
                if (c >= 256) { lo = cand; clo = c; } else { hi = cand; chi = c; }
            }
            prefix = lo; cge = clo;
#undef CNT1
#undef COUNT_GE16
            IS_T1(34); IS_T0(35);
            unsigned w0l = 0u, w0h = 0u, w1l = 0u, w1h = 0u;
            const unsigned short pl16 = (unsigned short)prefix; const unsigned ph16 = prefix << 16;
            if (cge == 256) {
#pragma unroll
                for (int j = 0; j < 32; ++j) { const u64 wa = __ballot((unsigned short)kw[j] >= pl16), wb = __ballot(kw[j] >= ph16);
                    asm volatile("s_nop 1\n\tv_writelane_b32 %0, %1, %2" : "+v"(w0l) : "s"((unsigned)wa), "n"(2 * j)); asm volatile("v_writelane_b32 %0, %1, %2" : "+v"(w0h) : "s"((unsigned)(wa >> 32)), "n"(2 * j));
                    asm volatile("s_nop 1\n\tv_writelane_b32 %0, %1, %2" : "+v"(w0l) : "s"((unsigned)wb), "n"(2 * j + 1)); asm volatile("v_writelane_b32 %0, %1, %2" : "+v"(w0h) : "s"((unsigned)(wb >> 32)), "n"(2 * j + 1)); }
                if (nj > 32) {
#pragma unroll
                    for (int j = 32; j < 64; ++j) { const u64 wa = __ballot((unsigned short)kw[j] >= pl16), wb = __ballot(kw[j] >= ph16);
                        asm volatile("s_nop 1\n\tv_writelane_b32 %0, %1, %2" : "+v"(w1l) : "s"((unsigned)wa), "n"(2 * j - 64)); asm volatile("v_writelane_b32 %0, %1, %2" : "+v"(w1h) : "s"((unsigned)(wa >> 32)), "n"(2 * j - 64));
                        asm volatile("s_nop 1\n\tv_writelane_b32 %0, %1, %2" : "+v"(w1l) : "s"((unsigned)wb), "n"(2 * j - 63)); asm volatile("v_writelane_b32 %0, %1, %2" : "+v"(w1h) : "s"((unsigned)(wb >> 32)), "n"(2 * j - 63)); }
                }
            } else {
                int cgt = 0;
#pragma unroll
                for (int j = 0; j < 64; ++j) cgt += __popcll(__ballot((unsigned short)kw[j] > pl16)) + __popcll(__ballot((kw[j] >> 16) > prefix));
                int need = 256 - cgt;
#define TIE_WORD(GT, EQ, SETL, SETH, LN) do { u64 word = (GT); u64 tm = (EQ);                                                          \
                    if (tm != 0ull && need > 0) { const int ce = __popcll(tm);                                                       \
                        if (ce <= need) { word |= tm; need -= ce; }                                                                  \
                        else { u64 selb = 0ull; for (int i = 0; i < need; ++i) { const u64 low = tm & (~tm + 1ull); selb |= low; tm ^= low; } word |= selb; need = 0; } } \
                    asm volatile("s_nop 1\n\tv_writelane_b32 %0, %1, %2" : "+v"(SETL) : "s"((unsigned)word), "n"(LN)); asm volatile("v_writelane_b32 %0, %1, %2" : "+v"(SETH) : "s"((unsigned)(word >> 32)), "n"(LN)); } while (0)
#pragma unroll
                for (int j = 0; j < 32; ++j) {
                    TIE_WORD(__ballot((unsigned short)kw[j] > pl16), __ballot((unsigned short)kw[j] == pl16), w0l, w0h, 2 * j);
                    TIE_WORD(__ballot((kw[j] >> 16) > prefix), __ballot((kw[j] >> 16) == prefix), w0l, w0h, 2 * j + 1); }
#pragma unroll
                for (int j = 32; j < 64; ++j) {
                    TIE_WORD(__ballot((unsigned short)kw[j] > pl16), __ballot((unsigned short)kw[j] == pl16), w1l, w1h, 2 * j - 64);
                    TIE_WORD(__ballot((kw[j] >> 16) > prefix), __ballot((kw[j] >> 16) == prefix), w1l, w1h, 2 * j - 63); }
#undef TIE_WORD
            }
            mrow[lane] = ((u64)w0h << 32) | w0l; mrow[64 + lane] = ((u64)w1h << 32) | w1l;
            IS_T1(35);
        }
    }
}

namespace att {
typedef short s16x4 __attribute__((ext_vector_type(4)));
constexpr int D = 128, NW = 8, QBLK = 32, KVBLK = 64, QB = NW * QBLK;
constexpr int SHM_V = KVBLK * D * 2, SHM_K = KVBLK * D * 2;
constexpr int L_WS = 2 * SHM_V + 2 * SHM_K;
constexpr int L_AUX = L_WS + NW * 64 * 4;
constexpr int TB_PAD = 320, TB_N = TB_PAD + 1984;
constexpr int L_FLG = L_AUX + 8192 * 4;
constexpr int L_END = L_FLG + 64;
constexpr float SKIP_MARGIN = 40.f;
constexpr float THR2 = 11.5f;
constexpr int FAR_DIST = 1513;

#define KSWZ(row, colB) ((row) * 256 + ((colB) ^ (((row) & 7) << 4)))
#define SBAR() __builtin_amdgcn_sched_barrier(0)
__device__ __forceinline__ int v_st(int k, int c) { const int kk = (k & ~0xC) | ((k & 4) << 1) | ((k & 8) >> 1); return ((kk >> 3) * 4 + (c >> 5)) * 512 + ((kk & 7) * 32 + (c & 31)) * 2; }
__device__ __forceinline__ int v_rd_base(int lane) { return ((lane & 3) << 3) | (((lane >> 2) & 3) << 6) | (((lane >> 4) & 1) << 5) | (((lane >> 5) & 1) << 8); }
constexpr int v_rd_off(int d0, int ks, int half) { return d0 * 512 + ks * 4096 + half * 2048; }
__device__ __forceinline__ int crow(int r, int hi) { return (r & 3) + 8 * (r >> 2) + 4 * hi; }
__device__ __forceinline__ bf16x8 load8(const GA bf16_t* p) { return *(const GA bf16x8*)p; }

__device__ __forceinline__ void mask_tile(f32x16& p0, f32x16& p1, int dq, unsigned W) {
    const float NEG = -__builtin_inff();
#pragma unroll
    for (int r = 0; r < 16; ++r) {
        const int c = (r & 3) + 8 * (r >> 2);
        if ((unsigned)(dq - c) >= W) p0[r] = NEG;
        if ((unsigned)(dq - c - 32) >= W) p1[r] = NEG;
    }
}
__device__ __forceinline__ void mask_bits(f32x16& p0, f32x16& p1, u64 w, int hi) {
    const float NEG = -__builtin_inff();
    unsigned w0 = (unsigned)w, w1 = (unsigned)(w >> 32);
    if (hi == 0) { w0 <<= 4; w1 <<= 4; }
#define MB4(W, P, g) do { u64 c0_, c1_, c2_, c3_; asm volatile(                          \
        "v_add_co_u32 %[w], %[c0], %[w], %[w]\n\tv_add_co_u32 %[w], %[c1], %[w], %[w]\n\t"                     \
        "v_add_co_u32 %[w], %[c2], %[w], %[w]\n\tv_add_co_u32 %[w], %[c3], %[w], %[w]\n\t"                     \
        "v_cndmask_b32 %[e3], %[neg], %[e3], %[c0]\n\tv_cndmask_b32 %[e2], %[neg], %[e2], %[c1]\n\t"           \
        "v_cndmask_b32 %[e1], %[neg], %[e1], %[c2]\n\tv_cndmask_b32 %[e0], %[neg], %[e0], %[c3]"               \
        : [w] "+v"(W), [e0] "+v"(P[4 * (g)]), [e1] "+v"(P[4 * (g) + 1]), [e2] "+v"(P[4 * (g) + 2]), [e3] "+v"(P[4 * (g) + 3]),         \
          [c0] "=&s"(c0_), [c1] "=&s"(c1_), [c2] "=&s"(c2_), [c3] "=&s"(c3_) : [neg] "v"(NEG)); } while (0)
    MB4(w0, p0, 3); MB4(w1, p1, 3); w0 <<= 4; w1 <<= 4;
    MB4(w0, p0, 2); MB4(w1, p1, 2); w0 <<= 4; w1 <<= 4;
    MB4(w0, p0, 1); MB4(w1, p1, 1); w0 <<= 4; w1 <<= 4;
    MB4(w0, p0, 0); MB4(w1, p1, 0);
#undef MB4
}
__device__ __forceinline__ void partialSM(f32x16& p0, f32x16& p1, float& m_reg, float& mn, float& alpha, float cb) {
    float pmax = p0[0];
#pragma unroll
    for (int r = 1; r < 16; ++r) pmax = fmaxf(pmax, p0[r]);
#pragma unroll
    for (int r = 0; r < 16; ++r) pmax = fmaxf(pmax, p1[r]);
    { auto rr = __builtin_amdgcn_permlane32_swap(__float_as_uint(pmax), __float_as_uint(pmax), false, false);
      pmax = fmaxf(__uint_as_float(rr[0]), __uint_as_float(rr[1])); }
    pmax += cb;
    if (__builtin_expect(__all((pmax - m_reg) <= THR2), 1)) { mn = m_reg; alpha = 1.f; }
    else { mn = fmaxf(m_reg, pmax); alpha = __builtin_amdgcn_exp2f(m_reg - mn); m_reg = mn; }
    const float sh = mn - cb;
#pragma unroll
    for (int r = 0; r < 16; ++r) p0[r] = p0[r] - sh;
#pragma unroll
    for (int r = 0; r < 16; ++r) p1[r] = p1[r] - sh;
#pragma unroll
    for (int r = 0; r < 16; ++r) p0[r] = __builtin_amdgcn_exp2f(p0[r]);
}
__device__ __forceinline__ void finishSM(f32x16& p0, f32x16& p1, float alpha, float& l_reg, bf16x8& pa0, bf16x8& pa1, bf16x8& pa2, bf16x8& pa3) {
#pragma unroll
    for (int r = 0; r < 16; ++r) p1[r] = __builtin_amdgcn_exp2f(p1[r]);
    float ps = 0;
#pragma unroll
    for (int r = 0; r < 16; ++r) ps += p0[r];
#pragma unroll
    for (int r = 0; r < 16; ++r) ps += p1[r];
    { auto rr = __builtin_amdgcn_permlane32_swap(__float_as_uint(ps), __float_as_uint(ps), false, false);
      ps = __uint_as_float(rr[0]) + __uint_as_float(rr[1]); }
    l_reg = l_reg * alpha + ps;
#define PK4(P, B_, OUT) do { unsigned a0 = cvt_pk_bf16(P[B_+0], P[B_+1]), a1 = cvt_pk_bf16(P[B_+2], P[B_+3]);                          \
        unsigned b0 = cvt_pk_bf16(P[B_+4], P[B_+5]), b1 = cvt_pk_bf16(P[B_+6], P[B_+7]);                                             \
        auto r0 = __builtin_amdgcn_permlane32_swap(a0, b0, false, false); auto r1 = __builtin_amdgcn_permlane32_swap(a1, b1, false, false); \
        u32x4 w = {r0[0], r1[0], r0[1], r1[1]}; OUT = *reinterpret_cast<bf16x8*>(&w); } while (0)
    PK4(p0, 0, pa0); PK4(p0, 8, pa1); PK4(p1, 0, pa2); PK4(p1, 8, pa3);
#undef PK4
}
template <int KB, int NQ>
__device__ __forceinline__ void qkt(f32x16& p0, f32x16& p1, const LAS char* K_lds, int r32, int hi, const bf16x8* qr, int koff) {
    p0 = f32x16{}; p1 = f32x16{};
    const LAS char* kb[4];
#pragma unroll
    for (int dd = 0; dd < 4; ++dd) kb[dd] = K_lds + KB * SHM_K + KSWZ(r32, (dd * 16 + hi * 8) * 2) + koff;
#pragma unroll
    for (int d0 = 0; d0 < NQ; ++d0) { const LAS char* a = kb[d0 & 3] + (d0 >> 2) * 128;
        bf16x8 b0 = *(const LAS bf16x8*)a;
        bf16x8 b1 = *(const LAS bf16x8*)(a + 32 * 256);
        p0 = __builtin_amdgcn_mfma_f32_32x32x16_bf16(b0, qr[d0], p0, 0, 0, 0);
        p1 = __builtin_amdgcn_mfma_f32_32x32x16_bf16(b1, qr[d0], p1, 0, 0, 0); }
}
template <int VB>
__device__ __forceinline__ void pv_tile(f32x16* o, int vb0, bf16x8 pa0, bf16x8 pa1, bf16x8 pa2, bf16x8 pa3) {
#define TRRD(dst, off) asm volatile("ds_read_b64_tr_b16 %0, %1 offset:%2" : "=&v"(dst) : "v"(vb0), "i"(off) : "memory")
#define PV_D0(d0) do { s16x4 l0, l1, l2, l3, h0, h1, h2, h3; constexpr int b_ = VB * SHM_V + v_rd_off(d0, 0, 0); \
        TRRD(l0, b_); TRRD(h0, b_ + 2048); TRRD(l1, b_ + 4096); TRRD(h1, b_ + 6144); TRRD(l2, b_ + 8192); TRRD(h2, b_ + 10240); TRRD(l3, b_ + 12288); TRRD(h3, b_ + 14336); \
        asm volatile("s_waitcnt lgkmcnt(0)" ::: "memory"); SBAR();   \
        o[d0] = __builtin_amdgcn_mfma_f32_32x32x16_bf16(pa0, (bf16x8){l0[0], l0[1], l0[2], l0[3], h0[0], h0[1], h0[2], h0[3]}, o[d0], 0, 0, 0);   \
        o[d0] = __builtin_amdgcn_mfma_f32_32x32x16_bf16(pa1, (bf16x8){l1[0], l1[1], l1[2], l1[3], h1[0], h1[1], h1[2], h1[3]}, o[d0], 0, 0, 0);   \
        o[d0] = __builtin_amdgcn_mfma_f32_32x32x16_bf16(pa2, (bf16x8){l2[0], l2[1], l2[2], l2[3], h2[0], h2[1], h2[2], h2[3]}, o[d0], 0, 0, 0);   \
        o[d0] = __builtin_amdgcn_mfma_f32_32x32x16_bf16(pa3, (bf16x8){l3[0], l3[1], l3[2], l3[3], h3[0], h3[1], h3[2], h3[3]}, o[d0], 0, 0, 0); } while (0)
    PV_D0(0); PV_D0(1); PV_D0(2); PV_D0(3);
#undef PV_D0
#undef TRRD
}
__device__ __forceinline__ void bias_dist(f32x16& p0, f32x16& p1, const LAS char* tbase) {
#pragma unroll
    for (int r = 0; r < 16; ++r) { const int c = (r & 3) + 8 * (r >> 2);
        p0[r] += *(const LAS float*)(tbase + (59 - c) * 4);
        p1[r] += *(const LAS float*)(tbase + (27 - c) * 4); }
}
__device__ __forceinline__ void bias_const(f32x16& p0, f32x16& p1, float c) {
#pragma unroll
    for (int r = 0; r < 16; ++r) { p0[r] += c; p1[r] += c; }
}
__device__ __forceinline__ void bias_key(f32x16& p0, f32x16& p1, const LAS char* kbase) {
#pragma unroll
    for (int g = 0; g < 4; ++g) { const f32x4 a = *(const LAS f32x4*)(kbase + (8 * g) * 4), b = *(const LAS f32x4*)(kbase + (32 + 8 * g) * 4);
#pragma unroll
        for (int q = 0; q < 4; ++q) { p0[4 * g + q] -= a[q]; p1[4 * g + q] -= b[q]; } }
}

struct Blk { const GA bf16_t* Q; const GA bf16_t* K; const GA bf16_t* V; int P0; int rs; };
struct Aux { const GA float* tb; int dscale; const GA float* cum; const GA u64* mrow0; float kmax; };

__device__ __forceinline__ int swa_jlo(int P0, int W) { const int lowk = P0 - W + 1; return lowk > 0 ? lowk / KVBLK : 0; }

template <int MODE, int NQ>
__device__ __forceinline__ void attn_block(const Blk& cur, int skv, int W, int koff, const Aux& ax, LAS char* lds, f32x16 (&o)[4], float& m_out, float& l_out) {
    const int tid = tid_l(), wid = __builtin_amdgcn_readfirstlane(tid >> 6), lane = tid & 63, r32 = lane & 31, hi = lane >> 5;
    const int rs = cur.rs;
    const int j_lo = swa_jlo(cur.P0, W);
    int j_hi = (cur.P0 + QB - 1) / KVBLK + 1; if (j_hi > skv / KVBLK) j_hi = skv / KVBLK;
    int NT = j_hi - j_lo;
    const int qlo = cur.P0 + wid * QBLK, qm = qlo + r32 - 4 * hi;
    LAS char* V_lds = lds; LAS char* K_lds = lds + 2 * SHM_V;
    LAS float* ws = (LAS float*)(lds + L_WS) + wid * 64; LAS float* li_l = ws; LAS float* al_l = ws + 32;
    LAS float* auxl = (LAS float*)(lds + L_AUX);
    float m_reg = -1e30f, l_reg = 0;
#pragma unroll
    for (int d_ = 0; d_ < 4; ++d_) o[d_] = f32x16{};
    const int sr = tid >> 4, sc = (tid & 15) * 8, vst0 = v_st(sr, sc), vst1 = v_st(32 + sr, sc), kws = KSWZ(sr, sc * 2);
    const int vb0 = (int)(unsigned)(uintptr_t)V_lds + v_rd_base(lane);
    const GA bf16_t* Kh = cur.K; const GA bf16_t* Vh = cur.V;
    bf16x8 qr[NQ]; bf16x8 st_v0, st_v1, st_k0, st_k1;
#define ROW(p, k0, rr) ((p) + (size_t)((k0) + (rr)) * rs + sc)
#define VMW() asm volatile("s_waitcnt vmcnt(0)" ::: "memory")
#define SLOAD_H(Kp, Vp, k0) do { st_v0 = load8(ROW(Vp, k0, sr)); st_v1 = load8(ROW(Vp, k0, 32 + sr));              \
                                 st_k0 = load8(ROW(Kp, k0, sr)); st_k1 = load8(ROW(Kp, k0, 32 + sr)); } while (0)
#define SWRITE_HK(bf) do { *(LAS bf16x8*)(K_lds + (bf) * SHM_K + kws) = st_k0; *(LAS bf16x8*)(K_lds + (bf) * SHM_K + kws + 32 * 256) = st_k1; } while (0)
#define SWRITE_HV(bf) do { *(LAS bf16x8*)(V_lds + (bf) * SHM_V + vst0) = st_v0; *(LAS bf16x8*)(V_lds + (bf) * SHM_V + vst1) = st_v1; } while (0)
#define SWRITE_H(bf) do { SWRITE_HV(bf); SWRITE_HK(bf); } while (0)
#define RESC(a) do { if (__any((a) < 1.f)) { if (hi == 0) al_l[r32] = (a); asm volatile("s_waitcnt lgkmcnt(0)" ::: "memory");              \
                     for (int d_ = 0; d_ < 4; ++d_) for (int r = 0; r < 16; ++r) o[d_][r] *= al_l[crow(r, hi)]; } } while (0)
#define KBASE(t) ((MODE == 1 ? (j_hi - 1 - (t)) : (j_lo + (t))) * KVBLK)
    LAS unsigned* flg = (LAS unsigned*)(lds + L_FLG);
    {
        const int kb0 = KBASE(0);
        if (MODE == 1 && tid < 8) flg[tid] = 0u;
#pragma unroll
        for (int d0 = 0; d0 < NQ; ++d0) qr[d0] = load8(cur.Q + (size_t)(wid * QBLK + r32) * rs + d0 * 16 + hi * 8);
        SLOAD_H(Kh, Vh, kb0);
        if (MODE == 1) { for (int i = tid; i < cur.P0 + QB; i += 512) auxl[i] = ax.cum[i]; }
        else { for (int i = tid; i < TB_N; i += 512) { int d = i - TB_PAD; d = d < 0 ? 0 : d; auxl[i] = ax.tb[d * ax.dscale]; } }
        VMW(); SWRITE_HK(0); SWRITE_HV(0);
        __syncthreads();
    }
    const float cfar = (MODE == 0 || MODE == 2) ? ax.tb[FAR_DIST] : 0.f;
    float qbound = 0.f;
    if (MODE == 1) { float ss = 0.f;
#pragma unroll
        for (int d0 = 0; d0 < NQ; ++d0) { const u32x4 w = *reinterpret_cast<const u32x4*>(&qr[d0]);
#pragma unroll
            for (int j = 0; j < 4; ++j) { const float a = bf_lo(w[j]), b = bf_hi(w[j]); ss = fmaf(a, a, ss); ss = fmaf(b, b, ss); } }
        { auto rr = __builtin_amdgcn_permlane32_swap(__float_as_uint(ss), __float_as_uint(ss), false, false); ss = __uint_as_float(rr[0]) + __uint_as_float(rr[1]); }
        qbound = sqrtf(ss) * ax.kmax * 1.001f + 1e-3f; }
    float cbv = 0.f;
#define BIASMASK(P0_, P1_, t) do { const int kb_ = KBASE(t); cbv = 0.f;                                                                \
        if (MODE == 1) { bias_key(P0_, P1_, (const LAS char*)(auxl + kb_ + 4 * hi)); }                                                       \
        else if (MODE == 3) { bias_dist(P0_, P1_, (const LAS char*)(auxl + (qm - kb_ - 59 + TB_PAD))); }                                     \
        else { if (cur.P0 - kb_ - 63 >= FAR_DIST) cbv = cfar; else bias_dist(P0_, P1_, (const LAS char*)(auxl + (qm - kb_ - 59 + TB_PAD))); } \
        if (MODE == 0) { mask_bits(P0_, P1_, mw, hi); }                                                                                  \
        else if (kb_ + KVBLK - 1 > qlo || kb_ <= qlo + QBLK - 1 - W) mask_tile(P0_, P1_, qm - kb_, (unsigned)W); } while (0)
#define MLOAD(t) do { if (MODE == 0) mw = ax.mrow0[(size_t)(wid * QBLK + r32) * 128 + (KBASE(t) >> 6)]; } while (0)
    f32x16 pA0, pA1, pB0, pB1; float mnA, mnB, alA, alB; bf16x8 pa0, pa1, pa2, pa3; u64 mw = 0ull;
    if (NT > 1) SLOAD_H(Kh, Vh, KBASE(1));
    MLOAD(0);
    SBAR(); qkt<0, NQ>(pA0, pA1, K_lds, r32, hi, qr, koff);
    BIASMASK(pA0, pA1, 0); partialSM(pA0, pA1, m_reg, mnA, alA, cbv);
    if (NT > 1) { VMW(); SWRITE_H(1); }
    __syncthreads();
#define HALF_STEP(PX0, PX1, mnX, alX, PY0, PY1, alY, t, KB, VB, SB) do {                                                      \
        MLOAD(t);                                                                                                             \
        if ((t) + 1 < NT) { SLOAD_H(Kh, Vh, KBASE((t) + 1)); }        \
        SBAR(); qkt<KB, NQ>(PX0, PX1, K_lds, r32, hi, qr, koff);                                                              \
        finishSM(PY0, PY1, alY, l_reg, pa0, pa1, pa2, pa3); SBAR();                                                           \
        pv_tile<VB>(o, vb0, pa0, pa1, pa2, pa3); BIASMASK(PX0, PX1, (t)); partialSM(PX0, PX1, m_reg, mnX, alX, cbv);          \
        __syncthreads();                                                                                                      \
        if ((t) + 1 < NT) { VMW(); SWRITE_H(SB); }                                                                            \
        RESC(alX); __syncthreads(); } while (0)
    for (int t = 1; t + 1 < NT; t += 2) {
        if (MODE == 1) {
            const u32x4 f0 = *(const LAS u32x4*)flg, f1 = *(const LAS u32x4*)(flg + 4);
            if ((f0[0] & f0[1] & f0[2] & f0[3] & f1[0] & f1[1] & f1[2] & f1[3]) != 0u) { NT = t + 1; break; }
        }
        HALF_STEP(pB0, pB1, mnB, alB, pA0, pA1, alA, t, 1, 0, 0);
        if (MODE == 1) {
            unsigned ok = 0u;
            if (t + 3 < NT) { const float ub = qbound - auxl[KBASE(t + 3) + KVBLK - 1]; ok = __all(ub < m_reg - SKIP_MARGIN) ? 1u : 0u; }
            if (lane == 0) flg[wid] = ok;
        }
        HALF_STEP(pA0, pA1, mnA, alA, pB0, pB1, alB, t + 1, 0, 1, 1);
    }
    const bool even = (NT & 1) == 0;
    if (even) { MLOAD(NT - 1); SBAR(); qkt<1, NQ>(pB0, pB1, K_lds, r32, hi, qr, koff); SBAR(); }
    finishSM(pA0, pA1, alA, l_reg, pa0, pa1, pa2, pa3); SBAR();
    pv_tile<0>(o, vb0, pa0, pa1, pa2, pa3);
    if (even) { BIASMASK(pB0, pB1, NT - 1); partialSM(pB0, pB1, m_reg, mnB, alB, cbv); __syncthreads(); RESC(alB);
        finishSM(pB0, pB1, alB, l_reg, pa0, pa1, pa2, pa3); SBAR(); pv_tile<1>(o, vb0, pa0, pa1, pa2, pa3); }
    if (hi == 0) li_l[r32] = l_reg; asm volatile("s_waitcnt lgkmcnt(0)" ::: "memory");
#pragma unroll
    for (int r = 0; r < 16; ++r) { const float rl = __builtin_amdgcn_rcpf(li_l[crow(r, hi)]);
#pragma unroll
        for (int d0 = 0; d0 < 4; ++d0) o[d0][r] *= rl; }
    m_out = m_reg; l_out = l_reg;
    __syncthreads();
#undef ROW
#undef VMW
#undef SLOAD_H
#undef SWRITE_HK
#undef SWRITE_HV
#undef SWRITE_H
#undef RESC
#undef KBASE
#undef BIASMASK
#undef MLOAD
#undef HALF_STEP
}
#undef KSWZ
}

__device__ __forceinline__ void store_y(const GA bf16_t* Zs, GA bf16_t* Y, const f32x16 (&o)[4], int row0w, int colbase, int r32, int hi) {
    bf16_t zv[16][4];
#pragma unroll
    for (int r = 0; r < 16; ++r) { const size_t off = (size_t)(row0w + att::crow(r, hi)) * DM + colbase + r32;
#pragma unroll
        for (int d0 = 0; d0 < 4; ++d0) zv[r][d0] = Zs[off + d0 * 32]; }
#pragma unroll
    for (int r = 0; r < 16; ++r) { const size_t off = (size_t)(row0w + att::crow(r, hi)) * DM + colbase + r32;
#pragma unroll
        for (int d0 = 0; d0 < 4; ++d0) { const float v = o[d0][r] * bf2f(zv[r][d0]); const float vn = __shfl_xor(v, 1);
            if ((r32 & 1) == 0) *(GA unsigned*)(Y + off + d0 * 32) = cvt_pk_bf16(v, vn); } }
}
template <int MODE>
__device__ __forceinline__ void attn_fast_unit(const Frame& F, int layer, int b, int h, int qb) {
    const int mixer = MODE;
    const size_t hb = ((size_t)(b * 4 + h) * SEQ) * 128;
    att::Blk cur{F.QKV + (size_t)(mixer * 3 + 0) * QS + hb + (size_t)qb * 256 * 128, F.QKV + (size_t)(mixer * 3 + 1) * QS + hb, F.QKV + (size_t)(mixer * 3 + 2) * QS + hb, qb * 256, 128};
    att::Aux ax{F.tb + (size_t)h * SEQ, 1, F.cum + (size_t)(b * 4 + h) * SEQ, F.mask + (size_t)(b * SEQ + qb * 256) * 128, 0.f};
    if (MODE == 1) ax.kmax = sqrtf(__uint_as_float(F.ctl[CW_KM + layer * 8 + b * 4 + h]));
    f32x16 o[4]; float m_, l_;
    att::attn_block<MODE, 8>(cur, SEQ, SEQ, 0, ax, (LAS char*)F.lds, o, m_, l_);
    const int tid = tid_l(), wid = tid >> 6, lane = tid & 63;
    GA unsigned char* w2 = launder(F.ws);
    store_y((const GA bf16_t*)(w2 + WS_ZS), (GA bf16_t*)(w2 + WS_Y), o, b * SEQ + qb * 256 + wid * 32, mixer * 512 + h * 128, lane & 31, lane >> 5);
}

__device__ __forceinline__ void attn_diffmap_unit(const Frame& F, int layer, int b, int h, int qb, int c) {
    const size_t hb = ((size_t)(b * 4 + h) * SEQ) * 128;
    const GA bf16_t* Qc = F.QKV + (size_t)(2 * 3 + 0) * QS + hb + (size_t)qb * 256 * 128; const GA bf16_t* Kc = F.QKV + (size_t)(2 * 3 + 1) * QS + hb; const GA bf16_t* Vc = F.QKV + (size_t)(2 * 3 + 2) * QS + hb;
    att::Aux ax{F.tb + (size_t)(4 + h) * SEQ, 1, (const GA float*)nullptr, (const GA u64*)nullptr, 0.f};
    f32x16 o[4]; float m_, l_;
    { att::Blk cur{Qc + c * 64, Kc, Vc, qb * 256, 128};
      att::attn_block<2, 4>(cur, SEQ, SEQ, c * 128, ax, (LAS char*)F.lds, o, m_, l_); }
    const int tid = tid_l(), wid = tid >> 6, lane = tid & 63, r32 = lane & 31, hi = lane >> 5;
    const int pair = (b * 4 + h) * 32 + qb;
    GA unsigned char* w2 = launder(F.ws);
    { GA f32x4* mine = (GA f32x4*)(w2 + WS_O1) + ((size_t)(c * 256 + pair) * 16) * 512 + tid;
#pragma unroll
      for (int d0 = 0; d0 < 4; ++d0)
#pragma unroll
          for (int g = 0; g < 4; ++g) { const f32x4 v = {o[d0][4 * g], o[d0][4 * g + 1], o[d0][4 * g + 2], o[d0][4 * g + 3]};
              asm volatile("global_store_dwordx4 %0, %1, off sc1" :: "v"(mine + (d0 * 4 + g) * 512), "v"(v) : "memory"); } }
    asm volatile("s_waitcnt vmcnt(0)" ::: "memory");
    __syncthreads();
    volatile LAS unsigned* lw = F.misc + 5;
    if (tid == 0) *lw = __hip_atomic_fetch_add((GA unsigned*)(w2 + WS_CTL) + CW_DC + layer * 256 + pair, 1u, __ATOMIC_RELAXED, __HIP_MEMORY_SCOPE_AGENT);
    __syncthreads();
    if (*lw == 0u) return;
    __builtin_amdgcn_fence(__ATOMIC_ACQUIRE, "agent");
    asm volatile("s_waitcnt vmcnt(0)" ::: "memory");
    const GA f32x4* other = (const GA f32x4*)(w2 + WS_O1) + ((size_t)((1 - c) * 256 + pair) * 16) * 512 + tid;
    const GA float* dp = (const GA float*)(w2 + WS_DP) + layer * 256;
    const float lam = dp[0];
#pragma unroll
    for (int g = 0; g < 4; ++g) {
        f32x4 ot[4];
#pragma unroll
        for (int d0 = 0; d0 < 4; ++d0) ot[d0] = other[(d0 * 4 + g) * 512];
#pragma unroll
        for (int q = 0; q < 4; ++q) { const int r = 4 * g + q;
            float ss = 0.f;
#pragma unroll
            for (int d0 = 0; d0 < 4; ++d0) { const float mo = o[d0][r], oth = ot[d0][q];
                const float a0 = (c == 0) ? mo : oth, a1 = (c == 0) ? oth : mo; const float v = fmaf(-lam, a1, a0); o[d0][r] = v; ss = fmaf(v, v, ss); }
            ss += __shfl_xor(ss, 1); ss += __shfl_xor(ss, 2); ss += __shfl_xor(ss, 4); ss += __shfl_xor(ss, 8); ss += __shfl_xor(ss, 16);
            const float rn = rsqrtf(ss * (1.0f / 128.0f) + RMS_EPS);
#pragma unroll
            for (int d0 = 0; d0 < 4; ++d0) o[d0][r] = o[d0][r] * rn;
        }
        asm volatile("" ::: "memory");
    }
#pragma unroll
    for (int d0 = 0; d0 < 4; ++d0) { const float sw = dp[128 + d0 * 32 + r32];
#pragma unroll
        for (int r = 0; r < 16; ++r) o[d0][r] *= sw; }
    store_y((const GA bf16_t*)(w2 + WS_ZS), (GA bf16_t*)(w2 + WS_Y), o, b * SEQ + qb * 256 + wid * 32, 2 * 512 + h * 128, r32, hi);
}
__device__ __forceinline__ void attn_dil_unit(const Frame& F, int u) {
    const int cfg = u >> 8, v = u & 255, b = v & 1, h = (v >> 1) & 3, x = v >> 3;
    const int dl = (cfg == 0) ? 1 : (cfg == 1 ? 4 : 16);
    const int rho = (cfg == 0) ? 0 : (cfg == 1 ? (x & 3) : (x & 15)), qb = (cfg == 0) ? x : (cfg == 1 ? (x >> 2) : (x >> 4));
    const size_t hb = ((size_t)(b * 4 + h) * SEQ) * 128;
    const GA bf16_t* Qd = F.QKV + (size_t)(3 * 3 + 0) * QS + hb; const GA bf16_t* Kd = F.QKV + (size_t)(3 * 3 + 1) * QS + hb; const GA bf16_t* Vd = F.QKV + (size_t)(3 * 3 + 2) * QS + hb;
    att::Blk cur{Qd + (size_t)(rho + dl * qb * 256) * 128, Kd + (size_t)rho * 128, Vd + (size_t)rho * 128, qb * 256, 128 * dl};
    att::Aux ax{F.tb + (size_t)(8 + h) * SEQ, dl, (const GA float*)nullptr, (const GA u64*)nullptr, 0.f};
    f32x16 o[4]; float m_, l_;
    att::attn_block<3, 8>(cur, SEQ / dl, 129, 0, ax, (LAS char*)F.lds, o, m_, l_);
    const int tid = tid_l(), wid = tid >> 6, lane = tid & 63, r32 = lane & 31, hi = lane >> 5;
    GA unsigned char* w2 = launder(F.ws);
    GA bf16_t* od = (GA bf16_t*)(w2 + WS_OD) + (size_t)cfg * MT * 512;
#pragma unroll
    for (int r = 0; r < 16; ++r) { const size_t row = (size_t)b * SEQ + rho + (size_t)dl * (qb * 256 + wid * 32 + att::crow(r, hi));
#pragma unroll
        for (int d0 = 0; d0 < 4; ++d0) od[row * 512 + h * 128 + d0 * 32 + r32] = (bf16_t)(cvt_pk_bf16(o[d0][r], 0.f) & 0xffffu); }
    if (hi == 0) { const size_t row = (size_t)b * SEQ + rho + (size_t)dl * (qb * 256 + wid * 32 + r32);
        ((GA float*)(w2 + WS_LSE))[((size_t)cfg * MT + row) * 4 + h] = m_ + __builtin_amdgcn_logf(l_); }
}
__device__ __forceinline__ void dil_merge_unit(const Frame& F, int u) {
    const int tid = tid_l(), row = u * 32 + (tid >> 4), cg = tid & 15, h = cg >> 2, col = cg * 32;
    const float l0 = F.LSE[((size_t)0 * MT + row) * 4 + h], l1 = F.LSE[((size_t)1 * MT + row) * 4 + h], l2 = F.LSE[((size_t)2 * MT + row) * 4 + h];
    const float mx = fmaxf(l0, fmaxf(l1, l2)); float w0 = ex2(l0 - mx), w1 = ex2(l1 - mx), w2 = ex2(l2 - mx); const float inv = 1.0f / (w0 + w1 + w2); w0 *= inv; w1 *= inv; w2 *= inv;
    const GA bf16_t* odb = (const GA bf16_t*)F.OD;
    const GA bf16_t* p0 = odb + ((size_t)0 * MT + row) * 512 + col; const GA bf16_t* p1 = odb + ((size_t)1 * MT + row) * 512 + col; const GA bf16_t* p2 = odb + ((size_t)2 * MT + row) * 512 + col;
    const size_t yo = (size_t)row * DM + 3 * 512 + col;
#pragma unroll
    for (int i = 0; i < 4; ++i) {
        const u32x4 A_ = *(const GA u32x4*)(p0 + 8 * i), B_ = *(const GA u32x4*)(p1 + 8 * i), C_ = *(const GA u32x4*)(p2 + 8 * i);
        const f32x4 a0 = {bf_lo(A_[0]), bf_hi(A_[0]), bf_lo(A_[1]), bf_hi(A_[1])}, a1 = {bf_lo(A_[2]), bf_hi(A_[2]), bf_lo(A_[3]), bf_hi(A_[3])}, b0 = {bf_lo(B_[0]), bf_hi(B_[0]), bf_lo(B_[1]), bf_hi(B_[1])}, b1 = {bf_lo(B_[2]), bf_hi(B_[2]), bf_lo(B_[3]), bf_hi(B_[3])},
                    c0 = {bf_lo(C_[0]), bf_hi(C_[0]), bf_lo(C_[1]), bf_hi(C_[1])}, c1 = {bf_lo(C_[2]), bf_hi(C_[2]), bf_lo(C_[3]), bf_hi(C_[3])};
        const u32x4 zw = *(const GA u32x4*)(F.Zs + yo + 8 * i);
        const f32x4 v0 = a0 * w0 + b0 * w1 + c0 * w2, v1 = a1 * w0 + b1 * w1 + c1 * w2;
        u32x4 w = {cvt_pk_bf16(v0[0] * bf_lo(zw[0]), v0[1] * bf_hi(zw[0])), cvt_pk_bf16(v0[2] * bf_lo(zw[1]), v0[3] * bf_hi(zw[1])),
                   cvt_pk_bf16(v1[0] * bf_lo(zw[2]), v1[1] * bf_hi(zw[2])), cvt_pk_bf16(v1[2] * bf_lo(zw[3]), v1[3] * bf_hi(zw[3]))};
        *(GA u32x4*)(F.Y + yo + 8 * i) = w; }
}

struct EpiMerged {
    static constexpr bool PERM = true, AFTER_DRAIN = false, MIDK = true, FP8 = false;
    const GA unsigned char* G; GA bf16_t* MG;
    static __device__ __forceinline__ float gq(unsigned w, int i) { return (float)((w >> (8 * i)) & 0xffu) + 0.5f; }
    __device__ __forceinline__ void mid(f32x4 (&acc)[2][2][4][2], const pg8::Unit& u, int bnext, int wr, int wc, int fr, int fq) const {
        const int row0 = u.pm * 256 + wr * 64 + fr, c0 = u.pn * 256 + wc * 32 + 8 * fq;
#pragma unroll
        for (int ai = 0; ai < 2; ++ai) {
            u32x2 num[4][2], den[4][2];
#pragma unroll
            for (int m = 0; m < 4; ++m) { const GA unsigned char* gp = G + (size_t)(row0 + ai * 128 + m * 16) * 8192 + c0;
#pragma unroll
                for (int bj = 0; bj < 2; ++bj) { num[m][bj] = *(const GA u32x2*)(gp + (bnext - 1) * DM + bj * 128); den[m][bj] = *(const GA u32x2*)(gp + bnext * DM + bj * 128); } }
#pragma unroll
            for (int m = 0; m < 4; ++m)
#pragma unroll
                for (int bj = 0; bj < 2; ++bj)
#pragma unroll
                    for (int j = 0; j < 4; ++j) {
                        acc[ai][bj][m][0][j] *= gq(num[m][bj][0], j) * __builtin_amdgcn_rcpf(gq(den[m][bj][0], j));
                        acc[ai][bj][m][1][j] *= gq(num[m][bj][1], j) * __builtin_amdgcn_rcpf(gq(den[m][bj][1], j)); }
            asm volatile("" ::: "memory");
        }
    }
    __device__ __forceinline__ void operator()(const f32x4 (&acc)[2][2][4][2], const pg8::Unit& u, int wr, int wc, int fr, int fq) const {
        const int row0 = u.pm * 256 + wr * 64 + fr, c0 = u.pn * 256 + wc * 32 + 8 * fq;
        u32x2 g3v[2][4][2];
#pragma unroll
        for (int ai = 0; ai < 2; ++ai)
#pragma unroll
            for (int m = 0; m < 4; ++m)
#pragma unroll
                for (int bj = 0; bj < 2; ++bj) g3v[ai][m][bj] = *(const GA u32x2*)(G + (size_t)(row0 + ai * 128 + m * 16) * 8192 + 3 * DM + c0 + bj * 128);
#pragma unroll
        for (int ai = 0; ai < 2; ++ai)
#pragma unroll
            for (int m = 0; m < 4; ++m) { const int r = row0 + ai * 128 + m * 16;
#pragma unroll
                for (int bj = 0; bj < 2; ++bj) { const u32x2 g3 = g3v[ai][m][bj];
                    const f32x4 v0 = acc[ai][bj][m][0] * (1.0f / 256.0f), v1 = acc[ai][bj][m][1] * (1.0f / 256.0f);
                    u32x4 w = {cvt_pk_bf16(v0[0] * gq(g3[0], 0), v0[1] * gq(g3[0], 1)), cvt_pk_bf16(v0[2] * gq(g3[0], 2), v0[3] * gq(g3[0], 3)),
                               cvt_pk_bf16(v1[0] * gq(g3[1], 0), v1[1] * gq(g3[1], 1)), cvt_pk_bf16(v1[2] * gq(g3[1], 2), v1[3] * gq(g3[1], 3))};
                    *(GA u32x4*)(MG + (size_t)r * DM + c0 + bj * 128) = w; } }
    }
};

struct EpiOut {
    static constexpr bool PERM = false, AFTER_DRAIN = false, MIDK = false, FP8 = false;
    GA float* xres; GA bf16_t* xb; GA float* ssq; GA unsigned char* xq; const GA float* xsrc; bool feed_next;
    __device__ __forceinline__ void operator()(const f32x4 (&acc)[2][2][4][2], const pg8::Unit& u, int wr, int wc, int fr, int fq) const {
        const int row0 = u.pm * 256 + wr * 64 + fr, col0 = u.pn * 256 + wc * 32 + 4 * fq;
#pragma unroll
        for (int h = 0; h < 4; ++h) {
            const int ai = h >> 1, mb = (h & 1) * 2;
            f32x4 xv[2][2][2];
#pragma unroll
            for (int m = 0; m < 2; ++m)
#pragma unroll
                for (int bj = 0; bj < 2; ++bj)
#pragma unroll
                    for (int n = 0; n < 2; ++n) { const size_t off_ = (size_t)(row0 + ai * 128 + (mb + m) * 16) * DM + col0 + bj * 128 + n * 16;
                        if (xsrc != nullptr) xv[m][bj][n] = *(const GA f32x4*)(xsrc + off_);
                        else { const u32x2 t_ = *(const GA u32x2*)(xb + off_); xv[m][bj][n] = (f32x4){bf_lo(t_[0]), bf_hi(t_[0]), bf_lo(t_[1]), bf_hi(t_[1])}; } }
#pragma unroll
            for (int m = 0; m < 2; ++m) { const int r = row0 + ai * 128 + (mb + m) * 16; float ss = 0.f;
#pragma unroll
                for (int bj = 0; bj < 2; ++bj)
#pragma unroll
                    for (int n = 0; n < 2; ++n) { const size_t off = (size_t)r * DM + col0 + bj * 128 + n * 16;
                        const f32x4 v = xv[m][bj][n] + acc[ai][bj][mb + m][n];
                        ss += v[0] * v[0] + v[1] * v[1] + v[2] * v[2] + v[3] * v[3];
                        { u32x2 w = {cvt_pk_bf16(v[0], v[1]), cvt_pk_bf16(v[2], v[3])}; *(GA u32x2*)(xb + off) = w; }
                        if (feed_next) *(GA unsigned*)(xq + off) = cvt4_fp8(v[0], v[1], v[2], v[3]); }
                ss += __shfl_xor(ss, 16); ss += __shfl_xor(ss, 32);
                if (fq == 0) ssq[(size_t)r * 32 + u.pn * 4 + wc] = ss; }
        }
    }
};

__device__ __forceinline__ void final_norm(const Frame& F) {
    const int tid = tid_l(), lane = tid & 63, wave = tid >> 6, G = gridDim.x, bid = blockIdx.x;
    for (int row = bid * 8 + wave; row < MT; row += G * 8) {
        float ss = (lane < 32) ? F.ssq[(size_t)row * 32 + lane] : 0.f; ss = wave_sum(ss);
        const float rs = rsqrtf(ss * (1.0f / DM) + RMS_EPS);
#pragma unroll
        for (int i = 0; i < 8; ++i) { const int c = (i * 64 + lane) * 4; const u32x2 t = *(const GA u32x2*)(F.xb + (size_t)row * DM + c); const f32x4 v = {bf_lo(t[0]), bf_hi(t[0]), bf_lo(t[1]), bf_hi(t[1])}, w = *(const GA f32x4*)(F.final_w + c);
            *(GA f32x4*)(F.out + (size_t)row * DM + c) = v * rs * w; }
    }
}

__device__ __forceinline__ Frame mkframe(const Args& args, GA unsigned char* ws, LAS unsigned char* lds) {
    Frame F;
    F.x = (const GA float*)args.in[0]; F.norm_w = (const GA float*)args.in[1]; F.w_in = (const GA float*)args.in[2]; F.fox_b = (const GA float*)args.in[3];
    F.lq1 = (const GA float*)args.in[4]; F.lk1 = (const GA float*)args.in[5]; F.lq2 = (const GA float*)args.in[6]; F.lk2 = (const GA float*)args.in[7];
    F.subln = (const GA float*)args.in[8]; F.w_branch = (const GA float*)args.in[9]; F.w_out = (const GA float*)args.in[10]; F.rel_bias = (const GA float*)args.in[11];
    F.final_w = (const GA float*)args.in[12]; F.out = (GA float*)args.out;
    F.ctl = (GA unsigned*)(ws + WS_CTL); F.WinT = (GA bf16_t*)(ws + WS_WIN); F.WbrT = (GA bf16_t*)(ws + WS_WBR); F.WoutT = (GA bf16_t*)(ws + WS_WOUT);
    F.xres = (GA float*)(ws + WS_XRES); F.xb = (GA bf16_t*)(ws + WS_XB); F.ssq = (GA float*)(ws + WS_SSQ); F.Zs = (GA bf16_t*)(ws + WS_ZS); F.G = (GA bf16_t*)(ws + WS_G);
    F.QKV = (GA bf16_t*)(ws + WS_QKV); F.IQ = (GA bf16_t*)(ws + WS_IQ); F.IK = (GA bf16_t*)(ws + WS_IK); F.IW = (GA float*)(ws + WS_IW); F.FF = (GA float*)(ws + WS_FF);
    F.cum = (GA float*)(ws + WS_CUM); F.tb = (GA float*)(ws + WS_TB); F.sc = (GA float*)(ws + WS_SC); F.mask = (GA u64*)(ws + WS_MASK); F.Y = (GA bf16_t*)(ws + WS_Y); F.MG = (GA bf16_t*)(ws + WS_MG);
    F.O1 = (GA float*)(ws + WS_O1); F.OD = (GA float*)(ws + WS_OD); F.LSE = (GA float*)(ws + WS_LSE); F.DP = (GA float*)(ws + WS_DP); F.ws = ws;
    F.lds = lds; F.misc = (volatile LAS unsigned*)(lds + LDS_MISC);
    return F;
}

constexpr unsigned WQ_L0 = 2u * WT_TB, WQ_TOTAL = WQ_L0 + 3u * WT_TL;
__device__ __forceinline__ void wq_tile(const Args& args, LAS unsigned char* ldsl, unsigned t) {
    const Frame F = mkframe(args, launder(args.ws), ldsl);
    if (t < WQ_L0) { weight_tile(F, 0, WT_TW + WT_TG + (int)t, (LAS float*)ldsl); return; }
    const unsigned t1 = t - WQ_L0, l1 = t1 / (unsigned)WT_TL;
    weight_tile(F, 1 + (int)l1, (int)(t1 - l1 * (unsigned)WT_TL), (LAS float*)ldsl);
}
__device__ __forceinline__ void wq_drain(const Args& args, LAS unsigned char* ldsl, unsigned bound) {
    volatile LAS unsigned* st = (volatile LAS unsigned*)(ldsl + LDS_MISC);
    GA unsigned* wq = (GA unsigned*)(args.ws + WS_CTL) + CW_WQ;
    for (;;) {
        __syncthreads();
        if (threadIdx.x == 0) st[11] = __hip_atomic_fetch_add(wq, 1u, __ATOMIC_RELAXED, __HIP_MEMORY_SCOPE_AGENT);
        __syncthreads();
        const unsigned t = st[11];
        if (t < WQ_TOTAL) wq_tile(args, ldsl, t);
        if (t + 1u >= bound) break;
    }
}
__device__ __forceinline__ void xcd_barrier_steal(const XcdBarrier& b, const Args& args, LAS unsigned char* ldsl) {
    asm volatile("s_waitcnt vmcnt(0)" ::: "memory");
    __syncthreads();
    volatile LAS unsigned* st = b.st;
    if (threadIdx.x == 0) {
        unsigned* bar = b.bar;
        __builtin_amdgcn_s_waitcnt(0);
        unsigned nloc = st[0], nx = st[1];
        if (nloc == 0u) { xcd_barrier_complete(bar, b.x, nloc, nx); st[0] = nloc; st[1] = nx; }
        const unsigned old = xb_add(&bar[XB_XSUB(b.x)], 1u);
        const unsigned gen = old / nloc;
        if (old + 1u == (gen + 1u) * nloc) {
            __builtin_amdgcn_fence(__ATOMIC_RELEASE, "agent");
            asm volatile("s_waitcnt vmcnt(0)" ::: "memory");
            const unsigned og = xb_add(&bar[XB_TOP], 1u);
            const unsigned tg = og / nx;
            if (og + 1u == (tg + 1u) * nx) xb_add(&bar[XB_TOPGEN], 1u);
            else XB_SPIN(xb_ld(&bar[XB_TOPGEN]) == tg, bar);
            __builtin_amdgcn_fence(__ATOMIC_ACQUIRE, "agent");
            xb_add(&bar[XB_XGEN(b.x)], 1u);
            asm volatile("s_waitcnt vmcnt(0)" ::: "memory");
            st[8] = 1u;
        } else { st[8] = 0u; st[9] = gen; }
    }
    __syncthreads();
    const unsigned leader_ = st[8];
    __syncthreads();
    if (leader_ == 0u) {
        unsigned sp = 0u;
        for (;;) {
            if (threadIdx.x == 0) {
                unsigned* bar = b.bar;
                unsigned done = (xb_ld(&bar[XB_XGEN(b.x)]) != st[9]) ? 1u : 0u, t = 0xffffffffu;
                if (!done) {
                    if (st[10] == 0u) { t = xb_add((unsigned*)(args.ws + WS_CTL) + CW_WQ, 1u); if (t >= WQ_TOTAL) { st[10] = 1u; t = 0xffffffffu; } }
                    if (t == 0xffffffffu) { __builtin_amdgcn_s_sleep(1);
                        if ((++sp & 255u) == 0u) { if (xb_ld(&bar[XB_TMO])) done = 1u; else if (sp > XB_SPIN_CAP) { atomicAdd(&bar[XB_TMO], 1u); done = 1u; } } }
                }
                st[8] = done; st[11] = t;
            }
            __syncthreads();
            const unsigned done = st[8], t = st[11];
            if (done) break;
            if (t != 0xffffffffu) wq_tile(args, ldsl, t);
            else __syncthreads();
        }
        if (threadIdx.x == 0) { __builtin_amdgcn_fence(__ATOMIC_ACQUIRE, "agent"); asm volatile("s_waitcnt vmcnt(0)" ::: "memory"); }
    }
    __syncthreads();
}

__global__ void __launch_bounds__(512, 2) fwd(Args args) {
    extern __shared__ __attribute__((aligned(16))) unsigned char lds[];
    LAS unsigned char* ldsl = (LAS unsigned char*)lds;
    if (threadIdx.x < 64) ((volatile LAS unsigned*)(ldsl + LDS_MISC))[threadIdx.x] = 0u;
    __syncthreads();
    const int lo = args.ph_lo, hi = args.ph_hi;
    const bool fused = (hi - lo) > 1;
    if (fused) (void)xcd_barrier_post((unsigned*)(args.ws + WS_CTL) + CW_BAR, (volatile LAS unsigned*)(ldsl + LDS_MISC));
#ifndef PH_EN
#define PH_EN 0xff
#endif
#define IN(k) (lo <= (k) && (k) < hi)
#if defined(BWPROBE)
#define BW_MATCH(k) (BWPROBE == 9 || ((k) == 0 ? 5 : ((k) - 1) % 5) == BWPROBE)
#define SEAM(k) do { if (IN((k) + 1)) { const unsigned long long bw0_ = __builtin_amdgcn_s_memrealtime(); XcdBarrier b_; b_.bar = (unsigned*)(args.ws + WS_CTL) + CW_BAR; b_.x = xb_xcc_id(); b_.st = (volatile LAS unsigned*)(ldsl + LDS_MISC); xcd_barrier(b_); \
    if (BW_MATCH(k) && threadIdx.x == 0) atomicAdd((unsigned*)(args.ws + WS_CTL) + 14336, (unsigned)(__builtin_amdgcn_s_memrealtime() - bw0_)); } } while (0)
#else
#define SEAM(k) do { if (IN((k) + 1)) { XcdBarrier b_; b_.bar = (unsigned*)(args.ws + WS_CTL) + CW_BAR; b_.x = xb_xcc_id(); b_.st = (volatile LAS unsigned*)(ldsl + LDS_MISC); xcd_barrier(b_); } } while (0)
#endif
#define SEAM_STEAL(k) do { if (IN((k) + 1)) { XcdBarrier b_; b_.bar = (unsigned*)(args.ws + WS_CTL) + CW_BAR; b_.x = xb_xcc_id(); b_.st = (volatile LAS unsigned*)(ldsl + LDS_MISC); xcd_barrier_steal(b_, args, ldsl); } } while (0)
    const int G = gridDim.x, bid = blockIdx.x;
#if defined(TPROBE)
    unsigned long long tp_acc = 0ull, tp_t0 = 0ull;
#define tp_acc_ref tp_acc
#define TP_BEGIN(k) do { if ((k) == TPROBE) tp_t0 = __builtin_amdgcn_s_memrealtime(); } while (0)
#define TP_END(k) do { if ((k) == TPROBE) tp_acc += __builtin_amdgcn_s_memrealtime() - tp_t0; } while (0)
#else
    unsigned long long tp_dummy = 0ull;
#define tp_acc_ref tp_dummy
#define TP_BEGIN(k) do { } while (0)
#define TP_END(k) do { } while (0)
#endif

    if ((PH_EN & 1) && IN(0)) { const Frame F = mkframe(args, launder(args.ws), ldsl); TP_BEGIN(0); p0_prologue(F);
#if defined(DUP) && DUP == 6
        __syncthreads(); p0_prologue(F);
#endif
        SEAM(0); TP_END(0); }

    for (int layer = 0; layer < DEPTH; ++layer) {
        const int pb = 1 + 5 * layer;
        if ((PH_EN & 2) && IN(pb)) { TP_BEGIN(1);
            GA unsigned char* ws = launder(args.ws);
            { pg8::Gemm g{(const GA bf16_t*)(ws + WS_XB), (const GA bf16_t*)(ws + WS_WIN) + (size_t)layer * NINP * DM, MT, NINP, DM}; pg8::StaticOrder S; S.init(MT, NINP, G, bid);
              EpiIn E{ws};
              pg8::gemm_phase<EpiIn, pg8::StaticOrder>(ldsl, g, S, E); }
            __syncthreads();
            { pg8::Gemm g{(const GA bf16_t*)(ws + WS_XQ), (const GA bf16_t*)(ws + WS_WG8 + (size_t)layer * N8 * DM), MT, N8, DM / 2}; pg8::StaticOrder S;
              if (G == 256) { if (bid < 192) S.init_part(MT, N8, 192, bid, 12); else S.init_part(MT, N8, 64, 2304 + (bid - 192), 14); } else S.init(MT, N8, G, (bid + 128) % G);
              EpiGate E{ws};
              pg8::gemm_phase<EpiGate, pg8::StaticOrder>(ldsl, g, S, E); }
            SEAM_STEAL(pb); TP_END(1);
        }
        if ((PH_EN & 4) && IN(pb + 1)) { TP_BEGIN(2);
            const Frame F = mkframe(args, launder(args.ws), ldsl);
            TP_BEGIN(20); if (bid < 8) fox_scan(F, layer, bid);
            fox_kmax(F, layer); TP_END(20);
            GA unsigned* ctr = F.ctl + CW_Q + 64 * (layer * 4 + 0);
            for (int u = q_next(ctr, F.misc + 4); u < 768 + 2048; u = q_next(ctr, F.misc + 4)) {
                if (u < 768) { TP_BEGIN(23); attn_dil_unit(F, u); TP_END(23); } else { TP_BEGIN(21); idxsel_unit(F, u - 768, tp_acc_ref); TP_END(21); }
            }
            SEAM_STEAL(pb + 1); TP_END(2);
        }
        if ((PH_EN & 16) && IN(pb + 2)) { TP_BEGIN(4);
            const Frame F = mkframe(args, launder(args.ws), ldsl);
            GA unsigned* ctr = F.ctl + CW_Q + 64 * (layer * 4 + 1);
            const int nunits = 1536;
            for (int u = q_next(ctr, F.misc + 4); u < nunits; u = q_next(ctr, F.misc + 4)) {
                if (u < 512) { const int qb = 31 - (u >> 4), r = u & 15; TP_BEGIN(40); TP_BEGIN(44 + (qb >= 16)); attn_diffmap_unit(F, layer, r & 1, (r >> 1) & 3, qb, r >> 3); TP_END(40); TP_END(44 + (qb >= 16)); }
                else if (u < 1024) { const int v = u - 512, qb = 31 - (v >> 4), r = v & 15, mode = r & 1, b = (r >> 1) & 1, h = r >> 2;
                    if (mode == 0) { TP_BEGIN(41); attn_fast_unit<0>(F, layer, b, h, qb); TP_END(41); } else { TP_BEGIN(42); attn_fast_unit<1>(F, layer, b, h, qb); TP_END(42); } }
                else { TP_BEGIN(43); dil_merge_unit(F, u - 1024); TP_END(43); }
            }
            if (layer == 0) { __syncthreads(); wq_drain(args, ldsl, WQ_L0); }
            SEAM_STEAL(pb + 2); TP_END(4);
        }
        if ((PH_EN & 32) && IN(pb + 3)) { TP_BEGIN(5);
            GA unsigned char* ws = launder(args.ws);
            pg8::Gemm g{(const GA bf16_t*)(ws + WS_Y), (const GA bf16_t*)(ws + WS_WBR) + (size_t)layer * DM * DM, MT, DM, DM}; pg8::StaticOrder S; S.init(MT, DM, G, bid);
            EpiMerged E{(const GA unsigned char*)(ws + WS_G), (GA bf16_t*)(ws + WS_MG)};
            pg8::gemm_phase<EpiMerged, pg8::StaticOrder>(ldsl, g, S, E);
#if defined(DUP) && DUP == 4
            __syncthreads(); pg8::gemm_phase<EpiMerged, pg8::StaticOrder>(ldsl, g, S, E);
#endif
            SEAM_STEAL(pb + 3); TP_END(5);
        }
        if ((PH_EN & 64) && IN(pb + 4)) { TP_BEGIN(6);
            GA unsigned char* ws = launder(args.ws);
            pg8::Gemm g{(const GA bf16_t*)(ws + WS_MG), (const GA bf16_t*)(ws + WS_WOUT) + (size_t)layer * DM * DM, MT, DM, DM}; pg8::StaticOrder S; S.init(MT, DM, G, bid);
            EpiOut E{(GA float*)(ws + WS_XRES), (GA bf16_t*)(ws + WS_XB), (GA float*)(ws + WS_SSQ), ws + WS_XQ, (layer == 0) ? (const GA float*)args.in[0] : (const GA float*)nullptr, layer + 1 < DEPTH};
            pg8::gemm_phase<EpiOut, pg8::StaticOrder>(ldsl, g, S, E);
            if (layer + 1 < DEPTH) { __syncthreads(); wq_drain(args, ldsl, WQ_L0 + (unsigned)(layer + 1) * WT_TL); }
            SEAM_STEAL(pb + 4); TP_END(6);
        }
    }
    if ((PH_EN & 128) && IN(21)) { TP_BEGIN(7); const Frame F = mkframe(args, launder(args.ws), ldsl); final_norm(F); TP_END(7); }
#if defined(BWPROBE)
    if (bid == 0) { __syncthreads(); const unsigned long long te = __builtin_amdgcn_s_memrealtime(); const unsigned long long tot = xb_ld((unsigned*)(args.ws + WS_CTL) + 14336);
        while ((__builtin_amdgcn_s_memrealtime() - te) * 32ull < tot) __builtin_amdgcn_s_sleep(8); }
#endif
#if defined(TPROBE)
    if (bid == 0) { const unsigned long long te = __builtin_amdgcn_s_memrealtime(); while (__builtin_amdgcn_s_memrealtime() - te < 8ull * tp_acc) __builtin_amdgcn_s_sleep(8); }
#endif
#undef IN
#undef SEAM
}

extern "C" void kernel_launch(void* const* d_in, const int* in_sizes, int n_in, void* d_out, int out_size, void* d_ws, size_t ws_size, hipStream_t stream) {
    static int grid = 0;
    if (grid == 0) {
        if (n_in != 13 || in_sizes[0] != MT * DM || out_size != MT * DM || ws_size < WS_END) {
            fprintf(stderr, "kernel_launch: unexpected shapes (n_in %d, in0 %d, out %d, ws %zu, need %zu)\n", n_in, n_in > 0 ? in_sizes[0] : -1, out_size, ws_size, (size_t)WS_END); grid = -1; return; }
        int dev = 0, cus = 0, per_cu = 0;
        if (hipGetDevice(&dev) != hipSuccess || hipDeviceGetAttribute(&cus, hipDeviceAttributeMultiprocessorCount, dev) != hipSuccess) { grid = -1; return; }
        if (hipFuncSetAttribute((const void*)fwd, hipFuncAttributeMaxDynamicSharedMemorySize, LDS_BYTES) != hipSuccess) { fprintf(stderr, "kernel_launch: hipFuncSetAttribute failed\n"); grid = -1; return; }
        if (hipOccupancyMaxActiveBlocksPerMultiprocessor(&per_cu, (const void*)fwd, 512, LDS_BYTES) != hipSuccess || per_cu < 1) fprintf(stderr, "kernel_launch: occupancy query reports %d\n", per_cu);
        (void)hipGetLastError();
        grid = cus;
    }
    if (grid < 0) return;
    if (hipMemsetAsync((char*)d_ws + WS_CTL, 0, CTL_BYTES, stream) != hipSuccess) return;
    Args a{};
    for (int i = 0; i < 13; ++i) a.in[i] = (const float*)d_in[i];
    a.out = (float*)d_out; a.ws = (unsigned char*)d_ws;
#if MK_LAUNCHES == 1
    a.ph_lo = 0; a.ph_hi = NPH;
    hipLaunchKernelGGL(fwd, dim3(grid), dim3(512), LDS_BYTES, stream, a);
#else
    for (int p = 0; p < NPH; ++p) { a.ph_lo = p; a.ph_hi = p + 1; hipLaunchKernelGGL(fwd, dim3(grid), dim3(512), LDS_BYTES, stream, a); }
#endif
}
```

```cpp
#include <hip/hip_runtime.h>
#include <stdint.h>
#include <stdio.h>

#ifndef MK_LAUNCHES
#define MK_LAUNCHES 1
#endif

#define LAS __attribute__((address_space(3)))
#define GA __attribute__((address_space(1)))
typedef unsigned short bf16_t;
typedef short bf16x8 __attribute__((ext_vector_type(8)));
typedef float f32x4 __attribute__((ext_vector_type(4)));
typedef float f32x16 __attribute__((ext_vector_type(16)));
typedef unsigned u32x4 __attribute__((ext_vector_type(4)));
typedef unsigned u32x2 __attribute__((ext_vector_type(2)));
typedef unsigned long long u64;

constexpr int DM = 2048, NB = 2, SEQ = 8192, DEPTH = 4, MT = NB * SEQ;
constexpr int NIN = 17492, NINP = 4864, N8 = 12800;
constexpr float W8SCALE = 512.f;
constexpr int NPH = 22;
constexpr float LOG2E = 1.4426950408889634f;
constexpr float QSC128 = 0.08838834764831845f * 1.4426950408889634f;
constexpr float QSC64 = 0.125f * 1.4426950408889634f;
constexpr float RMS_EPS = 1e-6f;
constexpr size_t QS = (size_t)NB * 4 * SEQ * 128;

constexpr size_t al256(size_t x) { return (x + 255) & ~(size_t)255; }
constexpr size_t WS_CTL = 0, CTL_BYTES = 65536;
constexpr size_t WS_WIN = WS_CTL + CTL_BYTES;
constexpr size_t WS_WBR = WS_WIN + (size_t)DEPTH * NINP * DM * 2;
constexpr size_t WS_WOUT = WS_WBR + (size_t)DEPTH * DM * DM * 2;
constexpr size_t WS_XRES = WS_WOUT + (size_t)DEPTH * DM * DM * 2;
constexpr size_t WS_XB = WS_XRES + (size_t)MT * DM * 4;
constexpr size_t WS_SSQ = WS_XB + (size_t)MT * DM * 2;
constexpr size_t WS_ZS = WS_SSQ + (size_t)MT * 32 * 4;
constexpr size_t WS_G = WS_ZS + (size_t)MT * DM * 2;
constexpr size_t WS_QKV = WS_G + (size_t)MT * 8192 * 2;
constexpr size_t WS_IQ = WS_QKV + 12 * QS * 2;
constexpr size_t WS_IK = WS_IQ + (size_t)MT * 1024 * 2;
constexpr size_t WS_IW = WS_IK + (size_t)MT * 64 * 2;
constexpr size_t WS_FF = WS_IW + (size_t)MT * 16 * 4;
constexpr size_t WS_CUM = WS_FF + (size_t)MT * 4 * 4;
constexpr size_t WS_TB = WS_CUM + (size_t)NB * 4 * SEQ * 4;
constexpr size_t WS_SC = WS_TB + (size_t)12 * SEQ * 4;
constexpr size_t WS_MASK = WS_SC + (size_t)NB * SEQ * SEQ * 4;
constexpr size_t WS_Y = WS_MASK + (size_t)NB * SEQ * 128 * 8;
constexpr size_t WS_MG = WS_Y + (size_t)MT * DM * 2;
constexpr size_t WS_O1 = WS_MG + (size_t)MT * DM * 2;
constexpr size_t WS_OD = WS_O1 + (size_t)2 * 256 * 64 * 512 * 4;
constexpr size_t WS_LSE = WS_OD + (size_t)3 * MT * 512 * 4;
constexpr size_t WS_DP = WS_LSE + (size_t)3 * MT * 4 * 4;
constexpr size_t WS_WG8 = WS_DP + 4 * 256 * 4;
constexpr size_t WS_XQ = WS_WG8 + (size_t)DEPTH * N8 * DM;
constexpr size_t WS_END = WS_XQ + (size_t)MT * DM;

constexpr int CW_BAR = 0;
constexpr int CW_Q = 4096;
constexpr int CW_DC = 8192;
constexpr int CW_WQ = 13312;
constexpr int CW_KM = 12288;

constexpr int LDS_STAGE = 131072;
constexpr int LDS_MISC = 131072;
constexpr int LDS_BYTES = 147456;

__device__ __forceinline__ unsigned cvt_pk_bf16(float lo, float hi) { unsigned r; asm volatile("v_cvt_pk_bf16_f32 %0, %1, %2" : "=v"(r) : "v"(lo), "v"(hi)); return r; }
__device__ __forceinline__ float bf_lo(unsigned w) { return __uint_as_float(w << 16); }
__device__ __forceinline__ float bf_hi(unsigned w) { return __uint_as_float(w & 0xffff0000u); }
__device__ __forceinline__ float bf2f(bf16_t b) { return __uint_as_float(((unsigned)b) << 16); }
__device__ __forceinline__ float ex2(float x) { return __builtin_amdgcn_exp2f(x); }
__device__ __forceinline__ float sigmoidf_(float x) { return __builtin_amdgcn_rcpf(1.0f + ex2(-x * LOG2E)); }
__device__ __forceinline__ int tid_l() { int t = threadIdx.x; asm volatile("" : "+v"(t)); return t; }
__device__ __forceinline__ GA unsigned char* launder(unsigned char* p) { asm volatile("" : "+s"(p)); return (GA unsigned char*)p; }
__device__ __forceinline__ GA unsigned char* launder(GA unsigned char* p) { asm volatile("" : "+s"(p)); return p; }
__device__ __forceinline__ float wave_sum(float v) {
#pragma unroll
    for (int o = 32; o > 0; o >>= 1) v += __shfl_xor(v, o);
    return v;
}

#define XB_TMO      128
#define XB_XCNT(j)  (256  + 64 * (j))
#define XB_XSUB(j)  (1280 + 64 * (j))
#define XB_XGEN(j)  (2304 + 64 * (j))
#define XB_TOP      3328
#define XB_TOPGEN   3392
#define XCD_BAR_WORDS 3456
#define XB_SPIN_CAP (1u << 18)

__device__ __forceinline__ unsigned xb_ld(unsigned* p)              { return __hip_atomic_load(p, __ATOMIC_RELAXED, __HIP_MEMORY_SCOPE_AGENT); }
__device__ __forceinline__ unsigned xb_add(unsigned* p, unsigned v) { return __hip_atomic_fetch_add(p, v, __ATOMIC_RELAXED, __HIP_MEMORY_SCOPE_AGENT); }
__device__ __forceinline__ unsigned xb_xcc_id() { return (unsigned)__builtin_amdgcn_s_getreg((3 << 11) | 20) & 0xFu; }
#define XB_SPIN(cond, bar) do { unsigned _sp = 0; while (cond) { __builtin_amdgcn_s_sleep(1); \
    if ((++_sp & 255u) == 0u) { if (xb_ld(&(bar)[XB_TMO])) break; if (_sp > XB_SPIN_CAP) { atomicAdd(&(bar)[XB_TMO], 1u); break; } } } } while (0)

struct XcdBarrier { unsigned* bar; unsigned x; volatile LAS unsigned* st; };

__device__ __forceinline__ XcdBarrier xcd_barrier_post(unsigned* bar, volatile LAS unsigned* st) {
    XcdBarrier b; b.bar = bar; b.x = xb_xcc_id(); b.st = st;
    if (threadIdx.x == 0) (void)xb_add(&bar[XB_XCNT(b.x)], 1u);
    return b;
}
__device__ __forceinline__ void xcd_barrier_complete(unsigned* bar, unsigned x, unsigned& nloc, unsigned& nx) {
    const unsigned G = gridDim.x * gridDim.y * gridDim.z;
    unsigned sum, cnt, mine, sp = 0u;
    for (;;) {
        sum = 0u; cnt = 0u; mine = 0u;
#pragma unroll
        for (unsigned j = 0; j < 16; ++j) { const unsigned c = xb_ld(&bar[XB_XCNT(j)]); sum += c; cnt += (c > 0u) ? 1u : 0u; mine = (j == x) ? c : mine; }
        if (sum == G) break;
        __builtin_amdgcn_s_sleep(1);
        if ((++sp & 255u) == 0u) { if (xb_ld(&bar[XB_TMO])) break; if (sp > XB_SPIN_CAP) { atomicAdd(&bar[XB_TMO], 1u); break; } }
    }
    nloc = mine > 0u ? mine : 1u; nx = cnt > 0u ? cnt : 1u;
}
__device__ __forceinline__ void xcd_barrier(const XcdBarrier& b) {
    asm volatile("s_waitcnt vmcnt(0)" ::: "memory");
    __syncthreads();
    if (threadIdx.x == 0) {
        unsigned* bar = b.bar;
        __builtin_amdgcn_s_waitcnt(0);
        unsigned nloc = b.st[0], nx = b.st[1];
        if (nloc == 0u) { xcd_barrier_complete(bar, b.x, nloc, nx); b.st[0] = nloc; b.st[1] = nx; }
        const unsigned old = xb_add(&bar[XB_XSUB(b.x)], 1u);
        const unsigned gen = old / nloc;
        if (old + 1u == (gen + 1u) * nloc) {
            __builtin_amdgcn_fence(__ATOMIC_RELEASE, "agent");
            asm volatile("s_waitcnt vmcnt(0)" ::: "memory");
            const unsigned og = xb_add(&bar[XB_TOP], 1u);
            const unsigned tg = og / nx;
            if (og + 1u == (tg + 1u) * nx) xb_add(&bar[XB_TOPGEN], 1u);
            else XB_SPIN(xb_ld(&bar[XB_TOPGEN]) == tg, bar);
            __builtin_amdgcn_fence(__ATOMIC_ACQUIRE, "agent");
            xb_add(&bar[XB_XGEN(b.x)], 1u);
            asm volatile("s_waitcnt vmcnt(0)" ::: "memory");
        } else {
            XB_SPIN(xb_ld(&bar[XB_XGEN(b.x)]) == gen, bar);
            __builtin_amdgcn_fence(__ATOMIC_ACQUIRE, "agent");
            asm volatile("s_waitcnt vmcnt(0)" ::: "memory");
        }
    }
    __syncthreads();
}

namespace pg8 {
constexpr int BM = 256, BK = 64, HALF = 128, HTB = HALF * BK * 2, STAGE_BYTES = 8 * HTB, NXCD = 8, WGM = 4;
__host__ __device__ __forceinline__ int lds_byte(int r, int c) { const int st = (r >> 4) * 2 + (c >> 5), rr = r & 15, cc = c & 31, ob = rr * 64 + cc * 2; return st * 1024 + (ob ^ (((ob >> 9) & 1) << 5)); }
__host__ __device__ __forceinline__ void stage_rc(int b, int& R, int& C) { const int st = b / 1024, sb = b % 1024, swz = sb ^ (((sb >> 9) & 1) << 5); R = (st >> 1) * 16 + swz / 64; C = (st & 1) * 32 + (swz % 64) / 2; }
__host__ __device__ __forceinline__ int perm32(int rho) { const int n = rho >> 4, i = rho & 15; return 8 * (i >> 2) + 4 * n + (i & 3); }
struct Unit { int pm, pn; };
struct Gemm { const GA bf16_t* A; const GA bf16_t* Bt; int M, N, K; };
struct StaticOrder {
    int nM, nN, nwg, G, c, cnt;
    __host__ __device__ void init(int M, int N, int G_, int c_) { nM = M / BM; nN = N / BM; nwg = nM * nN; G = G_; c = c_; cnt = 1 << 30; }
    __host__ __device__ void init_part(int M, int N, int stride, int first, int cnt_) { nM = M / BM; nN = N / BM; nwg = nM * nN; G = stride; c = first; cnt = cnt_; }
    __host__ __device__ bool next(int i, Unit& u) const {
        const long L = (long)i * G + c; if (L >= nwg || i >= cnt) return false;
        int wgid = (int)L; { const int q = nwg / NXCD, r = nwg % NXCD, xcd = wgid % NXCD, off = wgid / NXCD; wgid = (xcd < r ? xcd * (q + 1) : r * (q + 1) + (xcd - r) * q) + off; }
        const int nig = WGM * nN, gid = wgid / nig, fm = gid * WGM, gsz = (nM - fm) < WGM ? (nM - fm) : WGM;
        u.pm = fm + ((wgid % nig) % gsz); u.pn = (wgid % nig) / gsz; return true;
    }
    __device__ __forceinline__ void a_ready(const Unit&) const {}
    __device__ __forceinline__ void done(const Unit&) const {}
};

template <class Epi, class Sched>
__device__ __forceinline__ void gemm_phase(LAS unsigned char* lds, const Gemm g, const Sched& S, const Epi& E) {
    const int tid = tid_l(), wid = __builtin_amdgcn_readfirstlane(tid >> 6), lane = tid & 63, wr = wid >> 2, wc = wid & 3, fr = lane & 15, fq = lane >> 4;
    const int K = g.K, nt = K / BK;
    unsigned voffA[2], voffB[2];
#pragma unroll
    for (int i = 0; i < 2; ++i) { int R, C; stage_rc(tid * 16 + i * 8192, R, C); const int Rb = Epi::PERM ? ((R & ~31) + perm32(R & 31)) : R;
        voffA[i] = (unsigned)(R * K + C) * 2u; voffB[i] = (unsigned)(Rb * K + C) * 2u; }
    const size_t kstep = (size_t)(BK * 2);
    const size_t hstep = (size_t)HALF * K * 2;
    const size_t tstep = 2 * hstep;
    const unsigned ldsw = (unsigned)wid * 1024u;
    const int aoff = lds_byte(wr * 64 + fr, fq * 8), boff = lds_byte(wc * 32 + fr, fq * 8);
    typedef int v8i_t __attribute__((ext_vector_type(8)));
    const int aoff8 = lds_byte(wr * 64 + fr, (fq & 1) * 16) + (fq >> 1) * 1024, boff8 = lds_byte(wc * 32 + fr, (fq & 1) * 16) + (fq >> 1) * 1024;
#define PG8_SA(b, h) (((b) * 2 + (h)) * HTB)
#define PG8_SB(b, h) ((4 + (b) * 2 + (h)) * HTB)
#define PG8_STAGE(bufoff, gbase, voff) do { _Pragma("unroll") for (int _i = 0; _i < 2; ++_i) \
        __builtin_amdgcn_global_load_lds((const GA unsigned*)((const GA char*)(gbase) + (voff)[_i]), (LAS unsigned*)(lds + (bufoff) + ldsw + _i * 8192), 16, 0, 0); } while (0)
#define PG8_LDA(dst, b, h) do { if constexpr (Epi::FP8) { _Pragma("unroll") for (int m = 0; m < 4; ++m) { typedef int v4i_t_ __attribute__((ext_vector_type(4))); const LAS char* p_ = (const LAS char*)(lds + PG8_SA(b, h) + aoff8 + m * 2048); const v4i_t_ lo_ = *(const LAS v4i_t_*)p_, hi_ = *(const LAS v4i_t_*)(p_ + 16); dst##8[m] = __builtin_shufflevector(lo_, hi_, 0, 1, 2, 3, 4, 5, 6, 7); } } \
        else { _Pragma("unroll") for (int m = 0; m < 4; ++m) _Pragma("unroll") for (int k = 0; k < 2; ++k) dst[m][k] = *(const LAS bf16x8*)(lds + PG8_SA(b, h) + aoff + m * 2048 + k * 1024); } } while (0)
#define PG8_LDB(dst, b, h) do { if constexpr (Epi::FP8) { _Pragma("unroll") for (int n = 0; n < 2; ++n) { typedef int v4i_t_ __attribute__((ext_vector_type(4))); const LAS char* p_ = (const LAS char*)(lds + PG8_SB(b, h) + boff8 + n * 2048); const v4i_t_ lo_ = *(const LAS v4i_t_*)p_, hi_ = *(const LAS v4i_t_*)(p_ + 16); dst##8[n] = __builtin_shufflevector(lo_, hi_, 0, 1, 2, 3, 4, 5, 6, 7); } } \
        else { _Pragma("unroll") for (int n = 0; n < 2; ++n) _Pragma("unroll") for (int k = 0; k < 2; ++k) dst[n][k] = *(const LAS bf16x8*)(lds + PG8_SB(b, h) + boff + n * 2048 + k * 1024); } } while (0)
#define PG8_MMA(ai, bj, At, Bt) do { __builtin_amdgcn_s_setprio(1); _Pragma("unroll") for (int m = 0; m < 4; ++m) _Pragma("unroll") for (int n = 0; n < 2; ++n) { \
        if constexpr (Epi::FP8) asm volatile("v_mfma_scale_f32_16x16x128_f8f6f4 %0, %1, %2, %0, %3, %3 op_sel_hi:[0,0,0]" : "+v"(acc[ai][bj][m][n]) : "v"(Bt##8[n]), "v"(At##8[m]), "v"(sc127)); \
        else { _Pragma("unroll") for (int k = 0; k < 2; ++k) acc[ai][bj][m][n] = __builtin_amdgcn_mfma_f32_16x16x32_bf16(Bt[n][k], At[m][k], acc[ai][bj][m][n], 0, 0, 0); } } \
        __builtin_amdgcn_s_setprio(0); } while (0)
#define PG8_WAIT_V(n) asm volatile("s_waitcnt vmcnt(" #n ")" ::: "memory")
#define PG8_WAIT_L(n) asm volatile("s_waitcnt lgkmcnt(" #n ")" ::: "memory")
#define PG8_BAR __builtin_amdgcn_s_barrier()
#define PG8_SCHED __builtin_amdgcn_sched_barrier(0)
    Unit cur, nxt; int ui = 0;
    if (!S.next(0, cur)) return;
    f32x4 acc[2][2][4][2];
#pragma unroll
    for (int a = 0; a < 2; ++a)
#pragma unroll
        for (int b = 0; b < 2; ++b)
#pragma unroll
            for (int m = 0; m < 4; ++m)
#pragma unroll
                for (int n = 0; n < 2; ++n) acc[a][b][m][n] = (f32x4){0.f, 0.f, 0.f, 0.f};
    bf16x8 At[4][2], B0[2][2], B1[2][2]; v8i_t At8[4], B08[2], B18[2]; const int sc127 = 127;
    const GA char* cA = (const GA char*)g.A + (size_t)cur.pm * tstep; const GA char* cB = (const GA char*)g.Bt + (size_t)cur.pn * tstep;
    S.a_ready(cur);
    PG8_STAGE(PG8_SB(0, 0), cB, voffB); PG8_STAGE(PG8_SA(0, 0), cA, voffA); PG8_STAGE(PG8_SB(0, 1), cB + hstep, voffB); PG8_STAGE(PG8_SA(0, 1), cA + hstep, voffA);
    if (wr == 1) PG8_BAR;
    PG8_WAIT_V(4); PG8_BAR;
    PG8_STAGE(PG8_SB(1, 0), cB + kstep, voffB); PG8_STAGE(PG8_SA(1, 0), cA + kstep, voffA); PG8_STAGE(PG8_SB(1, 1), cB + hstep + kstep, voffB);
    PG8_WAIT_V(6); PG8_BAR;
    for (;;) {
        const bool has_next = S.next(ui + 1, nxt);
        const GA char* nA = has_next ? (const GA char*)g.A + (size_t)nxt.pm * tstep : cA; const GA char* nB = has_next ? (const GA char*)g.Bt + (size_t)nxt.pn * tstep : cB;
        for (int t = 0; t < nt; t += 2) {
            const bool last = (t == nt - 2);
            const GA char* a1 = cA + (size_t)(t + 1) * kstep;
            const GA char* a2 = last ? nA : cA + (size_t)(t + 2) * kstep; const GA char* b2 = last ? nB : cB + (size_t)(t + 2) * kstep;
            const GA char* a3 = a2 + kstep; const GA char* b3 = b2 + kstep;
            if (last && has_next) S.a_ready(nxt);
            if constexpr (Epi::MIDK) { if (t > 0 && (t & 7) == 0) E.mid(acc, cur, t >> 3, wr, wc, fr, fq); }
            PG8_LDB(B0, 0, 0); PG8_SCHED; PG8_LDA(At, 0, 0); PG8_STAGE(PG8_SA(1, 1), a1 + hstep, voffA);
            PG8_WAIT_L(8); PG8_BAR; PG8_WAIT_L(0); PG8_MMA(0, 0, At, B0); PG8_BAR; PG8_SCHED;
            PG8_LDB(B1, 0, 1); PG8_STAGE(PG8_SB(0, 0), b2, voffB);
            PG8_BAR; PG8_WAIT_L(0); PG8_MMA(0, 1, At, B1); PG8_BAR;
            PG8_LDA(At, 0, 1); PG8_STAGE(PG8_SA(0, 0), a2, voffA);
            PG8_BAR; PG8_WAIT_L(0); PG8_MMA(1, 0, At, B0); PG8_BAR; PG8_SCHED;
            PG8_STAGE(PG8_SB(0, 1), b2 + hstep, voffB);
            PG8_WAIT_V(6); PG8_BAR; PG8_MMA(1, 1, At, B1); PG8_BAR;
            PG8_LDB(B0, 1, 0); PG8_SCHED; PG8_LDA(At, 1, 0); PG8_STAGE(PG8_SA(0, 1), a2 + hstep, voffA);
            PG8_WAIT_L(8); PG8_BAR; PG8_WAIT_L(0); PG8_MMA(0, 0, At, B0); PG8_BAR; PG8_SCHED;
            PG8_LDB(B1, 1, 1); PG8_STAGE(PG8_SB(1, 0), b3, voffB);
            PG8_BAR; PG8_WAIT_L(0); PG8_MMA(0, 1, At, B1); PG8_BAR;
            PG8_LDA(At, 1, 1); PG8_STAGE(PG8_SA(1, 0), a3, voffA);
            PG8_BAR; PG8_WAIT_L(0); PG8_MMA(1, 0, At, B0); PG8_BAR; PG8_SCHED;
            PG8_STAGE(PG8_SB(1, 1), b3 + hstep, voffB);
            PG8_WAIT_V(6); PG8_BAR; PG8_MMA(1, 1, At, B1); PG8_BAR;
        }
        if constexpr (Epi::FP8) asm volatile("s_nop 15\n\ts_nop 15" ::: "memory");
        E(acc, cur, wr, wc, fr, fq); S.done(cur);
#if defined(DUP) && DUP == 7
        if constexpr (!Epi::MIDK && Epi::PERM) { asm volatile("s_waitcnt vmcnt(0)" ::: "memory"); E(acc, cur, wr, wc, fr, fq); E(acc, cur, wr, wc, fr, fq); }
#endif
        if (!has_next) break;
#pragma unroll
        for (int a = 0; a < 2; ++a)
#pragma unroll
            for (int b = 0; b < 2; ++b)
#pragma unroll
                for (int m = 0; m < 4; ++m)
#pragma unroll
                    for (int n = 0; n < 2; ++n) acc[a][b][m][n] = (f32x4){0.f, 0.f, 0.f, 0.f};
        cur = nxt; cA = nA; cB = nB; ++ui;
    }
    PG8_WAIT_V(0);
    if (wr == 0) PG8_BAR;
    PG8_BAR;
#undef PG8_SA
#undef PG8_SB
#undef PG8_STAGE
#undef PG8_LDA
#undef PG8_LDB
#undef PG8_MMA
#undef PG8_WAIT_V
#undef PG8_WAIT_L
#undef PG8_BAR
#undef PG8_SCHED
}
}

struct Args { const float* in[13]; float* out; unsigned char* ws; int ph_lo, ph_hi; };
struct Frame {
    const GA float* x; const GA float* norm_w; const GA float* w_in; const GA float* fox_b; const GA float* lq1; const GA float* lk1; const GA float* lq2; const GA float* lk2;
    const GA float* subln; const GA float* w_branch; const GA float* w_out; const GA float* rel_bias; const GA float* final_w; GA float* out;
    GA unsigned* ctl; GA bf16_t* WinT; GA bf16_t* WbrT; GA bf16_t* WoutT; GA float* xres; GA bf16_t* xb; GA float* ssq; GA bf16_t* Zs; GA bf16_t* G; GA bf16_t* QKV; GA bf16_t* IQ; GA bf16_t* IK;
    GA float* IW; GA float* FF; GA float* cum; GA float* tb; GA float* sc; GA u64* mask; GA bf16_t* Y; GA bf16_t* MG; GA float* O1; GA float* OD; GA float* LSE; GA float* DP; GA unsigned char* ws;
    LAS unsigned char* lds; volatile LAS unsigned* misc;
};

__device__ __forceinline__ int q_next(GA unsigned* ctr, volatile LAS unsigned* lw) {
    __syncthreads();
    if (threadIdx.x == 0) *lw = __hip_atomic_fetch_add(ctr, 1u, __ATOMIC_RELAXED, __HIP_MEMORY_SCOPE_AGENT);
    __syncthreads();
    return (int)*lw;
}

__device__ __forceinline__ int win_src_col(int n) {
    if (n < 2048) return n;
    if (n < 3072) return n - 2048 + 11776;
    if (n < 4608) return n - 3072 + 14420;
    if (n < 4672) return n - 4608 + 12800;
    if (n < 4688) return n - 4672 + 12864;
    if (n < 4692) return n - 4688 + 14416;
    return -1;
}
__device__ __forceinline__ int win8_src_col(int n) {
    if (n < 8192) return n + 2048;
    if (n < 9728) return n - 8192 + 10240;
    if (n < 11264) return n - 9728 + 12880;
    return n - 11264 + 15956;
}
__device__ __forceinline__ void transpose_tile(const GA float* src, int ld, int srccol4, const GA float* ksc, GA bf16_t* dst, int k0, int n0, LAS float* tile) {
    const int tid = tid_l(), tk = tid >> 5, tn4 = (tid & 31) * 4;
    f32x4 v[4];
#pragma unroll
    for (int i = 0; i < 4; ++i) { const int kk = tk + 16 * i; v[i] = (f32x4){0.f, 0.f, 0.f, 0.f};
        if (srccol4 >= 0) { v[i] = *(const GA f32x4*)(src + (size_t)(k0 + kk) * ld + srccol4); if (ksc) v[i] *= ksc[k0 + kk]; } }
#pragma unroll
    for (int i = 0; i < 4; ++i) { const int kk = tk + 16 * i;
#pragma unroll
        for (int j = 0; j < 4; ++j) tile[kk * 129 + tn4 + j] = v[i][j]; }
    __syncthreads();
    const int wn = tid >> 2, wk = tid & 3;
    float f[16];
#pragma unroll
    for (int j = 0; j < 16; ++j) f[j] = tile[(wk * 16 + j) * 129 + wn];
    u32x4 w0 = {cvt_pk_bf16(f[0], f[1]), cvt_pk_bf16(f[2], f[3]), cvt_pk_bf16(f[4], f[5]), cvt_pk_bf16(f[6], f[7])};
    u32x4 w1 = {cvt_pk_bf16(f[8], f[9]), cvt_pk_bf16(f[10], f[11]), cvt_pk_bf16(f[12], f[13]), cvt_pk_bf16(f[14], f[15])};
    GA u32x4* dp = (GA u32x4*)(dst + (size_t)(n0 + wn) * DM + k0 + wk * 16);
    dp[0] = w0; dp[1] = w1;
    __syncthreads();
}
__device__ __forceinline__ unsigned cvt4_fp8(float a, float b, float c, float d) {
    unsigned w = 0u; w = __builtin_amdgcn_cvt_pk_fp8_f32(a, b, w, false); w = __builtin_amdgcn_cvt_pk_fp8_f32(c, d, w, true); return w;
}
__device__ __forceinline__ void transpose_tile8(const GA float* src, int ld, int srccol4, const GA float* ksc, GA unsigned char* dst, int k0, int n0, LAS float* tile) {
    const int tid = tid_l(), tk = tid >> 5, tn4 = (tid & 31) * 4;
    f32x4 v[4];
#pragma unroll
    for (int i = 0; i < 4; ++i) { const int kk = tk + 16 * i; v[i] = *(const GA f32x4*)(src + (size_t)(k0 + kk) * ld + srccol4) * (ksc[k0 + kk] * W8SCALE); }
#pragma unroll
    for (int i = 0; i < 4; ++i) { const int kk = tk + 16 * i;
#pragma unroll
        for (int j = 0; j < 4; ++j) tile[kk * 129 + tn4 + j] = v[i][j]; }
    __syncthreads();
    const int wn = tid >> 2, wk = tid & 3;
    float f[16];
#pragma unroll
    for (int j = 0; j < 16; ++j) f[j] = tile[(wk * 16 + j) * 129 + wn];
    u32x4 w = {cvt4_fp8(f[0], f[1], f[2], f[3]), cvt4_fp8(f[4], f[5], f[6], f[7]), cvt4_fp8(f[8], f[9], f[10], f[11]), cvt4_fp8(f[12], f[13], f[14], f[15])};
    *(GA u32x4*)(dst + (size_t)(n0 + wn) * DM + k0 + wk * 16) = w;
    __syncthreads();
}
__device__ __forceinline__ void transpose_tile8_x2(const GA float* src, int ld, int col4a, int col4b, const GA float* ksc, GA unsigned char* dst, int k0a, int n0a, int k0b, int n0b, LAS float* tile) {
    const int tid = tid_l(), tk = tid >> 5, tn4 = (tid & 31) * 4;
    LAS float* tile_b = tile + 64 * 129;
    f32x4 va[4], vb[4];
#pragma unroll
    for (int i = 0; i < 4; ++i) { const int kk = tk + 16 * i; va[i] = *(const GA f32x4*)(src + (size_t)(k0a + kk) * ld + col4a); vb[i] = *(const GA f32x4*)(src + (size_t)(k0b + kk) * ld + col4b); }
#pragma unroll
    for (int i = 0; i < 4; ++i) { const int kk = tk + 16 * i; va[i] *= (ksc[k0a + kk] * W8SCALE); vb[i] *= (ksc[k0b + kk] * W8SCALE); }
#pragma unroll
    for (int i = 0; i < 4; ++i) { const int kk = tk + 16 * i;
#pragma unroll
        for (int j = 0; j < 4; ++j) { tile[kk * 129 + tn4 + j] = va[i][j]; tile_b[kk * 129 + tn4 + j] = vb[i][j]; } }
    __syncthreads();
    const int wn = tid >> 2, wk = tid & 3;
    { float f[16];
#pragma unroll
      for (int j = 0; j < 16; ++j) f[j] = tile[(wk * 16 + j) * 129 + wn];
      u32x4 w = {cvt4_fp8(f[0], f[1], f[2], f[3]), cvt4_fp8(f[4], f[5], f[6], f[7]), cvt4_fp8(f[8], f[9], f[10], f[11]), cvt4_fp8(f[12], f[13], f[14], f[15])};
      *(GA u32x4*)(dst + (size_t)(n0a + wn) * DM + k0a + wk * 16) = w; }
    { float f[16];
#pragma unroll
      for (int j = 0; j < 16; ++j) f[j] = tile_b[(wk * 16 + j) * 129 + wn];
      u32x4 w = {cvt4_fp8(f[0], f[1], f[2], f[3]), cvt4_fp8(f[4], f[5], f[6], f[7]), cvt4_fp8(f[8], f[9], f[10], f[11]), cvt4_fp8(f[12], f[13], f[14], f[15])};
      *(GA u32x4*)(dst + (size_t)(n0b + wn) * DM + k0b + wk * 16) = w; }
    __syncthreads();
}
__device__ __forceinline__ int t5_bucket(int d) {
    if (d < 16) return d;
    const int th[15] = {22, 30, 40, 54, 73, 99, 134, 182, 246, 332, 450, 609, 825, 1117, 1513};
    int b = 16;
#pragma unroll
    for (int i = 0; i < 15; ++i) b += (d >= th[i]) ? 1 : 0;
    return b;
}
constexpr int WT_TW = 32 * 38, WT_TG = 32 * 100, WT_TB = 32 * 16, WT_TL = WT_TW + WT_TG + 2 * WT_TB;
__device__ __forceinline__ void weight_tile(const Frame& F, int l, int r, LAS float* tile) {
    const int tid = tid_l();
    if (r < WT_TW) { const int nt = r % 38, kt = r / 38; const int n = nt * 128 + (tid & 31) * 4;
        transpose_tile(F.w_in + (size_t)l * DM * NIN, NIN, win_src_col(n), F.norm_w + l * DM, F.WinT + (size_t)l * NINP * DM, kt * 64, nt * 128, tile); }
    else if (r < WT_TW + WT_TG) { const int q = r - WT_TW, nt = q % 100, kt = q / 100;
        transpose_tile8(F.w_in + (size_t)l * DM * NIN, NIN, win8_src_col(nt * 128 + (tid & 31) * 4), F.norm_w + l * DM, F.ws + WS_WG8 + (size_t)l * N8 * DM, kt * 64, nt * 128, tile); }
    else if (r < WT_TW + WT_TG + WT_TB) { const int q = r - WT_TW - WT_TG, nt = q % 16, kt = q / 16;
        transpose_tile(F.w_branch + (size_t)l * DM * DM, DM, nt * 128 + (tid & 31) * 4, (const GA float*)nullptr, F.WbrT + (size_t)l * DM * DM, kt * 64, nt * 128, tile); }
    else { const int q = r - WT_TW - WT_TG - WT_TB, nt = q % 16, kt = q / 16;
        transpose_tile(F.w_out + (size_t)l * DM * DM, DM, nt * 128 + (tid & 31) * 4, (const GA float*)nullptr, F.WoutT + (size_t)l * DM * DM, kt * 64, nt * 128, tile); }
}
__device__ __forceinline__ void p0_prologue(const Frame& F) {
    const int tid = tid_l(), lane = tid & 63, wave = tid >> 6, G = gridDim.x, bid = blockIdx.x;
    LAS float* tile = (LAS float*)F.lds;
    for (int j = bid; j < WT_TW; j += G) weight_tile(F, 0, j, tile);
    for (int q = bid; q < WT_TG; q += 2 * G) {
        if (q + G < WT_TG) { const int nta = q % 100, kta = q / 100, ntb = (q + G) % 100, ktb = (q + G) / 100;
            transpose_tile8_x2(F.w_in, NIN, win8_src_col(nta * 128 + (tid & 31) * 4), win8_src_col(ntb * 128 + (tid & 31) * 4), F.norm_w, F.ws + WS_WG8, kta * 64, nta * 128, ktb * 64, ntb * 128, tile); }
        else weight_tile(F, 0, WT_TW + q, tile); }
    for (int row = bid * 8 + wave; row < MT; row += G * 8) {
        const GA float* xr = F.x + (size_t)row * DM; float ss = 0.f;
#pragma unroll
        for (int i = 0; i < 8; ++i) { const int c = (i * 64 + lane) * 4; const f32x4 v = *(const GA f32x4*)(xr + c);
            ss += v[0] * v[0] + v[1] * v[1] + v[2] * v[2] + v[3] * v[3];
            u32x2 w = {cvt_pk_bf16(v[0], v[1]), cvt_pk_bf16(v[2], v[3])}; *(GA u32x2*)(F.xb + (size_t)row * DM + c) = w;
            *(GA unsigned*)(F.ws + WS_XQ + (size_t)row * DM + c) = cvt4_fp8(v[0], v[1], v[2], v[3]); }
        ss = wave_sum(ss);
        if (lane < 32) F.ssq[(size_t)row * 32 + lane] = (lane == 0) ? ss : 0.f;
    }
    if (bid == 0 && tid < DEPTH * 128) { const int l = tid >> 7, i = tid & 127;
        const float lam_init = 0.8f - 0.6f * expf(-0.3f * (float)l);
        F.DP[l * 256 + 128 + i] = F.subln[l * 128 + i] * (1.0f - lam_init);
        if (i == 0) { float s1 = 0.f, s2 = 0.f;
            for (int k = 0; k < 64; ++k) { s1 = fmaf(F.lq1[l * 64 + k], F.lk1[l * 64 + k], s1); s2 = fmaf(F.lq2[l * 64 + k], F.lk2[l * 64 + k], s2); }
            F.DP[l * 256] = expf(s1) - expf(s2) + lam_init; F.DP[l * 256 + 1] = 1.0f - lam_init; } }
    for (int i = bid * 512 + tid; i < 12 * SEQ; i += G * 512) { const int hd = i / SEQ, d = i % SEQ; F.tb[i] = F.rel_bias[t5_bucket(d) * 12 + hd] * LOG2E; }
}

struct EpiIn {
    static constexpr bool PERM = true, AFTER_DRAIN = false, MIDK = false, FP8 = false;
    GA unsigned char* ws;
    template <int KIND>
    __device__ __forceinline__ void body(const f32x4 (&acc)[2][2][4][2], int row0_, int cl_, int fq, GA bf16_t* base, int ldc, float qscale, int headbase) const {
        int row0 = row0_, cl = cl_; asm volatile("" : "+v"(row0), "+v"(cl));
        const GA float* ssq = (const GA float*)(ws + WS_SSQ);
        float scv_[2][4];
#pragma unroll
        for (int ai = 0; ai < 2; ++ai) {
            f32x4 sq_[4][2];
#pragma unroll
            for (int m = 0; m < 4; ++m) { const GA float* sp = ssq + (size_t)(row0 + ai * 128 + m * 16) * 32 + fq * 8;
                sq_[m][0] = *(const GA f32x4*)sp; sq_[m][1] = *(const GA f32x4*)(sp + 4); }
#pragma unroll
            for (int m = 0; m < 4; ++m) { const f32x4 s4 = sq_[m][0] + sq_[m][1];
                float ssum = (s4[0] + s4[1]) + (s4[2] + s4[3]);
                ssum += __shfl_xor(ssum, 16); ssum += __shfl_xor(ssum, 32);
                scv_[ai][m] = __builtin_amdgcn_rsqf(ssum * (1.0f / DM) + RMS_EPS) * qscale; }
            asm volatile("" :: "v"(scv_[ai][0]), "v"(scv_[ai][1]), "v"(scv_[ai][2]), "v"(scv_[ai][3]));
        }
#pragma unroll
        for (int ai = 0; ai < 2; ++ai)
#pragma unroll
            for (int m = 0; m < 4; ++m) {
                const int r = row0 + ai * 128 + m * 16;
                const float sc = scv_[ai][m];
#pragma unroll
                for (int bj = 0; bj < 2; ++bj) {
                    f32x4 v0 = acc[ai][bj][m][0] * sc, v1 = acc[ai][bj][m][1] * sc;
                    if (KIND == 0) {
#pragma unroll
                        for (int j = 0; j < 4; ++j) { v0[j] = v0[j] * sigmoidf_(v0[j]); v1[j] = v1[j] * sigmoidf_(v1[j]); }
                    } else if (KIND == 1) {
#pragma unroll
                        for (int j = 0; j < 4; ++j) { v0[j] = sigmoidf_(v0[j]) * 256.0f; v1[j] = sigmoidf_(v1[j]) * 256.0f; }
                    }
                    if (KIND == 4) {
                        if (bj == 0) {
                            if (cl < 64) { u32x4 w = {cvt_pk_bf16(v0[0], v0[1]), cvt_pk_bf16(v0[2], v0[3]), cvt_pk_bf16(v1[0], v1[1]), cvt_pk_bf16(v1[2], v1[3])};
                                *(GA u32x4*)((GA bf16_t*)(ws + WS_IK) + (size_t)(r >> 5) * 2048 + (cl >> 4) * 512 + (((cl >> 3) & 1) * 32 + (r & 31)) * 8) = w; }
                            else if (cl < 80) { GA float* iw = (GA float*)(ws + WS_IW) + (size_t)r * 16 + (cl - 64); *(GA f32x4*)iw = v0; *(GA f32x4*)(iw + 4) = v1; }
                            else if (cl == 80) { *(GA f32x4*)((GA float*)(ws + WS_FF) + (size_t)r * 4) = v0; }
                        }
                    } else {
                        if (KIND == 1) {
                            u32x2 w;
                            { const unsigned a = __builtin_amdgcn_cvt_pk_u8_f32(v0[0], 0, 0u), b = __builtin_amdgcn_cvt_pk_u8_f32(v0[1], 1, a), c = __builtin_amdgcn_cvt_pk_u8_f32(v0[2], 2, b); w[0] = __builtin_amdgcn_cvt_pk_u8_f32(v0[3], 3, c); }
                            { const unsigned a = __builtin_amdgcn_cvt_pk_u8_f32(v1[0], 0, 0u), b = __builtin_amdgcn_cvt_pk_u8_f32(v1[1], 1, a), c = __builtin_amdgcn_cvt_pk_u8_f32(v1[2], 2, b); w[1] = __builtin_amdgcn_cvt_pk_u8_f32(v1[3], 3, c); }
                            *(GA u32x2*)((GA unsigned char*)base + (size_t)r * ldc + bj * 128 + cl) = w;
                            continue;
                        }
                        GA bf16_t* dst;
                        if (KIND == 2) { const int b = r >> 13, s = r & (SEQ - 1); dst = base + ((size_t)(b * 4 + headbase + bj) * SEQ + s) * 128 + cl; }
                        else dst = base + (size_t)r * ldc + bj * 128 + cl;
                        u32x4 w = {cvt_pk_bf16(v0[0], v0[1]), cvt_pk_bf16(v0[2], v0[3]), cvt_pk_bf16(v1[0], v1[1]), cvt_pk_bf16(v1[2], v1[3])};
                        *(GA u32x4*)dst = w;
                    }
                }
            }
    }
    __device__ __forceinline__ void operator()(const f32x4 (&acc)[2][2][4][2], const pg8::Unit& u, int wr, int wc, int fr, int fq) const {
        const int row0 = u.pm * 256 + wr * 64 + fr, pn = u.pn, cl = wc * 32 + 8 * fq;
        if (pn < 8) body<0>(acc, row0, cl, fq, (GA bf16_t*)(ws + WS_ZS) + pn * 256, DM, 1.f, 0);
        else if (pn < 12) body<3>(acc, row0, cl, fq, (GA bf16_t*)(ws + WS_IQ) + (pn - 8) * 256, 1024, 1.f, 0);
        else if (pn < 18) { const int t6 = pn - 12, which = t6 >> 1;
            body<2>(acc, row0, cl, fq, (GA bf16_t*)(ws + WS_QKV) + (size_t)(2 * 3 + which) * QS, 0, (which == 0) ? QSC64 : 1.f, (t6 & 1) * 2); }
        else body<4>(acc, row0, cl, fq, (GA bf16_t*)nullptr, 0, 1.f, 0);
    }
};

struct EpiGate {
    static constexpr bool PERM = true, AFTER_DRAIN = false, MIDK = false, FP8 = true;
    GA unsigned char* ws;
    __device__ __forceinline__ void operator()(const f32x4 (&acc)[2][2][4][2], const pg8::Unit& u, int wr, int wc, int fr, int fq) const {
        const int row0 = u.pm * 256 + wr * 64 + fr, cl = wc * 32 + 8 * fq, pn = u.pn;
        EpiIn e{ws};
        if (pn < 32) e.body<1>(acc, row0, cl, fq, (GA bf16_t*)(ws + WS_G + pn * 256), 8192, 1.0f / W8SCALE, 0);
        else { const int q = pn - 32, mixer = (q < 6) ? 0 : (q < 12 ? 1 : 3), t6 = q % 6, which = t6 >> 1;
            e.body<2>(acc, row0, cl, fq, (GA bf16_t*)(ws + WS_QKV) + (size_t)(mixer * 3 + which) * QS, 0, ((which == 0) ? QSC128 : 1.f) * (1.0f / W8SCALE), (t6 & 1) * 2); }
    }
};

__device__ __forceinline__ void fox_scan(const Frame& F, int layer, int seqid) {
    const int tid = tid_l(), lane = tid & 63, wave = tid >> 6, b = seqid >> 2, h = seqid & 3;
    LAS float* sm = (LAS float*)F.lds;
    const float bias = F.fox_b[layer * 4 + h];
    float v[16]; float run = 0.f;
#pragma unroll
    for (int i = 0; i < 16; ++i) { const int s = tid * 16 + i; const float x = F.FF[(size_t)(b * SEQ + s) * 4 + h] + bias;
        const float ls = fminf(x, 0.f) - log1pf(expf(-fabsf(x))); run += ls; v[i] = run; }
    float incl = run;
#pragma unroll
    for (int o = 1; o < 64; o <<= 1) { const float t = __shfl_up(incl, o); if (lane >= o) incl += t; }
    if (lane == 63) sm[wave] = incl;
    __syncthreads();
    float woff = 0.f;
    for (int w = 0; w < wave; ++w) woff += sm[w];
    const float excl = woff + incl - run;
#pragma unroll
    for (int i = 0; i < 16; ++i) F.cum[(size_t)(b * 4 + h) * SEQ + tid * 16 + i] = (excl + v[i]) * LOG2E;
    __syncthreads();
}
__device__ __forceinline__ void fox_kmax(const Frame& F, int layer) {
    const int tid = tid_l(), lane = tid & 63, wave = tid >> 6, G = gridDim.x, bid = blockIdx.x;
    const GA bf16_t* Kf = F.QKV + (size_t)(1 * 3 + 1) * QS;
    LAS float* sm = (LAS float*)F.lds;
    const int bh = bid & 7, part = bid >> 3, nparts = (G + 7 - bh) / 8;
    float mx = 0.f;
    for (int r4 = part * 8 + wave; r4 < SEQ / 4; r4 += nparts * 8) {
        const u32x4 w = *(const GA u32x4*)(Kf + ((size_t)bh * SEQ + r4 * 4 + (lane >> 4)) * 128 + (lane & 15) * 8); float ss = 0.f;
#pragma unroll
        for (int j = 0; j < 4; ++j) { const float a = bf_lo(w[j]), b = bf_hi(w[j]); ss = fmaf(a, a, ss); ss = fmaf(b, b, ss); }
        ss += __shfl_xor(ss, 1); ss += __shfl_xor(ss, 2); ss += __shfl_xor(ss, 4); ss += __shfl_xor(ss, 8);
        mx = fmaxf(mx, ss); }
#pragma unroll
    for (int o = 32; o > 0; o >>= 1) mx = fmaxf(mx, __shfl_xor(mx, o));
    __syncthreads();
    if (lane == 0) sm[wave] = mx;
    __syncthreads();
    if (tid == 0) { float m8 = sm[0];
#pragma unroll
        for (int w = 1; w < 8; ++w) m8 = fmaxf(m8, sm[w]);
        __hip_atomic_fetch_max(F.ctl + CW_KM + layer * 8 + bh, __float_as_uint(m8), __ATOMIC_RELAXED, __HIP_MEMORY_SCOPE_AGENT); }
    __syncthreads();
}
__device__ __forceinline__ void idx_unit(const Frame& F, int unit) {
    const int b = unit / 576; int id = unit % 576; int g = 0;
    while (8 * (g + 1) * (g + 2) <= id) ++g;
    const int rem = id - 8 * g * (g + 1), qb = 16 * g + rem / (g + 1), kc = rem % (g + 1);
    const int tid = tid_l(), lane = tid & 63, wave = __builtin_amdgcn_readfirstlane(tid >> 6), n32 = lane & 31, hi = lane >> 5;
    const int tq0 = qb * 64 + wave * 8;
    const int qa = (n32 >> 2) & 1, ha = (n32 & 3) + 4 * (n32 >> 3);
    bf16x8 Af[4][4]; float wr_[4][16];
#pragma unroll
    for (int p = 0; p < 4; ++p) {
        const GA bf16_t* qp = F.IQ + (size_t)(b * SEQ + tq0 + 2 * p + qa) * 1024 + ha * 64 + hi * 8;
#pragma unroll
        for (int ks = 0; ks < 4; ++ks) Af[p][ks] = *(const GA bf16x8*)(qp + ks * 16);
        const GA float* wp = F.IW + (size_t)(b * SEQ + tq0 + 2 * p + hi) * 16;
#pragma unroll
        for (int q4 = 0; q4 < 4; ++q4) { const f32x4 w4 = *(const GA f32x4*)(wp + 4 * q4); wr_[p][4 * q4] = w4[0]; wr_[p][4 * q4 + 1] = w4[1]; wr_[p][4 * q4 + 2] = w4[2]; wr_[p][4 * q4 + 3] = w4[3]; }
    }
    const int smax = tq0 + 7;
    int nj = (smax - kc * 1024) / 32 + 1; nj = nj > 32 ? 32 : nj;
    const GA bf16_t* kp0 = F.IK + (size_t)(b * SEQ + kc * 1024 + n32) * 64 + hi * 8;
    GA float* sp0 = F.sc + ((size_t)(b * SEQ + tq0 + hi)) * SEQ + kc * 1024 + n32;
    bf16x8 Bn[4];
#pragma unroll
    for (int ks = 0; ks < 4; ++ks) Bn[ks] = *(const GA bf16x8*)(kp0 + ks * 16);
    for (int j = 0; j < nj; ++j) {
        bf16x8 Bf[4];
#pragma unroll
        for (int ks = 0; ks < 4; ++ks) Bf[ks] = Bn[ks];
        if (j + 1 < nj) {
#pragma unroll
            for (int ks = 0; ks < 4; ++ks) Bn[ks] = *(const GA bf16x8*)(kp0 + (size_t)(j + 1) * 32 * 64 + ks * 16);
        }
#pragma unroll
        for (int p = 0; p < 4; ++p) {
            f32x16 c = {};
#pragma unroll
            for (int ks = 0; ks < 4; ++ks) c = __builtin_amdgcn_mfma_f32_32x32x16_bf16(Af[p][ks], Bf[ks], c, 0, 0, 0);
            float sc = 0.f;
#pragma unroll
            for (int r = 0; r < 16; ++r) sc = fmaf(wr_[p][r], fmaxf(c[r], 0.f), sc);
            sp0[(size_t)(2 * p) * SEQ + j * 32] = sc;
        }
    }
}

__device__ __forceinline__ unsigned sel_key(float f) { const unsigned u = __float_as_uint(f == 0.f ? 0.f : f); return (u >> 31) ? ~u : (u | 0x80000000u); }
__device__ __forceinline__ int wave_sum_i(int v) {
#pragma unroll
    for (int o = 32; o > 0; o >>= 1) v += __shfl_xor(v, o);
    return v;
}
__device__ __forceinline__ void select_row(const Frame& F, int row_) {
    const int row = __builtin_amdgcn_readfirstlane(row_);
    const int lane = tid_l() & 63, t = row & (SEQ - 1);
    GA u64* mrow = F.mask + (size_t)row * 128;
    if (t < 256) {
#pragma unroll
        for (int half = 0; half < 2; ++half) { const int j = half * 64 + lane; const int lo = j * 64; u64 w = 0ull;
            if (t >= lo + 63) w = ~0ull; else if (t >= lo) w = (~0ull) >> (63 - (t - lo));
            mrow[j] = w; }
        return;
    }
    const GA float* srow = F.sc + (size_t)row * SEQ + lane;
    const int nj = (t >> 6) + 1;
    unsigned key[128];
#pragma unroll
    for (int jj = 0; jj < 4; ++jj) {
        if (jj * 32 < nj) {
#pragma unroll
            for (int j = jj * 32; j < jj * 32 + 32; ++j) key[j] = __float_as_uint(srow[j * 64]);
        }
    }
#pragma unroll
    for (int jj = 0; jj < 4; ++jj) {
        if (jj * 32 < nj) {
#pragma unroll
            for (int j = jj * 32; j < jj * 32 + 32; ++j) key[j] = (j * 64 + lane <= t) ? sel_key(__uint_as_float(key[j])) : 0u;
        } else {
#pragma unroll
            for (int j = jj * 32; j < jj * 32 + 32; ++j) key[j] = 0u;
        }
    }
#define CNT8(j0) do { u64 b0 = __ballot(key[(j0)] >= cand), b1 = __ballot(key[(j0) + 1] >= cand), b2 = __ballot(key[(j0) + 2] >= cand), b3 = __ballot(key[(j0) + 3] >= cand), \
        b4 = __ballot(key[(j0) + 4] >= cand), b5 = __ballot(key[(j0) + 5] >= cand), b6 = __ballot(key[(j0) + 6] >= cand), b7 = __ballot(key[(j0) + 7] >= cand); \
        asm volatile("" : "+s"(b0), "+s"(b1), "+s"(b2), "+s"(b3), "+s"(b4), "+s"(b5), "+s"(b6), "+s"(b7)); \
        c += (__popcll(b0) + __popcll(b1)) + (__popcll(b2) + __popcll(b3)) + (__popcll(b4) + __popcll(b5)) + (__popcll(b6) + __popcll(b7)); } while (0)
#define COUNT_GE() do { c = 0; _Pragma("unroll") for (int jj = 0; jj < 4; ++jj) { if (jj * 32 < nj) { CNT8(jj * 32); CNT8(jj * 32 + 8); CNT8(jj * 32 + 16); CNT8(jj * 32 + 24); } } } while (0)
    unsigned mx = 0u;
#pragma unroll
    for (int j = 0; j < 128; ++j) mx = key[j] > mx ? key[j] : mx;
#pragma unroll
    for (int o = 32; o > 0; o >>= 1) { const unsigned t2 = (unsigned)__shfl_xor((int)mx, o); mx = t2 > mx ? t2 : mx; }
    unsigned prefix = 0u; int cge = 1 << 30, c, bit = 31;
    { const unsigned e9 = mx >> 23;
      for (unsigned k = 0; k < 6u && k <= e9; ++k) { const unsigned cand = (e9 - k) << 23; COUNT_GE();
          if (c >= 256) { prefix = cand; cge = c; bit = 22; break; } } }
    if (cge != 256) {
        for (; bit >= 0; --bit) {
            const unsigned cand = prefix | (1u << bit); COUNT_GE();
            if (c >= 256) { prefix = cand; cge = c; if (c == 256) break; }
        }
    }
#undef CNT8
#undef COUNT_GE
    if (cge == 256) {
        unsigned w0l = 0u, w0h = 0u, w1l = 0u, w1h = 0u;
#pragma unroll
        for (int j = 0; j < 64; ++j) { const u64 word = __ballot(key[j] >= prefix);
            asm volatile("s_nop 1\n\tv_writelane_b32 %0, %1, %2" : "+v"(w0l) : "s"((unsigned)word), "n"(j)); asm volatile("v_writelane_b32 %0, %1, %2" : "+v"(w0h) : "s"((unsigned)(word >> 32)), "n"(j)); }
        if (nj > 64) {
#pragma unroll
            for (int j = 64; j < 128; ++j) { const u64 word = __ballot(key[j] >= prefix);
                asm volatile("s_nop 1\n\tv_writelane_b32 %0, %1, %2" : "+v"(w1l) : "s"((unsigned)word), "n"(j - 64)); asm volatile("v_writelane_b32 %0, %1, %2" : "+v"(w1h) : "s"((unsigned)(word >> 32)), "n"(j - 64)); }
        }
        mrow[lane] = ((u64)w0h << 32) | w0l; mrow[64 + lane] = ((u64)w1h << 32) | w1l;
    } else {
        int cgt = 0;
        for (int j = 0; j < nj; ++j) { const int s = j * 64 + lane; const float v_ = srow[j * 64]; const unsigned k = (s <= t) ? sel_key(v_) : 0u; cgt += __popcll(__ballot(k > prefix)); }
        int need = 256 - cgt;
        for (int j = 0; j < nj; ++j) { const int s = j * 64 + lane; const float v_ = srow[j * 64]; const unsigned k = (s <= t) ? sel_key(v_) : 0u;
            u64 word = __ballot(k > prefix); u64 tm = __ballot(k == prefix);
            if (tm != 0ull && need > 0) { const int c = __popcll(tm);
                if (c <= need) { word |= tm; need -= c; }
                else { u64 selb = 0ull; for (int i = 0; i < need; ++i) { const u64 low = tm & (~tm + 1ull); selb |= low; tm ^= low; } word |= selb; need = 0; } }
            if (lane == 0) mrow[j] = word; }
        for (int j = nj + lane; j < 128; j += 64) mrow[j] = 0ull;
    }
}

#if defined(TPROBE)
#define IS_T0(k) do { if ((k) == TPROBE) is_t0 = __builtin_amdgcn_s_memrealtime(); } while (0)
#define IS_T1(k) do { if ((k) == TPROBE) tpacc += __builtin_amdgcn_s_memrealtime() - is_t0; } while (0)
#else
#define IS_T0(k) do { } while (0)
#define IS_T1(k) do { } while (0)
#endif
__device__ __forceinline__ void idxsel_unit(const Frame& F, int unit, unsigned long long& tpacc) {
    unsigned long long is_t0 = 0ull; (void)is_t0;
    const int b = unit & 1, t0 = (SEQ / 8 - 1 - (unit >> 1)) * 8;
    const int tid = tid_l(), lane = tid & 63, wave = __builtin_amdgcn_readfirstlane(tid >> 6), n32 = lane & 31, hi = lane >> 5;
    LAS unsigned short* S = (LAS unsigned short*)F.lds;
    IS_T0(30);
    {
        const int qa = (n32 >> 2) & 1, ha = (n32 & 3) + 4 * (n32 >> 3);
        typedef float f32x2_ __attribute__((ext_vector_type(2)));
        bf16x8 Af[4][4]; f32x2_ wr2[4][8];
#pragma unroll
        for (int p = 0; p < 4; ++p) {
            const GA bf16_t* qp = F.IQ + (size_t)(b * SEQ + t0 + 2 * p + qa) * 1024 + ha * 64 + hi * 8;
#pragma unroll
            for (int ks = 0; ks < 4; ++ks) Af[p][ks] = *(const GA bf16x8*)(qp + ks * 16);
            const GA float* wp = F.IW + (size_t)(b * SEQ + t0 + 2 * p + hi) * 16;
#pragma unroll
            for (int q4 = 0; q4 < 4; ++q4) { const f32x4 w4 = *(const GA f32x4*)(wp + 4 * q4); wr2[p][2 * q4] = (f32x2_){w4[0], w4[1]}; wr2[p][2 * q4 + 1] = (f32x2_){w4[2], w4[3]}; }
        }
        asm volatile("s_waitcnt vmcnt(0)" ::: "memory"); IS_T1(30); IS_T0(31);
        const int ntile = (t0 + 7) / 32 + 1;
        const GA bf16_t* kp0 = F.IK + (size_t)b * SEQ * 64 + lane * 8;
        bf16x8 Bn[4];
        if (wave < ntile) {
#pragma unroll
            for (int ks = 0; ks < 4; ++ks) Bn[ks] = *(const GA bf16x8*)(kp0 + (size_t)wave * 2048 + ks * 512);
        }
        for (int j = wave; j < ntile; j += 8) {
            bf16x8 Bf[4];
#pragma unroll
            for (int ks = 0; ks < 4; ++ks) Bf[ks] = Bn[ks];
            if (j + 8 < ntile) {
#pragma unroll
                for (int ks = 0; ks < 4; ++ks) Bn[ks] = *(const GA bf16x8*)(kp0 + (size_t)(j + 8) * 2048 + ks * 512);
            }
            const int s = j * 32 + n32;
            LAS unsigned short* sp = S + ((s >> 7) * 64 + (s & 63)) * 2 + ((s >> 6) & 1);
#define IDX_MM(C, p) do { C = f32x16{}; _Pragma("unroll") for (int ks = 0; ks < 4; ++ks) C = __builtin_amdgcn_mfma_f32_32x32x16_bf16(Af[p][ks], Bf[ks], C, 0, 0, 0); } while (0)
#define IDX_RED(C, p) do { f32x2_ s2 = {0.f, 0.f}; _Pragma("unroll") for (int r2 = 0; r2 < 8; ++r2) { \
                    const float f0 = C[2 * r2], f1 = C[2 * r2 + 1]; const int i0 = __float_as_int(f0), i1 = __float_as_int(f1); \
                    const f32x2_ x2 = {__int_as_float(i0 > 0 ? i0 : 0), __int_as_float(i1 > 0 ? i1 : 0)}; s2 = __builtin_elementwise_fma(wr2[p][r2], x2, s2); } \
                float sc = s2[0] + s2[1]; sc = fminf(fmaxf(sc, -65504.f), 65504.f);       \
                sp[(2 * (p) + hi) * 8192] = __builtin_bit_cast(unsigned short, (_Float16)sc); } while (0)
            f32x16 c0, c1;
            IDX_MM(c0, 0); IDX_MM(c1, 1); __builtin_amdgcn_sched_barrier(0);
            IDX_RED(c0, 0); __builtin_amdgcn_sched_barrier(0); IDX_MM(c0, 2); __builtin_amdgcn_sched_barrier(0);
            IDX_RED(c1, 1); __builtin_amdgcn_sched_barrier(0); IDX_MM(c1, 3); __builtin_amdgcn_sched_barrier(0);
            IDX_RED(c0, 2); IDX_RED(c1, 3);
#undef IDX_MM
#undef IDX_RED
        }
    }
    IS_T1(31); IS_T0(32);
    __syncthreads();
    IS_T1(32);
    {
        const int t = t0 + wave;
        GA u64* mrow = F.mask + (size_t)(b * SEQ + t) * 128;
        if (t < 256) {
#pragma unroll
            for (int half = 0; half < 2; ++half) { const int jw = half * 64 + lane; const int lo = jw * 64; u64 w = 0ull;
                if (t >= lo + 63) w = ~0ull; else if (t >= lo) w = (~0ull) >> (63 - (t - lo));
                mrow[jw] = w; }
        } else {
            const LAS unsigned* row = (const LAS unsigned*)(S + wave * 8192) + lane;
            const int nj = (t >> 7) + 1;
            unsigned kw[64];
            IS_T0(33);
#pragma unroll
            for (int jj = 0; jj < 4; ++jj) {
                if (jj * 16 < nj) {
#pragma unroll
                    for (int j = jj * 16; j < jj * 16 + 16; ++j) { unsigned w = row[j * 64];
                        w = ((w & 0x7fffu) == 0u ? (w & 0xffff0000u) : w); w = ((w & 0x7fff0000u) == 0u ? (w & 0x0000ffffu) : w);
                        const unsigned sg = ((w >> 15) & 0x00010001u) * 0xffffu;
                        w ^= (sg | 0x80008000u);
                        if (128 * j + lane > t) w &= 0xffff0000u;
                        if (128 * j + 64 + lane > t) w &= 0x0000ffffu;
                        kw[j] = w; }
                } else {
#pragma unroll
                    for (int j = jj * 16; j < jj * 16 + 16; ++j) kw[j] = 0u;
                }
            }
#define CNT1(j) asm volatile("v_pk_sub_u16 %1, %2, %3 clamp\n\tv_pk_min_u16 %1, %1, %4\n\tv_pk_add_u16 %0, %0, %1" : "+v"(acc2), "=&v"(tmp2) : "v"(kw[(j)]), "v"(cm2), "v"(one2))
#define COUNT_GE16(cand) do { const unsigned cm2 = (((cand) - 1u) & 0xffffu) * 0x00010001u, one2 = 0x00010001u; unsigned acc2 = 0u, tmp2; \
            _Pragma("unroll") for (int jj = 0; jj < 4; ++jj) { if (jj * 16 < nj) { _Pragma("unroll") for (int j = jj * 16; j < jj * 16 + 16; ++j) CNT1(j); } } \
            int v_ = (int)((acc2 & 0xffffu) + (acc2 >> 16));                                                                                            \
            v_ += __builtin_amdgcn_update_dpp(0, v_, 0x111, 0xf, 0xf, true); v_ += __builtin_amdgcn_update_dpp(0, v_, 0x112, 0xf, 0xf, true);            \
            v_ += __builtin_amdgcn_update_dpp(0, v_, 0x114, 0xf, 0xf, true); v_ += __builtin_amdgcn_update_dpp(0, v_, 0x118, 0xf, 0xf, true);            \
            v_ += __builtin_amdgcn_update_dpp(0, v_, 0x142, 0xa, 0xf, true); v_ += __builtin_amdgcn_update_dpp(0, v_, 0x143, 0xc, 0xf, true);            \
            c = __builtin_amdgcn_readlane(v_, 63); } while (0)
            IS_T1(33); IS_T0(34);
            unsigned prefix = 0u; int cge = 1 << 30, c, bit = 15;
            { unsigned mx = 0u;
#pragma unroll
              for (int j = 0; j < 64; ++j) { const unsigned a = kw[j] & 0xffffu, b2 = kw[j] >> 16; mx = a > mx ? a : mx; mx = b2 > mx ? b2 : mx; }
#pragma unroll
              for (int o = 32; o > 0; o >>= 1) { const unsigned t2 = (unsigned)__shfl_xor((int)mx, o); mx = t2 > mx ? t2 : mx; }
              const unsigned e6 = (unsigned)__builtin_amdgcn_readfirstlane((int)mx) >> 10;
              for (unsigned k = 0; k < 5u && k <= e6; ++k) { const unsigned cand = (e6 - k) << 10; COUNT_GE16(cand);
                  if (c >= 256) { prefix = cand; cge = c; bit = 9; break; } } }
            if (cge != 256) {
                for (; bit >= 0; --bit) {
                    const unsigned cand = prefix | (1u << bit); COUNT_GE16(cand);
                    if (c >= 256) { prefix = cand; cge = c; if (c == 256) break; }
                }
            }
#undef CNT1
#undef COUNT_GE16
            IS_T1(34); IS_T0(35);
            unsigned w0l = 0u, w0h = 0u, w1l = 0u, w1h = 0u;
            const unsigned short pl16 = (unsigned short)prefix; const unsigned ph16 = prefix << 16;
            if (cge == 256) {
#pragma unroll
                for (int j = 0; j < 32; ++j) { const u64 wa = __ballot((unsigned short)kw[j] >= pl16), wb = __ballot(kw[j] >= ph16);
                    asm volatile("s_nop 1\n\tv_writelane_b32 %0, %1, %2" : "+v"(w0l) : "s"((unsigned)wa), "n"(2 * j)); asm volatile("v_writelane_b32 %0, %1, %2" : "+v"(w0h) : "s"((unsigned)(wa >> 32)), "n"(2 * j));
                    asm volatile("s_nop 1\n\tv_writelane_b32 %0, %1, %2" : "+v"(w0l) : "s"((unsigned)wb), "n"(2 * j + 1)); asm volatile("v_writelane_b32 %0, %1, %2" : "+v"(w0h) : "s"((unsigned)(wb >> 32)), "n"(2 * j + 1)); }
                if (nj > 32) {
#pragma unroll
                    for (int j = 32; j < 64; ++j) { const u64 wa = __ballot((unsigned short)kw[j] >= pl16), wb = __ballot(kw[j] >= ph16);
                        asm volatile("s_nop 1\n\tv_writelane_b32 %0, %1, %2" : "+v"(w1l) : "s"((unsigned)wa), "n"(2 * j - 64)); asm volatile("v_writelane_b32 %0, %1, %2" : "+v"(w1h) : "s"((unsigned)(wa >> 32)), "n"(2 * j - 64));
                        asm volatile("s_nop 1\n\tv_writelane_b32 %0, %1, %2" : "+v"(w1l) : "s"((unsigned)wb), "n"(2 * j - 63)); asm volatile("v_writelane_b32 %0, %1, %2" : "+v"(w1h) : "s"((unsigned)(wb >> 32)), "n"(2 * j - 63)); }
                }
            } else {
                int cgt = 0;
#pragma unroll
                for (int j = 0; j < 64; ++j) cgt += __popcll(__ballot((unsigned short)kw[j] > pl16)) + __popcll(__ballot((kw[j] >> 16) > prefix));
                int need = 256 - cgt;
#define TIE_WORD(GT, EQ, SETL, SETH, LN) do { u64 word = (GT); u64 tm = (EQ);                                                          \
                    if (tm != 0ull && need > 0) { const int ce = __popcll(tm);                                                       \
                        if (ce <= need) { word |= tm; need -= ce; }                                                                  \
                        else { u64 selb = 0ull; for (int i = 0; i < need; ++i) { const u64 low = tm & (~tm + 1ull); selb |= low; tm ^= low; } word |= selb; need = 0; } } \
                    asm volatile("s_nop 1\n\tv_writelane_b32 %0, %1, %2" : "+v"(SETL) : "s"((unsigned)word), "n"(LN)); asm volatile("v_writelane_b32 %0, %1, %2" : "+v"(SETH) : "s"((unsigned)(word >> 32)), "n"(LN)); } while (0)
#pragma unroll
                for (int j = 0; j < 32; ++j) {
                    TIE_WORD(__ballot((unsigned short)kw[j] > pl16), __ballot((unsigned short)kw[j] == pl16), w0l, w0h, 2 * j);
                    TIE_WORD(__ballot((kw[j] >> 16) > prefix), __ballot((kw[j] >> 16) == prefix), w0l, w0h, 2 * j + 1); }
#pragma unroll
                for (int j = 32; j < 64; ++j) {
                    TIE_WORD(__ballot((unsigned short)kw[j] > pl16), __ballot((unsigned short)kw[j] == pl16), w1l, w1h, 2 * j - 64);
                    TIE_WORD(__ballot((kw[j] >> 16) > prefix), __ballot((kw[j] >> 16) == prefix), w1l, w1h, 2 * j - 63); }
#undef TIE_WORD
            }
            mrow[lane] = ((u64)w0h << 32) | w0l; mrow[64 + lane] = ((u64)w1h << 32) | w1l;
            IS_T1(35);
        }
    }
}

namespace att {
typedef short s16x4 __attribute__((ext_vector_type(4)));
constexpr int D = 128, NW = 8, QBLK = 32, KVBLK = 64, QB = NW * QBLK;
constexpr int SHM_V = KVBLK * D * 2, SHM_K = KVBLK * D * 2;
constexpr int L_WS = 2 * SHM_V + 2 * SHM_K;
constexpr int L_AUX = L_WS + NW * 64 * 4;
constexpr int TB_PAD = 320, TB_N = TB_PAD + 1984;
constexpr int L_FLG = L_AUX + 8192 * 4;
constexpr int L_END = L_FLG + 64;
constexpr float SKIP_MARGIN = 40.f;
constexpr float THR2 = 11.5f;
constexpr int FAR_DIST = 1513;

#define KSWZ(row, colB) ((row) * 256 + ((colB) ^ (((row) & 7) << 4)))
#define SBAR() __builtin_amdgcn_sched_barrier(0)
__device__ __forceinline__ int v_st(int k, int c) { const int kk = (k & ~0xC) | ((k & 4) << 1) | ((k & 8) >> 1); return ((kk >> 3) * 4 + (c >> 5)) * 512 + ((kk & 7) * 32 + (c & 31)) * 2; }
__device__ __forceinline__ int v_rd_base(int lane) { return ((lane & 3) << 3) | (((lane >> 2) & 3) << 6) | (((lane >> 4) & 1) << 5) | (((lane >> 5) & 1) << 8); }
constexpr int v_rd_off(int d0, int ks, int half) { return d0 * 512 + ks * 4096 + half * 2048; }
__device__ __forceinline__ int crow(int r, int hi) { return (r & 3) + 8 * (r >> 2) + 4 * hi; }
__device__ __forceinline__ bf16x8 load8(const GA bf16_t* p) { return *(const GA bf16x8*)p; }

__device__ __forceinline__ void mask_tile(f32x16& p0, f32x16& p1, int dq, unsigned W) {
    const float NEG = -__builtin_inff();
#pragma unroll
    for (int r = 0; r < 16; ++r) {
        const int c = (r & 3) + 8 * (r >> 2);
        if ((unsigned)(dq - c) >= W) p0[r] = NEG;
        if ((unsigned)(dq - c - 32) >= W) p1[r] = NEG;
    }
}
__device__ __forceinline__ void mask_bits(f32x16& p0, f32x16& p1, u64 w, int hi) {
    const float NEG = -__builtin_inff();
    unsigned w0 = (unsigned)w, w1 = (unsigned)(w >> 32);
    if (hi == 0) { w0 <<= 4; w1 <<= 4; }
#define MB4(W, P, g) do { u64 c0_, c1_, c2_, c3_; asm volatile(                          \
        "v_add_co_u32 %[w], %[c0], %[w], %[w]\n\tv_add_co_u32 %[w], %[c1], %[w], %[w]\n\t"                     \
        "v_add_co_u32 %[w], %[c2], %[w], %[w]\n\tv_add_co_u32 %[w], %[c3], %[w], %[w]\n\t"                     \
        "v_cndmask_b32 %[e3], %[neg], %[e3], %[c0]\n\tv_cndmask_b32 %[e2], %[neg], %[e2], %[c1]\n\t"           \
        "v_cndmask_b32 %[e1], %[neg], %[e1], %[c2]\n\tv_cndmask_b32 %[e0], %[neg], %[e0], %[c3]"               \
        : [w] "+v"(W), [e0] "+v"(P[4 * (g)]), [e1] "+v"(P[4 * (g) + 1]), [e2] "+v"(P[4 * (g) + 2]), [e3] "+v"(P[4 * (g) + 3]),         \
          [c0] "=&s"(c0_), [c1] "=&s"(c1_), [c2] "=&s"(c2_), [c3] "=&s"(c3_) : [neg] "v"(NEG)); } while (0)
    MB4(w0, p0, 3); MB4(w1, p1, 3); w0 <<= 4; w1 <<= 4;
    MB4(w0, p0, 2); MB4(w1, p1, 2); w0 <<= 4; w1 <<= 4;
    MB4(w0, p0, 1); MB4(w1, p1, 1); w0 <<= 4; w1 <<= 4;
    MB4(w0, p0, 0); MB4(w1, p1, 0);
#undef MB4
}
__device__ __forceinline__ void partialSM(f32x16& p0, f32x16& p1, float& m_reg, float& mn, float& alpha, float cb) {
    float pmax = p0[0];
#pragma unroll
    for (int r = 1; r < 16; ++r) pmax = fmaxf(pmax, p0[r]);
#pragma unroll
    for (int r = 0; r < 16; ++r) pmax = fmaxf(pmax, p1[r]);
    { auto rr = __builtin_amdgcn_permlane32_swap(__float_as_uint(pmax), __float_as_uint(pmax), false, false);
      pmax = fmaxf(__uint_as_float(rr[0]), __uint_as_float(rr[1])); }
    pmax += cb;
    if (__builtin_expect(__all((pmax - m_reg) <= THR2), 1)) { mn = m_reg; alpha = 1.f; }
    else { mn = fmaxf(m_reg, pmax); alpha = __builtin_amdgcn_exp2f(m_reg - mn); m_reg = mn; }
    const float sh = mn - cb;
#pragma unroll
    for (int r = 0; r < 16; ++r) p0[r] = p0[r] - sh;
#pragma unroll
    for (int r = 0; r < 16; ++r) p1[r] = p1[r] - sh;
#pragma unroll
    for (int r = 0; r < 16; ++r) p0[r] = __builtin_amdgcn_exp2f(p0[r]);
}
__device__ __forceinline__ void finishSM(f32x16& p0, f32x16& p1, float alpha, float& l_reg, bf16x8& pa0, bf16x8& pa1, bf16x8& pa2, bf16x8& pa3) {
#pragma unroll
    for (int r = 0; r < 16; ++r) p1[r] = __builtin_amdgcn_exp2f(p1[r]);
    float ps = 0;
#pragma unroll
    for (int r = 0; r < 16; ++r) ps += p0[r];
#pragma unroll
    for (int r = 0; r < 16; ++r) ps += p1[r];
    { auto rr = __builtin_amdgcn_permlane32_swap(__float_as_uint(ps), __float_as_uint(ps), false, false);
      ps = __uint_as_float(rr[0]) + __uint_as_float(rr[1]); }
    l_reg = l_reg * alpha + ps;
#define PK4(P, B_, OUT) do { unsigned a0 = cvt_pk_bf16(P[B_+0], P[B_+1]), a1 = cvt_pk_bf16(P[B_+2], P[B_+3]);                          \
        unsigned b0 = cvt_pk_bf16(P[B_+4], P[B_+5]), b1 = cvt_pk_bf16(P[B_+6], P[B_+7]);                                             \
        auto r0 = __builtin_amdgcn_permlane32_swap(a0, b0, false, false); auto r1 = __builtin_amdgcn_permlane32_swap(a1, b1, false, false); \
        u32x4 w = {r0[0], r1[0], r0[1], r1[1]}; OUT = *reinterpret_cast<bf16x8*>(&w); } while (0)
    PK4(p0, 0, pa0); PK4(p0, 8, pa1); PK4(p1, 0, pa2); PK4(p1, 8, pa3);
#undef PK4
}
template <int KB, int NQ>
__device__ __forceinline__ void qkt(f32x16& p0, f32x16& p1, const LAS char* K_lds, int r32, int hi, const bf16x8* qr, int koff) {
    p0 = f32x16{}; p1 = f32x16{};
    const LAS char* kb[4];
#pragma unroll
    for (int dd = 0; dd < 4; ++dd) kb[dd] = K_lds + KB * SHM_K + KSWZ(r32, (dd * 16 + hi * 8) * 2) + koff;
#pragma unroll
    for (int d0 = 0; d0 < NQ; ++d0) { const LAS char* a = kb[d0 & 3] + (d0 >> 2) * 128;
        bf16x8 b0 = *(const LAS bf16x8*)a;
        bf16x8 b1 = *(const LAS bf16x8*)(a + 32 * 256);
        p0 = __builtin_amdgcn_mfma_f32_32x32x16_bf16(b0, qr[d0], p0, 0, 0, 0);
        p1 = __builtin_amdgcn_mfma_f32_32x32x16_bf16(b1, qr[d0], p1, 0, 0, 0); }
}
template <int VB>
__device__ __forceinline__ void pv_tile(f32x16* o, int vb0, bf16x8 pa0, bf16x8 pa1, bf16x8 pa2, bf16x8 pa3) {
#define TRRD(dst, off) asm volatile("ds_read_b64_tr_b16 %0, %1 offset:%2" : "=&v"(dst) : "v"(vb0), "i"(off) : "memory")
#define PV_D0(d0) do { s16x4 l0, l1, l2, l3, h0, h1, h2, h3; constexpr int b_ = VB * SHM_V + v_rd_off(d0, 0, 0); \
        TRRD(l0, b_); TRRD(h0, b_ + 2048); TRRD(l1, b_ + 4096); TRRD(h1, b_ + 6144); TRRD(l2, b_ + 8192); TRRD(h2, b_ + 10240); TRRD(l3, b_ + 12288); TRRD(h3, b_ + 14336); \
        asm volatile("s_waitcnt lgkmcnt(0)" ::: "memory"); SBAR();   \
        o[d0] = __builtin_amdgcn_mfma_f32_32x32x16_bf16(pa0, (bf16x8){l0[0], l0[1], l0[2], l0[3], h0[0], h0[1], h0[2], h0[3]}, o[d0], 0, 0, 0);   \
        o[d0] = __builtin_amdgcn_mfma_f32_32x32x16_bf16(pa1, (bf16x8){l1[0], l1[1], l1[2], l1[3], h1[0], h1[1], h1[2], h1[3]}, o[d0], 0, 0, 0);   \
        o[d0] = __builtin_amdgcn_mfma_f32_32x32x16_bf16(pa2, (bf16x8){l2[0], l2[1], l2[2], l2[3], h2[0], h2[1], h2[2], h2[3]}, o[d0], 0, 0, 0);   \
        o[d0] = __builtin_amdgcn_mfma_f32_32x32x16_bf16(pa3, (bf16x8){l3[0], l3[1], l3[2], l3[3], h3[0], h3[1], h3[2], h3[3]}, o[d0], 0, 0, 0); } while (0)
    PV_D0(0); PV_D0(1); PV_D0(2); PV_D0(3);
#undef PV_D0
#undef TRRD
}
__device__ __forceinline__ void bias_dist(f32x16& p0, f32x16& p1, const LAS char* tbase) {
#pragma unroll
    for (int r = 0; r < 16; ++r) { const int c = (r & 3) + 8 * (r >> 2);
        p0[r] += *(const LAS float*)(tbase + (59 - c) * 4);
        p1[r] += *(const LAS float*)(tbase + (27 - c) * 4); }
}
__device__ __forceinline__ void bias_const(f32x16& p0, f32x16& p1, float c) {
#pragma unroll
    for (int r = 0; r < 16; ++r) { p0[r] += c; p1[r] += c; }
}
__device__ __forceinline__ void bias_key(f32x16& p0, f32x16& p1, const LAS char* kbase) {
#pragma unroll
    for (int g = 0; g < 4; ++g) { const f32x4 a = *(const LAS f32x4*)(kbase + (8 * g) * 4), b = *(const LAS f32x4*)(kbase + (32 + 8 * g) * 4);
#pragma unroll
        for (int q = 0; q < 4; ++q) { p0[4 * g + q] -= a[q]; p1[4 * g + q] -= b[q]; } }
}

struct Blk { const GA bf16_t* Q; const GA bf16_t* K; const GA bf16_t* V; int P0; int rs; };
struct Aux { const GA float* tb; int dscale; const GA float* cum; const GA u64* mrow0; float kmax; };

__device__ __forceinline__ int swa_jlo(int P0, int W) { const int lowk = P0 - W + 1; return lowk > 0 ? lowk / KVBLK : 0; }

template <int MODE, int NQ>
__device__ __forceinline__ void attn_block(const Blk& cur, int skv, int W, int koff, const Aux& ax, LAS char* lds, f32x16 (&o)[4], float& m_out, float& l_out) {
    const int tid = tid_l(), wid = __builtin_amdgcn_readfirstlane(tid >> 6), lane = tid & 63, r32 = lane & 31, hi = lane >> 5;
    const int rs = cur.rs;
    const int j_lo = swa_jlo(cur.P0, W);
    int j_hi = (cur.P0 + QB - 1) / KVBLK + 1; if (j_hi > skv / KVBLK) j_hi = skv / KVBLK;
    int NT = j_hi - j_lo;
    const int qlo = cur.P0 + wid * QBLK, qm = qlo + r32 - 4 * hi;
    LAS char* V_lds = lds; LAS char* K_lds = lds + 2 * SHM_V;
    LAS float* ws = (LAS float*)(lds + L_WS) + wid * 64; LAS float* li_l = ws; LAS float* al_l = ws + 32;
    LAS float* auxl = (LAS float*)(lds + L_AUX);
    float m_reg = -1e30f, l_reg = 0;
#pragma unroll
    for (int d_ = 0; d_ < 4; ++d_) o[d_] = f32x16{};
    const int sr = tid >> 4, sc = (tid & 15) * 8, vst0 = v_st(sr, sc), vst1 = v_st(32 + sr, sc), kws = KSWZ(sr, sc * 2);
    const int vb0 = (int)(unsigned)(uintptr_t)V_lds + v_rd_base(lane);
    const GA bf16_t* Kh = cur.K; const GA bf16_t* Vh = cur.V;
    bf16x8 qr[NQ]; bf16x8 st_v0, st_v1, st_k0, st_k1;
#define ROW(p, k0, rr) ((p) + (size_t)((k0) + (rr)) * rs + sc)
#define VMW() asm volatile("s_waitcnt vmcnt(0)" ::: "memory")
#define SLOAD_H(Kp, Vp, k0) do { st_v0 = load8(ROW(Vp, k0, sr)); st_v1 = load8(ROW(Vp, k0, 32 + sr));              \
                                 st_k0 = load8(ROW(Kp, k0, sr)); st_k1 = load8(ROW(Kp, k0, 32 + sr)); } while (0)
#define SWRITE_HK(bf) do { *(LAS bf16x8*)(K_lds + (bf) * SHM_K + kws) = st_k0; *(LAS bf16x8*)(K_lds + (bf) * SHM_K + kws + 32 * 256) = st_k1; } while (0)
#define SWRITE_HV(bf) do { *(LAS bf16x8*)(V_lds + (bf) * SHM_V + vst0) = st_v0; *(LAS bf16x8*)(V_lds + (bf) * SHM_V + vst1) = st_v1; } while (0)
#define SWRITE_H(bf) do { SWRITE_HV(bf); SWRITE_HK(bf); } while (0)
#define RESC(a) do { if (__any((a) < 1.f)) { if (hi == 0) al_l[r32] = (a); asm volatile("s_waitcnt lgkmcnt(0)" ::: "memory");              \
                     for (int d_ = 0; d_ < 4; ++d_) for (int r = 0; r < 16; ++r) o[d_][r] *= al_l[crow(r, hi)]; } } while (0)
#define KBASE(t) ((MODE == 1 ? (j_hi - 1 - (t)) : (j_lo + (t))) * KVBLK)
    LAS unsigned* flg = (LAS unsigned*)(lds + L_FLG);
    {
        const int kb0 = KBASE(0);
        if (MODE == 1 && tid < 8) flg[tid] = 0u;
#pragma unroll
        for (int d0 = 0; d0 < NQ; ++d0) qr[d0] = load8(cur.Q + (size_t)(wid * QBLK + r32) * rs + d0 * 16 + hi * 8);
        SLOAD_H(Kh, Vh, kb0);
        if (MODE == 1) { for (int i = tid; i < cur.P0 + QB; i += 512) auxl[i] = ax.cum[i]; }
        else { for (int i = tid; i < TB_N; i += 512) { int d = i - TB_PAD; d = d < 0 ? 0 : d; auxl[i] = ax.tb[d * ax.dscale]; } }
        VMW(); SWRITE_HK(0); SWRITE_HV(0);
        __syncthreads();
    }
    const float cfar = (MODE == 0 || MODE == 2) ? ax.tb[FAR_DIST] : 0.f;
    float qbound = 0.f;
    if (MODE == 1) { float ss = 0.f;
#pragma unroll
        for (int d0 = 0; d0 < NQ; ++d0) { const u32x4 w = *reinterpret_cast<const u32x4*>(&qr[d0]);
#pragma unroll
            for (int j = 0; j < 4; ++j) { const float a = bf_lo(w[j]), b = bf_hi(w[j]); ss = fmaf(a, a, ss); ss = fmaf(b, b, ss); } }
        { auto rr = __builtin_amdgcn_permlane32_swap(__float_as_uint(ss), __float_as_uint(ss), false, false); ss = __uint_as_float(rr[0]) + __uint_as_float(rr[1]); }
        qbound = sqrtf(ss) * ax.kmax * 1.001f + 1e-3f; }
    float cbv = 0.f;
#define BIASMASK(P0_, P1_, t) do { const int kb_ = KBASE(t); cbv = 0.f;                                                                \
        if (MODE == 1) { bias_key(P0_, P1_, (const LAS char*)(auxl + kb_ + 4 * hi)); }                                                       \
        else if (MODE == 3) { bias_dist(P0_, P1_, (const LAS char*)(auxl + (qm - kb_ - 59 + TB_PAD))); }                                     \
        else { if (cur.P0 - kb_ - 63 >= FAR_DIST) cbv = cfar; else bias_dist(P0_, P1_, (const LAS char*)(auxl + (qm - kb_ - 59 + TB_PAD))); } \
        if (MODE == 0) { mask_bits(P0_, P1_, mw, hi); }                                                                                  \
        else if (kb_ + KVBLK - 1 > qlo || kb_ <= qlo + QBLK - 1 - W) mask_tile(P0_, P1_, qm - kb_, (unsigned)W); } while (0)
#define MLOAD(t) do { if (MODE == 0) mw = ax.mrow0[(size_t)(wid * QBLK + r32) * 128 + (KBASE(t) >> 6)]; } while (0)
    f32x16 pA0, pA1, pB0, pB1; float mnA, mnB, alA, alB; bf16x8 pa0, pa1, pa2, pa3; u64 mw = 0ull;
    if (NT > 1) SLOAD_H(Kh, Vh, KBASE(1));
    MLOAD(0);
    SBAR(); qkt<0, NQ>(pA0, pA1, K_lds, r32, hi, qr, koff);
    BIASMASK(pA0, pA1, 0); partialSM(pA0, pA1, m_reg, mnA, alA, cbv);
    if (NT > 1) { VMW(); SWRITE_H(1); }
    __syncthreads();
#define HALF_STEP(PX0, PX1, mnX, alX, PY0, PY1, alY, t, KB, VB, SB) do {                                                      \
        MLOAD(t);                                                                                                             \
        if ((t) + 1 < NT) { SLOAD_H(Kh, Vh, KBASE((t) + 1)); }        \
        SBAR(); qkt<KB, NQ>(PX0, PX1, K_lds, r32, hi, qr, koff);                                                              \
        finishSM(PY0, PY1, alY, l_reg, pa0, pa1, pa2, pa3); SBAR();                                                           \
        pv_tile<VB>(o, vb0, pa0, pa1, pa2, pa3); BIASMASK(PX0, PX1, (t)); partialSM(PX0, PX1, m_reg, mnX, alX, cbv);          \
        __syncthreads();                                                                                                      \
        if ((t) + 1 < NT) { VMW(); SWRITE_H(SB); }                                                                            \
        RESC(alX); __syncthreads(); } while (0)
    for (int t = 1; t + 1 < NT; t += 2) {
        if (MODE == 1) {
            const u32x4 f0 = *(const LAS u32x4*)flg, f1 = *(const LAS u32x4*)(flg + 4);
            if ((f0[0] & f0[1] & f0[2] & f0[3] & f1[0] & f1[1] & f1[2] & f1[3]) != 0u) { NT = t + 1; break; }
        }
        HALF_STEP(pB0, pB1, mnB, alB, pA0, pA1, alA, t, 1, 0, 0);
        if (MODE == 1) {
            unsigned ok = 0u;
            if (t + 3 < NT) { const float ub = qbound - auxl[KBASE(t + 3) + KVBLK - 1]; ok = __all(ub < m_reg - SKIP_MARGIN) ? 1u : 0u; }
            if (lane == 0) flg[wid] = ok;
        }
        HALF_STEP(pA0, pA1, mnA, alA, pB0, pB1, alB, t + 1, 0, 1, 1);
    }
    const bool even = (NT & 1) == 0;
    if (even) { MLOAD(NT - 1); SBAR(); qkt<1, NQ>(pB0, pB1, K_lds, r32, hi, qr, koff); SBAR(); }
    finishSM(pA0, pA1, alA, l_reg, pa0, pa1, pa2, pa3); SBAR();
    pv_tile<0>(o, vb0, pa0, pa1, pa2, pa3);
    if (even) { BIASMASK(pB0, pB1, NT - 1); partialSM(pB0, pB1, m_reg, mnB, alB, cbv); __syncthreads(); RESC(alB);
        finishSM(pB0, pB1, alB, l_reg, pa0, pa1, pa2, pa3); SBAR(); pv_tile<1>(o, vb0, pa0, pa1, pa2, pa3); }
    if (hi == 0) li_l[r32] = l_reg; asm volatile("s_waitcnt lgkmcnt(0)" ::: "memory");
#pragma unroll
    for (int r = 0; r < 16; ++r) { const float rl = __builtin_amdgcn_rcpf(li_l[crow(r, hi)]);
#pragma unroll
        for (int d0 = 0; d0 < 4; ++d0) o[d0][r] *= rl; }
    m_out = m_reg; l_out = l_reg;
    __syncthreads();
#undef ROW
#undef VMW
#undef SLOAD_H
#undef SWRITE_HK
#undef SWRITE_HV
#undef SWRITE_H
#undef RESC
#undef KBASE
#undef BIASMASK
#undef MLOAD
#undef HALF_STEP
}
#undef KSWZ
}

__device__ __forceinline__ void store_y(const GA bf16_t* Zs, GA bf16_t* Y, const f32x16 (&o)[4], int row0w, int colbase, int r32, int hi) {
    bf16_t zv[16][4];
#pragma unroll
    for (int r = 0; r < 16; ++r) { const size_t off = (size_t)(row0w + att::crow(r, hi)) * DM + colbase + r32;
#pragma unroll
        for (int d0 = 0; d0 < 4; ++d0) zv[r][d0] = Zs[off + d0 * 32]; }
#pragma unroll
    for (int r = 0; r < 16; ++r) { const size_t off = (size_t)(row0w + att::crow(r, hi)) * DM + colbase + r32;
#pragma unroll
        for (int d0 = 0; d0 < 4; ++d0) { const float v = o[d0][r] * bf2f(zv[r][d0]); const float vn = __shfl_xor(v, 1);
            if ((r32 & 1) == 0) *(GA unsigned*)(Y + off + d0 * 32) = cvt_pk_bf16(v, vn); } }
}
template <int MODE>
__device__ __forceinline__ void attn_fast_unit(const Frame& F, int layer, int b, int h, int qb) {
    const int mixer = MODE;
    const size_t hb = ((size_t)(b * 4 + h) * SEQ) * 128;
    att::Blk cur{F.QKV + (size_t)(mixer * 3 + 0) * QS + hb + (size_t)qb * 256 * 128, F.QKV + (size_t)(mixer * 3 + 1) * QS + hb, F.QKV + (size_t)(mixer * 3 + 2) * QS + hb, qb * 256, 128};
    att::Aux ax{F.tb + (size_t)h * SEQ, 1, F.cum + (size_t)(b * 4 + h) * SEQ, F.mask + (size_t)(b * SEQ + qb * 256) * 128, 0.f};
    if (MODE == 1) ax.kmax = sqrtf(__uint_as_float(F.ctl[CW_KM + layer * 8 + b * 4 + h]));
    f32x16 o[4]; float m_, l_;
    att::attn_block<MODE, 8>(cur, SEQ, SEQ, 0, ax, (LAS char*)F.lds, o, m_, l_);
    const int tid = tid_l(), wid = tid >> 6, lane = tid & 63;
    GA unsigned char* w2 = launder(F.ws);
    store_y((const GA bf16_t*)(w2 + WS_ZS), (GA bf16_t*)(w2 + WS_Y), o, b * SEQ + qb * 256 + wid * 32, mixer * 512 + h * 128, lane & 31, lane >> 5);
}

__device__ __forceinline__ void attn_diffmap_unit(const Frame& F, int layer, int b, int h, int qb, int c) {
    const size_t hb = ((size_t)(b * 4 + h) * SEQ) * 128;
    const GA bf16_t* Qc = F.QKV + (size_t)(2 * 3 + 0) * QS + hb + (size_t)qb * 256 * 128; const GA bf16_t* Kc = F.QKV + (size_t)(2 * 3 + 1) * QS + hb; const GA bf16_t* Vc = F.QKV + (size_t)(2 * 3 + 2) * QS + hb;
    att::Aux ax{F.tb + (size_t)(4 + h) * SEQ, 1, (const GA float*)nullptr, (const GA u64*)nullptr, 0.f};
    f32x16 o[4]; float m_, l_;
    { att::Blk cur{Qc + c * 64, Kc, Vc, qb * 256, 128};
      att::attn_block<2, 4>(cur, SEQ, SEQ, c * 128, ax, (LAS char*)F.lds, o, m_, l_); }
    const int tid = tid_l(), wid = tid >> 6, lane = tid & 63, r32 = lane & 31, hi = lane >> 5;
    const int pair = (b * 4 + h) * 32 + qb;
    GA unsigned char* w2 = launder(F.ws);
    { GA f32x4* mine = (GA f32x4*)(w2 + WS_O1) + ((size_t)(c * 256 + pair) * 16) * 512 + tid;
#pragma unroll
      for (int d0 = 0; d0 < 4; ++d0)
#pragma unroll
          for (int g = 0; g < 4; ++g) { const f32x4 v = {o[d0][4 * g], o[d0][4 * g + 1], o[d0][4 * g + 2], o[d0][4 * g + 3]};
              asm volatile("global_store_dwordx4 %0, %1, off sc1" :: "v"(mine + (d0 * 4 + g) * 512), "v"(v) : "memory"); } }
    asm volatile("s_waitcnt vmcnt(0)" ::: "memory");
    __syncthreads();
    volatile LAS unsigned* lw = F.misc + 5;
    if (tid == 0) *lw = __hip_atomic_fetch_add((GA unsigned*)(w2 + WS_CTL) + CW_DC + layer * 256 + pair, 1u, __ATOMIC_RELAXED, __HIP_MEMORY_SCOPE_AGENT);
    __syncthreads();
    if (*lw == 0u) return;
    __builtin_amdgcn_fence(__ATOMIC_ACQUIRE, "agent");
    asm volatile("s_waitcnt vmcnt(0)" ::: "memory");
    const GA f32x4* other = (const GA f32x4*)(w2 + WS_O1) + ((size_t)((1 - c) * 256 + pair) * 16) * 512 + tid;
    const GA float* dp = (const GA float*)(w2 + WS_DP) + layer * 256;
    const float lam = dp[0];
#pragma unroll
    for (int g = 0; g < 4; ++g) {
        f32x4 ot[4];
#pragma unroll
        for (int d0 = 0; d0 < 4; ++d0) ot[d0] = other[(d0 * 4 + g) * 512];
#pragma unroll
        for (int q = 0; q < 4; ++q) { const int r = 4 * g + q;
            float ss = 0.f;
#pragma unroll
            for (int d0 = 0; d0 < 4; ++d0) { const float mo = o[d0][r], oth = ot[d0][q];
                const float a0 = (c == 0) ? mo : oth, a1 = (c == 0) ? oth : mo; const float v = fmaf(-lam, a1, a0); o[d0][r] = v; ss = fmaf(v, v, ss); }
            ss += __shfl_xor(ss, 1); ss += __shfl_xor(ss, 2); ss += __shfl_xor(ss, 4); ss += __shfl_xor(ss, 8); ss += __shfl_xor(ss, 16);
            const float rn = rsqrtf(ss * (1.0f / 128.0f) + RMS_EPS);
#pragma unroll
            for (int d0 = 0; d0 < 4; ++d0) o[d0][r] = o[d0][r] * rn;
        }
        asm volatile("" ::: "memory");
    }
#pragma unroll
    for (int d0 = 0; d0 < 4; ++d0) { const float sw = dp[128 + d0 * 32 + r32];
#pragma unroll
        for (int r = 0; r < 16; ++r) o[d0][r] *= sw; }
    store_y((const GA bf16_t*)(w2 + WS_ZS), (GA bf16_t*)(w2 + WS_Y), o, b * SEQ + qb * 256 + wid * 32, 2 * 512 + h * 128, r32, hi);
}
__device__ __forceinline__ void attn_dil_unit(const Frame& F, int u) {
    const int cfg = u >> 8, v = u & 255, b = v & 1, h = (v >> 1) & 3, x = v >> 3;
    const int dl = (cfg == 0) ? 1 : (cfg == 1 ? 4 : 16);
    const int rho = (cfg == 0) ? 0 : (cfg == 1 ? (x & 3) : (x & 15)), qb = (cfg == 0) ? x : (cfg == 1 ? (x >> 2) : (x >> 4));
    const size_t hb = ((size_t)(b * 4 + h) * SEQ) * 128;
    const GA bf16_t* Qd = F.QKV + (size_t)(3 * 3 + 0) * QS + hb; const GA bf16_t* Kd = F.QKV + (size_t)(3 * 3 + 1) * QS + hb; const GA bf16_t* Vd = F.QKV + (size_t)(3 * 3 + 2) * QS + hb;
    att::Blk cur{Qd + (size_t)(rho + dl * qb * 256) * 128, Kd + (size_t)rho * 128, Vd + (size_t)rho * 128, qb * 256, 128 * dl};
    att::Aux ax{F.tb + (size_t)(8 + h) * SEQ, dl, (const GA float*)nullptr, (const GA u64*)nullptr, 0.f};
    f32x16 o[4]; float m_, l_;
    att::attn_block<3, 8>(cur, SEQ / dl, 129, 0, ax, (LAS char*)F.lds, o, m_, l_);
    const int tid = tid_l(), wid = tid >> 6, lane = tid & 63, r32 = lane & 31, hi = lane >> 5;
    GA unsigned char* w2 = launder(F.ws);
    GA bf16_t* od = (GA bf16_t*)(w2 + WS_OD) + (size_t)cfg * MT * 512;
#pragma unroll
    for (int r = 0; r < 16; ++r) { const size_t row = (size_t)b * SEQ + rho + (size_t)dl * (qb * 256 + wid * 32 + att::crow(r, hi));
#pragma unroll
        for (int d0 = 0; d0 < 4; ++d0) od[row * 512 + h * 128 + d0 * 32 + r32] = (bf16_t)(cvt_pk_bf16(o[d0][r], 0.f) & 0xffffu); }
    if (hi == 0) { const size_t row = (size_t)b * SEQ + rho + (size_t)dl * (qb * 256 + wid * 32 + r32);
        ((GA float*)(w2 + WS_LSE))[((size_t)cfg * MT + row) * 4 + h] = m_ + __builtin_amdgcn_logf(l_); }
}
__device__ __forceinline__ void dil_merge_unit(const Frame& F, int u) {
    const int tid = tid_l(), row = u * 32 + (tid >> 4), cg = tid & 15, h = cg >> 2, col = cg * 32;
    const float l0 = F.LSE[((size_t)0 * MT + row) * 4 + h], l1 = F.LSE[((size_t)1 * MT + row) * 4 + h], l2 = F.LSE[((size_t)2 * MT + row) * 4 + h];
    const float mx = fmaxf(l0, fmaxf(l1, l2)); float w0 = ex2(l0 - mx), w1 = ex2(l1 - mx), w2 = ex2(l2 - mx); const float inv = 1.0f / (w0 + w1 + w2); w0 *= inv; w1 *= inv; w2 *= inv;
    const GA bf16_t* odb = (const GA bf16_t*)F.OD;
    const GA bf16_t* p0 = odb + ((size_t)0 * MT + row) * 512 + col; const GA bf16_t* p1 = odb + ((size_t)1 * MT + row) * 512 + col; const GA bf16_t* p2 = odb + ((size_t)2 * MT + row) * 512 + col;
    const size_t yo = (size_t)row * DM + 3 * 512 + col;
#pragma unroll
    for (int i = 0; i < 4; ++i) {
        const u32x4 A_ = *(const GA u32x4*)(p0 + 8 * i), B_ = *(const GA u32x4*)(p1 + 8 * i), C_ = *(const GA u32x4*)(p2 + 8 * i);
        const f32x4 a0 = {bf_lo(A_[0]), bf_hi(A_[0]), bf_lo(A_[1]), bf_hi(A_[1])}, a1 = {bf_lo(A_[2]), bf_hi(A_[2]), bf_lo(A_[3]), bf_hi(A_[3])}, b0 = {bf_lo(B_[0]), bf_hi(B_[0]), bf_lo(B_[1]), bf_hi(B_[1])}, b1 = {bf_lo(B_[2]), bf_hi(B_[2]), bf_lo(B_[3]), bf_hi(B_[3])},
                    c0 = {bf_lo(C_[0]), bf_hi(C_[0]), bf_lo(C_[1]), bf_hi(C_[1])}, c1 = {bf_lo(C_[2]), bf_hi(C_[2]), bf_lo(C_[3]), bf_hi(C_[3])};
        const u32x4 zw = *(const GA u32x4*)(F.Zs + yo + 8 * i);
        const f32x4 v0 = a0 * w0 + b0 * w1 + c0 * w2, v1 = a1 * w0 + b1 * w1 + c1 * w2;
        u32x4 w = {cvt_pk_bf16(v0[0] * bf_lo(zw[0]), v0[1] * bf_hi(zw[0])), cvt_pk_bf16(v0[2] * bf_lo(zw[1]), v0[3] * bf_hi(zw[1])),
                   cvt_pk_bf16(v1[0] * bf_lo(zw[2]), v1[1] * bf_hi(zw[2])), cvt_pk_bf16(v1[2] * bf_lo(zw[3]), v1[3] * bf_hi(zw[3]))};
        *(GA u32x4*)(F.Y + yo + 8 * i) = w; }
}

struct EpiMerged {
    static constexpr bool PERM = true, AFTER_DRAIN = false, MIDK = true, FP8 = false;
    const GA unsigned char* G; GA bf16_t* MG;
    static __device__ __forceinline__ float gq(unsigned w, int i) { return (float)((w >> (8 * i)) & 0xffu) + 0.5f; }
    __device__ __forceinline__ void mid(f32x4 (&acc)[2][2][4][2], const pg8::Unit& u, int bnext, int wr, int wc, int fr, int fq) const {
        const int row0 = u.pm * 256 + wr * 64 + fr, c0 = u.pn * 256 + wc * 32 + 8 * fq;
#pragma unroll
        for (int ai = 0; ai < 2; ++ai) {
            u32x2 num[4][2], den[4][2];
#pragma unroll
            for (int m = 0; m < 4; ++m) { const GA unsigned char* gp = G + (size_t)(row0 + ai * 128 + m * 16) * 8192 + c0;
#pragma unroll
                for (int bj = 0; bj < 2; ++bj) { num[m][bj] = *(const GA u32x2*)(gp + (bnext - 1) * DM + bj * 128); den[m][bj] = *(const GA u32x2*)(gp + bnext * DM + bj * 128); } }
#pragma unroll
            for (int m = 0; m < 4; ++m)
#pragma unroll
                for (int bj = 0; bj < 2; ++bj)
#pragma unroll
                    for (int j = 0; j < 4; ++j) {
                        acc[ai][bj][m][0][j] *= gq(num[m][bj][0], j) * __builtin_amdgcn_rcpf(gq(den[m][bj][0], j));
                        acc[ai][bj][m][1][j] *= gq(num[m][bj][1], j) * __builtin_amdgcn_rcpf(gq(den[m][bj][1], j)); }
            asm volatile("" ::: "memory");
        }
    }
    __device__ __forceinline__ void operator()(const f32x4 (&acc)[2][2][4][2], const pg8::Unit& u, int wr, int wc, int fr, int fq) const {
        const int row0 = u.pm * 256 + wr * 64 + fr, c0 = u.pn * 256 + wc * 32 + 8 * fq;
        u32x2 g3v[2][4][2];
#pragma unroll
        for (int ai = 0; ai < 2; ++ai)
#pragma unroll
            for (int m = 0; m < 4; ++m)
#pragma unroll
                for (int bj = 0; bj < 2; ++bj) g3v[ai][m][bj] = *(const GA u32x2*)(G + (size_t)(row0 + ai * 128 + m * 16) * 8192 + 3 * DM + c0 + bj * 128);
#pragma unroll
        for (int ai = 0; ai < 2; ++ai)
#pragma unroll
            for (int m = 0; m < 4; ++m) { const int r = row0 + ai * 128 + m * 16;
#pragma unroll
                for (int bj = 0; bj < 2; ++bj) { const u32x2 g3 = g3v[ai][m][bj];
                    const f32x4 v0 = acc[ai][bj][m][0] * (1.0f / 256.0f), v1 = acc[ai][bj][m][1] * (1.0f / 256.0f);
                    u32x4 w = {cvt_pk_bf16(v0[0] * gq(g3[0], 0), v0[1] * gq(g3[0], 1)), cvt_pk_bf16(v0[2] * gq(g3[0], 2), v0[3] * gq(g3[0], 3)),
                               cvt_pk_bf16(v1[0] * gq(g3[1], 0), v1[1] * gq(g3[1], 1)), cvt_pk_bf16(v1[2] * gq(g3[1], 2), v1[3] * gq(g3[1], 3))};
                    *(GA u32x4*)(MG + (size_t)r * DM + c0 + bj * 128) = w; } }
    }
};

struct EpiOut {
    static constexpr bool PERM = false, AFTER_DRAIN = false, MIDK = false, FP8 = false;
    GA float* xres; GA bf16_t* xb; GA float* ssq; GA unsigned char* xq; const GA float* xsrc; bool feed_next;
    __device__ __forceinline__ void operator()(const f32x4 (&acc)[2][2][4][2], const pg8::Unit& u, int wr, int wc, int fr, int fq) const {
        const int row0 = u.pm * 256 + wr * 64 + fr, col0 = u.pn * 256 + wc * 32 + 4 * fq;
#pragma unroll
        for (int h = 0; h < 4; ++h) {
            const int ai = h >> 1, mb = (h & 1) * 2;
            f32x4 xv[2][2][2];
#pragma unroll
            for (int m = 0; m < 2; ++m)
#pragma unroll
                for (int bj = 0; bj < 2; ++bj)
#pragma unroll
                    for (int n = 0; n < 2; ++n) { const size_t off_ = (size_t)(row0 + ai * 128 + (mb + m) * 16) * DM + col0 + bj * 128 + n * 16;
                        if (xsrc != nullptr) xv[m][bj][n] = *(const GA f32x4*)(xsrc + off_);
                        else { const u32x2 t_ = *(const GA u32x2*)(xb + off_); xv[m][bj][n] = (f32x4){bf_lo(t_[0]), bf_hi(t_[0]), bf_lo(t_[1]), bf_hi(t_[1])}; } }
#pragma unroll
            for (int m = 0; m < 2; ++m) { const int r = row0 + ai * 128 + (mb + m) * 16; float ss = 0.f;
#pragma unroll
                for (int bj = 0; bj < 2; ++bj)
#pragma unroll
                    for (int n = 0; n < 2; ++n) { const size_t off = (size_t)r * DM + col0 + bj * 128 + n * 16;
                        const f32x4 v = xv[m][bj][n] + acc[ai][bj][mb + m][n];
                        ss += v[0] * v[0] + v[1] * v[1] + v[2] * v[2] + v[3] * v[3];
                        { u32x2 w = {cvt_pk_bf16(v[0], v[1]), cvt_pk_bf16(v[2], v[3])}; *(GA u32x2*)(xb + off) = w; }
                        if (feed_next) *(GA unsigned*)(xq + off) = cvt4_fp8(v[0], v[1], v[2], v[3]); }
                ss += __shfl_xor(ss, 16); ss += __shfl_xor(ss, 32);
                if (fq == 0) ssq[(size_t)r * 32 + u.pn * 4 + wc] = ss; }
        }
    }
};

__device__ __forceinline__ void final_norm(const Frame& F) {
    const int tid = tid_l(), lane = tid & 63, wave = tid >> 6, G = gridDim.x, bid = blockIdx.x;
    for (int row = bid * 8 + wave; row < MT; row += G * 8) {
        float ss = (lane < 32) ? F.ssq[(size_t)row * 32 + lane] : 0.f; ss = wave_sum(ss);
        const float rs = rsqrtf(ss * (1.0f / DM) + RMS_EPS);
#pragma unroll
        for (int i = 0; i < 8; ++i) { const int c = (i * 64 + lane) * 4; const u32x2 t = *(const GA u32x2*)(F.xb + (size_t)row * DM + c); const f32x4 v = {bf_lo(t[0]), bf_hi(t[0]), bf_lo(t[1]), bf_hi(t[1])}, w = *(const GA f32x4*)(F.final_w + c);
            *(GA f32x4*)(F.out + (size_t)row * DM + c) = v * rs * w; }
    }
}

__device__ __forceinline__ Frame mkframe(const Args& args, GA unsigned char* ws, LAS unsigned char* lds) {
    Frame F;
    F.x = (const GA float*)args.in[0]; F.norm_w = (const GA float*)args.in[1]; F.w_in = (const GA float*)args.in[2]; F.fox_b = (const GA float*)args.in[3];
    F.lq1 = (const GA float*)args.in[4]; F.lk1 = (const GA float*)args.in[5]; F.lq2 = (const GA float*)args.in[6]; F.lk2 = (const GA float*)args.in[7];
    F.subln = (const GA float*)args.in[8]; F.w_branch = (const GA float*)args.in[9]; F.w_out = (const GA float*)args.in[10]; F.rel_bias = (const GA float*)args.in[11];
    F.final_w = (const GA float*)args.in[12]; F.out = (GA float*)args.out;
    F.ctl = (GA unsigned*)(ws + WS_CTL); F.WinT = (GA bf16_t*)(ws + WS_WIN); F.WbrT = (GA bf16_t*)(ws + WS_WBR); F.WoutT = (GA bf16_t*)(ws + WS_WOUT);
    F.xres = (GA float*)(ws + WS_XRES); F.xb = (GA bf16_t*)(ws + WS_XB); F.ssq = (GA float*)(ws + WS_SSQ); F.Zs = (GA bf16_t*)(ws + WS_ZS); F.G = (GA bf16_t*)(ws + WS_G);
    F.QKV = (GA bf16_t*)(ws + WS_QKV); F.IQ = (GA bf16_t*)(ws + WS_IQ); F.IK = (GA bf16_t*)(ws + WS_IK); F.IW = (GA float*)(ws + WS_IW); F.FF = (GA float*)(ws + WS_FF);
    F.cum = (GA float*)(ws + WS_CUM); F.tb = (GA float*)(ws + WS_TB); F.sc = (GA float*)(ws + WS_SC); F.mask = (GA u64*)(ws + WS_MASK); F.Y = (GA bf16_t*)(ws + WS_Y); F.MG = (GA bf16_t*)(ws + WS_MG);
    F.O1 = (GA float*)(ws + WS_O1); F.OD = (GA float*)(ws + WS_OD); F.LSE = (GA float*)(ws + WS_LSE); F.DP = (GA float*)(ws + WS_DP); F.ws = ws;
    F.lds = lds; F.misc = (volatile LAS unsigned*)(lds + LDS_MISC);
    return F;
}

constexpr unsigned WQ_L0 = 2u * WT_TB, WQ_TOTAL = WQ_L0 + 3u * WT_TL;
__device__ __forceinline__ void wq_tile(const Args& args, LAS unsigned char* ldsl, unsigned t) {
    const Frame F = mkframe(args, launder(args.ws), ldsl);
    if (t < WQ_L0) { weight_tile(F, 0, WT_TW + WT_TG + (int)t, (LAS float*)ldsl); return; }
    const unsigned t1 = t - WQ_L0, l1 = t1 / (unsigned)WT_TL;
    weight_tile(F, 1 + (int)l1, (int)(t1 - l1 * (unsigned)WT_TL), (LAS float*)ldsl);
}
__device__ __forceinline__ void wq_drain(const Args& args, LAS unsigned char* ldsl, unsigned bound) {
    volatile LAS unsigned* st = (volatile LAS unsigned*)(ldsl + LDS_MISC);
    GA unsigned* wq = (GA unsigned*)(args.ws + WS_CTL) + CW_WQ;
    for (;;) {
        __syncthreads();
        if (threadIdx.x == 0) st[11] = __hip_atomic_fetch_add(wq, 1u, __ATOMIC_RELAXED, __HIP_MEMORY_SCOPE_AGENT);
        __syncthreads();
        const unsigned t = st[11];
        if (t < WQ_TOTAL) wq_tile(args, ldsl, t);
        if (t + 1u >= bound) break;
    }
}
__device__ __forceinline__ void xcd_barrier_steal(const XcdBarrier& b, const Args& args, LAS unsigned char* ldsl) {
    asm volatile("s_waitcnt vmcnt(0)" ::: "memory");
    __syncthreads();
    volatile LAS unsigned* st = b.st;
    if (threadIdx.x == 0) {
        unsigned* bar = b.bar;
        __builtin_amdgcn_s_waitcnt(0);
        unsigned nloc = st[0], nx = st[1];
        if (nloc == 0u) { xcd_barrier_complete(bar, b.x, nloc, nx); st[0] = nloc; st[1] = nx; }
        const unsigned old = xb_add(&bar[XB_XSUB(b.x)], 1u);
        const unsigned gen = old / nloc;
        if (old + 1u == (gen + 1u) * nloc) {
            __builtin_amdgcn_fence(__ATOMIC_RELEASE, "agent");
            asm volatile("s_waitcnt vmcnt(0)" ::: "memory");
            const unsigned og = xb_add(&bar[XB_TOP], 1u);
            const unsigned tg = og / nx;
            if (og + 1u == (tg + 1u) * nx) xb_add(&bar[XB_TOPGEN], 1u);
            else XB_SPIN(xb_ld(&bar[XB_TOPGEN]) == tg, bar);
            __builtin_amdgcn_fence(__ATOMIC_ACQUIRE, "agent");
            xb_add(&bar[XB_XGEN(b.x)], 1u);
            asm volatile("s_waitcnt vmcnt(0)" ::: "memory");
            st[8] = 1u;
        } else { st[8] = 0u; st[9] = gen; }
    }
    __syncthreads();
    const unsigned leader_ = st[8];
    __syncthreads();
    if (leader_ == 0u) {
        unsigned sp = 0u;
        for (;;) {
            if (threadIdx.x == 0) {
                unsigned* bar = b.bar;
                unsigned done = (xb_ld(&bar[XB_XGEN(b.x)]) != st[9]) ? 1u : 0u, t = 0xffffffffu;
                if (!done) {
                    if (st[10] == 0u) { t = xb_add((unsigned*)(args.ws + WS_CTL) + CW_WQ, 1u); if (t >= WQ_TOTAL) { st[10] = 1u; t = 0xffffffffu; } }
                    if (t == 0xffffffffu) { __builtin_amdgcn_s_sleep(1);
                        if ((++sp & 255u) == 0u) { if (xb_ld(&bar[XB_TMO])) done = 1u; else if (sp > XB_SPIN_CAP) { atomicAdd(&bar[XB_TMO], 1u); done = 1u; } } }
                }
                st[8] = done; st[11] = t;
            }
            __syncthreads();
            const unsigned done = st[8], t = st[11];
            if (done) break;
            if (t != 0xffffffffu) wq_tile(args, ldsl, t);
            else __syncthreads();
        }
        if (threadIdx.x == 0) { __builtin_amdgcn_fence(__ATOMIC_ACQUIRE, "agent"); asm volatile("s_waitcnt vmcnt(0)" ::: "memory"); }
    }
    __syncthreads();
}

__global__ void __launch_bounds__(512, 2) fwd(Args args) {
    extern __shared__ __attribute__((aligned(16))) unsigned char lds[];
    LAS unsigned char* ldsl = (LAS unsigned char*)lds;
    if (threadIdx.x < 64) ((volatile LAS unsigned*)(ldsl + LDS_MISC))[threadIdx.x] = 0u;
    __syncthreads();
    const int lo = args.ph_lo, hi = args.ph_hi;
    const bool fused = (hi - lo) > 1;
    if (fused) (void)xcd_barrier_post((unsigned*)(args.ws + WS_CTL) + CW_BAR, (volatile LAS unsigned*)(ldsl + LDS_MISC));
#ifndef PH_EN
#define PH_EN 0xff
#endif
#define IN(k) (lo <= (k) && (k) < hi)
#if defined(BWPROBE)
#define BW_MATCH(k) (BWPROBE == 9 || ((k) == 0 ? 5 : ((k) - 1) % 5) == BWPROBE)
#define SEAM(k) do { if (IN((k) + 1)) { const unsigned long long bw0_ = __builtin_amdgcn_s_memrealtime(); XcdBarrier b_; b_.bar = (unsigned*)(args.ws + WS_CTL) + CW_BAR; b_.x = xb_xcc_id(); b_.st = (volatile LAS unsigned*)(ldsl + LDS_MISC); xcd_barrier(b_); \
    if (BW_MATCH(k) && threadIdx.x == 0) atomicAdd((unsigned*)(args.ws + WS_CTL) + 14336, (unsigned)(__builtin_amdgcn_s_memrealtime() - bw0_)); } } while (0)
#else
#define SEAM(k) do { if (IN((k) + 1)) { XcdBarrier b_; b_.bar = (unsigned*)(args.ws + WS_CTL) + CW_BAR; b_.x = xb_xcc_id(); b_.st = (volatile LAS unsigned*)(ldsl + LDS_MISC); xcd_barrier(b_); } } while (0)
#endif
#define SEAM_STEAL(k) do { if (IN((k) + 1)) { XcdBarrier b_; b_.bar = (unsigned*)(args.ws + WS_CTL) + CW_BAR; b_.x = xb_xcc_id(); b_.st = (volatile LAS unsigned*)(ldsl + LDS_MISC); xcd_barrier_steal(b_, args, ldsl); } } while (0)
    const int G = gridDim.x, bid = blockIdx.x;
#if defined(TPROBE)
    unsigned long long tp_acc = 0ull, tp_t0 = 0ull;
#define tp_acc_ref tp_acc
#define TP_BEGIN(k) do { if ((k) == TPROBE) tp_t0 = __builtin_amdgcn_s_memrealtime(); } while (0)
#define TP_END(k) do { if ((k) == TPROBE) tp_acc += __builtin_amdgcn_s_memrealtime() - tp_t0; } while (0)
#else
    unsigned long long tp_dummy = 0ull;
#define tp_acc_ref tp_dummy
#define TP_BEGIN(k) do { } while (0)
#define TP_END(k) do { } while (0)
#endif

    if ((PH_EN & 1) && IN(0)) { const Frame F = mkframe(args, launder(args.ws), ldsl); TP_BEGIN(0); p0_prologue(F);
#if defined(DUP) && DUP == 6
        __syncthreads(); p0_prologue(F);
#endif
        SEAM(0); TP_END(0); }

    for (int layer = 0; layer < DEPTH; ++layer) {
        const int pb = 1 + 5 * layer;
        if ((PH_EN & 2) && IN(pb)) { TP_BEGIN(1);
            GA unsigned char* ws = launder(args.ws);
            { pg8::Gemm g{(const GA bf16_t*)(ws + WS_XB), (const GA bf16_t*)(ws + WS_WIN) + (size_t)layer * NINP * DM, MT, NINP, DM}; pg8::StaticOrder S; S.init(MT, NINP, G, bid);
              EpiIn E{ws};
              pg8::gemm_phase<EpiIn, pg8::StaticOrder>(ldsl, g, S, E); }
            __syncthreads();
            { pg8::Gemm g{(const GA bf16_t*)(ws + WS_XQ), (const GA bf16_t*)(ws + WS_WG8 + (size_t)layer * N8 * DM), MT, N8, DM / 2}; pg8::StaticOrder S;
              if (G == 256) { if (bid < 192) S.init_part(MT, N8, 192, bid, 12); else S.init_part(MT, N8, 64, 2304 + (bid - 192), 14); } else S.init(MT, N8, G, (bid + 128) % G);
              EpiGate E{ws};
              pg8::gemm_phase<EpiGate, pg8::StaticOrder>(ldsl, g, S, E); }
            SEAM_STEAL(pb); TP_END(1);
        }
        if ((PH_EN & 4) && IN(pb + 1)) { TP_BEGIN(2);
            const Frame F = mkframe(args, launder(args.ws), ldsl);
            TP_BEGIN(20); if (bid < 8) fox_scan(F, layer, bid);
            fox_kmax(F, layer); TP_END(20);
            GA unsigned* ctr = F.ctl + CW_Q + 64 * (layer * 4 + 0);
            for (int u = q_next(ctr, F.misc + 4); u < 768 + 2048; u = q_next(ctr, F.misc + 4)) {
                if (u < 768) { TP_BEGIN(23); attn_dil_unit(F, u); TP_END(23); } else { TP_BEGIN(21); idxsel_unit(F, u - 768, tp_acc_ref); TP_END(21); }
            }
            SEAM_STEAL(pb + 1); TP_END(2);
        }
        if ((PH_EN & 16) && IN(pb + 2)) { TP_BEGIN(4);
            const Frame F = mkframe(args, launder(args.ws), ldsl);
            GA unsigned* ctr = F.ctl + CW_Q + 64 * (layer * 4 + 1);
            const int nunits = 1536;
            for (int u = q_next(ctr, F.misc + 4); u < nunits; u = q_next(ctr, F.misc + 4)) {
                if (u < 512) { const int qb = 31 - (u >> 4), r = u & 15; TP_BEGIN(40); TP_BEGIN(44 + (qb >= 16)); attn_diffmap_unit(F, layer, r & 1, (r >> 1) & 3, qb, r >> 3); TP_END(40); TP_END(44 + (qb >= 16)); }
                else if (u < 1024) { const int v = u - 512, qb = 31 - (v >> 4), r = v & 15, mode = r & 1, b = (r >> 1) & 1, h = r >> 2;
                    if (mode == 0) { TP_BEGIN(41); attn_fast_unit<0>(F, layer, b, h, qb); TP_END(41); } else { TP_BEGIN(42); attn_fast_unit<1>(F, layer, b, h, qb); TP_END(42); } }
                else { TP_BEGIN(43); dil_merge_unit(F, u - 1024); TP_END(43); }
            }
            if (layer == 0) { __syncthreads(); wq_drain(args, ldsl, WQ_L0); }
            SEAM_STEAL(pb + 2); TP_END(4);
        }
        if ((PH_EN & 32) && IN(pb + 3)) { TP_BEGIN(5);
            GA unsigned char* ws = launder(args.ws);
            pg8::Gemm g{(const GA bf16_t*)(ws + WS_Y), (const GA bf16_t*)(ws + WS_WBR) + (size_t)layer * DM * DM, MT, DM, DM}; pg8::StaticOrder S; S.init(MT, DM, G, bid);
            EpiMerged E{(const GA unsigned char*)(ws + WS_G), (GA bf16_t*)(ws + WS_MG)};
            pg8::gemm_phase<EpiMerged, pg8::StaticOrder>(ldsl, g, S, E);
#if defined(DUP) && DUP == 4
            __syncthreads(); pg8::gemm_phase<EpiMerged, pg8::StaticOrder>(ldsl, g, S, E);
#endif
            SEAM_STEAL(pb + 3); TP_END(5);
        }
        if ((PH_EN & 64) && IN(pb + 4)) { TP_BEGIN(6);
            GA unsigned char* ws = launder(args.ws);
            pg8::Gemm g{(const GA bf16_t*)(ws + WS_MG), (const GA bf16_t*)(ws + WS_WOUT) + (size_t)layer * DM * DM, MT, DM, DM}; pg8::StaticOrder S; S.init(MT, DM, G, bid);
            EpiOut E{(GA float*)(ws + WS_XRES), (GA bf16_t*)(ws + WS_XB), (GA float*)(ws + WS_SSQ), ws + WS_XQ, (layer == 0) ? (const GA float*)args.in[0] : (const GA float*)nullptr, layer + 1 < DEPTH};
            pg8::gemm_phase<EpiOut, pg8::StaticOrder>(ldsl, g, S, E);
            if (layer + 1 < DEPTH) { __syncthreads(); wq_drain(args, ldsl, WQ_L0 + (unsigned)(layer + 1) * WT_TL); }
            SEAM_STEAL(pb + 4); TP_END(6);
        }
    }
    if ((PH_EN & 128) && IN(21)) { TP_BEGIN(7); const Frame F = mkframe(args, launder(args.ws), ldsl); final_norm(F); TP_END(7); }
#if defined(BWPROBE)
    if (bid == 0) { __syncthreads(); const unsigned long long te = __builtin_amdgcn_s_memrealtime(); const unsigned long long tot = xb_ld((unsigned*)(args.ws + WS_CTL) + 14336);
        while ((__builtin_amdgcn_s_memrealtime() - te) * 32ull < tot) __builtin_amdgcn_s_sleep(8); }
#endif
#if defined(TPROBE)
    if (bid == 0) { const unsigned long long te = __builtin_amdgcn_s_memrealtime(); while (__builtin_amdgcn_s_memrealtime() - te < 8ull * tp_acc) __builtin_amdgcn_s_sleep(8); }
#endif
#undef IN
#undef SEAM
}

extern "C" void kernel_launch(void* const* d_in, const int* in_sizes, int n_in, void* d_out, int out_size, void* d_ws, size_t ws_size, hipStream_t stream) {
    static int grid = 0;
    if (grid == 0) {
        if (n_in != 13 || in_sizes[0] != MT * DM || out_size != MT * DM || ws_size < WS_END) {
            fprintf(stderr, "kernel_launch: unexpected shapes (n_in %d, in0 %d, out %d, ws %zu, need %zu)\n", n_in, n_in > 0 ? in_sizes[0] : -1, out_size, ws_size, (size_t)WS_END); grid = -1; return; }
        int dev = 0, cus = 0, per_cu = 0;
        if (hipGetDevice(&dev) != hipSuccess || hipDeviceGetAttribute(&cus, hipDeviceAttributeMultiprocessorCount, dev) != hipSuccess) { grid = -1; return; }
        if (hipFuncSetAttribute((const void*)fwd, hipFuncAttributeMaxDynamicSharedMemorySize, LDS_BYTES) != hipSuccess) { fprintf(stderr, "kernel_launch: hipFuncSetAttribute failed\n"); grid = -1; return; }
        if (hipOccupancyMaxActiveBlocksPerMultiprocessor(&per_cu, (const void*)fwd, 512, LDS_BYTES) != hipSuccess || per_cu < 1) fprintf(stderr, "kernel_launch: occupancy query reports %d\n", per_cu);
        (void)hipGetLastError();
        grid = cus;
    }
    if (grid < 0) return;
    if (hipMemsetAsync((char*)d_ws + WS_CTL, 0, CTL_BYTES, stream) != hipSuccess) return;
    Args a{};
    for (int i = 0; i < 13; ++i) a.in[i] = (const float*)d_in[i];
    a.out = (float*)d_out; a.ws = (unsigned char*)d_ws;
#if MK_LAUNCHES == 1
    a.ph_lo = 0; a.ph_hi = NPH;
    hipLaunchKernelGGL(fwd, dim3(grid), dim3(512), LDS_BYTES, stream, a);
#else
    for (int p = 0; p < NPH; ++p) { a.ph_lo = p; a.ph_hi = p + 1; hipLaunchKernelGGL(fwd, dim3(grid), dim3(512), LDS_BYTES, stream, a); }
#endif
}
```

```cpp
#include <hip/hip_runtime.h>
#include <stdint.h>
#include <stdio.h>

#ifndef MK_LAUNCHES
#define MK_LAUNCHES 1
#endif

#define LAS __attribute__((address_space(3)))
#define GA __attribute__((address_space(1)))
typedef unsigned short bf16_t;
typedef short bf16x8 __attribute__((ext_vector_type(8)));
typedef float f32x4 __attribute__((ext_vector_type(4)));
typedef float f32x16 __attribute__((ext_vector_type(16)));
typedef unsigned u32x4 __attribute__((ext_vector_type(4)));
typedef unsigned u32x2 __attribute__((ext_vector_type(2)));
typedef unsigned long long u64;

constexpr int DM = 2048, NB = 2, SEQ = 8192, DEPTH = 4, MT = NB * SEQ;
constexpr int NIN = 17492, NINP = 4864, N8 = 12800;
constexpr float W8SCALE = 512.f;
constexpr int NPH = 22;
constexpr float LOG2E = 1.4426950408889634f;
constexpr float QSC128 = 0.08838834764831845f * 1.4426950408889634f;
constexpr float QSC64 = 0.125f * 1.4426950408889634f;
constexpr float RMS_EPS = 1e-6f;
constexpr size_t QS = (size_t)NB * 4 * SEQ * 128;

constexpr size_t al256(size_t x) { return (x + 255) & ~(size_t)255; }
constexpr size_t WS_CTL = 0, CTL_BYTES = 65536;
constexpr size_t WS_WIN = WS_CTL + CTL_BYTES;
constexpr size_t WS_WBR = WS_WIN + (size_t)DEPTH * NINP * DM * 2;
constexpr size_t WS_WOUT = WS_WBR + (size_t)DEPTH * DM * DM * 2;
constexpr size_t WS_XRES = WS_WOUT + (size_t)DEPTH * DM * DM * 2;
constexpr size_t WS_XB = WS_XRES + (size_t)MT * DM * 4;
constexpr size_t WS_SSQ = WS_XB + (size_t)MT * DM * 2;
constexpr size_t WS_ZS = WS_SSQ + (size_t)MT * 32 * 4;
constexpr size_t WS_G = WS_ZS + (size_t)MT * DM * 2;
constexpr size_t WS_QKV = WS_G + (size_t)MT * 8192 * 2;
constexpr size_t WS_IQ = WS_QKV + 12 * QS * 2;
constexpr size_t WS_IK = WS_IQ + (size_t)MT * 1024 * 2;
constexpr size_t WS_IW = WS_IK + (size_t)MT * 64 * 2;
constexpr size_t WS_FF = WS_IW + (size_t)MT * 16 * 4;
constexpr size_t WS_CUM = WS_FF + (size_t)MT * 4 * 4;
constexpr size_t WS_TB = WS_CUM + (size_t)NB * 4 * SEQ * 4;
constexpr size_t WS_SC = WS_TB + (size_t)12 * SEQ * 4;
constexpr size_t WS_MASK = WS_SC + (size_t)NB * SEQ * SEQ * 4;
constexpr size_t WS_Y = WS_MASK + (size_t)NB * SEQ * 128 * 8;
constexpr size_t WS_MG = WS_Y + (size_t)MT * DM * 2;
constexpr size_t WS_O1 = WS_MG + (size_t)MT * DM * 2;
constexpr size_t WS_OD = WS_O1 + (size_t)2 * 256 * 64 * 512 * 4;
constexpr size_t WS_LSE = WS_OD + (size_t)3 * MT * 512 * 4;
constexpr size_t WS_DP = WS_LSE + (size_t)3 * MT * 4 * 4;
constexpr size_t WS_WG8 = WS_DP + 4 * 256 * 4;
constexpr size_t WS_XQ = WS_WG8 + (size_t)DEPTH * N8 * DM;
constexpr size_t WS_END = WS_XQ + (size_t)MT * DM;

constexpr int CW_BAR = 0;
constexpr int CW_Q = 4096;
constexpr int CW_DC = 8192;
constexpr int CW_WQ = 13312;
constexpr int CW_KM = 12288;

constexpr int LDS_STAGE = 131072;
constexpr int LDS_MISC = 131072;
constexpr int LDS_BYTES = 147456;

__device__ __forceinline__ unsigned cvt_pk_bf16(float lo, float hi) { unsigned r; asm volatile("v_cvt_pk_bf16_f32 %0, %1, %2" : "=v"(r) : "v"(lo), "v"(hi)); return r; }
__device__ __forceinline__ float bf_lo(unsigned w) { return __uint_as_float(w << 16); }
__device__ __forceinline__ float bf_hi(unsigned w) { return __uint_as_float(w & 0xffff0000u); }
__device__ __forceinline__ float bf2f(bf16_t b) { return __uint_as_float(((unsigned)b) << 16); }
__device__ __forceinline__ float ex2(float x) { return __builtin_amdgcn_exp2f(x); }
__device__ __forceinline__ float sigmoidf_(float x) { return __builtin_amdgcn_rcpf(1.0f + ex2(-x * LOG2E)); }
__device__ __forceinline__ int tid_l() { int t = threadIdx.x; asm volatile("" : "+v"(t)); return t; }
__device__ __forceinline__ GA unsigned char* launder(unsigned char* p) { asm volatile("" : "+s"(p)); return (GA unsigned char*)p; }
__device__ __forceinline__ GA unsigned char* launder(GA unsigned char* p) { asm volatile("" : "+s"(p)); return p; }
__device__ __forceinline__ float wave_sum(float v) {
#pragma unroll
    for (int o = 32; o > 0; o >>= 1) v += __shfl_xor(v, o);
    return v;
}

#define XB_TMO      128
#define XB_XCNT(j)  (256  + 64 * (j))
#define XB_XSUB(j)  (1280 + 64 * (j))
#define XB_XGEN(j)  (2304 + 64 * (j))
#define XB_TOP      3328
#define XB_TOPGEN   3392
#define XCD_BAR_WORDS 3456
#define XB_SPIN_CAP (1u << 18)

__device__ __forceinline__ unsigned xb_ld(unsigned* p)              { return __hip_atomic_load(p, __ATOMIC_RELAXED, __HIP_MEMORY_SCOPE_AGENT); }
__device__ __forceinline__ unsigned xb_add(unsigned* p, unsigned v) { return __hip_atomic_fetch_add(p, v, __ATOMIC_RELAXED, __HIP_MEMORY_SCOPE_AGENT); }
__device__ __forceinline__ unsigned xb_xcc_id() { return (unsigned)__builtin_amdgcn_s_getreg((3 << 11) | 20) & 0xFu; }
#define XB_SPIN(cond, bar) do { unsigned _sp = 0; while (cond) { __builtin_amdgcn_s_sleep(1); \
    if ((++_sp & 255u) == 0u) { if (xb_ld(&(bar)[XB_TMO])) break; if (_sp > XB_SPIN_CAP) { atomicAdd(&(bar)[XB_TMO], 1u); break; } } } } while (0)

struct XcdBarrier { unsigned* bar; unsigned x; volatile LAS unsigned* st; };

__device__ __forceinline__ XcdBarrier xcd_barrier_post(unsigned* bar, volatile LAS unsigned* st) {
    XcdBarrier b; b.bar = bar; b.x = xb_xcc_id(); b.st = st;
    if (threadIdx.x == 0) (void)xb_add(&bar[XB_XCNT(b.x)], 1u);
    return b;
}
__device__ __forceinline__ void xcd_barrier_complete(unsigned* bar, unsigned x, unsigned& nloc, unsigned& nx) {
    const unsigned G = gridDim.x * gridDim.y * gridDim.z;
    unsigned sum, cnt, mine, sp = 0u;
    for (;;) {
        sum = 0u; cnt = 0u; mine = 0u;
#pragma unroll
        for (unsigned j = 0; j < 16; ++j) { const unsigned c = xb_ld(&bar[XB_XCNT(j)]); sum += c; cnt += (c > 0u) ? 1u : 0u; mine = (j == x) ? c : mine; }
        if (sum == G) break;
        __builtin_amdgcn_s_sleep(1);
        if ((++sp & 255u) == 0u) { if (xb_ld(&bar[XB_TMO])) break; if (sp > XB_SPIN_CAP) { atomicAdd(&bar[XB_TMO], 1u); break; } }
    }
    nloc = mine > 0u ? mine : 1u; nx = cnt > 0u ? cnt : 1u;
}
__device__ __forceinline__ void xcd_barrier(const XcdBarrier& b) {
    asm volatile("s_waitcnt vmcnt(0)" ::: "memory");
    __syncthreads();
    if (threadIdx.x == 0) {
        unsigned* bar = b.bar;
        __builtin_amdgcn_s_waitcnt(0);
        unsigned nloc = b.st[0], nx = b.st[1];
        if (nloc == 0u) { xcd_barrier_complete(bar, b.x, nloc, nx); b.st[0] = nloc; b.st[1] = nx; }
        const unsigned old = xb_add(&bar[XB_XSUB(b.x)], 1u);
        const unsigned gen = old / nloc;
        if (old + 1u == (gen + 1u) * nloc) {
            __builtin_amdgcn_fence(__ATOMIC_RELEASE, "agent");
            asm volatile("s_waitcnt vmcnt(0)" ::: "memory");
            const unsigned og = xb_add(&bar[XB_TOP], 1u);
            const unsigned tg = og / nx;
            if (og + 1u == (tg + 1u) * nx) xb_add(&bar[XB_TOPGEN], 1u);
            else XB_SPIN(xb_ld(&bar[XB_TOPGEN]) == tg, bar);
            __builtin_amdgcn_fence(__ATOMIC_ACQUIRE, "agent");
            xb_add(&bar[XB_XGEN(b.x)], 1u);
            asm volatile("s_waitcnt vmcnt(0)" ::: "memory");
        } else {
            XB_SPIN(xb_ld(&bar[XB_XGEN(b.x)]) == gen, bar);
            __builtin_amdgcn_fence(__ATOMIC_ACQUIRE, "agent");
            asm volatile("s_waitcnt vmcnt(0)" ::: "memory");
        }
    }
    __syncthreads();
}

namespace pg8 {
constexpr int BM = 256, BK = 64, HALF = 128, HTB = HALF * BK * 2, STAGE_BYTES = 8 * HTB, NXCD = 8, WGM = 4;
__host__ __device__ __forceinline__ int lds_byte(int r, int c) { const int st = (r >> 4) * 2 + (c >> 5), rr = r & 15, cc = c & 31, ob = rr * 64 + cc * 2; return st * 1024 + (ob ^ (((ob >> 9) & 1) << 5)); }
__host__ __device__ __forceinline__ void stage_rc(int b, int& R, int& C) { const int st = b / 1024, sb = b % 1024, swz = sb ^ (((sb >> 9) & 1) << 5); R = (st >> 1) * 16 + swz / 64; C = (st & 1) * 32 + (swz % 64) / 2; }
__host__ __device__ __forceinline__ int perm32(int rho) { const int n = rho >> 4, i = rho & 15; return 8 * (i >> 2) + 4 * n + (i & 3); }
struct Unit { int pm, pn; };
struct Gemm { const GA bf16_t* A; const GA bf16_t* Bt; int M, N, K; };
struct StaticOrder {
    int nM, nN, nwg, G, c, cnt;
    __host__ __device__ void init(int M, int N, int G_, int c_) { nM = M / BM; nN = N / BM; nwg = nM * nN; G = G_; c = c_; cnt = 1 << 30; }
    __host__ __device__ void init_part(int M, int N, int stride, int first, int cnt_) { nM = M / BM; nN = N / BM; nwg = nM * nN; G = stride; c = first; cnt = cnt_; }
    __host__ __device__ bool next(int i, Unit& u) const {
        const long L = (long)i * G + c; if (L >= nwg || i >= cnt) return false;
        int wgid = (int)L; { const int q = nwg / NXCD, r = nwg % NXCD, xcd = wgid % NXCD, off = wgid / NXCD; wgid = (xcd < r ? xcd * (q + 1) : r * (q + 1) + (xcd - r) * q) + off; }
        const int nig = WGM * nN, gid = wgid / nig, fm = gid * WGM, gsz = (nM - fm) < WGM ? (nM - fm) : WGM;
        u.pm = fm + ((wgid % nig) % gsz); u.pn = (wgid % nig) / gsz; return true;
    }
    __device__ __forceinline__ void a_ready(const Unit&) const {}
    __device__ __forceinline__ void done(const Unit&) const {}
};

template <class Epi, class Sched>
__device__ __forceinline__ void gemm_phase(LAS unsigned char* lds, const Gemm g, const Sched& S, const Epi& E) {
    const int tid = tid_l(), wid = __builtin_amdgcn_readfirstlane(tid >> 6), lane = tid & 63, wr = wid >> 2, wc = wid & 3, fr = lane & 15, fq = lane >> 4;
    const int K = g.K, nt = K / BK;
    unsigned voffA[2], voffB[2];
#pragma unroll
    for (int i = 0; i < 2; ++i) { int R, C; stage_rc(tid * 16 + i * 8192, R, C); const int Rb = Epi::PERM ? ((R & ~31) + perm32(R & 31)) : R;
        voffA[i] = (unsigned)(R * K + C) * 2u; voffB[i] = (unsigned)(Rb * K + C) * 2u; }
    const size_t kstep = (size_t)(BK * 2);
    const size_t hstep = (size_t)HALF * K * 2;
    const size_t tstep = 2 * hstep;
    const unsigned ldsw = (unsigned)wid * 1024u;
    const int aoff = lds_byte(wr * 64 + fr, fq * 8), boff = lds_byte(wc * 32 + fr, fq * 8);
    typedef int v8i_t __attribute__((ext_vector_type(8)));
    const int aoff8 = lds_byte(wr * 64 + fr, (fq & 1) * 16) + (fq >> 1) * 1024, boff8 = lds_byte(wc * 32 + fr, (fq & 1) * 16) + (fq >> 1) * 1024;
#define PG8_SA(b, h) (((b) * 2 + (h)) * HTB)
#define PG8_SB(b, h) ((4 + (b) * 2 + (h)) * HTB)
#define PG8_STAGE(bufoff, gbase, voff) do { _Pragma("unroll") for (int _i = 0; _i < 2; ++_i) \
        __builtin_amdgcn_global_load_lds((const GA unsigned*)((const GA char*)(gbase) + (voff)[_i]), (LAS unsigned*)(lds + (bufoff) + ldsw + _i * 8192), 16, 0, 0); } while (0)
#define PG8_LDA(dst, b, h) do { if constexpr (Epi::FP8) { _Pragma("unroll") for (int m = 0; m < 4; ++m) { typedef int v4i_t_ __attribute__((ext_vector_type(4))); const LAS char* p_ = (const LAS char*)(lds + PG8_SA(b, h) + aoff8 + m * 2048); const v4i_t_ lo_ = *(const LAS v4i_t_*)p_, hi_ = *(const LAS v4i_t_*)(p_ + 16); dst##8[m] = __builtin_shufflevector(lo_, hi_, 0, 1, 2, 3, 4, 5, 6, 7); } } \
        else { _Pragma("unroll") for (int m = 0; m < 4; ++m) _Pragma("unroll") for (int k = 0; k < 2; ++k) dst[m][k] = *(const LAS bf16x8*)(lds + PG8_SA(b, h) + aoff + m * 2048 + k * 1024); } } while (0)
#define PG8_LDB(dst, b, h) do { if constexpr (Epi::FP8) { _Pragma("unroll") for (int n = 0; n < 2; ++n) { typedef int v4i_t_ __attribute__((ext_vector_type(4))); const LAS char* p_ = (const LAS char*)(lds + PG8_SB(b, h) + boff8 + n * 2048); const v4i_t_ lo_ = *(const LAS v4i_t_*)p_, hi_ = *(const LAS v4i_t_*)(p_ + 16); dst##8[n] = __builtin_shufflevector(lo_, hi_, 0, 1, 2, 3, 4, 5, 6, 7); } } \
        else { _Pragma("unroll") for (int n = 0; n < 2; ++n) _Pragma("unroll") for (int k = 0; k < 2; ++k) dst[n][k] = *(const LAS bf16x8*)(lds + PG8_SB(b, h) + boff + n * 2048 + k * 1024); } } while (0)
#define PG8_MMA(ai, bj, At, Bt) do { __builtin_amdgcn_s_setprio(1); _Pragma("unroll") for (int m = 0; m < 4; ++m) _Pragma("unroll") for (int n = 0; n < 2; ++n) { \
        if constexpr (Epi::FP8) asm volatile("v_mfma_scale_f32_16x16x128_f8f6f4 %0, %1, %2, %0, %3, %3 op_sel_hi:[0,0,0]" : "+v"(acc[ai][bj][m][n]) : "v"(Bt##8[n]), "v"(At##8[m]), "v"(sc127)); \
        else { _Pragma("unroll") for (int k = 0; k < 2; ++k) acc[ai][bj][m][n] = __builtin_amdgcn_mfma_f32_16x16x32_bf16(Bt[n][k], At[m][k], acc[ai][bj][m][n], 0, 0, 0); } } \
        __builtin_amdgcn_s_setprio(0); } while (0)
#define PG8_WAIT_V(n) asm volatile("s_waitcnt vmcnt(" #n ")" ::: "memory")
#define PG8_WAIT_L(n) asm volatile("s_waitcnt lgkmcnt(" #n ")" ::: "memory")
#define PG8_BAR __builtin_amdgcn_s_barrier()
#define PG8_SCHED __builtin_amdgcn_sched_barrier(0)
    Unit cur, nxt; int ui = 0;
    if (!S.next(0, cur)) return;
    f32x4 acc[2][2][4][2];
#pragma unroll
    for (int a = 0; a < 2; ++a)
#pragma unroll
        for (int b = 0; b < 2; ++b)
#pragma unroll
            for (int m = 0; m < 4; ++m)
#pragma unroll
                for (int n = 0; n < 2; ++n) acc[a][b][m][n] = (f32x4){0.f, 0.f, 0.f, 0.f};
    bf16x8 At[4][2], B0[2][2], B1[2][2]; v8i_t At8[4], B08[2], B18[2]; const int sc127 = 127;
    const GA char* cA = (const GA char*)g.A + (size_t)cur.pm * tstep; const GA char* cB = (const GA char*)g.Bt + (size_t)cur.pn * tstep;
    S.a_ready(cur);
    PG8_STAGE(PG8_SB(0, 0), cB, voffB); PG8_STAGE(PG8_SA(0, 0), cA, voffA); PG8_STAGE(PG8_SB(0, 1), cB + hstep, voffB); PG8_STAGE(PG8_SA(0, 1), cA + hstep, voffA);
    if (wr == 1) PG8_BAR;
    PG8_WAIT_V(4); PG8_BAR;
    PG8_STAGE(PG8_SB(1, 0), cB + kstep, voffB); PG8_STAGE(PG8_SA(1, 0), cA + kstep, voffA); PG8_STAGE(PG8_SB(1, 1), cB + hstep + kstep, voffB);
    PG8_WAIT_V(6); PG8_BAR;
    for (;;) {
        const bool has_next = S.next(ui + 1, nxt);
        const GA char* nA = has_next ? (const GA char*)g.A + (size_t)nxt.pm * tstep : cA; const GA char* nB = has_next ? (const GA char*)g.Bt + (size_t)nxt.pn * tstep : cB;
        for (int t = 0; t < nt; t += 2) {
            const bool last = (t == nt - 2);
            const GA char* a1 = cA + (size_t)(t + 1) * kstep;
            const GA char* a2 = last ? nA : cA + (size_t)(t + 2) * kstep; const GA char* b2 = last ? nB : cB + (size_t)(t + 2) * kstep;
            const GA char* a3 = a2 + kstep; const GA char* b3 = b2 + kstep;
            if (last && has_next) S.a_ready(nxt);
            if constexpr (Epi::MIDK) { if (t > 0 && (t & 7) == 0) E.mid(acc, cur, t >> 3, wr, wc, fr, fq); }
            PG8_LDB(B0, 0, 0); PG8_SCHED; PG8_LDA(At, 0, 0); PG8_STAGE(PG8_SA(1, 1), a1 + hstep, voffA);
            PG8_WAIT_L(8); PG8_BAR; PG8_WAIT_L(0); PG8_MMA(0, 0, At, B0); PG8_BAR; PG8_SCHED;
            PG8_LDB(B1, 0, 1); PG8_STAGE(PG8_SB(0, 0), b2, voffB);
            PG8_BAR; PG8_WAIT_L(0); PG8_MMA(0, 1, At, B1); PG8_BAR;
            PG8_LDA(At, 0, 1); PG8_STAGE(PG8_SA(0, 0), a2, voffA);
            PG8_BAR; PG8_WAIT_L(0); PG8_MMA(1, 0, At, B0); PG8_BAR; PG8_SCHED;
            PG8_STAGE(PG8_SB(0, 1), b2 + hstep, voffB);
            PG8_WAIT_V(6); PG8_BAR; PG8_MMA(1, 1, At, B1); PG8_BAR;
            PG8_LDB(B0, 1, 0); PG8_SCHED; PG8_LDA(At, 1, 0); PG8_STAGE(PG8_SA(0, 1), a2 + hstep, voffA);
            PG8_WAIT_L(8); PG8_BAR; PG8_WAIT_L(0); PG8_MMA(0, 0, At, B0); PG8_BAR; PG8_SCHED;
            PG8_LDB(B1, 1, 1); PG8_STAGE(PG8_SB(1, 0), b3, voffB);
            PG8_BAR; PG8_WAIT_L(0); PG8_MMA(0, 1, At, B1); PG8_BAR;
            PG8_LDA(At, 1, 1); PG8_STAGE(PG8_SA(1, 0), a3, voffA);
            PG8_BAR; PG8_WAIT_L(0); PG8_MMA(1, 0, At, B0); PG8_BAR; PG8_SCHED;
            PG8_STAGE(PG8_SB(1, 1), b3 + hstep, voffB);
            PG8_WAIT_V(6); PG8_BAR; PG8_MMA(1, 1, At, B1); PG8_BAR;
        }
        if constexpr (Epi::FP8) asm volatile("s_nop 15\n\ts_nop 15" ::: "memory");
        E(acc, cur, wr, wc, fr, fq); S.done(cur);
#if defined(DUP) && DUP == 7
        if constexpr (!Epi::MIDK && Epi::PERM) { asm volatile("s_waitcnt vmcnt(0)" ::: "memory"); E(acc, cur, wr, wc, fr, fq); E(acc, cur, wr, wc, fr, fq); }
#endif
        if (!has_next) break;
#pragma unroll
        for (int a = 0; a < 2; ++a)
#pragma unroll
            for (int b = 0; b < 2; ++b)
#pragma unroll
                for (int m = 0; m < 4; ++m)
#pragma unroll
                    for (int n = 0; n < 2; ++n) acc[a][b][m][n] = (f32x4){0.f, 0.f, 0.f, 0.f};
        cur = nxt; cA = nA; cB = nB; ++ui;
    }
    PG8_WAIT_V(0);
    if (wr == 0) PG8_BAR;
    PG8_BAR;
#undef PG8_SA
#undef PG8_SB
#undef PG8_STAGE
#undef PG8_LDA
#undef PG8_LDB
#undef PG8_MMA
#undef PG8_WAIT_V
#undef PG8_WAIT_L
#undef PG8_BAR
#undef PG8_SCHED
}
}

struct Args { const float* in[13]; float* out; unsigned char* ws; int ph_lo, ph_hi; };
struct Frame {
    const GA float* x; const GA float* norm_w; const GA float* w_in; const GA float* fox_b; const GA float* lq1; const GA float* lk1; const GA float* lq2; const GA float* lk2;
    const GA float* subln; const GA float* w_branch; const GA float* w_out; const GA float* rel_bias; const GA float* final_w; GA float* out;
    GA unsigned* ctl; GA bf16_t* WinT; GA bf16_t* WbrT; GA bf16_t* WoutT; GA float* xres; GA bf16_t* xb; GA float* ssq; GA bf16_t* Zs; GA bf16_t* G; GA bf16_t* QKV; GA bf16_t* IQ; GA bf16_t* IK;
    GA float* IW; GA float* FF; GA float* cum; GA float* tb; GA float* sc; GA u64* mask; GA bf16_t* Y; GA bf16_t* MG; GA float* O1; GA float* OD; GA float* LSE; GA float* DP; GA unsigned char* ws;
    LAS unsigned char* lds; volatile LAS unsigned* misc;
};

__device__ __forceinline__ int q_next(GA unsigned* ctr, volatile LAS unsigned* lw) {
    __syncthreads();
    if (threadIdx.x == 0) *lw = __hip_atomic_fetch_add(ctr, 1u, __ATOMIC_RELAXED, __HIP_MEMORY_SCOPE_AGENT);
    __syncthreads();
    return (int)*lw;
}

__device__ __forceinline__ int win_src_col(int n) {
    if (n < 2048) return n;
    if (n < 3072) return n - 2048 + 11776;
    if (n < 4608) return n - 3072 + 14420;
    if (n < 4672) return n - 4608 + 12800;
    if (n < 4688) return n - 4672 + 12864;
    if (n < 4692) return n - 4688 + 14416;
    return -1;
}
__device__ __forceinline__ int win8_src_col(int n) {
    if (n < 8192) return n + 2048;
    if (n < 9728) return n - 8192 + 10240;
    if (n < 11264) return n - 9728 + 12880;
    return n - 11264 + 15956;
}
__device__ __forceinline__ void transpose_tile(const GA float* src, int ld, int srccol4, const GA float* ksc, GA bf16_t* dst, int k0, int n0, LAS float* tile) {
    const int tid = tid_l(), tk = tid >> 5, tn4 = (tid & 31) * 4;
    f32x4 v[4];
#pragma unroll
    for (int i = 0; i < 4; ++i) { const int kk = tk + 16 * i; v[i] = (f32x4){0.f, 0.f, 0.f, 0.f};
        if (srccol4 >= 0) { v[i] = *(const GA f32x4*)(src + (size_t)(k0 + kk) * ld + srccol4); if (ksc) v[i] *= ksc[k0 + kk]; } }
#pragma unroll
    for (int i = 0; i < 4; ++i) { const int kk = tk + 16 * i;
#pragma unroll
        for (int j = 0; j < 4; ++j) tile[kk * 129 + tn4 + j] = v[i][j]; }
    __syncthreads();
    const int wn = tid >> 2, wk = tid & 3;
    float f[16];
#pragma unroll
    for (int j = 0; j < 16; ++j) f[j] = tile[(wk * 16 + j) * 129 + wn];
    u32x4 w0 = {cvt_pk_bf16(f[0], f[1]), cvt_pk_bf16(f[2], f[3]), cvt_pk_bf16(f[4], f[5]), cvt_pk_bf16(f[6], f[7])};
    u32x4 w1 = {cvt_pk_bf16(f[8], f[9]), cvt_pk_bf16(f[10], f[11]), cvt_pk_bf16(f[12], f[13]), cvt_pk_bf16(f[14], f[15])};
    GA u32x4* dp = (GA u32x4*)(dst + (size_t)(n0 + wn) * DM + k0 + wk * 16);
    dp[0] = w0; dp[1] = w1;
    __syncthreads();
}
__device__ __forceinline__ unsigned cvt4_fp8(float a, float b, float c, float d) {
    unsigned w = 0u; w = __builtin_amdgcn_cvt_pk_fp8_f32(a, b, w, false); w = __builtin_amdgcn_cvt_pk_fp8_f32(c, d, w, true); return w;
}
__device__ __forceinline__ void transpose_tile8(const GA float* src, int ld, int srccol4, const GA float* ksc, GA unsigned char* dst, int k0, int n0, LAS float* tile) {
    const int tid = tid_l(), tk = tid >> 5, tn4 = (tid & 31) * 4;
    f32x4 v[4];
#pragma unroll
    for (int i = 0; i < 4; ++i) { const int kk = tk + 16 * i; v[i] = *(const GA f32x4*)(src + (size_t)(k0 + kk) * ld + srccol4) * (ksc[k0 + kk] * W8SCALE); }
#pragma unroll
    for (int i = 0; i < 4; ++i) { const int kk = tk + 16 * i;
#pragma unroll
        for (int j = 0; j < 4; ++j) tile[kk * 129 + tn4 + j] = v[i][j]; }
    __syncthreads();
    const int wn = tid >> 2, wk = tid & 3;
    float f[16];
#pragma unroll
    for (int j = 0; j < 16; ++j) f[j] = tile[(wk * 16 + j) * 129 + wn];
    u32x4 w = {cvt4_fp8(f[0], f[1], f[2], f[3]), cvt4_fp8(f[4], f[5], f[6], f[7]), cvt4_fp8(f[8], f[9], f[10], f[11]), cvt4_fp8(f[12], f[13], f[14], f[15])};
    *(GA u32x4*)(dst + (size_t)(n0 + wn) * DM + k0 + wk * 16) = w;
    __syncthreads();
}
__device__ __forceinline__ int t5_bucket(int d) {
    if (d < 16) return d;
    const int th[15] = {22, 30, 40, 54, 73, 99, 134, 182, 246, 332, 450, 609, 825, 1117, 1513};
    int b = 16;
#pragma unroll
    for (int i = 0; i < 15; ++i) b += (d >= th[i]) ? 1 : 0;
    return b;
}
constexpr int WT_TW = 32 * 38, WT_TG = 32 * 100, WT_TB = 32 * 16, WT_TL = WT_TW + WT_TG + 2 * WT_TB;
__device__ __forceinline__ void weight_tile(const Frame& F, int l, int r, LAS float* tile) {
    const int tid = tid_l();
    if (r < WT_TW) { const int nt = r % 38, kt = r / 38; const int n = nt * 128 + (tid & 31) * 4;
        transpose_tile(F.w_in + (size_t)l * DM * NIN, NIN, win_src_col(n), F.norm_w + l * DM, F.WinT + (size_t)l * NINP * DM, kt * 64, nt * 128, tile); }
    else if (r < WT_TW + WT_TG) { const int q = r - WT_TW, nt = q % 100, kt = q / 100;
        transpose_tile8(F.w_in + (size_t)l * DM * NIN, NIN, win8_src_col(nt * 128 + (tid & 31) * 4), F.norm_w + l * DM, F.ws + WS_WG8 + (size_t)l * N8 * DM, kt * 64, nt * 128, tile); }
    else if (r < WT_TW + WT_TG + WT_TB) { const int q = r - WT_TW - WT_TG, nt = q % 16, kt = q / 16;
        transpose_tile(F.w_branch + (size_t)l * DM * DM, DM, nt * 128 + (tid & 31) * 4, (const GA float*)nullptr, F.WbrT + (size_t)l * DM * DM, kt * 64, nt * 128, tile); }
    else { const int q = r - WT_TW - WT_TG - WT_TB, nt = q % 16, kt = q / 16;
        transpose_tile(F.w_out + (size_t)l * DM * DM, DM, nt * 128 + (tid & 31) * 4, (const GA float*)nullptr, F.WoutT + (size_t)l * DM * DM, kt * 64, nt * 128, tile); }
}
__device__ __forceinline__ void p0_prologue(const Frame& F) {
    const int tid = tid_l(), lane = tid & 63, wave = tid >> 6, G = gridDim.x, bid = blockIdx.x;
    LAS float* tile = (LAS float*)F.lds;
    for (int j = bid; j < WT_TW + WT_TG; j += G) weight_tile(F, 0, j, tile);
    for (int row = bid * 8 + wave; row < MT; row += G * 8) {
        const GA float* xr = F.x + (size_t)row * DM; float ss = 0.f;
#pragma unroll
        for (int i = 0; i < 8; ++i) { const int c = (i * 64 + lane) * 4; const f32x4 v = *(const GA f32x4*)(xr + c);
            ss += v[0] * v[0] + v[1] * v[1] + v[2] * v[2] + v[3] * v[3];
            u32x2 w = {cvt_pk_bf16(v[0], v[1]), cvt_pk_bf16(v[2], v[3])}; *(GA u32x2*)(F.xb + (size_t)row * DM + c) = w;
            *(GA unsigned*)(F.ws + WS_XQ + (size_t)row * DM + c) = cvt4_fp8(v[0], v[1], v[2], v[3]); }
        ss = wave_sum(ss);
        if (lane < 32) F.ssq[(size_t)row * 32 + lane] = (lane == 0) ? ss : 0.f;
    }
    if (bid == 0 && tid < DEPTH * 128) { const int l = tid >> 7, i = tid & 127;
        const float lam_init = 0.8f - 0.6f * expf(-0.3f * (float)l);
        F.DP[l * 256 + 128 + i] = F.subln[l * 128 + i] * (1.0f - lam_init);
        if (i == 0) { float s1 = 0.f, s2 = 0.f;
            for (int k = 0; k < 64; ++k) { s1 = fmaf(F.lq1[l * 64 + k], F.lk1[l * 64 + k], s1); s2 = fmaf(F.lq2[l * 64 + k], F.lk2[l * 64 + k], s2); }
            F.DP[l * 256] = expf(s1) - expf(s2) + lam_init; F.DP[l * 256 + 1] = 1.0f - lam_init; } }
    for (int i = bid * 512 + tid; i < 12 * SEQ; i += G * 512) { const int hd = i / SEQ, d = i % SEQ; F.tb[i] = F.rel_bias[t5_bucket(d) * 12 + hd] * LOG2E; }
}

struct EpiIn {
    static constexpr bool PERM = true, AFTER_DRAIN = false, MIDK = false, FP8 = false;
    GA unsigned char* ws;
    template <int KIND>
    __device__ __forceinline__ void body(const f32x4 (&acc)[2][2][4][2], int row0_, int cl_, int fq, GA bf16_t* base, int ldc, float qscale, int headbase) const {
        int row0 = row0_, cl = cl_; asm volatile("" : "+v"(row0), "+v"(cl));
        const GA float* ssq = (const GA float*)(ws + WS_SSQ);
        float scv_[2][4];
#pragma unroll
        for (int ai = 0; ai < 2; ++ai) {
            f32x4 sq_[4][2];
#pragma unroll
            for (int m = 0; m < 4; ++m) { const GA float* sp = ssq + (size_t)(row0 + ai * 128 + m * 16) * 32 + fq * 8;
                sq_[m][0] = *(const GA f32x4*)sp; sq_[m][1] = *(const GA f32x4*)(sp + 4); }
#pragma unroll
            for (int m = 0; m < 4; ++m) { const f32x4 s4 = sq_[m][0] + sq_[m][1];
                float ssum = (s4[0] + s4[1]) + (s4[2] + s4[3]);
                ssum += __shfl_xor(ssum, 16); ssum += __shfl_xor(ssum, 32);
                scv_[ai][m] = __builtin_amdgcn_rsqf(ssum * (1.0f / DM) + RMS_EPS) * qscale; }
            asm volatile("" :: "v"(scv_[ai][0]), "v"(scv_[ai][1]), "v"(scv_[ai][2]), "v"(scv_[ai][3]));
        }
#pragma unroll
        for (int ai = 0; ai < 2; ++ai)
#pragma unroll
            for (int m = 0; m < 4; ++m) {
                const int r = row0 + ai * 128 + m * 16;
                const float sc = scv_[ai][m];
#pragma unroll
                for (int bj = 0; bj < 2; ++bj) {
                    f32x4 v0 = acc[ai][bj][m][0] * sc, v1 = acc[ai][bj][m][1] * sc;
                    if (KIND == 0) {
#pragma unroll
                        for (int j = 0; j < 4; ++j) { v0[j] = v0[j] * sigmoidf_(v0[j]); v1[j] = v1[j] * sigmoidf_(v1[j]); }
                    } else if (KIND == 1) {
#pragma unroll
                        for (int j = 0; j < 4; ++j) { v0[j] = sigmoidf_(v0[j]) * 256.0f; v1[j] = sigmoidf_(v1[j]) * 256.0f; }
                    }
                    if (KIND == 4) {
                        if (bj == 0) {
                            if (cl < 64) { u32x4 w = {cvt_pk_bf16(v0[0], v0[1]), cvt_pk_bf16(v0[2], v0[3]), cvt_pk_bf16(v1[0], v1[1]), cvt_pk_bf16(v1[2], v1[3])};
                                *(GA u32x4*)((GA bf16_t*)(ws + WS_IK) + (size_t)(r >> 5) * 2048 + (cl >> 4) * 512 + (((cl >> 3) & 1) * 32 + (r & 31)) * 8) = w; }
                            else if (cl < 80) { GA float* iw = (GA float*)(ws + WS_IW) + (size_t)r * 16 + (cl - 64); *(GA f32x4*)iw = v0; *(GA f32x4*)(iw + 4) = v1; }
                            else if (cl == 80) { *(GA f32x4*)((GA float*)(ws + WS_FF) + (size_t)r * 4) = v0; }
                        }
                    } else {
                        if (KIND == 1) {
                            u32x2 w;
                            { const unsigned a = __builtin_amdgcn_cvt_pk_u8_f32(v0[0], 0, 0u), b = __builtin_amdgcn_cvt_pk_u8_f32(v0[1], 1, a), c = __builtin_amdgcn_cvt_pk_u8_f32(v0[2], 2, b); w[0] = __builtin_amdgcn_cvt_pk_u8_f32(v0[3], 3, c); }
                            { const unsigned a = __builtin_amdgcn_cvt_pk_u8_f32(v1[0], 0, 0u), b = __builtin_amdgcn_cvt_pk_u8_f32(v1[1], 1, a), c = __builtin_amdgcn_cvt_pk_u8_f32(v1[2], 2, b); w[1] = __builtin_amdgcn_cvt_pk_u8_f32(v1[3], 3, c); }
                            *(GA u32x2*)((GA unsigned char*)base + (size_t)r * ldc + bj * 128 + cl) = w;
                            continue;
                        }
                        GA bf16_t* dst;
                        if (KIND == 2) { const int b = r >> 13, s = r & (SEQ - 1); dst = base + ((size_t)(b * 4 + headbase + bj) * SEQ + s) * 128 + cl; }
                        else dst = base + (size_t)r * ldc + bj * 128 + cl;
                        u32x4 w = {cvt_pk_bf16(v0[0], v0[1]), cvt_pk_bf16(v0[2], v0[3]), cvt_pk_bf16(v1[0], v1[1]), cvt_pk_bf16(v1[2], v1[3])};
                        *(GA u32x4*)dst = w;
                    }
                }
            }
    }
    __device__ __forceinline__ void operator()(const f32x4 (&acc)[2][2][4][2], const pg8::Unit& u, int wr, int wc, int fr, int fq) const {
        const int row0 = u.pm * 256 + wr * 64 + fr, pn = u.pn, cl = wc * 32 + 8 * fq;
        if (pn < 8) body<0>(acc, row0, cl, fq, (GA bf16_t*)(ws + WS_ZS) + pn * 256, DM, 1.f, 0);
        else if (pn < 12) body<3>(acc, row0, cl, fq, (GA bf16_t*)(ws + WS_IQ) + (pn - 8) * 256, 1024, 1.f, 0);
        else if (pn < 18) { const int t6 = pn - 12, which = t6 >> 1;
            body<2>(acc, row0, cl, fq, (GA bf16_t*)(ws + WS_QKV) + (size_t)(2 * 3 + which) * QS, 0, (which == 0) ? QSC64 : 1.f, (t6 & 1) * 2); }
        else body<4>(acc, row0, cl, fq, (GA bf16_t*)nullptr, 0, 1.f, 0);
    }
};

struct EpiGate {
    static constexpr bool PERM = true, AFTER_DRAIN = false, MIDK = false, FP8 = true;
    GA unsigned char* ws;
    __device__ __forceinline__ void operator()(const f32x4 (&acc)[2][2][4][2], const pg8::Unit& u, int wr, int wc, int fr, int fq) const {
        const int row0 = u.pm * 256 + wr * 64 + fr, cl = wc * 32 + 8 * fq, pn = u.pn;
        EpiIn e{ws};
        if (pn < 32) e.body<1>(acc, row0, cl, fq, (GA bf16_t*)(ws + WS_G + pn * 256), 8192, 1.0f / W8SCALE, 0);
        else { const int q = pn - 32, mixer = (q < 6) ? 0 : (q < 12 ? 1 : 3), t6 = q % 6, which = t6 >> 1;
            e.body<2>(acc, row0, cl, fq, (GA bf16_t*)(ws + WS_QKV) + (size_t)(mixer * 3 + which) * QS, 0, ((which == 0) ? QSC128 : 1.f) * (1.0f / W8SCALE), (t6 & 1) * 2); }
    }
};

__device__ __forceinline__ void fox_scan(const Frame& F, int layer, int seqid) {
    const int tid = tid_l(), lane = tid & 63, wave = tid >> 6, b = seqid >> 2, h = seqid & 3;
    LAS float* sm = (LAS float*)F.lds;
    const float bias = F.fox_b[layer * 4 + h];
    float v[16]; float run = 0.f;
#pragma unroll
    for (int i = 0; i < 16; ++i) { const int s = tid * 16 + i; const float x = F.FF[(size_t)(b * SEQ + s) * 4 + h] + bias;
        const float ls = fminf(x, 0.f) - log1pf(expf(-fabsf(x))); run += ls; v[i] = run; }
    float incl = run;
#pragma unroll
    for (int o = 1; o < 64; o <<= 1) { const float t = __shfl_up(incl, o); if (lane >= o) incl += t; }
    if (lane == 63) sm[wave] = incl;
    __syncthreads();
    float woff = 0.f;
    for (int w = 0; w < wave; ++w) woff += sm[w];
    const float excl = woff + incl - run;
#pragma unroll
    for (int i = 0; i < 16; ++i) F.cum[(size_t)(b * 4 + h) * SEQ + tid * 16 + i] = (excl + v[i]) * LOG2E;
    __syncthreads();
}
__device__ __forceinline__ void fox_kmax(const Frame& F, int layer) {
    const int tid = tid_l(), lane = tid & 63, wave = tid >> 6, G = gridDim.x, bid = blockIdx.x;
    const GA bf16_t* Kf = F.QKV + (size_t)(1 * 3 + 1) * QS;
    LAS float* sm = (LAS float*)F.lds;
    const int bh = bid & 7, part = bid >> 3, nparts = (G + 7 - bh) / 8;
    float mx = 0.f;
    for (int r4 = part * 8 + wave; r4 < SEQ / 4; r4 += nparts * 8) {
        const u32x4 w = *(const GA u32x4*)(Kf + ((size_t)bh * SEQ + r4 * 4 + (lane >> 4)) * 128 + (lane & 15) * 8); float ss = 0.f;
#pragma unroll
        for (int j = 0; j < 4; ++j) { const float a = bf_lo(w[j]), b = bf_hi(w[j]); ss = fmaf(a, a, ss); ss = fmaf(b, b, ss); }
        ss += __shfl_xor(ss, 1); ss += __shfl_xor(ss, 2); ss += __shfl_xor(ss, 4); ss += __shfl_xor(ss, 8);
        mx = fmaxf(mx, ss); }
#pragma unroll
    for (int o = 32; o > 0; o >>= 1) mx = fmaxf(mx, __shfl_xor(mx, o));
    __syncthreads();
    if (lane == 0) sm[wave] = mx;
    __syncthreads();
    if (tid == 0) { float m8 = sm[0];
#pragma unroll
        for (int w = 1; w < 8; ++w) m8 = fmaxf(m8, sm[w]);
        __hip_atomic_fetch_max(F.ctl + CW_KM + layer * 8 + bh, __float_as_uint(m8), __ATOMIC_RELAXED, __HIP_MEMORY_SCOPE_AGENT); }
    __syncthreads();
}
__device__ __forceinline__ void idx_unit(const Frame& F, int unit) {
    const int b = unit / 576; int id = unit % 576; int g = 0;
    while (8 * (g + 1) * (g + 2) <= id) ++g;
    const int rem = id - 8 * g * (g + 1), qb = 16 * g + rem / (g + 1), kc = rem % (g + 1);
    const int tid = tid_l(), lane = tid & 63, wave = __builtin_amdgcn_readfirstlane(tid >> 6), n32 = lane & 31, hi = lane >> 5;
    const int tq0 = qb * 64 + wave * 8;
    const int qa = (n32 >> 2) & 1, ha = (n32 & 3) + 4 * (n32 >> 3);
    bf16x8 Af[4][4]; float wr_[4][16];
#pragma unroll
    for (int p = 0; p < 4; ++p) {
        const GA bf16_t* qp = F.IQ + (size_t)(b * SEQ + tq0 + 2 * p + qa) * 1024 + ha * 64 + hi * 8;
#pragma unroll
        for (int ks = 0; ks < 4; ++ks) Af[p][ks] = *(const GA bf16x8*)(qp + ks * 16);
        const GA float* wp = F.IW + (size_t)(b * SEQ + tq0 + 2 * p + hi) * 16;
#pragma unroll
        for (int q4 = 0; q4 < 4; ++q4) { const f32x4 w4 = *(const GA f32x4*)(wp + 4 * q4); wr_[p][4 * q4] = w4[0]; wr_[p][4 * q4 + 1] = w4[1]; wr_[p][4 * q4 + 2] = w4[2]; wr_[p][4 * q4 + 3] = w4[3]; }
    }
    const int smax = tq0 + 7;
    int nj = (smax - kc * 1024) / 32 + 1; nj = nj > 32 ? 32 : nj;
    const GA bf16_t* kp0 = F.IK + (size_t)(b * SEQ + kc * 1024 + n32) * 64 + hi * 8;
    GA float* sp0 = F.sc + ((size_t)(b * SEQ + tq0 + hi)) * SEQ + kc * 1024 + n32;
    bf16x8 Bn[4];
#pragma unroll
    for (int ks = 0; ks < 4; ++ks) Bn[ks] = *(const GA bf16x8*)(kp0 + ks * 16);
    for (int j = 0; j < nj; ++j) {
        bf16x8 Bf[4];
#pragma unroll
        for (int ks = 0; ks < 4; ++ks) Bf[ks] = Bn[ks];
        if (j + 1 < nj) {
#pragma unroll
            for (int ks = 0; ks < 4; ++ks) Bn[ks] = *(const GA bf16x8*)(kp0 + (size_t)(j + 1) * 32 * 64 + ks * 16);
        }
#pragma unroll
        for (int p = 0; p < 4; ++p) {
            f32x16 c = {};
#pragma unroll
            for (int ks = 0; ks < 4; ++ks) c = __builtin_amdgcn_mfma_f32_32x32x16_bf16(Af[p][ks], Bf[ks], c, 0, 0, 0);
            float sc = 0.f;
#pragma unroll
            for (int r = 0; r < 16; ++r) sc = fmaf(wr_[p][r], fmaxf(c[r], 0.f), sc);
            sp0[(size_t)(2 * p) * SEQ + j * 32] = sc;
        }
    }
}

__device__ __forceinline__ unsigned sel_key(float f) { const unsigned u = __float_as_uint(f == 0.f ? 0.f : f); return (u >> 31) ? ~u : (u | 0x80000000u); }
__device__ __forceinline__ int wave_sum_i(int v) {
#pragma unroll
    for (int o = 32; o > 0; o >>= 1) v += __shfl_xor(v, o);
    return v;
}
__device__ __forceinline__ void select_row(const Frame& F, int row_) {
    const int row = __builtin_amdgcn_readfirstlane(row_);
    const int lane = tid_l() & 63, t = row & (SEQ - 1);
    GA u64* mrow = F.mask + (size_t)row * 128;
    if (t < 256) {
#pragma unroll
        for (int half = 0; half < 2; ++half) { const int j = half * 64 + lane; const int lo = j * 64; u64 w = 0ull;
            if (t >= lo + 63) w = ~0ull; else if (t >= lo) w = (~0ull) >> (63 - (t - lo));
            mrow[j] = w; }
        return;
    }
    const GA float* srow = F.sc + (size_t)row * SEQ + lane;
    const int nj = (t >> 6) + 1;
    unsigned key[128];
#pragma unroll
    for (int jj = 0; jj < 4; ++jj) {
        if (jj * 32 < nj) {
#pragma unroll
            for (int j = jj * 32; j < jj * 32 + 32; ++j) key[j] = __float_as_uint(srow[j * 64]);
        }
    }
#pragma unroll
    for (int jj = 0; jj < 4; ++jj) {
        if (jj * 32 < nj) {
#pragma unroll
            for (int j = jj * 32; j < jj * 32 + 32; ++j) key[j] = (j * 64 + lane <= t) ? sel_key(__uint_as_float(key[j])) : 0u;
        } else {
#pragma unroll
            for (int j = jj * 32; j < jj * 32 + 32; ++j) key[j] = 0u;
        }
    }
#define CNT8(j0) do { u64 b0 = __ballot(key[(j0)] >= cand), b1 = __ballot(key[(j0) + 1] >= cand), b2 = __ballot(key[(j0) + 2] >= cand), b3 = __ballot(key[(j0) + 3] >= cand), \
        b4 = __ballot(key[(j0) + 4] >= cand), b5 = __ballot(key[(j0) + 5] >= cand), b6 = __ballot(key[(j0) + 6] >= cand), b7 = __ballot(key[(j0) + 7] >= cand); \
        asm volatile("" : "+s"(b0), "+s"(b1), "+s"(b2), "+s"(b3), "+s"(b4), "+s"(b5), "+s"(b6), "+s"(b7)); \
        c += (__popcll(b0) + __popcll(b1)) + (__popcll(b2) + __popcll(b3)) + (__popcll(b4) + __popcll(b5)) + (__popcll(b6) + __popcll(b7)); } while (0)
#define COUNT_GE() do { c = 0; _Pragma("unroll") for (int jj = 0; jj < 4; ++jj) { if (jj * 32 < nj) { CNT8(jj * 32); CNT8(jj * 32 + 8); CNT8(jj * 32 + 16); CNT8(jj * 32 + 24); } } } while (0)
    unsigned mx = 0u;
#pragma unroll
    for (int j = 0; j < 128; ++j) mx = key[j] > mx ? key[j] : mx;
#pragma unroll
    for (int o = 32; o > 0; o >>= 1) { const unsigned t2 = (unsigned)__shfl_xor((int)mx, o); mx = t2 > mx ? t2 : mx; }
    unsigned prefix = 0u; int cge = 1 << 30, c, bit = 31;
    { const unsigned e9 = mx >> 23;
      for (unsigned k = 0; k < 6u && k <= e9; ++k) { const unsigned cand = (e9 - k) << 23; COUNT_GE();
          if (c >= 256) { prefix = cand; cge = c; bit = 22; break; } } }
    if (cge != 256) {
        for (; bit >= 0; --bit) {
            const unsigned cand = prefix | (1u << bit); COUNT_GE();
            if (c >= 256) { prefix = cand; cge = c; if (c == 256) break; }
        }
    }
#undef CNT8
#undef COUNT_GE
    if (cge == 256) {
        unsigned w0l = 0u, w0h = 0u, w1l = 0u, w1h = 0u;
#pragma unroll
        for (int j = 0; j < 64; ++j) { const u64 word = __ballot(key[j] >= prefix);
            asm volatile("s_nop 1\n\tv_writelane_b32 %0, %1, %2" : "+v"(w0l) : "s"((unsigned)word), "n"(j)); asm volatile("v_writelane_b32 %0, %1, %2" : "+v"(w0h) : "s"((unsigned)(word >> 32)), "n"(j)); }
        if (nj > 64) {
#pragma unroll
            for (int j = 64; j < 128; ++j) { const u64 word = __ballot(key[j] >= prefix);
                asm volatile("s_nop 1\n\tv_writelane_b32 %0, %1, %2" : "+v"(w1l) : "s"((unsigned)word), "n"(j - 64)); asm volatile("v_writelane_b32 %0, %1, %2" : "+v"(w1h) : "s"((unsigned)(word >> 32)), "n"(j - 64)); }
        }
        mrow[lane] = ((u64)w0h << 32) | w0l; mrow[64 + lane] = ((u64)w1h << 32) | w1l;
    } else {
        int cgt = 0;
        for (int j = 0; j < nj; ++j) { const int s = j * 64 + lane; const float v_ = srow[j * 64]; const unsigned k = (s <= t) ? sel_key(v_) : 0u; cgt += __popcll(__ballot(k > prefix)); }
        int need = 256 - cgt;
        for (int j = 0; j < nj; ++j) { const int s = j * 64 + lane; const float v_ = srow[j * 64]; const unsigned k = (s <= t) ? sel_key(v_) : 0u;
            u64 word = __ballot(k > prefix); u64 tm = __ballot(k == prefix);
            if (tm != 0ull && need > 0) { const int c = __popcll(tm);
                if (c <= need) { word |= tm; need -= c; }
                else { u64 selb = 0ull; for (int i = 0; i < need; ++i) { const u64 low = tm & (~tm + 1ull); selb |= low; tm ^= low; } word |= selb; need = 0; } }
            if (lane == 0) mrow[j] = word; }
        for (int j = nj + lane; j < 128; j += 64) mrow[j] = 0ull;
    }
}

#if defined(TPROBE)
#define IS_T0(k) do { if ((k) == TPROBE) is_t0 = __builtin_amdgcn_s_memrealtime(); } while (0)
#define IS_T1(k) do { if ((k) == TPROBE) tpacc += __builtin_amdgcn_s_memrealtime() - is_t0; } while (0)
#else
#define IS_T0(k) do { } while (0)
#define IS_T1(k) do { } while (0)
#endif
__device__ __forceinline__ void idxsel_unit(const Frame& F, int unit, unsigned long long& tpacc) {
    unsigned long long is_t0 = 0ull; (void)is_t0;
    const int b = unit & 1, t0 = (SEQ / 8 - 1 - (unit >> 1)) * 8;
    const int tid = tid_l(), lane = tid & 63, wave = __builtin_amdgcn_readfirstlane(tid >> 6), n32 = lane & 31, hi = lane >> 5;
    LAS unsigned short* S = (LAS unsigned short*)F.lds;
    IS_T0(30);
    {
        const int qa = (n32 >> 2) & 1, ha = (n32 & 3) + 4 * (n32 >> 3);
        typedef float f32x2_ __attribute__((ext_vector_type(2)));
        bf16x8 Af[4][4]; f32x2_ wr2[4][8];
#pragma unroll
        for (int p = 0; p < 4; ++p) {
            const GA bf16_t* qp = F.IQ + (size_t)(b * SEQ + t0 + 2 * p + qa) * 1024 + ha * 64 + hi * 8;
#pragma unroll
            for (int ks = 0; ks < 4; ++ks) Af[p][ks] = *(const GA bf16x8*)(qp + ks * 16);
            const GA float* wp = F.IW + (size_t)(b * SEQ + t0 + 2 * p + hi) * 16;
#pragma unroll
            for (int q4 = 0; q4 < 4; ++q4) { const f32x4 w4 = *(const GA f32x4*)(wp + 4 * q4); wr2[p][2 * q4] = (f32x2_){w4[0], w4[1]}; wr2[p][2 * q4 + 1] = (f32x2_){w4[2], w4[3]}; }
        }
        asm volatile("s_waitcnt vmcnt(0)" ::: "memory"); IS_T1(30); IS_T0(31);
        const int ntile = (t0 + 7) / 32 + 1;
        const GA bf16_t* kp0 = F.IK + (size_t)b * SEQ * 64 + lane * 8;
        bf16x8 Bn[4];
        if (wave < ntile) {
#pragma unroll
            for (int ks = 0; ks < 4; ++ks) Bn[ks] = *(const GA bf16x8*)(kp0 + (size_t)wave * 2048 + ks * 512);
        }
        for (int j = wave; j < ntile; j += 8) {
            bf16x8 Bf[4];
#pragma unroll
            for (int ks = 0; ks < 4; ++ks) Bf[ks] = Bn[ks];
            if (j + 8 < ntile) {
#pragma unroll
                for (int ks = 0; ks < 4; ++ks) Bn[ks] = *(const GA bf16x8*)(kp0 + (size_t)(j + 8) * 2048 + ks * 512);
            }
            const int s = j * 32 + n32;
            LAS unsigned short* sp = S + ((s >> 7) * 64 + (s & 63)) * 2 + ((s >> 6) & 1);
#define IDX_MM(C, p) do { C = f32x16{}; _Pragma("unroll") for (int ks = 0; ks < 4; ++ks) C = __builtin_amdgcn_mfma_f32_32x32x16_bf16(Af[p][ks], Bf[ks], C, 0, 0, 0); } while (0)
#define IDX_RED(C, p) do { f32x2_ s2 = {0.f, 0.f}; _Pragma("unroll") for (int r2 = 0; r2 < 8; ++r2) { \
                    const float f0 = C[2 * r2], f1 = C[2 * r2 + 1]; const int i0 = __float_as_int(f0), i1 = __float_as_int(f1); \
                    const f32x2_ x2 = {__int_as_float(i0 > 0 ? i0 : 0), __int_as_float(i1 > 0 ? i1 : 0)}; s2 = __builtin_elementwise_fma(wr2[p][r2], x2, s2); } \
                float sc = s2[0] + s2[1]; sc = fminf(fmaxf(sc, -65504.f), 65504.f);       \
                sp[(2 * (p) + hi) * 8192] = __builtin_bit_cast(unsigned short, (_Float16)sc); } while (0)
            f32x16 c0, c1;
            IDX_MM(c0, 0); IDX_MM(c1, 1); __builtin_amdgcn_sched_barrier(0);
            IDX_RED(c0, 0); __builtin_amdgcn_sched_barrier(0); IDX_MM(c0, 2); __builtin_amdgcn_sched_barrier(0);
            IDX_RED(c1, 1); __builtin_amdgcn_sched_barrier(0); IDX_MM(c1, 3); __builtin_amdgcn_sched_barrier(0);
            IDX_RED(c0, 2); IDX_RED(c1, 3);
#undef IDX_MM
#undef IDX_RED
        }
    }
    IS_T1(31); IS_T0(32);
    __syncthreads();
    IS_T1(32);
    {
        const int t = t0 + wave;
        GA u64* mrow = F.mask + (size_t)(b * SEQ + t) * 128;
        if (t < 256) {
#pragma unroll
            for (int half = 0; half < 2; ++half) { const int jw = half * 64 + lane; const int lo = jw * 64; u64 w = 0ull;
                if (t >= lo + 63) w = ~0ull; else if (t >= lo) w = (~0ull) >> (63 - (t - lo));
                mrow[jw] = w; }
        } else {
            const LAS unsigned* row = (const LAS unsigned*)(S + wave * 8192) + lane;
            const int nj = (t >> 7) + 1;
            unsigned kw[64];
            IS_T0(33);
            { LAS unsigned short* rw = S + wave * 8192; const int sa = 128 * (nj - 1) + lane, sb = sa + 64;
              if (sa > t) rw[((sa >> 7) * 64 + (sa & 63)) * 2] = (unsigned short)0xffffu;
              if (sb > t) rw[((sb >> 7) * 64 + (sb & 63)) * 2 + 1] = (unsigned short)0xffffu;
              asm volatile("" ::: "memory"); }
#pragma unroll
            for (int jj = 0; jj < 4; ++jj) {
                if (jj * 16 < nj) {
#pragma unroll
                    for (int j = jj * 16; j < jj * 16 + 16; ++j) { unsigned w = row[j * 64];
                        const unsigned sg = ((w >> 15) & 0x00010001u) * 0xffffu;
                        w ^= (sg | 0x80008000u);
                        kw[j] = (j < nj) ? w : 0u; }
                } else {
#pragma unroll
                    for (int j = jj * 16; j < jj * 16 + 16; ++j) kw[j] = 0u;
                }
            }
#define CNT1(j) asm volatile("v_pk_sub_u16 %1, %2, %3 clamp\n\tv_pk_min_u16 %1, %1, %4\n\tv_pk_add_u16 %0, %0, %1" : "+v"(acc2), "=&v"(tmp2) : "v"(kw[(j)]), "v"(cm2), "v"(one2))
#define COUNT_GE16(cand) do { const unsigned cm2 = (((cand) - 1u) & 0xffffu) * 0x00010001u, one2 = 0x00010001u; unsigned acc2 = 0u, tmp2; \
            _Pragma("unroll") for (int jj = 0; jj < 4; ++jj) { if (jj * 16 < nj) { _Pragma("unroll") for (int j = jj * 16; j < jj * 16 + 16; ++j) CNT1(j); } } \
            int v_ = (int)((acc2 & 0xffffu) + (acc2 >> 16));                                                                                            \
            v_ += __builtin_amdgcn_update_dpp(0, v_, 0x111, 0xf, 0xf, true); v_ += __builtin_amdgcn_update_dpp(0, v_, 0x112, 0xf, 0xf, true);            \
            v_ += __builtin_amdgcn_update_dpp(0, v_, 0x114, 0xf, 0xf, true); v_ += __builtin_amdgcn_update_dpp(0, v_, 0x118, 0xf, 0xf, true);            \
            v_ += __builtin_amdgcn_update_dpp(0, v_, 0x142, 0xa, 0xf, true); v_ += __builtin_amdgcn_update_dpp(0, v_, 0x143, 0xc, 0xf, true);            \
            c = __builtin_amdgcn_readlane(v_, 63); } while (0)
            IS_T1(33); IS_T0(34);
            unsigned prefix = 0u; int cge = 1 << 30, c, bit = 15;
            { unsigned mx = 0u;
#pragma unroll
              for (int j = 0; j < 64; ++j) asm("v_pk_max_u16 %0, %0, %1" : "+v"(mx) : "v"(kw[j]));
              mx = (mx & 0xffffu) > (mx >> 16) ? (mx & 0xffffu) : (mx >> 16);
#pragma unroll
              for (int o = 32; o > 0; o >>= 1) { const unsigned t2 = (unsigned)__shfl_xor((int)mx, o); mx = t2 > mx ? t2 : mx; }
              const unsigned e6 = (unsigned)__builtin_amdgcn_readfirstlane((int)mx) >> 10;
              for (unsigned k = 0; k < 5u && k <= e6; ++k) { const unsigned cand = (e6 - k) << 10; COUNT_GE16(cand);
                  if (c >= 256) { prefix = cand; cge = c; bit = 9; break; } } }
            if (cge != 256) {
                for (; bit >= 0; --bit) {
                    const unsigned cand = prefix | (1u << bit); COUNT_GE16(cand);
                    if (c >= 256) { prefix = cand; cge = c; if (c == 256) break; }
                }
            }
#undef CNT1
#undef COUNT_GE16
            IS_T1(34); IS_T0(35);
            unsigned w0l = 0u, w0h = 0u, w1l = 0u, w1h = 0u;
            const unsigned short pl16 = (unsigned short)prefix; const unsigned ph16 = prefix << 16;
            if (cge == 256) {
#pragma unroll
                for (int j = 0; j < 32; ++j) { const u64 wa = __ballot((unsigned short)kw[j] >= pl16), wb = __ballot(kw[j] >= ph16);
                    asm volatile("s_nop 1\n\tv_writelane_b32 %0, %1, %2" : "+v"(w0l) : "s"((unsigned)wa), "n"(2 * j)); asm volatile("v_writelane_b32 %0, %1, %2" : "+v"(w0h) : "s"((unsigned)(wa >> 32)), "n"(2 * j));
                    asm volatile("s_nop 1\n\tv_writelane_b32 %0, %1, %2" : "+v"(w0l) : "s"((unsigned)wb), "n"(2 * j + 1)); asm volatile("v_writelane_b32 %0, %1, %2" : "+v"(w0h) : "s"((unsigned)(wb >> 32)), "n"(2 * j + 1)); }
                if (nj > 32) {
#pragma unroll
                    for (int j = 32; j < 64; ++j) { const u64 wa = __ballot((unsigned short)kw[j] >= pl16), wb = __ballot(kw[j] >= ph16);
                        asm volatile("s_nop 1\n\tv_writelane_b32 %0, %1, %2" : "+v"(w1l) : "s"((unsigned)wa), "n"(2 * j - 64)); asm volatile("v_writelane_b32 %0, %1, %2" : "+v"(w1h) : "s"((unsigned)(wa >> 32)), "n"(2 * j - 64));
                        asm volatile("s_nop 1\n\tv_writelane_b32 %0, %1, %2" : "+v"(w1l) : "s"((unsigned)wb), "n"(2 * j - 63)); asm volatile("v_writelane_b32 %0, %1, %2" : "+v"(w1h) : "s"((unsigned)(wb >> 32)), "n"(2 * j - 63)); }
                }
            } else {
                int cgt = 0;
#pragma unroll
                for (int j = 0; j < 64; ++j) cgt += __popcll(__ballot((unsigned short)kw[j] > pl16)) + __popcll(__ballot((kw[j] >> 16) > prefix));
                int need = 256 - cgt;
#define TIE_WORD(GT, EQ, SETL, SETH, LN) do { u64 word = (GT); u64 tm = (EQ);                                                          \
                    if (tm != 0ull && need > 0) { const int ce = __popcll(tm);                                                       \
                        if (ce <= need) { word |= tm; need -= ce; }                                                                  \
                        else { u64 selb = 0ull; for (int i = 0; i < need; ++i) { const u64 low = tm & (~tm + 1ull); selb |= low; tm ^= low; } word |= selb; need = 0; } } \
                    asm volatile("s_nop 1\n\tv_writelane_b32 %0, %1, %2" : "+v"(SETL) : "s"((unsigned)word), "n"(LN)); asm volatile("v_writelane_b32 %0, %1, %2" : "+v"(SETH) : "s"((unsigned)(word >> 32)), "n"(LN)); } while (0)
#pragma unroll
                for (int j = 0; j < 32; ++j) {
                    TIE_WORD(__ballot((unsigned short)kw[j] > pl16), __ballot((unsigned short)kw[j] == pl16), w0l, w0h, 2 * j);
                    TIE_WORD(__ballot((kw[j] >> 16) > prefix), __ballot((kw[j] >> 16) == prefix), w0l, w0h, 2 * j + 1); }
#pragma unroll
                for (int j = 32; j < 64; ++j) {
                    TIE_WORD(__ballot((unsigned short)kw[j] > pl16), __ballot((unsigned short)kw[j] == pl16), w1l, w1h, 2 * j - 64);
                    TIE_WORD(__ballot((kw[j] >> 16) > prefix), __ballot((kw[j] >> 16) == prefix), w1l, w1h, 2 * j - 63); }
#undef TIE_WORD
            }
            mrow[lane] = ((u64)w0h << 32) | w0l; mrow[64 + lane] = ((u64)w1h << 32) | w1l;
            IS_T1(35);
        }
    }
}

namespace att {
typedef short s16x4 __attribute__((ext_vector_type(4)));
constexpr int D = 128, NW = 8, QBLK = 32, KVBLK = 64, QB = NW * QBLK;
constexpr int SHM_V = KVBLK * D * 2, SHM_K = KVBLK * D * 2;
constexpr int L_WS = 2 * SHM_V + 2 * SHM_K;
constexpr int L_AUX = L_WS + NW * 64 * 4;
constexpr int TB_PAD = 320, TB_N = TB_PAD + 1984;
constexpr int L_FLG = L_AUX + 8192 * 4;
constexpr int L_END = L_FLG + 64;
constexpr float SKIP_MARGIN = 40.f;
constexpr float THR2 = 11.5f;
constexpr int FAR_DIST = 1513;

#define KSWZ(row, colB) ((row) * 256 + ((colB) ^ (((row) & 7) << 4)))
#define SBAR() __builtin_amdgcn_sched_barrier(0)
__device__ __forceinline__ int v_st(int k, int c) { const int kk = (k & ~0xC) | ((k & 4) << 1) | ((k & 8) >> 1); return ((kk >> 3) * 4 + (c >> 5)) * 512 + ((kk & 7) * 32 + (c & 31)) * 2; }
__device__ __forceinline__ int v_rd_base(int lane) { return ((lane & 3) << 3) | (((lane >> 2) & 3) << 6) | (((lane >> 4) & 1) << 5) | (((lane >> 5) & 1) << 8); }
constexpr int v_rd_off(int d0, int ks, int half) { return d0 * 512 + ks * 4096 + half * 2048; }
__device__ __forceinline__ int crow(int r, int hi) { return (r & 3) + 8 * (r >> 2) + 4 * hi; }
__device__ __forceinline__ bf16x8 load8(const GA bf16_t* p) { return *(const GA bf16x8*)p; }

__device__ __forceinline__ void mask_tile(f32x16& p0, f32x16& p1, int dq, unsigned W) {
    const float NEG = -__builtin_inff();
#pragma unroll
    for (int r = 0; r < 16; ++r) {
        const int c = (r & 3) + 8 * (r >> 2);
        if ((unsigned)(dq - c) >= W) p0[r] = NEG;
        if ((unsigned)(dq - c - 32) >= W) p1[r] = NEG;
    }
}
__device__ __forceinline__ void mask_bits(f32x16& p0, f32x16& p1, u64 w, int hi) {
    const float NEG = -__builtin_inff();
    unsigned w0 = (unsigned)w, w1 = (unsigned)(w >> 32);
    if (hi == 0) { w0 <<= 4; w1 <<= 4; }
#define MB4(W, P, g) do { u64 c0_, c1_, c2_, c3_; asm volatile(                          \
        "v_add_co_u32 %[w], %[c0], %[w], %[w]\n\tv_add_co_u32 %[w], %[c1], %[w], %[w]\n\t"                     \
        "v_add_co_u32 %[w], %[c2], %[w], %[w]\n\tv_add_co_u32 %[w], %[c3], %[w], %[w]\n\t"                     \
        "v_cndmask_b32 %[e3], %[neg], %[e3], %[c0]\n\tv_cndmask_b32 %[e2], %[neg], %[e2], %[c1]\n\t"           \
        "v_cndmask_b32 %[e1], %[neg], %[e1], %[c2]\n\tv_cndmask_b32 %[e0], %[neg], %[e0], %[c3]"               \
        : [w] "+v"(W), [e0] "+v"(P[4 * (g)]), [e1] "+v"(P[4 * (g) + 1]), [e2] "+v"(P[4 * (g) + 2]), [e3] "+v"(P[4 * (g) + 3]),         \
          [c0] "=&s"(c0_), [c1] "=&s"(c1_), [c2] "=&s"(c2_), [c3] "=&s"(c3_) : [neg] "v"(NEG)); } while (0)
    MB4(w0, p0, 3); MB4(w1, p1, 3); w0 <<= 4; w1 <<= 4;
    MB4(w0, p0, 2); MB4(w1, p1, 2); w0 <<= 4; w1 <<= 4;
    MB4(w0, p0, 1); MB4(w1, p1, 1); w0 <<= 4; w1 <<= 4;
    MB4(w0, p0, 0); MB4(w1, p1, 0);
#undef MB4
}
__device__ __forceinline__ void partialSM(f32x16& p0, f32x16& p1, float& m_reg, float& mn, float& alpha, float cb) {
    float pmax = p0[0];
#pragma unroll
    for (int r = 1; r < 16; ++r) pmax = fmaxf(pmax, p0[r]);
#pragma unroll
    for (int r = 0; r < 16; ++r) pmax = fmaxf(pmax, p1[r]);
    { auto rr = __builtin_amdgcn_permlane32_swap(__float_as_uint(pmax), __float_as_uint(pmax), false, false);
      pmax = fmaxf(__uint_as_float(rr[0]), __uint_as_float(rr[1])); }
    pmax += cb;
    if (__builtin_expect(__all((pmax - m_reg) <= THR2), 1)) { mn = m_reg; alpha = 1.f; }
    else { mn = fmaxf(m_reg, pmax); alpha = __builtin_amdgcn_exp2f(m_reg - mn); m_reg = mn; }
    const float sh = mn - cb;
#pragma unroll
    for (int r = 0; r < 16; ++r) p0[r] = p0[r] - sh;
#pragma unroll
    for (int r = 0; r < 16; ++r) p1[r] = p1[r] - sh;
#pragma unroll
    for (int r = 0; r < 16; ++r) p0[r] = __builtin_amdgcn_exp2f(p0[r]);
}
__device__ __forceinline__ void finishSM(f32x16& p0, f32x16& p1, float alpha, float& l_reg, bf16x8& pa0, bf16x8& pa1, bf16x8& pa2, bf16x8& pa3) {
#pragma unroll
    for (int r = 0; r < 16; ++r) p1[r] = __builtin_amdgcn_exp2f(p1[r]);
    float ps = 0;
#pragma unroll
    for (int r = 0; r < 16; ++r) ps += p0[r];
#pragma unroll
    for (int r = 0; r < 16; ++r) ps += p1[r];
    { auto rr = __builtin_amdgcn_permlane32_swap(__float_as_uint(ps), __float_as_uint(ps), false, false);
      ps = __uint_as_float(rr[0]) + __uint_as_float(rr[1]); }
    l_reg = l_reg * alpha + ps;
#define PK4(P, B_, OUT) do { unsigned a0 = cvt_pk_bf16(P[B_+0], P[B_+1]), a1 = cvt_pk_bf16(P[B_+2], P[B_+3]);                          \
        unsigned b0 = cvt_pk_bf16(P[B_+4], P[B_+5]), b1 = cvt_pk_bf16(P[B_+6], P[B_+7]);                                             \
        auto r0 = __builtin_amdgcn_permlane32_swap(a0, b0, false, false); auto r1 = __builtin_amdgcn_permlane32_swap(a1, b1, false, false); \
        u32x4 w = {r0[0], r1[0], r0[1], r1[1]}; OUT = *reinterpret_cast<bf16x8*>(&w); } while (0)
    PK4(p0, 0, pa0); PK4(p0, 8, pa1); PK4(p1, 0, pa2); PK4(p1, 8, pa3);
#undef PK4
}
template <int KB, int NQ>
__device__ __forceinline__ void qkt(f32x16& p0, f32x16& p1, const LAS char* K_lds, int r32, int hi, const bf16x8* qr, int koff) {
    p0 = f32x16{}; p1 = f32x16{};
    const LAS char* kb[4];
#pragma unroll
    for (int dd = 0; dd < 4; ++dd) kb[dd] = K_lds + KB * SHM_K + KSWZ(r32, (dd * 16 + hi * 8) * 2) + koff;
#pragma unroll
    for (int d0 = 0; d0 < NQ; ++d0) { const LAS char* a = kb[d0 & 3] + (d0 >> 2) * 128;
        bf16x8 b0 = *(const LAS bf16x8*)a;
        bf16x8 b1 = *(const LAS bf16x8*)(a + 32 * 256);
        p0 = __builtin_amdgcn_mfma_f32_32x32x16_bf16(b0, qr[d0], p0, 0, 0, 0);
        p1 = __builtin_amdgcn_mfma_f32_32x32x16_bf16(b1, qr[d0], p1, 0, 0, 0); }
}
template <int VB>
__device__ __forceinline__ void pv_tile(f32x16* o, int vb0, bf16x8 pa0, bf16x8 pa1, bf16x8 pa2, bf16x8 pa3) {
#define TRRD(dst, off) asm volatile("ds_read_b64_tr_b16 %0, %1 offset:%2" : "=&v"(dst) : "v"(vb0), "i"(off) : "memory")
#define PV_D0(d0) do { s16x4 l0, l1, l2, l3, h0, h1, h2, h3; constexpr int b_ = VB * SHM_V + v_rd_off(d0, 0, 0); \
        TRRD(l0, b_); TRRD(h0, b_ + 2048); TRRD(l1, b_ + 4096); TRRD(h1, b_ + 6144); TRRD(l2, b_ + 8192); TRRD(h2, b_ + 10240); TRRD(l3, b_ + 12288); TRRD(h3, b_ + 14336); \
        asm volatile("s_waitcnt lgkmcnt(0)" ::: "memory"); SBAR();   \
        o[d0] = __builtin_amdgcn_mfma_f32_32x32x16_bf16(pa0, (bf16x8){l0[0], l0[1], l0[2], l0[3], h0[0], h0[1], h0[2], h0[3]}, o[d0], 0, 0, 0);   \
        o[d0] = __builtin_amdgcn_mfma_f32_32x32x16_bf16(pa1, (bf16x8){l1[0], l1[1], l1[2], l1[3], h1[0], h1[1], h1[2], h1[3]}, o[d0], 0, 0, 0);   \
        o[d0] = __builtin_amdgcn_mfma_f32_32x32x16_bf16(pa2, (bf16x8){l2[0], l2[1], l2[2], l2[3], h2[0], h2[1], h2[2], h2[3]}, o[d0], 0, 0, 0);   \
        o[d0] = __builtin_amdgcn_mfma_f32_32x32x16_bf16(pa3, (bf16x8){l3[0], l3[1], l3[2], l3[3], h3[0], h3[1], h3[2], h3[3]}, o[d0], 0, 0, 0); } while (0)
    PV_D0(0); PV_D0(1); PV_D0(2); PV_D0(3);
#undef PV_D0
#undef TRRD
}
__device__ __forceinline__ void bias_dist(f32x16& p0, f32x16& p1, const LAS char* tbase) {
#pragma unroll
    for (int r = 0; r < 16; ++r) { const int c = (r & 3) + 8 * (r >> 2);
        p0[r] += *(const LAS float*)(tbase + (59 - c) * 4);
        p1[r] += *(const LAS float*)(tbase + (27 - c) * 4); }
}
__device__ __forceinline__ void bias_const(f32x16& p0, f32x16& p1, float c) {
#pragma unroll
    for (int r = 0; r < 16; ++r) { p0[r] += c; p1[r] += c; }
}
__device__ __forceinline__ void bias_key(f32x16& p0, f32x16& p1, const LAS char* kbase) {
#pragma unroll
    for (int g = 0; g < 4; ++g) { const f32x4 a = *(const LAS f32x4*)(kbase + (8 * g) * 4), b = *(const LAS f32x4*)(kbase + (32 + 8 * g) * 4);
#pragma unroll
        for (int q = 0; q < 4; ++q) { p0[4 * g + q] -= a[q]; p1[4 * g + q] -= b[q]; } }
}

struct Blk { const GA bf16_t* Q; const GA bf16_t* K; const GA bf16_t* V; int P0; int rs; };
struct Aux { const GA float* tb; int dscale; const GA float* cum; const GA u64* mrow0; float kmax; };

__device__ __forceinline__ int swa_jlo(int P0, int W) { const int lowk = P0 - W + 1; return lowk > 0 ? lowk / KVBLK : 0; }

template <int MODE, int NQ>
__device__ __forceinline__ void attn_block(const Blk& cur, int skv, int W, int koff, const Aux& ax, LAS char* lds, f32x16 (&o)[4], float& m_out, float& l_out) {
    const int tid = tid_l(), wid = __builtin_amdgcn_readfirstlane(tid >> 6), lane = tid & 63, r32 = lane & 31, hi = lane >> 5;
    const int rs = cur.rs;
    const int j_lo = swa_jlo(cur.P0, W);
    int j_hi = (cur.P0 + QB - 1) / KVBLK + 1; if (j_hi > skv / KVBLK) j_hi = skv / KVBLK;
    int NT = j_hi - j_lo;
    const int qlo = cur.P0 + wid * QBLK, qm = qlo + r32 - 4 * hi;
    LAS char* V_lds = lds; LAS char* K_lds = lds + 2 * SHM_V;
    LAS float* ws = (LAS float*)(lds + L_WS) + wid * 64; LAS float* li_l = ws; LAS float* al_l = ws + 32;
    LAS float* auxl = (LAS float*)(lds + L_AUX);
    float m_reg = -1e30f, l_reg = 0;
#pragma unroll
    for (int d_ = 0; d_ < 4; ++d_) o[d_] = f32x16{};
    const int sr = tid >> 4, sc = (tid & 15) * 8, vst0 = v_st(sr, sc), vst1 = v_st(32 + sr, sc), kws = KSWZ(sr, sc * 2);
    const int vb0 = (int)(unsigned)(uintptr_t)V_lds + v_rd_base(lane);
    const GA bf16_t* Kh = cur.K; const GA bf16_t* Vh = cur.V;
    bf16x8 qr[NQ]; bf16x8 st_v0, st_v1, st_k0, st_k1;
#define ROW(p, k0, rr) ((p) + (size_t)((k0) + (rr)) * rs + sc)
#define VMW() asm volatile("s_waitcnt vmcnt(0)" ::: "memory")
#define SLOAD_H(Kp, Vp, k0) do { st_v0 = load8(ROW(Vp, k0, sr)); st_v1 = load8(ROW(Vp, k0, 32 + sr));              \
                                 st_k0 = load8(ROW(Kp, k0, sr)); st_k1 = load8(ROW(Kp, k0, 32 + sr)); } while (0)
#define SWRITE_HK(bf) do { *(LAS bf16x8*)(K_lds + (bf) * SHM_K + kws) = st_k0; *(LAS bf16x8*)(K_lds + (bf) * SHM_K + kws + 32 * 256) = st_k1; } while (0)
#define SWRITE_HV(bf) do { *(LAS bf16x8*)(V_lds + (bf) * SHM_V + vst0) = st_v0; *(LAS bf16x8*)(V_lds + (bf) * SHM_V + vst1) = st_v1; } while (0)
#define SWRITE_H(bf) do { SWRITE_HV(bf); SWRITE_HK(bf); } while (0)
#define RESC(a) do { if (__any((a) < 1.f)) { if (hi == 0) al_l[r32] = (a); asm volatile("s_waitcnt lgkmcnt(0)" ::: "memory");              \
                     for (int d_ = 0; d_ < 4; ++d_) for (int r = 0; r < 16; ++r) o[d_][r] *= al_l[crow(r, hi)]; } } while (0)
#define KBASE(t) ((MODE == 1 ? (j_hi - 1 - (t)) : (j_lo + (t))) * KVBLK)
    LAS unsigned* flg = (LAS unsigned*)(lds + L_FLG);
    {
        const int kb0 = KBASE(0);
        if (MODE == 1 && tid < 8) flg[tid] = 0u;
#pragma unroll
        for (int d0 = 0; d0 < NQ; ++d0) qr[d0] = load8(cur.Q + (size_t)(wid * QBLK + r32) * rs + d0 * 16 + hi * 8);
        SLOAD_H(Kh, Vh, kb0);
        if (MODE == 1) { for (int i = tid; i < cur.P0 + QB; i += 512) auxl[i] = ax.cum[i]; }
        else { for (int i = tid; i < TB_N; i += 512) { int d = i - TB_PAD; d = d < 0 ? 0 : d; auxl[i] = ax.tb[d * ax.dscale]; } }
        VMW(); SWRITE_HK(0); SWRITE_HV(0);
        __syncthreads();
    }
    const float cfar = (MODE == 0 || MODE == 2) ? ax.tb[FAR_DIST] : 0.f;
    float qbound = 0.f;
    if (MODE == 1) { float ss = 0.f;
#pragma unroll
        for (int d0 = 0; d0 < NQ; ++d0) { const u32x4 w = *reinterpret_cast<const u32x4*>(&qr[d0]);
#pragma unroll
            for (int j = 0; j < 4; ++j) { const float a = bf_lo(w[j]), b = bf_hi(w[j]); ss = fmaf(a, a, ss); ss = fmaf(b, b, ss); } }
        { auto rr = __builtin_amdgcn_permlane32_swap(__float_as_uint(ss), __float_as_uint(ss), false, false); ss = __uint_as_float(rr[0]) + __uint_as_float(rr[1]); }
        qbound = sqrtf(ss) * ax.kmax * 1.001f + 1e-3f; }
    float cbv = 0.f;
#define BIASMASK(P0_, P1_, t) do { const int kb_ = KBASE(t); cbv = 0.f;                                                                \
        if (MODE == 1) { bias_key(P0_, P1_, (const LAS char*)(auxl + kb_ + 4 * hi)); }                                                       \
        else if (MODE == 3) { bias_dist(P0_, P1_, (const LAS char*)(auxl + (qm - kb_ - 59 + TB_PAD))); }                                     \
        else { if (cur.P0 - kb_ - 63 >= FAR_DIST) cbv = cfar; else bias_dist(P0_, P1_, (const LAS char*)(auxl + (qm - kb_ - 59 + TB_PAD))); } \
        if (MODE == 0) { mask_bits(P0_, P1_, mw, hi); }                                                                                  \
        else if (kb_ + KVBLK - 1 > qlo || kb_ <= qlo + QBLK - 1 - W) mask_tile(P0_, P1_, qm - kb_, (unsigned)W); } while (0)
#define MLOAD(t) do { if (MODE == 0) mw = ax.mrow0[(size_t)(wid * QBLK + r32) * 128 + (KBASE(t) >> 6)]; } while (0)
    f32x16 pA0, pA1, pB0, pB1; float mnA, mnB, alA, alB; bf16x8 pa0, pa1, pa2, pa3; u64 mw = 0ull;
    if (NT > 1) SLOAD_H(Kh, Vh, KBASE(1));
    MLOAD(0);
    SBAR(); qkt<0, NQ>(pA0, pA1, K_lds, r32, hi, qr, koff);
    BIASMASK(pA0, pA1, 0); partialSM(pA0, pA1, m_reg, mnA, alA, cbv);
    if (NT > 1) { VMW(); SWRITE_H(1); }
    __syncthreads();
#define HALF_STEP(PX0, PX1, mnX, alX, PY0, PY1, alY, t, KB, VB, SB) do {                                                      \
        MLOAD(t);                                                                                                             \
        if ((t) + 1 < NT) { SLOAD_H(Kh, Vh, KBASE((t) + 1)); }        \
        SBAR(); qkt<KB, NQ>(PX0, PX1, K_lds, r32, hi, qr, koff);                                                              \
        finishSM(PY0, PY1, alY, l_reg, pa0, pa1, pa2, pa3); SBAR();                                                           \
        pv_tile<VB>(o, vb0, pa0, pa1, pa2, pa3); BIASMASK(PX0, PX1, (t)); partialSM(PX0, PX1, m_reg, mnX, alX, cbv);          \
        __syncthreads();                                                                                                      \
        if ((t) + 1 < NT) { VMW(); SWRITE_H(SB); }                                                                            \
        RESC(alX); __syncthreads(); } while (0)
    for (int t = 1; t + 1 < NT; t += 2) {
        if (MODE == 1) {
            const u32x4 f0 = *(const LAS u32x4*)flg, f1 = *(const LAS u32x4*)(flg + 4);
            if ((f0[0] & f0[1] & f0[2] & f0[3] & f1[0] & f1[1] & f1[2] & f1[3]) != 0u) { NT = t + 1; break; }
        }
        HALF_STEP(pB0, pB1, mnB, alB, pA0, pA1, alA, t, 1, 0, 0);
        if (MODE == 1) {
            unsigned ok = 0u;
            if (t + 3 < NT) { const float ub = qbound - auxl[KBASE(t + 3) + KVBLK - 1]; ok = __all(ub < m_reg - SKIP_MARGIN) ? 1u : 0u; }
            if (lane == 0) flg[wid] = ok;
        }
        HALF_STEP(pA0, pA1, mnA, alA, pB0, pB1, alB, t + 1, 0, 1, 1);
    }
    const bool even = (NT & 1) == 0;
    if (even) { MLOAD(NT - 1); SBAR(); qkt<1, NQ>(pB0, pB1, K_lds, r32, hi, qr, koff); SBAR(); }
    finishSM(pA0, pA1, alA, l_reg, pa0, pa1, pa2, pa3); SBAR();
    pv_tile<0>(o, vb0, pa0, pa1, pa2, pa3);
    if (even) { BIASMASK(pB0, pB1, NT - 1); partialSM(pB0, pB1, m_reg, mnB, alB, cbv); __syncthreads(); RESC(alB);
        finishSM(pB0, pB1, alB, l_reg, pa0, pa1, pa2, pa3); SBAR(); pv_tile<1>(o, vb0, pa0, pa1, pa2, pa3); }
    if (hi == 0) li_l[r32] = l_reg; asm volatile("s_waitcnt lgkmcnt(0)" ::: "memory");
#pragma unroll
    for (int r = 0; r < 16; ++r) { const float rl = __builtin_amdgcn_rcpf(li_l[crow(r, hi)]);
#pragma unroll
        for (int d0 = 0; d0 < 4; ++d0) o[d0][r] *= rl; }
    m_out = m_reg; l_out = l_reg;
    __syncthreads();
#undef ROW
#undef VMW
#undef SLOAD_H
#undef SWRITE_HK
#undef SWRITE_HV
#undef SWRITE_H
#undef RESC
#undef KBASE
#undef BIASMASK
#undef MLOAD
#undef HALF_STEP
}
#undef KSWZ
}

__device__ __forceinline__ void store_y(const GA bf16_t* Zs, GA bf16_t* Y, const f32x16 (&o)[4], int row0w, int colbase, int r32, int hi) {
    bf16_t zv[16][4];
#pragma unroll
    for (int r = 0; r < 16; ++r) { const size_t off = (size_t)(row0w + att::crow(r, hi)) * DM + colbase + r32;
#pragma unroll
        for (int d0 = 0; d0 < 4; ++d0) zv[r][d0] = Zs[off + d0 * 32]; }
#pragma unroll
    for (int r = 0; r < 16; ++r) { const size_t off = (size_t)(row0w + att::crow(r, hi)) * DM + colbase + r32;
#pragma unroll
        for (int d0 = 0; d0 < 4; ++d0) { const float v = o[d0][r] * bf2f(zv[r][d0]); const float vn = __shfl_xor(v, 1);
            if ((r32 & 1) == 0) *(GA unsigned*)(Y + off + d0 * 32) = cvt_pk_bf16(v, vn); } }
}
template <int MODE>
__device__ __forceinline__ void attn_fast_unit(const Frame& F, int layer, int b, int h, int qb) {
    const int mixer = MODE;
    const size_t hb = ((size_t)(b * 4 + h) * SEQ) * 128;
    att::Blk cur{F.QKV + (size_t)(mixer * 3 + 0) * QS + hb + (size_t)qb * 256 * 128, F.QKV + (size_t)(mixer * 3 + 1) * QS + hb, F.QKV + (size_t)(mixer * 3 + 2) * QS + hb, qb * 256, 128};
    att::Aux ax{F.tb + (size_t)h * SEQ, 1, F.cum + (size_t)(b * 4 + h) * SEQ, F.mask + (size_t)(b * SEQ + qb * 256) * 128, 0.f};
    if (MODE == 1) ax.kmax = sqrtf(__uint_as_float(F.ctl[CW_KM + layer * 8 + b * 4 + h]));
    f32x16 o[4]; float m_, l_;
    att::attn_block<MODE, 8>(cur, SEQ, SEQ, 0, ax, (LAS char*)F.lds, o, m_, l_);
    const int tid = tid_l(), wid = tid >> 6, lane = tid & 63;
    GA unsigned char* w2 = launder(F.ws);
    store_y((const GA bf16_t*)(w2 + WS_ZS), (GA bf16_t*)(w2 + WS_Y), o, b * SEQ + qb * 256 + wid * 32, mixer * 512 + h * 128, lane & 31, lane >> 5);
}

__device__ __forceinline__ void attn_diffmap_unit(const Frame& F, int layer, int b, int h, int qb, int c) {
    const size_t hb = ((size_t)(b * 4 + h) * SEQ) * 128;
    const GA bf16_t* Qc = F.QKV + (size_t)(2 * 3 + 0) * QS + hb + (size_t)qb * 256 * 128; const GA bf16_t* Kc = F.QKV + (size_t)(2 * 3 + 1) * QS + hb; const GA bf16_t* Vc = F.QKV + (size_t)(2 * 3 + 2) * QS + hb;
    att::Aux ax{F.tb + (size_t)(4 + h) * SEQ, 1, (const GA float*)nullptr, (const GA u64*)nullptr, 0.f};
    f32x16 o[4]; float m_, l_;
    { att::Blk cur{Qc + c * 64, Kc, Vc, qb * 256, 128};
      att::attn_block<2, 4>(cur, SEQ, SEQ, c * 128, ax, (LAS char*)F.lds, o, m_, l_); }
    const int tid = tid_l(), wid = tid >> 6, lane = tid & 63, r32 = lane & 31, hi = lane >> 5;
    const int pair = (b * 4 + h) * 32 + qb;
    GA unsigned char* w2 = launder(F.ws);
    { GA f32x4* mine = (GA f32x4*)(w2 + WS_O1) + ((size_t)(c * 256 + pair) * 16) * 512 + tid;
#pragma unroll
      for (int d0 = 0; d0 < 4; ++d0)
#pragma unroll
          for (int g = 0; g < 4; ++g) { const f32x4 v = {o[d0][4 * g], o[d0][4 * g + 1], o[d0][4 * g + 2], o[d0][4 * g + 3]};
              asm volatile("global_store_dwordx4 %0, %1, off sc1" :: "v"(mine + (d0 * 4 + g) * 512), "v"(v) : "memory"); } }
    asm volatile("s_waitcnt vmcnt(0)" ::: "memory");
    __syncthreads();
    volatile LAS unsigned* lw = F.misc + 5;
    if (tid == 0) *lw = __hip_atomic_fetch_add((GA unsigned*)(w2 + WS_CTL) + CW_DC + layer * 256 + pair, 1u, __ATOMIC_RELAXED, __HIP_MEMORY_SCOPE_AGENT);
    __syncthreads();
    if (*lw == 0u) return;
    __builtin_amdgcn_fence(__ATOMIC_ACQUIRE, "agent");
    asm volatile("s_waitcnt vmcnt(0)" ::: "memory");
    const GA f32x4* other = (const GA f32x4*)(w2 + WS_O1) + ((size_t)((1 - c) * 256 + pair) * 16) * 512 + tid;
    const GA float* dp = (const GA float*)(w2 + WS_DP) + layer * 256;
    const float lam = dp[0];
#pragma unroll
    for (int g = 0; g < 4; ++g) {
        f32x4 ot[4];
#pragma unroll
        for (int d0 = 0; d0 < 4; ++d0) ot[d0] = other[(d0 * 4 + g) * 512];
#pragma unroll
        for (int q = 0; q < 4; ++q) { const int r = 4 * g + q;
            float ss = 0.f;
#pragma unroll
            for (int d0 = 0; d0 < 4; ++d0) { const float mo = o[d0][r], oth = ot[d0][q];
                const float a0 = (c == 0) ? mo : oth, a1 = (c == 0) ? oth : mo; const float v = fmaf(-lam, a1, a0); o[d0][r] = v; ss = fmaf(v, v, ss); }
            ss += __shfl_xor(ss, 1); ss += __shfl_xor(ss, 2); ss += __shfl_xor(ss, 4); ss += __shfl_xor(ss, 8); ss += __shfl_xor(ss, 16);
            const float rn = rsqrtf(ss * (1.0f / 128.0f) + RMS_EPS);
#pragma unroll
            for (int d0 = 0; d0 < 4; ++d0) o[d0][r] = o[d0][r] * rn;
        }
        asm volatile("" ::: "memory");
    }
#pragma unroll
    for (int d0 = 0; d0 < 4; ++d0) { const float sw = dp[128 + d0 * 32 + r32];
#pragma unroll
        for (int r = 0; r < 16; ++r) o[d0][r] *= sw; }
    store_y((const GA bf16_t*)(w2 + WS_ZS), (GA bf16_t*)(w2 + WS_Y), o, b * SEQ + qb * 256 + wid * 32, 2 * 512 + h * 128, r32, hi);
}
__device__ __forceinline__ void attn_dil_unit(const Frame& F, int u) {
    const int cfg = u >> 8, v = u & 255, b = v & 1, h = (v >> 1) & 3, x = v >> 3;
    const int dl = (cfg == 0) ? 1 : (cfg == 1 ? 4 : 16);
    const int rho = (cfg == 0) ? 0 : (cfg == 1 ? (x & 3) : (x & 15)), qb = (cfg == 0) ? x : (cfg == 1 ? (x >> 2) : (x >> 4));
    const size_t hb = ((size_t)(b * 4 + h) * SEQ) * 128;
    const GA bf16_t* Qd = F.QKV + (size_t)(3 * 3 + 0) * QS + hb; const GA bf16_t* Kd = F.QKV + (size_t)(3 * 3 + 1) * QS + hb; const GA bf16_t* Vd = F.QKV + (size_t)(3 * 3 + 2) * QS + hb;
    att::Blk cur{Qd + (size_t)(rho + dl * qb * 256) * 128, Kd + (size_t)rho * 128, Vd + (size_t)rho * 128, qb * 256, 128 * dl};
    att::Aux ax{F.tb + (size_t)(8 + h) * SEQ, dl, (const GA float*)nullptr, (const GA u64*)nullptr, 0.f};
    f32x16 o[4]; float m_, l_;
    att::attn_block<3, 8>(cur, SEQ / dl, 129, 0, ax, (LAS char*)F.lds, o, m_, l_);
    const int tid = tid_l(), wid = tid >> 6, lane = tid & 63, r32 = lane & 31, hi = lane >> 5;
    GA unsigned char* w2 = launder(F.ws);
    GA bf16_t* od = (GA bf16_t*)(w2 + WS_OD) + (size_t)cfg * MT * 512;
#pragma unroll
    for (int r = 0; r < 16; ++r) { const size_t row = (size_t)b * SEQ + rho + (size_t)dl * (qb * 256 + wid * 32 + att::crow(r, hi));
#pragma unroll
        for (int d0 = 0; d0 < 4; ++d0) od[row * 512 + h * 128 + d0 * 32 + r32] = (bf16_t)(cvt_pk_bf16(o[d0][r], 0.f) & 0xffffu); }
    if (hi == 0) { const size_t row = (size_t)b * SEQ + rho + (size_t)dl * (qb * 256 + wid * 32 + r32);
        ((GA float*)(w2 + WS_LSE))[((size_t)cfg * MT + row) * 4 + h] = m_ + __builtin_amdgcn_logf(l_); }
}
__device__ __forceinline__ void dil_merge_unit(const Frame& F, int u) {
    const int tid = tid_l(), row = u * 32 + (tid >> 4), cg = tid & 15, h = cg >> 2, col = cg * 32;
    const float l0 = F.LSE[((size_t)0 * MT + row) * 4 + h], l1 = F.LSE[((size_t)1 * MT + row) * 4 + h], l2 = F.LSE[((size_t)2 * MT + row) * 4 + h];
    const float mx = fmaxf(l0, fmaxf(l1, l2)); float w0 = ex2(l0 - mx), w1 = ex2(l1 - mx), w2 = ex2(l2 - mx); const float inv = 1.0f / (w0 + w1 + w2); w0 *= inv; w1 *= inv; w2 *= inv;
    const GA bf16_t* odb = (const GA bf16_t*)F.OD;
    const GA bf16_t* p0 = odb + ((size_t)0 * MT + row) * 512 + col; const GA bf16_t* p1 = odb + ((size_t)1 * MT + row) * 512 + col; const GA bf16_t* p2 = odb + ((size_t)2 * MT + row) * 512 + col;
    const size_t yo = (size_t)row * DM + 3 * 512 + col;
#pragma unroll
    for (int i = 0; i < 4; ++i) {
        const u32x4 A_ = *(const GA u32x4*)(p0 + 8 * i), B_ = *(const GA u32x4*)(p1 + 8 * i), C_ = *(const GA u32x4*)(p2 + 8 * i);
        const f32x4 a0 = {bf_lo(A_[0]), bf_hi(A_[0]), bf_lo(A_[1]), bf_hi(A_[1])}, a1 = {bf_lo(A_[2]), bf_hi(A_[2]), bf_lo(A_[3]), bf_hi(A_[3])}, b0 = {bf_lo(B_[0]), bf_hi(B_[0]), bf_lo(B_[1]), bf_hi(B_[1])}, b1 = {bf_lo(B_[2]), bf_hi(B_[2]), bf_lo(B_[3]), bf_hi(B_[3])},
                    c0 = {bf_lo(C_[0]), bf_hi(C_[0]), bf_lo(C_[1]), bf_hi(C_[1])}, c1 = {bf_lo(C_[2]), bf_hi(C_[2]), bf_lo(C_[3]), bf_hi(C_[3])};
        const u32x4 zw = *(const GA u32x4*)(F.Zs + yo + 8 * i);
        const f32x4 v0 = a0 * w0 + b0 * w1 + c0 * w2, v1 = a1 * w0 + b1 * w1 + c1 * w2;
        u32x4 w = {cvt_pk_bf16(v0[0] * bf_lo(zw[0]), v0[1] * bf_hi(zw[0])), cvt_pk_bf16(v0[2] * bf_lo(zw[1]), v0[3] * bf_hi(zw[1])),
                   cvt_pk_bf16(v1[0] * bf_lo(zw[2]), v1[1] * bf_hi(zw[2])), cvt_pk_bf16(v1[2] * bf_lo(zw[3]), v1[3] * bf_hi(zw[3]))};
        *(GA u32x4*)(F.Y + yo + 8 * i) = w; }
}

struct EpiMerged {
    static constexpr bool PERM = true, AFTER_DRAIN = false, MIDK = true, FP8 = false;
    const GA unsigned char* G; GA bf16_t* MG;
    static __device__ __forceinline__ float gq(unsigned w, int i) { return (float)((w >> (8 * i)) & 0xffu) + 0.5f; }
    __device__ __forceinline__ void mid(f32x4 (&acc)[2][2][4][2], const pg8::Unit& u, int bnext, int wr, int wc, int fr, int fq) const {
        const int row0 = u.pm * 256 + wr * 64 + fr, c0 = u.pn * 256 + wc * 32 + 8 * fq;
#pragma unroll
        for (int ai = 0; ai < 2; ++ai) {
            u32x2 num[4][2], den[4][2];
#pragma unroll
            for (int m = 0; m < 4; ++m) { const GA unsigned char* gp = G + (size_t)(row0 + ai * 128 + m * 16) * 8192 + c0;
#pragma unroll
                for (int bj = 0; bj < 2; ++bj) { num[m][bj] = *(const GA u32x2*)(gp + (bnext - 1) * DM + bj * 128); den[m][bj] = *(const GA u32x2*)(gp + bnext * DM + bj * 128); } }
#pragma unroll
            for (int m = 0; m < 4; ++m)
#pragma unroll
                for (int bj = 0; bj < 2; ++bj)
#pragma unroll
                    for (int j = 0; j < 4; ++j) {
                        acc[ai][bj][m][0][j] *= gq(num[m][bj][0], j) * __builtin_amdgcn_rcpf(gq(den[m][bj][0], j));
                        acc[ai][bj][m][1][j] *= gq(num[m][bj][1], j) * __builtin_amdgcn_rcpf(gq(den[m][bj][1], j)); }
            asm volatile("" ::: "memory");
        }
    }
    __device__ __forceinline__ void operator()(const f32x4 (&acc)[2][2][4][2], const pg8::Unit& u, int wr, int wc, int fr, int fq) const {
        const int row0 = u.pm * 256 + wr * 64 + fr, c0 = u.pn * 256 + wc * 32 + 8 * fq;
        u32x2 g3v[2][4][2];
#pragma unroll
        for (int ai = 0; ai < 2; ++ai)
#pragma unroll
            for (int m = 0; m < 4; ++m)
#pragma unroll
                for (int bj = 0; bj < 2; ++bj) g3v[ai][m][bj] = *(const GA u32x2*)(G + (size_t)(row0 + ai * 128 + m * 16) * 8192 + 3 * DM + c0 + bj * 128);
#pragma unroll
        for (int ai = 0; ai < 2; ++ai)
#pragma unroll
            for (int m = 0; m < 4; ++m) { const int r = row0 + ai * 128 + m * 16;
#pragma unroll
                for (int bj = 0; bj < 2; ++bj) { const u32x2 g3 = g3v[ai][m][bj];
                    const f32x4 v0 = acc[ai][bj][m][0] * (1.0f / 256.0f), v1 = acc[ai][bj][m][1] * (1.0f / 256.0f);
                    u32x4 w = {cvt_pk_bf16(v0[0] * gq(g3[0], 0), v0[1] * gq(g3[0], 1)), cvt_pk_bf16(v0[2] * gq(g3[0], 2), v0[3] * gq(g3[0], 3)),
                               cvt_pk_bf16(v1[0] * gq(g3[1], 0), v1[1] * gq(g3[1], 1)), cvt_pk_bf16(v1[2] * gq(g3[1], 2), v1[3] * gq(g3[1], 3))};
                    *(GA u32x4*)(MG + (size_t)r * DM + c0 + bj * 128) = w; } }
    }
};

struct EpiOut {
    static constexpr bool PERM = false, AFTER_DRAIN = false, MIDK = false, FP8 = false;
    GA float* xres; GA bf16_t* xb; GA float* ssq; GA unsigned char* xq; const GA float* xsrc; bool feed_next;
    __device__ __forceinline__ void operator()(const f32x4 (&acc)[2][2][4][2], const pg8::Unit& u, int wr, int wc, int fr, int fq) const {
        const int row0 = u.pm * 256 + wr * 64 + fr, col0 = u.pn * 256 + wc * 32 + 4 * fq;
#pragma unroll
        for (int h = 0; h < 4; ++h) {
            const int ai = h >> 1, mb = (h & 1) * 2;
            f32x4 xv[2][2][2];
#pragma unroll
            for (int m = 0; m < 2; ++m)
#pragma unroll
                for (int bj = 0; bj < 2; ++bj)
#pragma unroll
                    for (int n = 0; n < 2; ++n) { const size_t off_ = (size_t)(row0 + ai * 128 + (mb + m) * 16) * DM + col0 + bj * 128 + n * 16;
                        if (xsrc != nullptr) xv[m][bj][n] = *(const GA f32x4*)(xsrc + off_);
                        else { const u32x2 t_ = *(const GA u32x2*)(xb + off_); xv[m][bj][n] = (f32x4){bf_lo(t_[0]), bf_hi(t_[0]), bf_lo(t_[1]), bf_hi(t_[1])}; } }
#pragma unroll
            for (int m = 0; m < 2; ++m) { const int r = row0 + ai * 128 + (mb + m) * 16; float ss = 0.f;
#pragma unroll
                for (int bj = 0; bj < 2; ++bj)
#pragma unroll
                    for (int n = 0; n < 2; ++n) { const size_t off = (size_t)r * DM + col0 + bj * 128 + n * 16;
                        const f32x4 v = xv[m][bj][n] + acc[ai][bj][mb + m][n];
                        ss += v[0] * v[0] + v[1] * v[1] + v[2] * v[2] + v[3] * v[3];
                        { u32x2 w = {cvt_pk_bf16(v[0], v[1]), cvt_pk_bf16(v[2], v[3])}; *(GA u32x2*)(xb + off) = w; }
                        if (feed_next) *(GA unsigned*)(xq + off) = cvt4_fp8(v[0], v[1], v[2], v[3]); }
                ss += __shfl_xor(ss, 16); ss += __shfl_xor(ss, 32);
                if (fq == 0) ssq[(size_t)r * 32 + u.pn * 4 + wc] = ss; }
        }
    }
};

__device__ __forceinline__ void final_norm(const Frame& F) {
    const int tid = tid_l(), lane = tid & 63, wave = tid >> 6, G = gridDim.x, bid = blockIdx.x;
    for (int row = bid * 8 + wave; row < MT; row += G * 8) {
        float ss = (lane < 32) ? F.ssq[(size_t)row * 32 + lane] : 0.f; ss = wave_sum(ss);
        const float rs = rsqrtf(ss * (1.0f / DM) + RMS_EPS);
#pragma unroll
        for (int i = 0; i < 8; ++i) { const int c = (i * 64 + lane) * 4; const u32x2 t = *(const GA u32x2*)(F.xb + (size_t)row * DM + c); const f32x4 v = {bf_lo(t[0]), bf_hi(t[0]), bf_lo(t[1]), bf_hi(t[1])}, w = *(const GA f32x4*)(F.final_w + c);
            *(GA f32x4*)(F.out + (size_t)row * DM + c) = v * rs * w; }
    }
}

__device__ __forceinline__ Frame mkframe(const Args& args, GA unsigned char* ws, LAS unsigned char* lds) {
    Frame F;
    F.x = (const GA float*)args.in[0]; F.norm_w = (const GA float*)args.in[1]; F.w_in = (const GA float*)args.in[2]; F.fox_b = (const GA float*)args.in[3];
    F.lq1 = (const GA float*)args.in[4]; F.lk1 = (const GA float*)args.in[5]; F.lq2 = (const GA float*)args.in[6]; F.lk2 = (const GA float*)args.in[7];
    F.subln = (const GA float*)args.in[8]; F.w_branch = (const GA float*)args.in[9]; F.w_out = (const GA float*)args.in[10]; F.rel_bias = (const GA float*)args.in[11];
    F.final_w = (const GA float*)args.in[12]; F.out = (GA float*)args.out;
    F.ctl = (GA unsigned*)(ws + WS_CTL); F.WinT = (GA bf16_t*)(ws + WS_WIN); F.WbrT = (GA bf16_t*)(ws + WS_WBR); F.WoutT = (GA bf16_t*)(ws + WS_WOUT);
    F.xres = (GA float*)(ws + WS_XRES); F.xb = (GA bf16_t*)(ws + WS_XB); F.ssq = (GA float*)(ws + WS_SSQ); F.Zs = (GA bf16_t*)(ws + WS_ZS); F.G = (GA bf16_t*)(ws + WS_G);
    F.QKV = (GA bf16_t*)(ws + WS_QKV); F.IQ = (GA bf16_t*)(ws + WS_IQ); F.IK = (GA bf16_t*)(ws + WS_IK); F.IW = (GA float*)(ws + WS_IW); F.FF = (GA float*)(ws + WS_FF);
    F.cum = (GA float*)(ws + WS_CUM); F.tb = (GA float*)(ws + WS_TB); F.sc = (GA float*)(ws + WS_SC); F.mask = (GA u64*)(ws + WS_MASK); F.Y = (GA bf16_t*)(ws + WS_Y); F.MG = (GA bf16_t*)(ws + WS_MG);
    F.O1 = (GA float*)(ws + WS_O1); F.OD = (GA float*)(ws + WS_OD); F.LSE = (GA float*)(ws + WS_LSE); F.DP = (GA float*)(ws + WS_DP); F.ws = ws;
    F.lds = lds; F.misc = (volatile LAS unsigned*)(lds + LDS_MISC);
    return F;
}

constexpr unsigned WQ_L0 = 2u * WT_TB, WQ_TOTAL = WQ_L0 + 3u * WT_TL;
__device__ __forceinline__ void wq_tile(const Args& args, LAS unsigned char* ldsl, unsigned t) {
    const Frame F = mkframe(args, launder(args.ws), ldsl);
    if (t < WQ_L0) { weight_tile(F, 0, WT_TW + WT_TG + (int)t, (LAS float*)ldsl); return; }
    const unsigned t1 = t - WQ_L0, l1 = t1 / (unsigned)WT_TL;
    weight_tile(F, 1 + (int)l1, (int)(t1 - l1 * (unsigned)WT_TL), (LAS float*)ldsl);
}
__device__ __forceinline__ void wq_drain(const Args& args, LAS unsigned char* ldsl, unsigned bound) {
    volatile LAS unsigned* st = (volatile LAS unsigned*)(ldsl + LDS_MISC);
    GA unsigned* wq = (GA unsigned*)(args.ws + WS_CTL) + CW_WQ;
    for (;;) {
        __syncthreads();
        if (threadIdx.x == 0) st[11] = __hip_atomic_fetch_add(wq, 1u, __ATOMIC_RELAXED, __HIP_MEMORY_SCOPE_AGENT);
        __syncthreads();
        const unsigned t = st[11];
        if (t < WQ_TOTAL) wq_tile(args, ldsl, t);
        if (t + 1u >= bound) break;
    }
}
__device__ __forceinline__ void xcd_barrier_steal(const XcdBarrier& b, const Args& args, LAS unsigned char* ldsl) {
    asm volatile("s_waitcnt vmcnt(0)" ::: "memory");
    __syncthreads();
    volatile LAS unsigned* st = b.st;
    if (threadIdx.x == 0) {
        unsigned* bar = b.bar;
        __builtin_amdgcn_s_waitcnt(0);
        unsigned nloc = st[0], nx = st[1];
        if (nloc == 0u) { xcd_barrier_complete(bar, b.x, nloc, nx); st[0] = nloc; st[1] = nx; }
        const unsigned old = xb_add(&bar[XB_XSUB(b.x)], 1u);
        const unsigned gen = old / nloc;
        if (old + 1u == (gen + 1u) * nloc) {
            __builtin_amdgcn_fence(__ATOMIC_RELEASE, "agent");
            asm volatile("s_waitcnt vmcnt(0)" ::: "memory");
            const unsigned og = xb_add(&bar[XB_TOP], 1u);
            const unsigned tg = og / nx;
            if (og + 1u == (tg + 1u) * nx) xb_add(&bar[XB_TOPGEN], 1u);
            else XB_SPIN(xb_ld(&bar[XB_TOPGEN]) == tg, bar);
            __builtin_amdgcn_fence(__ATOMIC_ACQUIRE, "agent");
            xb_add(&bar[XB_XGEN(b.x)], 1u);
            asm volatile("s_waitcnt vmcnt(0)" ::: "memory");
            st[8] = 1u;
        } else { st[8] = 0u; st[9] = gen; }
    }
    __syncthreads();
    const unsigned leader_ = st[8];
    __syncthreads();
    if (leader_ == 0u) {
        unsigned sp = 0u;
        for (;;) {
            if (threadIdx.x == 0) {
                unsigned* bar = b.bar;
                unsigned done = (xb_ld(&bar[XB_XGEN(b.x)]) != st[9]) ? 1u : 0u, t = 0xffffffffu;
                if (!done) {
                    if (st[10] == 0u) { t = xb_add((unsigned*)(args.ws + WS_CTL) + CW_WQ, 1u); if (t >= WQ_TOTAL) { st[10] = 1u; t = 0xffffffffu; } }
                    if (t == 0xffffffffu) { __builtin_amdgcn_s_sleep(1);
                        if ((++sp & 255u) == 0u) { if (xb_ld(&bar[XB_TMO])) done = 1u; else if (sp > XB_SPIN_CAP) { atomicAdd(&bar[XB_TMO], 1u); done = 1u; } } }
                }
                st[8] = done; st[11] = t;
            }
            __syncthreads();
            const unsigned done = st[8], t = st[11];
            if (done) break;
            if (t != 0xffffffffu) wq_tile(args, ldsl, t);
            else __syncthreads();
        }
        if (threadIdx.x == 0) { __builtin_amdgcn_fence(__ATOMIC_ACQUIRE, "agent"); asm volatile("s_waitcnt vmcnt(0)" ::: "memory"); }
    }
    __syncthreads();
}

__global__ void __launch_bounds__(512, 2) fwd(Args args) {
    extern __shared__ __attribute__((aligned(16))) unsigned char lds[];
    LAS unsigned char* ldsl = (LAS unsigned char*)lds;
    if (threadIdx.x < 64) ((volatile LAS unsigned*)(ldsl + LDS_MISC))[threadIdx.x] = 0u;
    __syncthreads();
    const int lo = args.ph_lo, hi = args.ph_hi;
    const bool fused = (hi - lo) > 1;
    if (fused) (void)xcd_barrier_post((unsigned*)(args.ws + WS_CTL) + CW_BAR, (volatile LAS unsigned*)(ldsl + LDS_MISC));
#ifndef PH_EN
#define PH_EN 0xff
#endif
#define IN(k) (lo <= (k) && (k) < hi)
#if defined(BWPROBE)
#define BW_MATCH(k) (BWPROBE == 9 || ((k) == 0 ? 5 : ((k) - 1) % 5) == BWPROBE)
#define SEAM(k) do { if (IN((k) + 1)) { const unsigned long long bw0_ = __builtin_amdgcn_s_memrealtime(); XcdBarrier b_; b_.bar = (unsigned*)(args.ws + WS_CTL) + CW_BAR; b_.x = xb_xcc_id(); b_.st = (volatile LAS unsigned*)(ldsl + LDS_MISC); xcd_barrier(b_); \
    if (BW_MATCH(k) && threadIdx.x == 0) atomicAdd((unsigned*)(args.ws + WS_CTL) + 14336, (unsigned)(__builtin_amdgcn_s_memrealtime() - bw0_)); } } while (0)
#else
#define SEAM(k) do { if (IN((k) + 1)) { XcdBarrier b_; b_.bar = (unsigned*)(args.ws + WS_CTL) + CW_BAR; b_.x = xb_xcc_id(); b_.st = (volatile LAS unsigned*)(ldsl + LDS_MISC); xcd_barrier(b_); } } while (0)
#endif
#define SEAM_STEAL(k) do { if (IN((k) + 1)) { XcdBarrier b_; b_.bar = (unsigned*)(args.ws + WS_CTL) + CW_BAR; b_.x = xb_xcc_id(); b_.st = (volatile LAS unsigned*)(ldsl + LDS_MISC); xcd_barrier_steal(b_, args, ldsl); } } while (0)
    const int G = gridDim.x, bid = blockIdx.x;
#if defined(TPROBE)
    unsigned long long tp_acc = 0ull, tp_t0 = 0ull;
#define tp_acc_ref tp_acc
#define TP_BEGIN(k) do { if ((k) == TPROBE) tp_t0 = __builtin_amdgcn_s_memrealtime(); } while (0)
#define TP_END(k) do { if ((k) == TPROBE) tp_acc += __builtin_amdgcn_s_memrealtime() - tp_t0; } while (0)
#else
    unsigned long long tp_dummy = 0ull;
#define tp_acc_ref tp_dummy
#define TP_BEGIN(k) do { } while (0)
#define TP_END(k) do { } while (0)
#endif

    if ((PH_EN & 1) && IN(0)) { const Frame F = mkframe(args, launder(args.ws), ldsl); TP_BEGIN(0); p0_prologue(F);
#if defined(DUP) && DUP == 6
        __syncthreads(); p0_prologue(F);
#endif
        SEAM(0); TP_END(0); }

    for (int layer = 0; layer < DEPTH; ++layer) {
        const int pb = 1 + 5 * layer;
        if ((PH_EN & 2) && IN(pb)) { TP_BEGIN(1);
            GA unsigned char* ws = launder(args.ws);
            { pg8::Gemm g{(const GA bf16_t*)(ws + WS_XB), (const GA bf16_t*)(ws + WS_WIN) + (size_t)layer * NINP * DM, MT, NINP, DM}; pg8::StaticOrder S; S.init(MT, NINP, G, bid);
              EpiIn E{ws};
              pg8::gemm_phase<EpiIn, pg8::StaticOrder>(ldsl, g, S, E); }
            __syncthreads();
            { pg8::Gemm g{(const GA bf16_t*)(ws + WS_XQ), (const GA bf16_t*)(ws + WS_WG8 + (size_t)layer * N8 * DM), MT, N8, DM / 2}; pg8::StaticOrder S;
              if (G == 256) { if (bid < 192) S.init_part(MT, N8, 192, bid, 12); else S.init_part(MT, N8, 64, 2304 + (bid - 192), 14); } else S.init(MT, N8, G, (bid + 128) % G);
              EpiGate E{ws};
              pg8::gemm_phase<EpiGate, pg8::StaticOrder>(ldsl, g, S, E); }
            SEAM_STEAL(pb); TP_END(1);
        }
        if ((PH_EN & 4) && IN(pb + 1)) { TP_BEGIN(2);
            const Frame F = mkframe(args, launder(args.ws), ldsl);
            TP_BEGIN(20); if (bid < 8) fox_scan(F, layer, bid);
            fox_kmax(F, layer); TP_END(20);
            GA unsigned* ctr = F.ctl + CW_Q + 64 * (layer * 4 + 0);
            for (int u = q_next(ctr, F.misc + 4); u < 768 + 2048; u = q_next(ctr, F.misc + 4)) {
                if (u < 768) { TP_BEGIN(23); attn_dil_unit(F, u); TP_END(23); } else { TP_BEGIN(21); idxsel_unit(F, u - 768, tp_acc_ref); TP_END(21); }
            }
            SEAM_STEAL(pb + 1); TP_END(2);
        }
        if ((PH_EN & 16) && IN(pb + 2)) { TP_BEGIN(4);
            const Frame F = mkframe(args, launder(args.ws), ldsl);
            GA unsigned* ctr = F.ctl + CW_Q + 64 * (layer * 4 + 1);
            const int nunits = 1536;
            for (int u = q_next(ctr, F.misc + 4); u < nunits; u = q_next(ctr, F.misc + 4)) {
                if (u < 512) { const int qb = 31 - (u >> 4), r = u & 15; TP_BEGIN(40); TP_BEGIN(44 + (qb >= 16)); attn_diffmap_unit(F, layer, r & 1, (r >> 1) & 3, qb, r >> 3); TP_END(40); TP_END(44 + (qb >= 16)); }
                else if (u < 1024) { const int v = u - 512, qb = 31 - (v >> 4), r = v & 15, mode = r & 1, b = (r >> 1) & 1, h = r >> 2;
                    if (mode == 0) { TP_BEGIN(41); attn_fast_unit<0>(F, layer, b, h, qb); TP_END(41); } else { TP_BEGIN(42); attn_fast_unit<1>(F, layer, b, h, qb); TP_END(42); } }
                else { TP_BEGIN(43); dil_merge_unit(F, u - 1024); TP_END(43); }
            }
            if (layer == 0) { __syncthreads(); wq_drain(args, ldsl, WQ_L0); }
            SEAM_STEAL(pb + 2); TP_END(4);
        }
        if ((PH_EN & 32) && IN(pb + 3)) { TP_BEGIN(5);
            GA unsigned char* ws = launder(args.ws);
            pg8::Gemm g{(const GA bf16_t*)(ws + WS_Y), (const GA bf16_t*)(ws + WS_WBR) + (size_t)layer * DM * DM, MT, DM, DM}; pg8::StaticOrder S; S.init(MT, DM, G, bid);
            EpiMerged E{(const GA unsigned char*)(ws + WS_G), (GA bf16_t*)(ws + WS_MG)};
            pg8::gemm_phase<EpiMerged, pg8::StaticOrder>(ldsl, g, S, E);
#if defined(DUP) && DUP == 4
            __syncthreads(); pg8::gemm_phase<EpiMerged, pg8::StaticOrder>(ldsl, g, S, E);
#endif
            SEAM_STEAL(pb + 3); TP_END(5);
        }
        if ((PH_EN & 64) && IN(pb + 4)) { TP_BEGIN(6);
            GA unsigned char* ws = launder(args.ws);
            pg8::Gemm g{(const GA bf16_t*)(ws + WS_MG), (const GA bf16_t*)(ws + WS_WOUT) + (size_t)layer * DM * DM, MT, DM, DM}; pg8::StaticOrder S; S.init(MT, DM, G, bid);
            EpiOut E{(GA float*)(ws + WS_XRES), (GA bf16_t*)(ws + WS_XB), (GA float*)(ws + WS_SSQ), ws + WS_XQ, (layer == 0) ? (const GA float*)args.in[0] : (const GA float*)nullptr, layer + 1 < DEPTH};
            pg8::gemm_phase<EpiOut, pg8::StaticOrder>(ldsl, g, S, E);
            if (layer + 1 < DEPTH) { __syncthreads(); wq_drain(args, ldsl, WQ_L0 + (unsigned)(layer + 1) * WT_TL); }
            SEAM_STEAL(pb + 4); TP_END(6);
        }
    }
    if ((PH_EN & 128) && IN(21)) { TP_BEGIN(7); const Frame F = mkframe(args, launder(args.ws), ldsl); final_norm(F); TP_END(7); }
#if defined(BWPROBE)
    if (bid == 0) { __syncthreads(); const unsigned long long te = __builtin_amdgcn_s_memrealtime(); const unsigned long long tot = xb_ld((unsigned*)(args.ws + WS_CTL) + 14336);
        while ((__builtin_amdgcn_s_memrealtime() - te) * 32ull < tot) __builtin_amdgcn_s_sleep(8); }
#endif
#if defined(TPROBE)
    if (bid == 0) { const unsigned long long te = __builtin_amdgcn_s_memrealtime(); while (__builtin_amdgcn_s_memrealtime() - te < 8ull * tp_acc) __builtin_amdgcn_s_sleep(8); }
#endif
#undef IN
#undef SEAM
}

extern "C" void kernel_launch(void* const* d_in, const int* in_sizes, int n_in, void* d_out, int out_size, void* d_ws, size_t ws_size, hipStream_t stream) {
    static int grid = 0;
    if (grid == 0) {
        if (n_in != 13 || in_sizes[0] != MT * DM || out_size != MT * DM || ws_size < WS_END) {
            fprintf(stderr, "kernel_launch: unexpected shapes (n_in %d, in0 %d, out %d, ws %zu, need %zu)\n", n_in, n_in > 0 ? in_sizes[0] : -1, out_size, ws_size, (size_t)WS_END); grid = -1; return; }
        int dev = 0, cus = 0, per_cu = 0;
        if (hipGetDevice(&dev) != hipSuccess || hipDeviceGetAttribute(&cus, hipDeviceAttributeMultiprocessorCount, dev) != hipSuccess) { grid = -1; return; }
        if (hipFuncSetAttribute((const void*)fwd, hipFuncAttributeMaxDynamicSharedMemorySize, LDS_BYTES) != hipSuccess) { fprintf(stderr, "kernel_launch: hipFuncSetAttribute failed\n"); grid = -1; return; }
        if (hipOccupancyMaxActiveBlocksPerMultiprocessor(&per_cu, (const void*)fwd, 512, LDS_BYTES) != hipSuccess || per_cu < 1) fprintf(stderr, "kernel_launch: occupancy query reports %d\n", per_cu);
        (void)hipGetLastError();
        grid = cus;
    }
    if (grid < 0) return;
    if (hipMemsetAsync((char*)d_ws + WS_CTL, 0, CTL_BYTES, stream) != hipSuccess) return;
    Args a{};
    for (int i = 0; i < 13; ++i) a.in[i] = (const float*)d_in[i];
    a.out = (float*)d_out; a.ws = (unsigned char*)d_ws;
#if MK_LAUNCHES == 1
    a.ph_lo = 0; a.ph_hi = NPH;
    hipLaunchKernelGGL(fwd, dim3(grid), dim3(512), LDS_BYTES, stream, a);
#else
    for (int p = 0; p < NPH; ++p) { a.ph_lo = p; a.ph_hi = p + 1; hipLaunchKernelGGL(fwd, dim3(grid), dim3(512), LDS_BYTES, stream, a); }
#endif
}
```

```cpp
#include <hip/hip_runtime.h>
#include <stdint.h>
#include <stdio.h>

#ifndef MK_LAUNCHES
#define MK_LAUNCHES 1
#endif

#define LAS __attribute__((address_space(3)))
#define GA __attribute__((address_space(1)))
typedef unsigned short bf16_t;
typedef short bf16x8 __attribute__((ext_vector_type(8)));
typedef float f32x4 __attribute__((ext_vector_type(4)));
typedef float f32x16 __attribute__((ext_vector_type(16)));
typedef unsigned u32x4 __attribute__((ext_vector_type(4)));
typedef unsigned u32x2 __attribute__((ext_vector_type(2)));
typedef unsigned long long u64;

constexpr int DM = 2048, NB = 2, SEQ = 8192, DEPTH = 4, MT = NB * SEQ;
constexpr int NIN = 17492, NINP = 4864, N8 = 12800;
constexpr float W8SCALE = 512.f;
constexpr int NPH = 22;
constexpr float LOG2E = 1.4426950408889634f;
constexpr float QSC128 = 0.08838834764831845f * 1.4426950408889634f;
constexpr float QSC64 = 0.125f * 1.4426950408889634f;
constexpr float RMS_EPS = 1e-6f;
constexpr size_t QS = (size_t)NB * 4 * SEQ * 128;

constexpr size_t al256(size_t x) { return (x + 255) & ~(size_t)255; }
constexpr size_t WS_CTL = 0, CTL_BYTES = 65536;
constexpr size_t WS_WIN = WS_CTL + CTL_BYTES;
constexpr size_t WS_WBR = WS_WIN + (size_t)DEPTH * NINP * DM * 2;
constexpr size_t WS_WOUT = WS_WBR + (size_t)DEPTH * DM * DM * 2;
constexpr size_t WS_XRES = WS_WOUT + (size_t)DEPTH * DM * DM * 2;
constexpr size_t WS_XB = WS_XRES + (size_t)MT * DM * 4;
constexpr size_t WS_SSQ = WS_XB + (size_t)MT * DM * 2;
constexpr size_t WS_ZS = WS_SSQ + (size_t)MT * 32 * 4;
constexpr size_t WS_G = WS_ZS + (size_t)MT * DM * 2;
constexpr size_t WS_QKV = WS_G + (size_t)MT * 8192 * 2;
constexpr size_t WS_IQ = WS_QKV + 12 * QS * 2;
constexpr size_t WS_IK = WS_IQ + (size_t)MT * 1024 * 2;
constexpr size_t WS_IW = WS_IK + (size_t)MT * 64 * 2;
constexpr size_t WS_FF = WS_IW + (size_t)MT * 16 * 4;
constexpr size_t WS_CUM = WS_FF + (size_t)MT * 4 * 4;
constexpr size_t WS_TB = WS_CUM + (size_t)NB * 4 * SEQ * 4;
constexpr size_t WS_SC = WS_TB + (size_t)12 * SEQ * 4;
constexpr size_t WS_MASK = WS_SC + (size_t)NB * SEQ * SEQ * 4;
constexpr size_t WS_Y = WS_MASK + (size_t)NB * SEQ * 128 * 8;
constexpr size_t WS_MG = WS_Y + (size_t)MT * DM * 2;
constexpr size_t WS_O1 = WS_MG + (size_t)MT * DM * 2;
constexpr size_t WS_OD = WS_O1 + (size_t)2 * 256 * 64 * 512 * 4;
constexpr size_t WS_LSE = WS_OD + (size_t)3 * MT * 512 * 4;
constexpr size_t WS_DP = WS_LSE + (size_t)3 * MT * 4 * 4;
constexpr size_t WS_WG8 = WS_DP + 4 * 256 * 4;
constexpr size_t WS_XQ = WS_WG8 + (size_t)DEPTH * N8 * DM;
constexpr size_t WS_END = WS_XQ + (size_t)MT * DM;

constexpr int CW_BAR = 0;
constexpr int CW_Q = 4096;
constexpr int CW_DC = 8192;
constexpr int CW_WQ = 13312;
constexpr int CW_KM = 12288;

constexpr int LDS_STAGE = 131072;
constexpr int LDS_MISC = 131072;
constexpr int LDS_BYTES = 147456;

__device__ __forceinline__ unsigned cvt_pk_bf16(float lo, float hi) { unsigned r; asm volatile("v_cvt_pk_bf16_f32 %0, %1, %2" : "=v"(r) : "v"(lo), "v"(hi)); return r; }
__device__ __forceinline__ float bf_lo(unsigned w) { return __uint_as_float(w << 16); }
__device__ __forceinline__ float bf_hi(unsigned w) { return __uint_as_float(w & 0xffff0000u); }
__device__ __forceinline__ float bf2f(bf16_t b) { return __uint_as_float(((unsigned)b) << 16); }
__device__ __forceinline__ float ex2(float x) { return __builtin_amdgcn_exp2f(x); }
__device__ __forceinline__ float sigmoidf_(float x) { return __builtin_amdgcn_rcpf(1.0f + ex2(-x * LOG2E)); }
__device__ __forceinline__ int tid_l() { int t = threadIdx.x; asm volatile("" : "+v"(t)); return t; }
__device__ __forceinline__ GA unsigned char* launder(unsigned char* p) { asm volatile("" : "+s"(p)); return (GA unsigned char*)p; }
__device__ __forceinline__ GA unsigned char* launder(GA unsigned char* p) { asm volatile("" : "+s"(p)); return p; }
__device__ __forceinline__ float wave_sum(float v) {
#pragma unroll
    for (int o = 32; o > 0; o >>= 1) v += __shfl_xor(v, o);
    return v;
}

#define XB_TMO      128
#define XB_XCNT(j)  (256  + 64 * (j))
#define XB_XSUB(j)  (1280 + 64 * (j))
#define XB_XGEN(j)  (2304 + 64 * (j))
#define XB_TOP      3328
#define XB_TOPGEN   3392
#define XCD_BAR_WORDS 3456
#define XB_SPIN_CAP (1u << 18)

__device__ __forceinline__ unsigned xb_ld(unsigned* p)              { return __hip_atomic_load(p, __ATOMIC_RELAXED, __HIP_MEMORY_SCOPE_AGENT); }
__device__ __forceinline__ unsigned xb_add(unsigned* p, unsigned v) { return __hip_atomic_fetch_add(p, v, __ATOMIC_RELAXED, __HIP_MEMORY_SCOPE_AGENT); }
__device__ __forceinline__ unsigned xb_xcc_id() { return (unsigned)__builtin_amdgcn_s_getreg((3 << 11) | 20) & 0xFu; }
#define XB_SPIN(cond, bar) do { unsigned _sp = 0; while (cond) { __builtin_amdgcn_s_sleep(1); \
    if ((++_sp & 255u) == 0u) { if (xb_ld(&(bar)[XB_TMO])) break; if (_sp > XB_SPIN_CAP) { atomicAdd(&(bar)[XB_TMO], 1u); break; } } } } while (0)

struct XcdBarrier { unsigned* bar; unsigned x; volatile LAS unsigned* st; };

__device__ __forceinline__ XcdBarrier xcd_barrier_post(unsigned* bar, volatile LAS unsigned* st) {
    XcdBarrier b; b.bar = bar; b.x = xb_xcc_id(); b.st = st;
    if (threadIdx.x == 0) (void)xb_add(&bar[XB_XCNT(b.x)], 1u);
    return b;
}
__device__ __forceinline__ void xcd_barrier_complete(unsigned* bar, unsigned x, unsigned& nloc, unsigned& nx) {
    const unsigned G = gridDim.x * gridDim.y * gridDim.z;
    unsigned sum, cnt, mine, sp = 0u;
    for (;;) {
        sum = 0u; cnt = 0u; mine = 0u;
#pragma unroll
        for (unsigned j = 0; j < 16; ++j) { const unsigned c = xb_ld(&bar[XB_XCNT(j)]); sum += c; cnt += (c > 0u) ? 1u : 0u; mine = (j == x) ? c : mine; }
        if (sum == G) break;
        __builtin_amdgcn_s_sleep(1);
        if ((++sp & 255u) == 0u) { if (xb_ld(&bar[XB_TMO])) break; if (sp > XB_SPIN_CAP) { atomicAdd(&bar[XB_TMO], 1u); break; } }
    }
    nloc = mine > 0u ? mine : 1u; nx = cnt > 0u ? cnt : 1u;
}
__device__ __forceinline__ void xcd_barrier(const XcdBarrier& b) {
    asm volatile("s_waitcnt vmcnt(0)" ::: "memory");
    __syncthreads();
    if (threadIdx.x == 0) {
        unsigned* bar = b.bar;
        __builtin_amdgcn_s_waitcnt(0);
        unsigned nloc = b.st[0], nx = b.st[1];
        if (nloc == 0u) { xcd_barrier_complete(bar, b.x, nloc, nx); b.st[0] = nloc; b.st[1] = nx; }
        const unsigned old = xb_add(&bar[XB_XSUB(b.x)], 1u);
        const unsigned gen = old / nloc;
        if (old + 1u == (gen + 1u) * nloc) {
            __builtin_amdgcn_fence(__ATOMIC_RELEASE, "agent");
            asm volatile("s_waitcnt vmcnt(0)" ::: "memory");
            const unsigned og = xb_add(&bar[XB_TOP], 1u);
            const unsigned tg = og / nx;
            if (og + 1u == (tg + 1u) * nx) xb_add(&bar[XB_TOPGEN], 1u);
            else XB_SPIN(xb_ld(&bar[XB_TOPGEN]) == tg, bar);
            __builtin_amdgcn_fence(__ATOMIC_ACQUIRE, "agent");
            xb_add(&bar[XB_XGEN(b.x)], 1u);
            asm volatile("s_waitcnt vmcnt(0)" ::: "memory");
        } else {
            XB_SPIN(xb_ld(&bar[XB_XGEN(b.x)]) == gen, bar);
            __builtin_amdgcn_fence(__ATOMIC_ACQUIRE, "agent");
            asm volatile("s_waitcnt vmcnt(0)" ::: "memory");
        }
    }
    __syncthreads();
}

namespace pg8 {
constexpr int BM = 256, BK = 64, HALF = 128, HTB = HALF * BK * 2, STAGE_BYTES = 8 * HTB, NXCD = 8, WGM = 4;
__host__ __device__ __forceinline__ int lds_byte(int r, int c) { const int st = (r >> 4) * 2 + (c >> 5), rr = r & 15, cc = c & 31, ob = rr * 64 + cc * 2; return st * 1024 + (ob ^ (((ob >> 9) & 1) << 5)); }
__host__ __device__ __forceinline__ void stage_rc(int b, int& R, int& C) { const int st = b / 1024, sb = b % 1024, swz = sb ^ (((sb >> 9) & 1) << 5); R = (st >> 1) * 16 + swz / 64; C = (st & 1) * 32 + (swz % 64) / 2; }
__host__ __device__ __forceinline__ int perm32(int rho) { const int n = rho >> 4, i = rho & 15; return 8 * (i >> 2) + 4 * n + (i & 3); }
struct Unit { int pm, pn; };
struct Gemm { const GA bf16_t* A; const GA bf16_t* Bt; int M, N, K; };
struct StaticOrder {
    int nM, nN, nwg, G, c, cnt;
    __host__ __device__ void init(int M, int N, int G_, int c_) { nM = M / BM; nN = N / BM; nwg = nM * nN; G = G_; c = c_; cnt = 1 << 30; }
    __host__ __device__ void init_part(int M, int N, int stride, int first, int cnt_) { nM = M / BM; nN = N / BM; nwg = nM * nN; G = stride; c = first; cnt = cnt_; }
    __host__ __device__ bool next(int i, Unit& u) const {
        const long L = (long)i * G + c; if (L >= nwg || i >= cnt) return false;
        int wgid = (int)L; { const int q = nwg / NXCD, r = nwg % NXCD, xcd = wgid % NXCD, off = wgid / NXCD; wgid = (xcd < r ? xcd * (q + 1) : r * (q + 1) + (xcd - r) * q) + off; }
        const int nig = WGM * nN, gid = wgid / nig, fm = gid * WGM, gsz = (nM - fm) < WGM ? (nM - fm) : WGM;
        u.pm = fm + ((wgid % nig) % gsz); u.pn = (wgid % nig) / gsz; return true;
    }
    __device__ __forceinline__ void a_ready(const Unit&) const {}
    __device__ __forceinline__ void done(const Unit&) const {}
};

template <class Epi, class Sched>
__device__ __forceinline__ void gemm_phase(LAS unsigned char* lds, const Gemm g, const Sched& S, const Epi& E) {
    const int tid = tid_l(), wid = __builtin_amdgcn_readfirstlane(tid >> 6), lane = tid & 63, wr = wid >> 2, wc = wid & 3, fr = lane & 15, fq = lane >> 4;
    const int K = g.K, nt = K / BK;
    unsigned voffA[2], voffB[2];
#pragma unroll
    for (int i = 0; i < 2; ++i) { int R, C; stage_rc(tid * 16 + i * 8192, R, C); const int Rb = Epi::PERM ? ((R & ~31) + perm32(R & 31)) : R;
        voffA[i] = (unsigned)(R * K + C) * 2u; voffB[i] = (unsigned)(Rb * K + C) * 2u; }
    const size_t kstep = (size_t)(BK * 2);
    const size_t hstep = (size_t)HALF * K * 2;
    const size_t tstep = 2 * hstep;
    const unsigned ldsw = (unsigned)wid * 1024u;
    const int aoff = lds_byte(wr * 64 + fr, fq * 8), boff = lds_byte(wc * 32 + fr, fq * 8);
    typedef int v8i_t __attribute__((ext_vector_type(8)));
    const int aoff8 = lds_byte(wr * 64 + fr, (fq & 1) * 16) + (fq >> 1) * 1024, boff8 = lds_byte(wc * 32 + fr, (fq & 1) * 16) + (fq >> 1) * 1024;
#define PG8_SA(b, h) (((b) * 2 + (h)) * HTB)
#define PG8_SB(b, h) ((4 + (b) * 2 + (h)) * HTB)
#define PG8_STAGE(bufoff, gbase, voff) do { _Pragma("unroll") for (int _i = 0; _i < 2; ++_i) \
        __builtin_amdgcn_global_load_lds((const GA unsigned*)((const GA char*)(gbase) + (voff)[_i]), (LAS unsigned*)(lds + (bufoff) + ldsw + _i * 8192), 16, 0, 0); } while (0)
#define PG8_LDA(dst, b, h) do { if constexpr (Epi::FP8) { _Pragma("unroll") for (int m = 0; m < 4; ++m) { typedef int v4i_t_ __attribute__((ext_vector_type(4))); const LAS char* p_ = (const LAS char*)(lds + PG8_SA(b, h) + aoff8 + m * 2048); const v4i_t_ lo_ = *(const LAS v4i_t_*)p_, hi_ = *(const LAS v4i_t_*)(p_ + 16); dst##8[m] = __builtin_shufflevector(lo_, hi_, 0, 1, 2, 3, 4, 5, 6, 7); } } \
        else { _Pragma("unroll") for (int m = 0; m < 4; ++m) _Pragma("unroll") for (int k = 0; k < 2; ++k) dst[m][k] = *(const LAS bf16x8*)(lds + PG8_SA(b, h) + aoff + m * 2048 + k * 1024); } } while (0)
#define PG8_LDB(dst, b, h) do { if constexpr (Epi::FP8) { _Pragma("unroll") for (int n = 0; n < 2; ++n) { typedef int v4i_t_ __attribute__((ext_vector_type(4))); const LAS char* p_ = (const LAS char*)(lds + PG8_SB(b, h) + boff8 + n * 2048); const v4i_t_ lo_ = *(const LAS v4i_t_*)p_, hi_ = *(const LAS v4i_t_*)(p_ + 16); dst##8[n] = __builtin_shufflevector(lo_, hi_, 0, 1, 2, 3, 4, 5, 6, 7); } } \
        else { _Pragma("unroll") for (int n = 0; n < 2; ++n) _Pragma("unroll") for (int k = 0; k < 2; ++k) dst[n][k] = *(const LAS bf16x8*)(lds + PG8_SB(b, h) + boff + n * 2048 + k * 1024); } } while (0)
#define PG8_MMA(ai, bj, At, Bt) do { __builtin_amdgcn_s_setprio(1); _Pragma("unroll") for (int m = 0; m < 4; ++m) _Pragma("unroll") for (int n = 0; n < 2; ++n) { \
        if constexpr (Epi::FP8) asm volatile("v_mfma_scale_f32_16x16x128_f8f6f4 %0, %1, %2, %0, %3, %3 op_sel_hi:[0,0,0]" : "+v"(acc[ai][bj][m][n]) : "v"(Bt##8[n]), "v"(At##8[m]), "v"(sc127)); \
        else { _Pragma("unroll") for (int k = 0; k < 2; ++k) acc[ai][bj][m][n] = __builtin_amdgcn_mfma_f32_16x16x32_bf16(Bt[n][k], At[m][k], acc[ai][bj][m][n], 0, 0, 0); } } \
        __builtin_amdgcn_s_setprio(0); } while (0)
#define PG8_WAIT_V(n) asm volatile("s_waitcnt vmcnt(" #n ")" ::: "memory")
#define PG8_WAIT_L(n) asm volatile("s_waitcnt lgkmcnt(" #n ")" ::: "memory")
#define PG8_BAR __builtin_amdgcn_s_barrier()
#define PG8_SCHED __builtin_amdgcn_sched_barrier(0)
    Unit cur, nxt; int ui = 0;
    if (!S.next(0, cur)) return;
    f32x4 acc[2][2][4][2];
#pragma unroll
    for (int a = 0; a < 2; ++a)
#pragma unroll
        for (int b = 0; b < 2; ++b)
#pragma unroll
            for (int m = 0; m < 4; ++m)
#pragma unroll
                for (int n = 0; n < 2; ++n) acc[a][b][m][n] = (f32x4){0.f, 0.f, 0.f, 0.f};
    bf16x8 At[4][2], B0[2][2], B1[2][2]; v8i_t At8[4], B08[2], B18[2]; const int sc127 = 127;
    const GA char* cA = (const GA char*)g.A + (size_t)cur.pm * tstep; const GA char* cB = (const GA char*)g.Bt + (size_t)cur.pn * tstep;
    S.a_ready(cur);
    PG8_STAGE(PG8_SB(0, 0), cB, voffB); PG8_STAGE(PG8_SA(0, 0), cA, voffA); PG8_STAGE(PG8_SB(0, 1), cB + hstep, voffB); PG8_STAGE(PG8_SA(0, 1), cA + hstep, voffA);
    if (wr == 1) PG8_BAR;
    PG8_WAIT_V(4); PG8_BAR;
    PG8_STAGE(PG8_SB(1, 0), cB + kstep, voffB); PG8_STAGE(PG8_SA(1, 0), cA + kstep, voffA); PG8_STAGE(PG8_SB(1, 1), cB + hstep + kstep, voffB);
    PG8_WAIT_V(6); PG8_BAR;
    for (;;) {
        const bool has_next = S.next(ui + 1, nxt);
        const GA char* nA = has_next ? (const GA char*)g.A + (size_t)nxt.pm * tstep : cA; const GA char* nB = has_next ? (const GA char*)g.Bt + (size_t)nxt.pn * tstep : cB;
        for (int t = 0; t < nt; t += 2) {
            const bool last = (t == nt - 2);
            const GA char* a1 = cA + (size_t)(t + 1) * kstep;
            const GA char* a2 = last ? nA : cA + (size_t)(t + 2) * kstep; const GA char* b2 = last ? nB : cB + (size_t)(t + 2) * kstep;
            const GA char* a3 = a2 + kstep; const GA char* b3 = b2 + kstep;
            if (last && has_next) S.a_ready(nxt);
            if constexpr (Epi::MIDK) { if (t > 0 && (t & 7) == 0) E.mid(acc, cur, t >> 3, wr, wc, fr, fq); }
            PG8_LDB(B0, 0, 0); PG8_SCHED; PG8_LDA(At, 0, 0); PG8_STAGE(PG8_SA(1, 1), a1 + hstep, voffA);
            PG8_WAIT_L(8); PG8_BAR; PG8_WAIT_L(0); PG8_MMA(0, 0, At, B0); PG8_BAR; PG8_SCHED;
            PG8_LDB(B1, 0, 1); PG8_STAGE(PG8_SB(0, 0), b2, voffB);
            PG8_BAR; PG8_WAIT_L(0); PG8_MMA(0, 1, At, B1); PG8_BAR;
            PG8_LDA(At, 0, 1); PG8_STAGE(PG8_SA(0, 0), a2, voffA);
            PG8_BAR; PG8_WAIT_L(0); PG8_MMA(1, 0, At, B0); PG8_BAR; PG8_SCHED;
            PG8_STAGE(PG8_SB(0, 1), b2 + hstep, voffB);
            PG8_WAIT_V(6); PG8_BAR; PG8_MMA(1, 1, At, B1); PG8_BAR;
            PG8_LDB(B0, 1, 0); PG8_SCHED; PG8_LDA(At, 1, 0); PG8_STAGE(PG8_SA(0, 1), a2 + hstep, voffA);
            PG8_WAIT_L(8); PG8_BAR; PG8_WAIT_L(0); PG8_MMA(0, 0, At, B0); PG8_BAR; PG8_SCHED;
            PG8_LDB(B1, 1, 1); PG8_STAGE(PG8_SB(1, 0), b3, voffB);
            PG8_BAR; PG8_WAIT_L(0); PG8_MMA(0, 1, At, B1); PG8_BAR;
            PG8_LDA(At, 1, 1); PG8_STAGE(PG8_SA(1, 0), a3, voffA);
            PG8_BAR; PG8_WAIT_L(0); PG8_MMA(1, 0, At, B0); PG8_BAR; PG8_SCHED;
            PG8_STAGE(PG8_SB(1, 1), b3 + hstep, voffB);
            PG8_WAIT_V(6); PG8_BAR; PG8_MMA(1, 1, At, B1); PG8_BAR;
        }
        if constexpr (Epi::FP8) asm volatile("s_nop 15\n\ts_nop 15" ::: "memory");
        E(acc, cur, wr, wc, fr, fq); S.done(cur);
#if defined(DUP) && DUP == 7
        if constexpr (!Epi::MIDK && Epi::PERM) { asm volatile("s_waitcnt vmcnt(0)" ::: "memory"); E(acc, cur, wr, wc, fr, fq); E(acc, cur, wr, wc, fr, fq); }
#endif
        if (!has_next) break;
#pragma unroll
        for (int a = 0; a < 2; ++a)
#pragma unroll
            for (int b = 0; b < 2; ++b)
#pragma unroll
                for (int m = 0; m < 4; ++m)
#pragma unroll
                    for (int n = 0; n < 2; ++n) acc[a][b][m][n] = (f32x4){0.f, 0.f, 0.f, 0.f};
        cur = nxt; cA = nA; cB = nB; ++ui;
    }
    PG8_WAIT_V(0);
    if (wr == 0) PG8_BAR;
    PG8_BAR;
#undef PG8_SA
#undef PG8_SB
#undef PG8_STAGE
#undef PG8_LDA
#undef PG8_LDB
#undef PG8_MMA
#undef PG8_WAIT_V
#undef PG8_WAIT_L
#undef PG8_BAR
#undef PG8_SCHED
}
}

struct Args { const float* in[13]; float* out; unsigned char* ws; int ph_lo, ph_hi; };
struct Frame {
    const GA float* x; const GA float* norm_w; const GA float* w_in; const GA float* fox_b; const GA float* lq1; const GA float* lk1; const GA float* lq2; const GA float* lk2;
    const GA float* subln; const GA float* w_branch; const GA float* w_out; const GA float* rel_bias; const GA float* final_w; GA float* out;
    GA unsigned* ctl; GA bf16_t* WinT; GA bf16_t* WbrT; GA bf16_t* WoutT; GA float* xres; GA bf16_t* xb; GA float* ssq; GA bf16_t* Zs; GA bf16_t* G; GA bf16_t* QKV; GA bf16_t* IQ; GA bf16_t* IK;
    GA float* IW; GA float* FF; GA float* cum; GA float* tb; GA float* sc; GA u64* mask; GA bf16_t* Y; GA bf16_t* MG; GA float* O1; GA float* OD; GA float* LSE; GA float* DP; GA unsigned char* ws;
    LAS unsigned char* lds; volatile LAS unsigned* misc;
};

__device__ __forceinline__ int q_next(GA unsigned* ctr, volatile LAS unsigned* lw) {
    __syncthreads();
    if (threadIdx.x == 0) *lw = __hip_atomic_fetch_add(ctr, 1u, __ATOMIC_RELAXED, __HIP_MEMORY_SCOPE_AGENT);
    __syncthreads();
    return (int)*lw;
}

__device__ __forceinline__ int win_src_col(int n) {
    if (n < 2048) return n;
    if (n < 3072) return n - 2048 + 11776;
    if (n < 4608) return n - 3072 + 14420;
    if (n < 4672) return n - 4608 + 12800;
    if (n < 4688) return n - 4672 + 12864;
    if (n < 4692) return n - 4688 + 14416;
    return -1;
}
__device__ __forceinline__ int win8_src_col(int n) {
    if (n < 8192) return n + 2048;
    if (n < 9728) return n - 8192 + 10240;
    if (n < 11264) return n - 9728 + 12880;
    return n - 11264 + 15956;
}
__device__ __forceinline__ void transpose_tile(const GA float* src, int ld, int srccol4, const GA float* ksc, GA bf16_t* dst, int k0, int n0, LAS float* tile) {
    const int tid = tid_l(), tk = tid >> 5, tn4 = (tid & 31) * 4;
    f32x4 v[4];
#pragma unroll
    for (int i = 0; i < 4; ++i) { const int kk = tk + 16 * i; v[i] = (f32x4){0.f, 0.f, 0.f, 0.f};
        if (srccol4 >= 0) { v[i] = *(const GA f32x4*)(src + (size_t)(k0 + kk) * ld + srccol4); if (ksc) v[i] *= ksc[k0 + kk]; } }
#pragma unroll
    for (int i = 0; i < 4; ++i) { const int kk = tk + 16 * i;
#pragma unroll
        for (int j = 0; j < 4; ++j) tile[kk * 129 + tn4 + j] = v[i][j]; }
    __syncthreads();
    const int wn = tid >> 2, wk = tid & 3;
    float f[16];
#pragma unroll
    for (int j = 0; j < 16; ++j) f[j] = tile[(wk * 16 + j) * 129 + wn];
    u32x4 w0 = {cvt_pk_bf16(f[0], f[1]), cvt_pk_bf16(f[2], f[3]), cvt_pk_bf16(f[4], f[5]), cvt_pk_bf16(f[6], f[7])};
    u32x4 w1 = {cvt_pk_bf16(f[8], f[9]), cvt_pk_bf16(f[10], f[11]), cvt_pk_bf16(f[12], f[13]), cvt_pk_bf16(f[14], f[15])};
    GA u32x4* dp = (GA u32x4*)(dst + (size_t)(n0 + wn) * DM + k0 + wk * 16);
    dp[0] = w0; dp[1] = w1;
    __syncthreads();
}
__device__ __forceinline__ unsigned cvt4_fp8(float a, float b, float c, float d) {
    unsigned w = 0u; w = __builtin_amdgcn_cvt_pk_fp8_f32(a, b, w, false); w = __builtin_amdgcn_cvt_pk_fp8_f32(c, d, w, true); return w;
}
__device__ __forceinline__ void transpose_tile8(const GA float* src, int ld, int srccol4, const GA float* ksc, GA unsigned char* dst, int k0, int n0, LAS float* tile) {
    const int tid = tid_l(), tk = tid >> 5, tn4 = (tid & 31) * 4;
    f32x4 v[4];
#pragma unroll
    for (int i = 0; i < 4; ++i) { const int kk = tk + 16 * i; v[i] = *(const GA f32x4*)(src + (size_t)(k0 + kk) * ld + srccol4) * (ksc[k0 + kk] * W8SCALE); }
#pragma unroll
    for (int i = 0; i < 4; ++i) { const int kk = tk + 16 * i;
#pragma unroll
        for (int j = 0; j < 4; ++j) tile[kk * 129 + tn4 + j] = v[i][j]; }
    __syncthreads();
    const int wn = tid >> 2, wk = tid & 3;
    float f[16];
#pragma unroll
    for (int j = 0; j < 16; ++j) f[j] = tile[(wk * 16 + j) * 129 + wn];
    u32x4 w = {cvt4_fp8(f[0], f[1], f[2], f[3]), cvt4_fp8(f[4], f[5], f[6], f[7]), cvt4_fp8(f[8], f[9], f[10], f[11]), cvt4_fp8(f[12], f[13], f[14], f[15])};
    *(GA u32x4*)(dst + (size_t)(n0 + wn) * DM + k0 + wk * 16) = w;
    __syncthreads();
}
__device__ __forceinline__ int t5_bucket(int d) {
    if (d < 16) return d;
    const int th[15] = {22, 30, 40, 54, 73, 99, 134, 182, 246, 332, 450, 609, 825, 1117, 1513};
    int b = 16;
#pragma unroll
    for (int i = 0; i < 15; ++i) b += (d >= th[i]) ? 1 : 0;
    return b;
}
constexpr int WT_TW = 32 * 38, WT_TG = 32 * 100, WT_TB = 32 * 16, WT_TL = WT_TW + WT_TG + 2 * WT_TB;
__device__ __forceinline__ void weight_tile(const Frame& F, int l, int r, LAS float* tile) {
    const int tid = tid_l();
    if (r < WT_TW) { const int nt = r % 38, kt = r / 38; const int n = nt * 128 + (tid & 31) * 4;
        transpose_tile(F.w_in + (size_t)l * DM * NIN, NIN, win_src_col(n), F.norm_w + l * DM, F.WinT + (size_t)l * NINP * DM, kt * 64, nt * 128, tile); }
    else if (r < WT_TW + WT_TG) { const int q = r - WT_TW, nt = q % 100, kt = q / 100;
        transpose_tile8(F.w_in + (size_t)l * DM * NIN, NIN, win8_src_col(nt * 128 + (tid & 31) * 4), F.norm_w + l * DM, F.ws + WS_WG8 + (size_t)l * N8 * DM, kt * 64, nt * 128, tile); }
    else if (r < WT_TW + WT_TG + WT_TB) { const int q = r - WT_TW - WT_TG, nt = q % 16, kt = q / 16;
        transpose_tile(F.w_branch + (size_t)l * DM * DM, DM, nt * 128 + (tid & 31) * 4, (const GA float*)nullptr, F.WbrT + (size_t)l * DM * DM, kt * 64, nt * 128, tile); }
    else { const int q = r - WT_TW - WT_TG - WT_TB, nt = q % 16, kt = q / 16;
        transpose_tile(F.w_out + (size_t)l * DM * DM, DM, nt * 128 + (tid & 31) * 4, (const GA float*)nullptr, F.WoutT + (size_t)l * DM * DM, kt * 64, nt * 128, tile); }
}
__device__ __forceinline__ void p0_prologue(const Frame& F) {
    const int tid = tid_l(), lane = tid & 63, wave = tid >> 6, G = gridDim.x, bid = blockIdx.x;
    LAS float* tile = (LAS float*)F.lds;
    for (int j = bid; j < WT_TW + WT_TG; j += G) weight_tile(F, 0, j, tile);
    for (int row = bid * 8 + wave; row < MT; row += G * 8) {
        const GA float* xr = F.x + (size_t)row * DM; float ss = 0.f;
#pragma unroll
        for (int i = 0; i < 8; ++i) { const int c = (i * 64 + lane) * 4; const f32x4 v = *(const GA f32x4*)(xr + c);
            ss += v[0] * v[0] + v[1] * v[1] + v[2] * v[2] + v[3] * v[3];
            u32x2 w = {cvt_pk_bf16(v[0], v[1]), cvt_pk_bf16(v[2], v[3])}; *(GA u32x2*)(F.xb + (size_t)row * DM + c) = w;
            *(GA unsigned*)(F.ws + WS_XQ + (size_t)row * DM + c) = cvt4_fp8(v[0], v[1], v[2], v[3]); }
        ss = wave_sum(ss);
        if (lane < 32) F.ssq[(size_t)row * 32 + lane] = (lane == 0) ? ss : 0.f;
    }
    if (bid == 0 && tid < DEPTH * 128) { const int l = tid >> 7, i = tid & 127;
        const float lam_init = 0.8f - 0.6f * expf(-0.3f * (float)l);
        F.DP[l * 256 + 128 + i] = F.subln[l * 128 + i] * (1.0f - lam_init);
        if (i == 0) { float s1 = 0.f, s2 = 0.f;
            for (int k = 0; k < 64; ++k) { s1 = fmaf(F.lq1[l * 64 + k], F.lk1[l * 64 + k], s1); s2 = fmaf(F.lq2[l * 64 + k], F.lk2[l * 64 + k], s2); }
            F.DP[l * 256] = expf(s1) - expf(s2) + lam_init; F.DP[l * 256 + 1] = 1.0f - lam_init; } }
    for (int i = bid * 512 + tid; i < 12 * SEQ; i += G * 512) { const int hd = i / SEQ, d = i % SEQ; F.tb[i] = F.rel_bias[t5_bucket(d) * 12 + hd] * LOG2E; }
}

struct EpiIn {
    static constexpr bool PERM = true, AFTER_DRAIN = false, MIDK = false, FP8 = false;
    GA unsigned char* ws;
    template <int KIND>
    __device__ __forceinline__ void body(const f32x4 (&acc)[2][2][4][2], int row0_, int cl_, int fq, GA bf16_t* base, int ldc, float qscale, int headbase) const {
        int row0 = row0_, cl = cl_; asm volatile("" : "+v"(row0), "+v"(cl));
        const GA float* ssq = (const GA float*)(ws + WS_SSQ);
        float scv_[2][4];
#pragma unroll
        for (int ai = 0; ai < 2; ++ai) {
            f32x4 sq_[4][2];
#pragma unroll
            for (int m = 0; m < 4; ++m) { const GA float* sp = ssq + (size_t)(row0 + ai * 128 + m * 16) * 32 + fq * 8;
                sq_[m][0] = *(const GA f32x4*)sp; sq_[m][1] = *(const GA f32x4*)(sp + 4); }
#pragma unroll
            for (int m = 0; m < 4; ++m) { const f32x4 s4 = sq_[m][0] + sq_[m][1];
                float ssum = (s4[0] + s4[1]) + (s4[2] + s4[3]);
                ssum += __shfl_xor(ssum, 16); ssum += __shfl_xor(ssum, 32);
                scv_[ai][m] = __builtin_amdgcn_rsqf(ssum * (1.0f / DM) + RMS_EPS) * qscale; }
            asm volatile("" :: "v"(scv_[ai][0]), "v"(scv_[ai][1]), "v"(scv_[ai][2]), "v"(scv_[ai][3]));
        }
#pragma unroll
        for (int ai = 0; ai < 2; ++ai)
#pragma unroll
            for (int m = 0; m < 4; ++m) {
                const int r = row0 + ai * 128 + m * 16;
                const float sc = scv_[ai][m];
#pragma unroll
                for (int bj = 0; bj < 2; ++bj) {
                    f32x4 v0 = acc[ai][bj][m][0] * sc, v1 = acc[ai][bj][m][1] * sc;
                    if (KIND == 0) {
#pragma unroll
                        for (int j = 0; j < 4; ++j) { v0[j] = v0[j] * sigmoidf_(v0[j]); v1[j] = v1[j] * sigmoidf_(v1[j]); }
                    } else if (KIND == 1) {
#pragma unroll
                        for (int j = 0; j < 4; ++j) { v0[j] = sigmoidf_(v0[j]) * 256.0f; v1[j] = sigmoidf_(v1[j]) * 256.0f; }
                    }
                    if (KIND == 4) {
                        if (bj == 0) {
                            if (cl < 64) { u32x4 w = {cvt_pk_bf16(v0[0], v0[1]), cvt_pk_bf16(v0[2], v0[3]), cvt_pk_bf16(v1[0], v1[1]), cvt_pk_bf16(v1[2], v1[3])};
                                *(GA u32x4*)((GA bf16_t*)(ws + WS_IK) + (size_t)(r >> 5) * 2048 + (cl >> 4) * 512 + (((cl >> 3) & 1) * 32 + (r & 31)) * 8) = w; }
                            else if (cl < 80) { GA float* iw = (GA float*)(ws + WS_IW) + (size_t)r * 16 + (cl - 64); *(GA f32x4*)iw = v0; *(GA f32x4*)(iw + 4) = v1; }
                            else if (cl == 80) { *(GA f32x4*)((GA float*)(ws + WS_FF) + (size_t)r * 4) = v0; }
                        }
                    } else {
                        if (KIND == 1) {
                            u32x2 w;
                            { const unsigned a = __builtin_amdgcn_cvt_pk_u8_f32(v0[0], 0, 0u), b = __builtin_amdgcn_cvt_pk_u8_f32(v0[1], 1, a), c = __builtin_amdgcn_cvt_pk_u8_f32(v0[2], 2, b); w[0] = __builtin_amdgcn_cvt_pk_u8_f32(v0[3], 3, c); }
                            { const unsigned a = __builtin_amdgcn_cvt_pk_u8_f32(v1[0], 0, 0u), b = __builtin_amdgcn_cvt_pk_u8_f32(v1[1], 1, a), c = __builtin_amdgcn_cvt_pk_u8_f32(v1[2], 2, b); w[1] = __builtin_amdgcn_cvt_pk_u8_f32(v1[3], 3, c); }
                            *(GA u32x2*)((GA unsigned char*)base + (size_t)r * ldc + bj * 128 + cl) = w;
                            continue;
                        }
                        GA bf16_t* dst;
                        if (KIND == 2) { const int b = r >> 13, s = r & (SEQ - 1); dst = base + ((size_t)(b * 4 + headbase + bj) * SEQ + s) * 128 + cl; }
                        else dst = base + (size_t)r * ldc + bj * 128 + cl;
                        u32x4 w = {cvt_pk_bf16(v0[0], v0[1]), cvt_pk_bf16(v0[2], v0[3]), cvt_pk_bf16(v1[0], v1[1]), cvt_pk_bf16(v1[2], v1[3])};
                        *(GA u32x4*)dst = w;
                    }
                }
            }
    }
    __device__ __forceinline__ void operator()(const f32x4 (&acc)[2][2][4][2], const pg8::Unit& u, int wr, int wc, int fr, int fq) const {
        const int row0 = u.pm * 256 + wr * 64 + fr, pn = u.pn, cl = wc * 32 + 8 * fq;
        if (pn < 8) body<0>(acc, row0, cl, fq, (GA bf16_t*)(ws + WS_ZS) + pn * 256, DM, 1.f, 0);
        else if (pn < 12) body<3>(acc, row0, cl, fq, (GA bf16_t*)(ws + WS_IQ) + (pn - 8) * 256, 1024, 1.f, 0);
        else if (pn < 18) { const int t6 = pn - 12, which = t6 >> 1;
            body<2>(acc, row0, cl, fq, (GA bf16_t*)(ws + WS_QKV) + (size_t)(2 * 3 + which) * QS, 0, (which == 0) ? QSC64 : 1.f, (t6 & 1) * 2); }
        else body<4>(acc, row0, cl, fq, (GA bf16_t*)nullptr, 0, 1.f, 0);
    }
};

struct EpiGate {
    static constexpr bool PERM = true, AFTER_DRAIN = false, MIDK = false, FP8 = true;
    GA unsigned char* ws;
    __device__ __forceinline__ void operator()(const f32x4 (&acc)[2][2][4][2], const pg8::Unit& u, int wr, int wc, int fr, int fq) const {
        const int row0 = u.pm * 256 + wr * 64 + fr, cl = wc * 32 + 8 * fq, pn = u.pn;
        EpiIn e{ws};
        if (pn < 32) e.body<1>(acc, row0, cl, fq, (GA bf16_t*)(ws + WS_G + pn * 256), 8192, 1.0f / W8SCALE, 0);
        else { const int q = pn - 32, mixer = (q < 6) ? 0 : (q < 12 ? 1 : 3), t6 = q % 6, which = t6 >> 1;
            e.body<2>(acc, row0, cl, fq, (GA bf16_t*)(ws + WS_QKV) + (size_t)(mixer * 3 + which) * QS, 0, ((which == 0) ? QSC128 : 1.f) * (1.0f / W8SCALE), (t6 & 1) * 2); }
    }
};

__device__ __forceinline__ void fox_scan(const Frame& F, int layer, int seqid) {
    const int tid = tid_l(), lane = tid & 63, wave = tid >> 6, b = seqid >> 2, h = seqid & 3;
    LAS float* sm = (LAS float*)F.lds;
    const float bias = F.fox_b[layer * 4 + h];
    float v[16]; float run = 0.f;
#pragma unroll
    for (int i = 0; i < 16; ++i) { const int s = tid * 16 + i; const float x = F.FF[(size_t)(b * SEQ + s) * 4 + h] + bias;
        const float ls = fminf(x, 0.f) - log1pf(expf(-fabsf(x))); run += ls; v[i] = run; }
    float incl = run;
#pragma unroll
    for (int o = 1; o < 64; o <<= 1) { const float t = __shfl_up(incl, o); if (lane >= o) incl += t; }
    if (lane == 63) sm[wave] = incl;
    __syncthreads();
    float woff = 0.f;
    for (int w = 0; w < wave; ++w) woff += sm[w];
    const float excl = woff + incl - run;
#pragma unroll
    for (int i = 0; i < 16; ++i) F.cum[(size_t)(b * 4 + h) * SEQ + tid * 16 + i] = (excl + v[i]) * LOG2E;
    __syncthreads();
}
__device__ __forceinline__ void fox_kmax(const Frame& F, int layer) {
    const int tid = tid_l(), lane = tid & 63, wave = tid >> 6, G = gridDim.x, bid = blockIdx.x;
    const GA bf16_t* Kf = F.QKV + (size_t)(1 * 3 + 1) * QS;
    LAS float* sm = (LAS float*)F.lds;
    const int bh = bid & 7, part = bid >> 3, nparts = (G + 7 - bh) / 8;
    float mx = 0.f;
    for (int r4 = part * 8 + wave; r4 < SEQ / 4; r4 += nparts * 8) {
        const u32x4 w = *(const GA u32x4*)(Kf + ((size_t)bh * SEQ + r4 * 4 + (lane >> 4)) * 128 + (lane & 15) * 8); float ss = 0.f;
#pragma unroll
        for (int j = 0; j < 4; ++j) { const float a = bf_lo(w[j]), b = bf_hi(w[j]); ss = fmaf(a, a, ss); ss = fmaf(b, b, ss); }
        ss += __shfl_xor(ss, 1); ss += __shfl_xor(ss, 2); ss += __shfl_xor(ss, 4); ss += __shfl_xor(ss, 8);
        mx = fmaxf(mx, ss); }
#pragma unroll
    for (int o = 32; o > 0; o >>= 1) mx = fmaxf(mx, __shfl_xor(mx, o));
    __syncthreads();
    if (lane == 0) sm[wave] = mx;
    __syncthreads();
    if (tid == 0) { float m8 = sm[0];
#pragma unroll
        for (int w = 1; w < 8; ++w) m8 = fmaxf(m8, sm[w]);
        __hip_atomic_fetch_max(F.ctl + CW_KM + layer * 8 + bh, __float_as_uint(m8), __ATOMIC_RELAXED, __HIP_MEMORY_SCOPE_AGENT); }
    __syncthreads();
}
__device__ __forceinline__ void idx_unit(const Frame& F, int unit) {
    const int b = unit / 576; int id = unit % 576; int g = 0;
    while (8 * (g + 1) * (g + 2) <= id) ++g;
    const int rem = id - 8 * g * (g + 1), qb = 16 * g + rem / (g + 1), kc = rem % (g + 1);
    const int tid = tid_l(), lane = tid & 63, wave = __builtin_amdgcn_readfirstlane(tid >> 6), n32 = lane & 31, hi = lane >> 5;
    const int tq0 = qb * 64 + wave * 8;
    const int qa = (n32 >> 2) & 1, ha = (n32 & 3) + 4 * (n32 >> 3);
    bf16x8 Af[4][4]; float wr_[4][16];
#pragma unroll
    for (int p = 0; p < 4; ++p) {
        const GA bf16_t* qp = F.IQ + (size_t)(b * SEQ + tq0 + 2 * p + qa) * 1024 + ha * 64 + hi * 8;
#pragma unroll
        for (int ks = 0; ks < 4; ++ks) Af[p][ks] = *(const GA bf16x8*)(qp + ks * 16);
        const GA float* wp = F.IW + (size_t)(b * SEQ + tq0 + 2 * p + hi) * 16;
#pragma unroll
        for (int q4 = 0; q4 < 4; ++q4) { const f32x4 w4 = *(const GA f32x4*)(wp + 4 * q4); wr_[p][4 * q4] = w4[0]; wr_[p][4 * q4 + 1] = w4[1]; wr_[p][4 * q4 + 2] = w4[2]; wr_[p][4 * q4 + 3] = w4[3]; }
    }
    const int smax = tq0 + 7;
    int nj = (smax - kc * 1024) / 32 + 1; nj = nj > 32 ? 32 : nj;
    const GA bf16_t* kp0 = F.IK + (size_t)(b * SEQ + kc * 1024 + n32) * 64 + hi * 8;
    GA float* sp0 = F.sc + ((size_t)(b * SEQ + tq0 + hi)) * SEQ + kc * 1024 + n32;
    bf16x8 Bn[4];
#pragma unroll
    for (int ks = 0; ks < 4; ++ks) Bn[ks] = *(const GA bf16x8*)(kp0 + ks * 16);
    for (int j = 0; j < nj; ++j) {
        bf16x8 Bf[4];
#pragma unroll
        for (int ks = 0; ks < 4; ++ks) Bf[ks] = Bn[ks];
        if (j + 1 < nj) {
#pragma unroll
            for (int ks = 0; ks < 4; ++ks) Bn[ks] = *(const GA bf16x8*)(kp0 + (size_t)(j + 1) * 32 * 64 + ks * 16);
        }
#pragma unroll
        for (int p = 0; p < 4; ++p) {
            f32x16 c = {};
#pragma unroll
            for (int ks = 0; ks < 4; ++ks) c = __builtin_amdgcn_mfma_f32_32x32x16_bf16(Af[p][ks], Bf[ks], c, 0, 0, 0);
            float sc = 0.f;
#pragma unroll
            for (int r = 0; r < 16; ++r) sc = fmaf(wr_[p][r], fmaxf(c[r], 0.f), sc);
            sp0[(size_t)(2 * p) * SEQ + j * 32] = sc;
        }
    }
}

__device__ __forceinline__ unsigned sel_key(float f) { const unsigned u = __float_as_uint(f == 0.f ? 0.f : f); return (u >> 31) ? ~u : (u | 0x80000000u); }
__device__ __forceinline__ int wave_sum_i(int v) {
#pragma unroll
    for (int o = 32; o > 0; o >>= 1) v += __shfl_xor(v, o);
    return v;
}
__device__ __forceinline__ void select_row(const Frame& F, int row_) {
    const int row = __builtin_amdgcn_readfirstlane(row_);
    const int lane = tid_l() & 63, t = row & (SEQ - 1);
    GA u64* mrow = F.mask + (size_t)row * 128;
    if (t < 256) {
#pragma unroll
        for (int half = 0; half < 2; ++half) { const int j = half * 64 + lane; const int lo = j * 64; u64 w = 0ull;
            if (t >= lo + 63) w = ~0ull; else if (t >= lo) w = (~0ull) >> (63 - (t - lo));
            mrow[j] = w; }
        return;
    }
    const GA float* srow = F.sc + (size_t)row * SEQ + lane;
    const int nj = (t >> 6) + 1;
    unsigned key[128];
#pragma unroll
    for (int jj = 0; jj < 4; ++jj) {
        if (jj * 32 < nj) {
#pragma unroll
            for (int j = jj * 32; j < jj * 32 + 32; ++j) key[j] = __float_as_uint(srow[j * 64]);
        }
    }
#pragma unroll
    for (int jj = 0; jj < 4; ++jj) {
        if (jj * 32 < nj) {
#pragma unroll
            for (int j = jj * 32; j < jj * 32 + 32; ++j) key[j] = (j * 64 + lane <= t) ? sel_key(__uint_as_float(key[j])) : 0u;
        } else {
#pragma unroll
            for (int j = jj * 32; j < jj * 32 + 32; ++j) key[j] = 0u;
        }
    }
#define CNT8(j0) do { u64 b0 = __ballot(key[(j0)] >= cand), b1 = __ballot(key[(j0) + 1] >= cand), b2 = __ballot(key[(j0) + 2] >= cand), b3 = __ballot(key[(j0) + 3] >= cand), \
        b4 = __ballot(key[(j0) + 4] >= cand), b5 = __ballot(key[(j0) + 5] >= cand), b6 = __ballot(key[(j0) + 6] >= cand), b7 = __ballot(key[(j0) + 7] >= cand); \
        asm volatile("" : "+s"(b0), "+s"(b1), "+s"(b2), "+s"(b3), "+s"(b4), "+s"(b5), "+s"(b6), "+s"(b7)); \
        c += (__popcll(b0) + __popcll(b1)) + (__popcll(b2) + __popcll(b3)) + (__popcll(b4) + __popcll(b5)) + (__popcll(b6) + __popcll(b7)); } while (0)
#define COUNT_GE() do { c = 0; _Pragma("unroll") for (int jj = 0; jj < 4; ++jj) { if (jj * 32 < nj) { CNT8(jj * 32); CNT8(jj * 32 + 8); CNT8(jj * 32 + 16); CNT8(jj * 32 + 24); } } } while (0)
    unsigned mx = 0u;
#pragma unroll
    for (int j = 0; j < 128; ++j) mx = key[j] > mx ? key[j] : mx;
#pragma unroll
    for (int o = 32; o > 0; o >>= 1) { const unsigned t2 = (unsigned)__shfl_xor((int)mx, o); mx = t2 > mx ? t2 : mx; }
    unsigned prefix = 0u; int cge = 1 << 30, c, bit = 31;
    { const unsigned e9 = mx >> 23;
      for (unsigned k = 0; k < 6u && k <= e9; ++k) { const unsigned cand = (e9 - k) << 23; COUNT_GE();
          if (c >= 256) { prefix = cand; cge = c; bit = 22; break; } } }
    if (cge != 256) {
        for (; bit >= 0; --bit) {
            const unsigned cand = prefix | (1u << bit); COUNT_GE();
            if (c >= 256) { prefix = cand; cge = c; if (c == 256) break; }
        }
    }
#undef CNT8
#undef COUNT_GE
    if (cge == 256) {
        unsigned w0l = 0u, w0h = 0u, w1l = 0u, w1h = 0u;
#pragma unroll
        for (int j = 0; j < 64; ++j) { const u64 word = __ballot(key[j] >= prefix);
            asm volatile("s_nop 1\n\tv_writelane_b32 %0, %1, %2" : "+v"(w0l) : "s"((unsigned)word), "n"(j)); asm volatile("v_writelane_b32 %0, %1, %2" : "+v"(w0h) : "s"((unsigned)(word >> 32)), "n"(j)); }
        if (nj > 64) {
#pragma unroll
            for (int j = 64; j < 128; ++j) { const u64 word = __ballot(key[j] >= prefix);
                asm volatile("s_nop 1\n\tv_writelane_b32 %0, %1, %2" : "+v"(w1l) : "s"((unsigned)word), "n"(j - 64)); asm volatile("v_writelane_b32 %0, %1, %2" : "+v"(w1h) : "s"((unsigned)(word >> 32)), "n"(j - 64)); }
        }
        mrow[lane] = ((u64)w0h << 32) | w0l; mrow[64 + lane] = ((u64)w1h << 32) | w1l;
    } else {
        int cgt = 0;
        for (int j = 0; j < nj; ++j) { const int s = j * 64 + lane; const float v_ = srow[j * 64]; const unsigned k = (s <= t) ? sel_key(v_) : 0u; cgt += __popcll(__ballot(k > prefix)); }
        int need = 256 - cgt;
        for (int j = 0; j < nj; ++j) { const int s = j * 64 + lane; const float v_ = srow[j * 64]; const unsigned k = (s <= t) ? sel_key(v_) : 0u;
            u64 word = __ballot(k > prefix); u64 tm = __ballot(k == prefix);
            if (tm != 0ull && need > 0) { const int c = __popcll(tm);
                if (c <= need) { word |= tm; need -= c; }
                else { u64 selb = 0ull; for (int i = 0; i < need; ++i) { const u64 low = tm & (~tm + 1ull); selb |= low; tm ^= low; } word |= selb; need = 0; } }
            if (lane == 0) mrow[j] = word; }
        for (int j = nj + lane; j < 128; j += 64) mrow[j] = 0ull;
    }
}

#if defined(TPROBE)
#define IS_T0(k) do { if ((k) == TPROBE) is_t0 = __builtin_amdgcn_s_memrealtime(); } while (0)
#define IS_T1(k) do { if ((k) == TPROBE) tpacc += __builtin_amdgcn_s_memrealtime() - is_t0; } while (0)
#else
#define IS_T0(k) do { } while (0)
#define IS_T1(k) do { } while (0)
#endif
__device__ __forceinline__ void idxsel_unit(const Frame& F, int unit, unsigned long long& tpacc) {
    unsigned long long is_t0 = 0ull; (void)is_t0;
    const int b = unit & 1, t0 = (SEQ / 8 - 1 - (unit >> 1)) * 8;
    const int tid = tid_l(), lane = tid & 63, wave = __builtin_amdgcn_readfirstlane(tid >> 6), n32 = lane & 31, hi = lane >> 5;
    LAS unsigned short* S = (LAS unsigned short*)F.lds;
    IS_T0(30);
    {
        const int qa = (n32 >> 2) & 1, ha = (n32 & 3) + 4 * (n32 >> 3);
        typedef float f32x2_ __attribute__((ext_vector_type(2)));
        bf16x8 Af[4][4]; f32x2_ wr2[4][8];
#pragma unroll
        for (int p = 0; p < 4; ++p) {
            const GA bf16_t* qp = F.IQ + (size_t)(b * SEQ + t0 + 2 * p + qa) * 1024 + ha * 64 + hi * 8;
#pragma unroll
            for (int ks = 0; ks < 4; ++ks) Af[p][ks] = *(const GA bf16x8*)(qp + ks * 16);
            const GA float* wp = F.IW + (size_t)(b * SEQ + t0 + 2 * p + hi) * 16;
#pragma unroll
            for (int q4 = 0; q4 < 4; ++q4) { const f32x4 w4 = *(const GA f32x4*)(wp + 4 * q4); wr2[p][2 * q4] = (f32x2_){w4[0], w4[1]}; wr2[p][2 * q4 + 1] = (f32x2_){w4[2], w4[3]}; }
        }
        asm volatile("s_waitcnt vmcnt(0)" ::: "memory"); IS_T1(30); IS_T0(31);
        const int ntile = (t0 + 7) / 32 + 1;
        const GA bf16_t* kp0 = F.IK + (size_t)b * SEQ * 64 + lane * 8;
        bf16x8 Bn[4];
        if (wave < ntile) {
#pragma unroll
            for (int ks = 0; ks < 4; ++ks) Bn[ks] = *(const GA bf16x8*)(kp0 + (size_t)wave * 2048 + ks * 512);
        }
        for (int j = wave; j < ntile; j += 8) {
            bf16x8 Bf[4];
#pragma unroll
            for (int ks = 0; ks < 4; ++ks) Bf[ks] = Bn[ks];
            if (j + 8 < ntile) {
#pragma unroll
                for (int ks = 0; ks < 4; ++ks) Bn[ks] = *(const GA bf16x8*)(kp0 + (size_t)(j + 8) * 2048 + ks * 512);
            }
            const int s = j * 32 + n32;
            LAS unsigned short* sp = S + ((s >> 7) * 64 + (s & 63)) * 2 + ((s >> 6) & 1);
#define IDX_MM(C, p) do { C = f32x16{}; _Pragma("unroll") for (int ks = 0; ks < 4; ++ks) C = __builtin_amdgcn_mfma_f32_32x32x16_bf16(Af[p][ks], Bf[ks], C, 0, 0, 0); } while (0)
#define IDX_RED(C, p) do { f32x2_ s2 = {0.f, 0.f}; _Pragma("unroll") for (int r2 = 0; r2 < 8; ++r2) { \
                    const float f0 = C[2 * r2], f1 = C[2 * r2 + 1]; const int i0 = __float_as_int(f0), i1 = __float_as_int(f1); \
                    const f32x2_ x2 = {__int_as_float(i0 > 0 ? i0 : 0), __int_as_float(i1 > 0 ? i1 : 0)}; s2 = __builtin_elementwise_fma(wr2[p][r2], x2, s2); } \
                float sc = s2[0] + s2[1]; sc = fminf(fmaxf(sc, -65504.f), 65504.f);       \
                sp[(2 * (p) + hi) * 8192] = __builtin_bit_cast(unsigned short, (_Float16)sc); } while (0)
            f32x16 c0, c1;
            IDX_MM(c0, 0); IDX_MM(c1, 1); __builtin_amdgcn_sched_barrier(0);
            IDX_RED(c0, 0); __builtin_amdgcn_sched_barrier(0); IDX_MM(c0, 2); __builtin_amdgcn_sched_barrier(0);
            IDX_RED(c1, 1); __builtin_amdgcn_sched_barrier(0); IDX_MM(c1, 3); __builtin_amdgcn_sched_barrier(0);
            IDX_RED(c0, 2); IDX_RED(c1, 3);
#undef IDX_MM
#undef IDX_RED
        }
    }
    IS_T1(31); IS_T0(32);
    __syncthreads();
    IS_T1(32);
    {
        const int t = t0 + wave;
        GA u64* mrow = F.mask + (size_t)(b * SEQ + t) * 128;
        if (t < 256) {
#pragma unroll
            for (int half = 0; half < 2; ++half) { const int jw = half * 64 + lane; const int lo = jw * 64; u64 w = 0ull;
                if (t >= lo + 63) w = ~0ull; else if (t >= lo) w = (~0ull) >> (63 - (t - lo));
                mrow[jw] = w; }
        } else {
            const LAS unsigned* row = (const LAS unsigned*)(S + wave * 8192) + lane;
            const int nj = (t >> 7) + 1;
            unsigned kw[64];
            IS_T0(33);
            { LAS unsigned short* rw = S + wave * 8192; const int sa = 128 * (nj - 1) + lane, sb = sa + 64;
              if (sa > t) rw[((sa >> 7) * 64 + (sa & 63)) * 2] = (unsigned short)0xffffu;
              if (sb > t) rw[((sb >> 7) * 64 + (sb & 63)) * 2 + 1] = (unsigned short)0xffffu;
              asm volatile("" ::: "memory"); }
            const unsigned sh15 = 0x000f000fu;
#pragma unroll
            for (int jj = 0; jj < 4; ++jj) {
                if (jj * 16 < nj) {
#pragma unroll
                    for (int j = jj * 16; j < jj * 16 + 16; ++j) { unsigned w = row[j * 64]; unsigned sg;
                        asm("v_pk_ashrrev_i16 %0, %1, %2" : "=v"(sg) : "v"(sh15), "v"(w));
                        w ^= (sg | 0x80008000u);
                        kw[j] = (j < nj) ? w : 0u; }
                } else {
#pragma unroll
                    for (int j = jj * 16; j < jj * 16 + 16; ++j) kw[j] = 0u;
                }
            }
#define CNT1(j) asm volatile("v_pk_sub_u16 %1, %2, %3 clamp\n\tv_pk_min_u16 %1, %1, %4\n\tv_pk_add_u16 %0, %0, %1" : "+v"(acc2), "=&v"(tmp2) : "v"(kw[(j)]), "v"(cm2), "v"(one2))
#define COUNT_GE16(cand) do { const unsigned cm2 = (((cand) - 1u) & 0xffffu) * 0x00010001u, one2 = 0x00010001u; unsigned acc2 = 0u, tmp2; \
            _Pragma("unroll") for (int jj = 0; jj < 4; ++jj) { if (jj * 16 < nj) { _Pragma("unroll") for (int j = jj * 16; j < jj * 16 + 16; ++j) CNT1(j); } } \
            int v_ = (int)((acc2 & 0xffffu) + (acc2 >> 16));                                                                                            \
            v_ += __builtin_amdgcn_update_dpp(0, v_, 0x111, 0xf, 0xf, true); v_ += __builtin_amdgcn_update_dpp(0, v_, 0x112, 0xf, 0xf, true);            \
            v_ += __builtin_amdgcn_update_dpp(0, v_, 0x114, 0xf, 0xf, true); v_ += __builtin_amdgcn_update_dpp(0, v_, 0x118, 0xf, 0xf, true);            \
            v_ += __builtin_amdgcn_update_dpp(0, v_, 0x142, 0xa, 0xf, true); v_ += __builtin_amdgcn_update_dpp(0, v_, 0x143, 0xc, 0xf, true);            \
            c = __builtin_amdgcn_readlane(v_, 63); } while (0)
            IS_T1(33); IS_T0(34);
            unsigned prefix = 0u; int cge = 1 << 30, c;
            unsigned lo = 0u, hi; int clo = t + 1, chi = 0;
            { unsigned mx = 0u;
#pragma unroll
              for (int j = 0; j < 64; ++j) asm("v_pk_max_u16 %0, %0, %1" : "+v"(mx) : "v"(kw[j]));
              mx = (mx & 0xffffu) > (mx >> 16) ? (mx & 0xffffu) : (mx >> 16);
#pragma unroll
              for (int o = 32; o > 0; o >>= 1) { const unsigned t2 = (unsigned)__shfl_xor((int)mx, o); mx = t2 > mx ? t2 : mx; }
              const unsigned e6 = (unsigned)__builtin_amdgcn_readfirstlane((int)mx) >> 10;
              hi = (e6 + 1u) << 10;
              for (unsigned k = 0; k < 5u && k < e6; ++k) { const unsigned cand = (e6 - k) << 10; COUNT_GE16(cand);
                  if (c >= 256) { lo = cand; clo = c; break; } else { hi = cand; chi = c; } } }
            for (int it = 0; clo != 256 && hi - lo > 1u; ++it) {
                const unsigned span = hi - lo; unsigned cand;
                if (it >= 3 && (it & 1)) cand = lo + (span >> 1);
                else { const float frac = (float)(256 - chi) / (float)(clo - chi); unsigned d = (unsigned)(frac * (float)span + 0.5f); d = d < 1u ? 1u : (d > span - 1u ? span - 1u : d); cand = hi - d; }
                COUNT_GE16(cand);
                if (c >= 256) { lo = cand; clo = c; } else { hi = cand; chi = c; }
            }
            prefix = lo; cge = clo;
#undef CNT1
#undef COUNT_GE16
            IS_T1(34); IS_T0(35);
            unsigned w0l = 0u, w0h = 0u, w1l = 0u, w1h = 0u;
            const unsigned short pl16 = (unsigned short)prefix; const unsigned ph16 = prefix << 16;
            if (cge == 256) {
#pragma unroll
                for (int j = 0; j < 32; ++j) { const u64 wa = __ballot((unsigned short)kw[j] >= pl16), wb = __ballot(kw[j] >= ph16);
                    asm volatile("s_nop 1\n\tv_writelane_b32 %0, %1, %2" : "+v"(w0l) : "s"((unsigned)wa), "n"(2 * j)); asm volatile("v_writelane_b32 %0, %1, %2" : "+v"(w0h) : "s"((unsigned)(wa >> 32)), "n"(2 * j));
                    asm volatile("s_nop 1\n\tv_writelane_b32 %0, %1, %2" : "+v"(w0l) : "s"((unsigned)wb), "n"(2 * j + 1)); asm volatile("v_writelane_b32 %0, %1, %2" : "+v"(w0h) : "s"((unsigned)(wb >> 32)), "n"(2 * j + 1)); }
                if (nj > 32) {
#pragma unroll
                    for (int j = 32; j < 64; ++j) { const u64 wa = __ballot((unsigned short)kw[j] >= pl16), wb = __ballot(kw[j] >= ph16);
                        asm volatile("s_nop 1\n\tv_writelane_b32 %0, %1, %2" : "+v"(w1l) : "s"((unsigned)wa), "n"(2 * j - 64)); asm volatile("v_writelane_b32 %0, %1, %2" : "+v"(w1h) : "s"((unsigned)(wa >> 32)), "n"(2 * j - 64));
                        asm volatile("s_nop 1\n\tv_writelane_b32 %0, %1, %2" : "+v"(w1l) : "s"((unsigned)wb), "n"(2 * j - 63)); asm volatile("v_writelane_b32 %0, %1, %2" : "+v"(w1h) : "s"((unsigned)(wb >> 32)), "n"(2 * j - 63)); }
                }
            } else {
                int cgt = 0;
#pragma unroll
                for (int j = 0; j < 64; ++j) cgt += __popcll(__ballot((unsigned short)kw[j] > pl16)) + __popcll(__ballot((kw[j] >> 16) > prefix));
                int need = 256 - cgt;
#define TIE_WORD(GT, EQ, SETL, SETH, LN) do { u64 word = (GT); u64 tm = (EQ);                                                          \
                    if (tm != 0ull && need > 0) { const int ce = __popcll(tm);                                                       \
                        if (ce <= need) { word |= tm; need -= ce; }                                                                  \
                        else { u64 selb = 0ull; for (int i = 0; i < need; ++i) { const u64 low = tm & (~tm + 1ull); selb |= low; tm ^= low; } word |= selb; need = 0; } } \
                    asm volatile("s_nop 1\n\tv_writelane_b32 %0, %1, %2" : "+v"(SETL) : "s"((unsigned)word), "n"(LN)); asm volatile("v_writelane_b32 %0, %1, %2" : "+v"(SETH) : "s"((unsigned)(word >> 32)), "n"(LN)); } while (0)
#pragma unroll
                for (int j = 0; j < 32; ++j) {
                    TIE_WORD(__ballot((unsigned short)kw[j] > pl16), __ballot((unsigned short)kw[j] == pl16), w0l, w0h, 2 * j);
                    TIE_WORD(__ballot((kw[j] >> 16) > prefix), __ballot((kw[j] >> 16) == prefix), w0l, w0h, 2 * j + 1); }
#pragma unroll
                for (int j = 32; j < 64; ++j) {
                    TIE_WORD(__ballot((unsigned short)kw[j] > pl16), __ballot((unsigned short)kw[j] == pl16), w1l, w1h, 2 * j - 64);
                    TIE_WORD(__ballot((kw[j] >> 16) > prefix), __ballot((kw[j] >> 16) == prefix), w1l, w1h, 2 * j - 63); }
#undef TIE_WORD
            }
            mrow[lane] = ((u64)w0h << 32) | w0l; mrow[64 + lane] = ((u64)w1h << 32) | w1l;
            IS_T1(35);
        }
    }
}

namespace att {
typedef short s16x4 __attribute__((ext_vector_type(4)));
constexpr int D = 128, NW = 8, QBLK = 32, KVBLK = 64, QB = NW * QBLK;
constexpr int SHM_V = KVBLK * D * 2, SHM_K = KVBLK * D * 2;
constexpr int L_WS = 2 * SHM_V + 2 * SHM_K;
constexpr int L_AUX = L_WS + NW * 64 * 4;
constexpr int TB_PAD = 320, TB_N = TB_PAD + 1984;
constexpr int L_FLG = L_AUX + 8192 * 4;
constexpr int L_END = L_FLG + 64;
constexpr float SKIP_MARGIN = 40.f;
constexpr float THR2 = 11.5f;
constexpr int FAR_DIST = 1513;

#define KSWZ(row, colB) ((row) * 256 + ((colB) ^ (((row) & 7) << 4)))
#define SBAR() __builtin_amdgcn_sched_barrier(0)
__device__ __forceinline__ int v_st(int k, int c) { const int kk = (k & ~0xC) | ((k & 4) << 1) | ((k & 8) >> 1); return ((kk >> 3) * 4 + (c >> 5)) * 512 + ((kk & 7) * 32 + (c & 31)) * 2; }
__device__ __forceinline__ int v_rd_base(int lane) { return ((lane & 3) << 3) | (((lane >> 2) & 3) << 6) | (((lane >> 4) & 1) << 5) | (((lane >> 5) & 1) << 8); }
constexpr int v_rd_off(int d0, int ks, int half) { return d0 * 512 + ks * 4096 + half * 2048; }
__device__ __forceinline__ int crow(int r, int hi) { return (r & 3) + 8 * (r >> 2) + 4 * hi; }
__device__ __forceinline__ bf16x8 load8(const GA bf16_t* p) { return *(const GA bf16x8*)p; }

__device__ __forceinline__ void mask_tile(f32x16& p0, f32x16& p1, int dq, unsigned W) {
    const float NEG = -__builtin_inff();
#pragma unroll
    for (int r = 0; r < 16; ++r) {
        const int c = (r & 3) + 8 * (r >> 2);
        if ((unsigned)(dq - c) >= W) p0[r] = NEG;
        if ((unsigned)(dq - c - 32) >= W) p1[r] = NEG;
    }
}
__device__ __forceinline__ void mask_bits(f32x16& p0, f32x16& p1, u64 w, int hi) {
    const float NEG = -__builtin_inff();
    unsigned w0 = (unsigned)w, w1 = (unsigned)(w >> 32);
    if (hi == 0) { w0 <<= 4; w1 <<= 4; }
#define MB4(W, P, g) do { u64 c0_, c1_, c2_, c3_; asm volatile(                          \
        "v_add_co_u32 %[w], %[c0], %[w], %[w]\n\tv_add_co_u32 %[w], %[c1], %[w], %[w]\n\t"                     \
        "v_add_co_u32 %[w], %[c2], %[w], %[w]\n\tv_add_co_u32 %[w], %[c3], %[w], %[w]\n\t"                     \
        "v_cndmask_b32 %[e3], %[neg], %[e3], %[c0]\n\tv_cndmask_b32 %[e2], %[neg], %[e2], %[c1]\n\t"           \
        "v_cndmask_b32 %[e1], %[neg], %[e1], %[c2]\n\tv_cndmask_b32 %[e0], %[neg], %[e0], %[c3]"               \
        : [w] "+v"(W), [e0] "+v"(P[4 * (g)]), [e1] "+v"(P[4 * (g) + 1]), [e2] "+v"(P[4 * (g) + 2]), [e3] "+v"(P[4 * (g) + 3]),         \
          [c0] "=&s"(c0_), [c1] "=&s"(c1_), [c2] "=&s"(c2_), [c3] "=&s"(c3_) : [neg] "v"(NEG)); } while (0)
    MB4(w0, p0, 3); MB4(w1, p1, 3); w0 <<= 4; w1 <<= 4;
    MB4(w0, p0, 2); MB4(w1, p1, 2); w0 <<= 4; w1 <<= 4;
    MB4(w0, p0, 1); MB4(w1, p1, 1); w0 <<= 4; w1 <<= 4;
    MB4(w0, p0, 0); MB4(w1, p1, 0);
#undef MB4
}
__device__ __forceinline__ void partialSM(f32x16& p0, f32x16& p1, float& m_reg, float& mn, float& alpha, float cb) {
    float pmax = p0[0];
#pragma unroll
    for (int r = 1; r < 16; ++r) pmax = fmaxf(pmax, p0[r]);
#pragma unroll
    for (int r = 0; r < 16; ++r) pmax = fmaxf(pmax, p1[r]);
    { auto rr = __builtin_amdgcn_permlane32_swap(__float_as_uint(pmax), __float_as_uint(pmax), false, false);
      pmax = fmaxf(__uint_as_float(rr[0]), __uint_as_float(rr[1])); }
    pmax += cb;
    if (__builtin_expect(__all((pmax - m_reg) <= THR2), 1)) { mn = m_reg; alpha = 1.f; }
    else { mn = fmaxf(m_reg, pmax); alpha = __builtin_amdgcn_exp2f(m_reg - mn); m_reg = mn; }
    const float sh = mn - cb;
#pragma unroll
    for (int r = 0; r < 16; ++r) p0[r] = p0[r] - sh;
#pragma unroll
    for (int r = 0; r < 16; ++r) p1[r] = p1[r] - sh;
#pragma unroll
    for (int r = 0; r < 16; ++r) p0[r] = __builtin_amdgcn_exp2f(p0[r]);
}
__device__ __forceinline__ void finishSM(f32x16& p0, f32x16& p1, float alpha, float& l_reg, bf16x8& pa0, bf16x8& pa1, bf16x8& pa2, bf16x8& pa3) {
#pragma unroll
    for (int r = 0; r < 16; ++r) p1[r] = __builtin_amdgcn_exp2f(p1[r]);
    float ps = 0;
#pragma unroll
    for (int r = 0; r < 16; ++r) ps += p0[r];
#pragma unroll
    for (int r = 0; r < 16; ++r) ps += p1[r];
    { auto rr = __builtin_amdgcn_permlane32_swap(__float_as_uint(ps), __float_as_uint(ps), false, false);
      ps = __uint_as_float(rr[0]) + __uint_as_float(rr[1]); }
    l_reg = l_reg * alpha + ps;
#define PK4(P, B_, OUT) do { unsigned a0 = cvt_pk_bf16(P[B_+0], P[B_+1]), a1 = cvt_pk_bf16(P[B_+2], P[B_+3]);                          \
        unsigned b0 = cvt_pk_bf16(P[B_+4], P[B_+5]), b1 = cvt_pk_bf16(P[B_+6], P[B_+7]);                                             \
        auto r0 = __builtin_amdgcn_permlane32_swap(a0, b0, false, false); auto r1 = __builtin_amdgcn_permlane32_swap(a1, b1, false, false); \
        u32x4 w = {r0[0], r1[0], r0[1], r1[1]}; OUT = *reinterpret_cast<bf16x8*>(&w); } while (0)
    PK4(p0, 0, pa0); PK4(p0, 8, pa1); PK4(p1, 0, pa2); PK4(p1, 8, pa3);
#undef PK4
}
template <int KB, int NQ>
__device__ __forceinline__ void qkt(f32x16& p0, f32x16& p1, const LAS char* K_lds, int r32, int hi, const bf16x8* qr, int koff) {
    p0 = f32x16{}; p1 = f32x16{};
    const LAS char* kb[4];
#pragma unroll
    for (int dd = 0; dd < 4; ++dd) kb[dd] = K_lds + KB * SHM_K + KSWZ(r32, (dd * 16 + hi * 8) * 2) + koff;
#pragma unroll
    for (int d0 = 0; d0 < NQ; ++d0) { const LAS char* a = kb[d0 & 3] + (d0 >> 2) * 128;
        bf16x8 b0 = *(const LAS bf16x8*)a;
        bf16x8 b1 = *(const LAS bf16x8*)(a + 32 * 256);
        p0 = __builtin_amdgcn_mfma_f32_32x32x16_bf16(b0, qr[d0], p0, 0, 0, 0);
        p1 = __builtin_amdgcn_mfma_f32_32x32x16_bf16(b1, qr[d0], p1, 0, 0, 0); }
}
template <int VB>
__device__ __forceinline__ void pv_tile(f32x16* o, int vb0, bf16x8 pa0, bf16x8 pa1, bf16x8 pa2, bf16x8 pa3) {
#define TRRD(dst, off) asm volatile("ds_read_b64_tr_b16 %0, %1 offset:%2" : "=&v"(dst) : "v"(vb0), "i"(off) : "memory")
#define PV_D0(d0) do { s16x4 l0, l1, l2, l3, h0, h1, h2, h3; constexpr int b_ = VB * SHM_V + v_rd_off(d0, 0, 0); \
        TRRD(l0, b_); TRRD(h0, b_ + 2048); TRRD(l1, b_ + 4096); TRRD(h1, b_ + 6144); TRRD(l2, b_ + 8192); TRRD(h2, b_ + 10240); TRRD(l3, b_ + 12288); TRRD(h3, b_ + 14336); \
        asm volatile("s_waitcnt lgkmcnt(0)" ::: "memory"); SBAR();   \
        o[d0] = __builtin_amdgcn_mfma_f32_32x32x16_bf16(pa0, (bf16x8){l0[0], l0[1], l0[2], l0[3], h0[0], h0[1], h0[2], h0[3]}, o[d0], 0, 0, 0);   \
        o[d0] = __builtin_amdgcn_mfma_f32_32x32x16_bf16(pa1, (bf16x8){l1[0], l1[1], l1[2], l1[3], h1[0], h1[1], h1[2], h1[3]}, o[d0], 0, 0, 0);   \
        o[d0] = __builtin_amdgcn_mfma_f32_32x32x16_bf16(pa2, (bf16x8){l2[0], l2[1], l2[2], l2[3], h2[0], h2[1], h2[2], h2[3]}, o[d0], 0, 0, 0);   \
        o[d0] = __builtin_amdgcn_mfma_f32_32x32x16_bf16(pa3, (bf16x8){l3[0], l3[1], l3[2], l3[3], h3[0], h3[1], h3[2], h3[3]}, o[d0], 0, 0, 0); } while (0)
    PV_D0(0); PV_D0(1); PV_D0(2); PV_D0(3);
#undef PV_D0
#undef TRRD
}
__device__ __forceinline__ void bias_dist(f32x16& p0, f32x16& p1, const LAS char* tbase) {
#pragma unroll
    for (int r = 0; r < 16; ++r) { const int c = (r & 3) + 8 * (r >> 2);
        p0[r] += *(const LAS float*)(tbase + (59 - c) * 4);
        p1[r] += *(const LAS float*)(tbase + (27 - c) * 4); }
}
__device__ __forceinline__ void bias_const(f32x16& p0, f32x16& p1, float c) {
#pragma unroll
    for (int r = 0; r < 16; ++r) { p0[r] += c; p1[r] += c; }
}
__device__ __forceinline__ void bias_key(f32x16& p0, f32x16& p1, const LAS char* kbase) {
#pragma unroll
    for (int g = 0; g < 4; ++g) { const f32x4 a = *(const LAS f32x4*)(kbase + (8 * g) * 4), b = *(const LAS f32x4*)(kbase + (32 + 8 * g) * 4);
#pragma unroll
        for (int q = 0; q < 4; ++q) { p0[4 * g + q] -= a[q]; p1[4 * g + q] -= b[q]; } }
}

struct Blk { const GA bf16_t* Q; const GA bf16_t* K; const GA bf16_t* V; int P0; int rs; };
struct Aux { const GA float* tb; int dscale; const GA float* cum; const GA u64* mrow0; float kmax; };

__device__ __forceinline__ int swa_jlo(int P0, int W) { const int lowk = P0 - W + 1; return lowk > 0 ? lowk / KVBLK : 0; }

template <int MODE, int NQ>
__device__ __forceinline__ void attn_block(const Blk& cur, int skv, int W, int koff, const Aux& ax, LAS char* lds, f32x16 (&o)[4], float& m_out, float& l_out) {
    const int tid = tid_l(), wid = __builtin_amdgcn_readfirstlane(tid >> 6), lane = tid & 63, r32 = lane & 31, hi = lane >> 5;
    const int rs = cur.rs;
    const int j_lo = swa_jlo(cur.P0, W);
    int j_hi = (cur.P0 + QB - 1) / KVBLK + 1; if (j_hi > skv / KVBLK) j_hi = skv / KVBLK;
    int NT = j_hi - j_lo;
    const int qlo = cur.P0 + wid * QBLK, qm = qlo + r32 - 4 * hi;
    LAS char* V_lds = lds; LAS char* K_lds = lds + 2 * SHM_V;
    LAS float* ws = (LAS float*)(lds + L_WS) + wid * 64; LAS float* li_l = ws; LAS float* al_l = ws + 32;
    LAS float* auxl = (LAS float*)(lds + L_AUX);
    float m_reg = -1e30f, l_reg = 0;
#pragma unroll
    for (int d_ = 0; d_ < 4; ++d_) o[d_] = f32x16{};
    const int sr = tid >> 4, sc = (tid & 15) * 8, vst0 = v_st(sr, sc), vst1 = v_st(32 + sr, sc), kws = KSWZ(sr, sc * 2);
    const int vb0 = (int)(unsigned)(uintptr_t)V_lds + v_rd_base(lane);
    const GA bf16_t* Kh = cur.K; const GA bf16_t* Vh = cur.V;
    bf16x8 qr[NQ]; bf16x8 st_v0, st_v1, st_k0, st_k1;
#define ROW(p, k0, rr) ((p) + (size_t)((k0) + (rr)) * rs + sc)
#define VMW() asm volatile("s_waitcnt vmcnt(0)" ::: "memory")
#define SLOAD_H(Kp, Vp, k0) do { st_v0 = load8(ROW(Vp, k0, sr)); st_v1 = load8(ROW(Vp, k0, 32 + sr));              \
                                 st_k0 = load8(ROW(Kp, k0, sr)); st_k1 = load8(ROW(Kp, k0, 32 + sr)); } while (0)
#define SWRITE_HK(bf) do { *(LAS bf16x8*)(K_lds + (bf) * SHM_K + kws) = st_k0; *(LAS bf16x8*)(K_lds + (bf) * SHM_K + kws + 32 * 256) = st_k1; } while (0)
#define SWRITE_HV(bf) do { *(LAS bf16x8*)(V_lds + (bf) * SHM_V + vst0) = st_v0; *(LAS bf16x8*)(V_lds + (bf) * SHM_V + vst1) = st_v1; } while (0)
#define SWRITE_H(bf) do { SWRITE_HV(bf); SWRITE_HK(bf); } while (0)
#define RESC(a) do { if (__any((a) < 1.f)) { if (hi == 0) al_l[r32] = (a); asm volatile("s_waitcnt lgkmcnt(0)" ::: "memory");              \
                     for (int d_ = 0; d_ < 4; ++d_) for (int r = 0; r < 16; ++r) o[d_][r] *= al_l[crow(r, hi)]; } } while (0)
#define KBASE(t) ((MODE == 1 ? (j_hi - 1 - (t)) : (j_lo + (t))) * KVBLK)
    LAS unsigned* flg = (LAS unsigned*)(lds + L_FLG);
    {
        const int kb0 = KBASE(0);
        if (MODE == 1 && tid < 8) flg[tid] = 0u;
#pragma unroll
        for (int d0 = 0; d0 < NQ; ++d0) qr[d0] = load8(cur.Q + (size_t)(wid * QBLK + r32) * rs + d0 * 16 + hi * 8);
        SLOAD_H(Kh, Vh, kb0);
        if (MODE == 1) { for (int i = tid; i < cur.P0 + QB; i += 512) auxl[i] = ax.cum[i]; }
        else { for (int i = tid; i < TB_N; i += 512) { int d = i - TB_PAD; d = d < 0 ? 0 : d; auxl[i] = ax.tb[d * ax.dscale]; } }
        VMW(); SWRITE_HK(0); SWRITE_HV(0);
        __syncthreads();
    }
    const float cfar = (MODE == 0 || MODE == 2) ? ax.tb[FAR_DIST] : 0.f;
    float qbound = 0.f;
    if (MODE == 1) { float ss = 0.f;
#pragma unroll
        for (int d0 = 0; d0 < NQ; ++d0) { const u32x4 w = *reinterpret_cast<const u32x4*>(&qr[d0]);
#pragma unroll
            for (int j = 0; j < 4; ++j) { const float a = bf_lo(w[j]), b = bf_hi(w[j]); ss = fmaf(a, a, ss); ss = fmaf(b, b, ss); } }
        { auto rr = __builtin_amdgcn_permlane32_swap(__float_as_uint(ss), __float_as_uint(ss), false, false); ss = __uint_as_float(rr[0]) + __uint_as_float(rr[1]); }
        qbound = sqrtf(ss) * ax.kmax * 1.001f + 1e-3f; }
    float cbv = 0.f;
#define BIASMASK(P0_, P1_, t) do { const int kb_ = KBASE(t); cbv = 0.f;                                                                \
        if (MODE == 1) { bias_key(P0_, P1_, (const LAS char*)(auxl + kb_ + 4 * hi)); }                                                       \
        else if (MODE == 3) { bias_dist(P0_, P1_, (const LAS char*)(auxl + (qm - kb_ - 59 + TB_PAD))); }                                     \
        else { if (cur.P0 - kb_ - 63 >= FAR_DIST) cbv = cfar; else bias_dist(P0_, P1_, (const LAS char*)(auxl + (qm - kb_ - 59 + TB_PAD))); } \
        if (MODE == 0) { mask_bits(P0_, P1_, mw, hi); }                                                                                  \
        else if (kb_ + KVBLK - 1 > qlo || kb_ <= qlo + QBLK - 1 - W) mask_tile(P0_, P1_, qm - kb_, (unsigned)W); } while (0)
#define MLOAD(t) do { if (MODE == 0) mw = ax.mrow0[(size_t)(wid * QBLK + r32) * 128 + (KBASE(t) >> 6)]; } while (0)
    f32x16 pA0, pA1, pB0, pB1; float mnA, mnB, alA, alB; bf16x8 pa0, pa1, pa2, pa3; u64 mw = 0ull;
    if (NT > 1) SLOAD_H(Kh, Vh, KBASE(1));
    MLOAD(0);
    SBAR(); qkt<0, NQ>(pA0, pA1, K_lds, r32, hi, qr, koff);
    BIASMASK(pA0, pA1, 0); partialSM(pA0, pA1, m_reg, mnA, alA, cbv);
    if (NT > 1) { VMW(); SWRITE_H(1); }
    __syncthreads();
#define HALF_STEP(PX0, PX1, mnX, alX, PY0, PY1, alY, t, KB, VB, SB) do {                                                      \
        MLOAD(t);                                                                                                             \
        if ((t) + 1 < NT) { SLOAD_H(Kh, Vh, KBASE((t) + 1)); }        \
        SBAR(); qkt<KB, NQ>(PX0, PX1, K_lds, r32, hi, qr, koff);                                                              \
        finishSM(PY0, PY1, alY, l_reg, pa0, pa1, pa2, pa3); SBAR();                                                           \
        pv_tile<VB>(o, vb0, pa0, pa1, pa2, pa3); BIASMASK(PX0, PX1, (t)); partialSM(PX0, PX1, m_reg, mnX, alX, cbv);          \
        __syncthreads();                                                                                                      \
        if ((t) + 1 < NT) { VMW(); SWRITE_H(SB); }                                                                            \
        RESC(alX); __syncthreads(); } while (0)
    for (int t = 1; t + 1 < NT; t += 2) {
        if (MODE == 1) {
            const u32x4 f0 = *(const LAS u32x4*)flg, f1 = *(const LAS u32x4*)(flg + 4);
            if ((f0[0] & f0[1] & f0[2] & f0[3] & f1[0] & f1[1] & f1[2] & f1[3]) != 0u) { NT = t + 1; break; }
        }
        HALF_STEP(pB0, pB1, mnB, alB, pA0, pA1, alA, t, 1, 0, 0);
        if (MODE == 1) {
            unsigned ok = 0u;
            if (t + 3 < NT) { const float ub = qbound - auxl[KBASE(t + 3) + KVBLK - 1]; ok = __all(ub < m_reg - SKIP_MARGIN) ? 1u : 0u; }
            if (lane == 0) flg[wid] = ok;
        }
        HALF_STEP(pA0, pA1, mnA, alA, pB0, pB1, alB, t + 1, 0, 1, 1);
    }
    const bool even = (NT & 1) == 0;
    if (even) { MLOAD(NT - 1); SBAR(); qkt<1, NQ>(pB0, pB1, K_lds, r32, hi, qr, koff); SBAR(); }
    finishSM(pA0, pA1, alA, l_reg, pa0, pa1, pa2, pa3); SBAR();
    pv_tile<0>(o, vb0, pa0, pa1, pa2, pa3);
    if (even) { BIASMASK(pB0, pB1, NT - 1); partialSM(pB0, pB1, m_reg, mnB, alB, cbv); __syncthreads(); RESC(alB);
        finishSM(pB0, pB1, alB, l_reg, pa0, pa1, pa2, pa3); SBAR(); pv_tile<1>(o, vb0, pa0, pa1, pa2, pa3); }
    if (hi == 0) li_l[r32] = l_reg; asm volatile("s_waitcnt lgkmcnt(0)" ::: "memory");
#pragma unroll
    for (int r = 0; r < 16; ++r) { const float rl = __builtin_amdgcn_rcpf(li_l[crow(r, hi)]);
#pragma unroll
        for (int d0 = 0; d0 < 4; ++d0) o[d0][r] *= rl; }
    m_out = m_reg; l_out = l_reg;
    __syncthreads();
#undef ROW
#undef VMW
#undef SLOAD_H
#undef SWRITE_HK
#undef SWRITE_HV
#undef SWRITE_H
#undef RESC
#undef KBASE
#undef BIASMASK
#undef MLOAD
#undef HALF_STEP
}
#undef KSWZ
}

__device__ __forceinline__ void store_y(const GA bf16_t* Zs, GA bf16_t* Y, const f32x16 (&o)[4], int row0w, int colbase, int r32, int hi) {
    bf16_t zv[16][4];
#pragma unroll
    for (int r = 0; r < 16; ++r) { const size_t off = (size_t)(row0w + att::crow(r, hi)) * DM + colbase + r32;
#pragma unroll
        for (int d0 = 0; d0 < 4; ++d0) zv[r][d0] = Zs[off + d0 * 32]; }
#pragma unroll
    for (int r = 0; r < 16; ++r) { const size_t off = (size_t)(row0w + att::crow(r, hi)) * DM + colbase + r32;
#pragma unroll
        for (int d0 = 0; d0 < 4; ++d0) { const float v = o[d0][r] * bf2f(zv[r][d0]); const float vn = __shfl_xor(v, 1);
            if ((r32 & 1) == 0) *(GA unsigned*)(Y + off + d0 * 32) = cvt_pk_bf16(v, vn); } }
}
template <int MODE>
__device__ __forceinline__ void attn_fast_unit(const Frame& F, int layer, int b, int h, int qb) {
    const int mixer = MODE;
    const size_t hb = ((size_t)(b * 4 + h) * SEQ) * 128;
    att::Blk cur{F.QKV + (size_t)(mixer * 3 + 0) * QS + hb + (size_t)qb * 256 * 128, F.QKV + (size_t)(mixer * 3 + 1) * QS + hb, F.QKV + (size_t)(mixer * 3 + 2) * QS + hb, qb * 256, 128};
    att::Aux ax{F.tb + (size_t)h * SEQ, 1, F.cum + (size_t)(b * 4 + h) * SEQ, F.mask + (size_t)(b * SEQ + qb * 256) * 128, 0.f};
    if (MODE == 1) ax.kmax = sqrtf(__uint_as_float(F.ctl[CW_KM + layer * 8 + b * 4 + h]));
    f32x16 o[4]; float m_, l_;
    att::attn_block<MODE, 8>(cur, SEQ, SEQ, 0, ax, (LAS char*)F.lds, o, m_, l_);
    const int tid = tid_l(), wid = tid >> 6, lane = tid & 63;
    GA unsigned char* w2 = launder(F.ws);
    store_y((const GA bf16_t*)(w2 + WS_ZS), (GA bf16_t*)(w2 + WS_Y), o, b * SEQ + qb * 256 + wid * 32, mixer * 512 + h * 128, lane & 31, lane >> 5);
}

__device__ __forceinline__ void attn_diffmap_unit(const Frame& F, int layer, int b, int h, int qb, int c) {
    const size_t hb = ((size_t)(b * 4 + h) * SEQ) * 128;
    const GA bf16_t* Qc = F.QKV + (size_t)(2 * 3 + 0) * QS + hb + (size_t)qb * 256 * 128; const GA bf16_t* Kc = F.QKV + (size_t)(2 * 3 + 1) * QS + hb; const GA bf16_t* Vc = F.QKV + (size_t)(2 * 3 + 2) * QS + hb;
    att::Aux ax{F.tb + (size_t)(4 + h) * SEQ, 1, (const GA float*)nullptr, (const GA u64*)nullptr, 0.f};
    f32x16 o[4]; float m_, l_;
    { att::Blk cur{Qc + c * 64, Kc, Vc, qb * 256, 128};
      att::attn_block<2, 4>(cur, SEQ, SEQ, c * 128, ax, (LAS char*)F.lds, o, m_, l_); }
    const int tid = tid_l(), wid = tid >> 6, lane = tid & 63, r32 = lane & 31, hi = lane >> 5;
    const int pair = (b * 4 + h) * 32 + qb;
    GA unsigned char* w2 = launder(F.ws);
    { GA f32x4* mine = (GA f32x4*)(w2 + WS_O1) + ((size_t)(c * 256 + pair) * 16) * 512 + tid;
#pragma unroll
      for (int d0 = 0; d0 < 4; ++d0)
#pragma unroll
          for (int g = 0; g < 4; ++g) { const f32x4 v = {o[d0][4 * g], o[d0][4 * g + 1], o[d0][4 * g + 2], o[d0][4 * g + 3]};
              asm volatile("global_store_dwordx4 %0, %1, off sc1" :: "v"(mine + (d0 * 4 + g) * 512), "v"(v) : "memory"); } }
    asm volatile("s_waitcnt vmcnt(0)" ::: "memory");
    __syncthreads();
    volatile LAS unsigned* lw = F.misc + 5;
    if (tid == 0) *lw = __hip_atomic_fetch_add((GA unsigned*)(w2 + WS_CTL) + CW_DC + layer * 256 + pair, 1u, __ATOMIC_RELAXED, __HIP_MEMORY_SCOPE_AGENT);
    __syncthreads();
    if (*lw == 0u) return;
    __builtin_amdgcn_fence(__ATOMIC_ACQUIRE, "agent");
    asm volatile("s_waitcnt vmcnt(0)" ::: "memory");
    const GA f32x4* other = (const GA f32x4*)(w2 + WS_O1) + ((size_t)((1 - c) * 256 + pair) * 16) * 512 + tid;
    const GA float* dp = (const GA float*)(w2 + WS_DP) + layer * 256;
    const float lam = dp[0];
#pragma unroll
    for (int g = 0; g < 4; ++g) {
        f32x4 ot[4];
#pragma unroll
        for (int d0 = 0; d0 < 4; ++d0) ot[d0] = other[(d0 * 4 + g) * 512];
#pragma unroll
        for (int q = 0; q < 4; ++q) { const int r = 4 * g + q;
            float ss = 0.f;
#pragma unroll
            for (int d0 = 0; d0 < 4; ++d0) { const float mo = o[d0][r], oth = ot[d0][q];
                const float a0 = (c == 0) ? mo : oth, a1 = (c == 0) ? oth : mo; const float v = fmaf(-lam, a1, a0); o[d0][r] = v; ss = fmaf(v, v, ss); }
            ss += __shfl_xor(ss, 1); ss += __shfl_xor(ss, 2); ss += __shfl_xor(ss, 4); ss += __shfl_xor(ss, 8); ss += __shfl_xor(ss, 16);
            const float rn = rsqrtf(ss * (1.0f / 128.0f) + RMS_EPS);
#pragma unroll
            for (int d0 = 0; d0 < 4; ++d0) o[d0][r] = o[d0][r] * rn;
        }
        asm volatile("" ::: "memory");
    }
#pragma unroll
    for (int d0 = 0; d0 < 4; ++d0) { const float sw = dp[128 + d0 * 32 + r32];
#pragma unroll
        for (int r = 0; r < 16; ++r) o[d0][r] *= sw; }
    store_y((const GA bf16_t*)(w2 + WS_ZS), (GA bf16_t*)(w2 + WS_Y), o, b * SEQ + qb * 256 + wid * 32, 2 * 512 + h * 128, r32, hi);
}
__device__ __forceinline__ void attn_dil_unit(const Frame& F, int u) {
    const int cfg = u >> 8, v = u & 255, b = v & 1, h = (v >> 1) & 3, x = v >> 3;
    const int dl = (cfg == 0) ? 1 : (cfg == 1 ? 4 : 16);
    const int rho = (cfg == 0) ? 0 : (cfg == 1 ? (x & 3) : (x & 15)), qb = (cfg == 0) ? x : (cfg == 1 ? (x >> 2) : (x >> 4));
    const size_t hb = ((size_t)(b * 4 + h) * SEQ) * 128;
    const GA bf16_t* Qd = F.QKV + (size_t)(3 * 3 + 0) * QS + hb; const GA bf16_t* Kd = F.QKV + (size_t)(3 * 3 + 1) * QS + hb; const GA bf16_t* Vd = F.QKV + (size_t)(3 * 3 + 2) * QS + hb;
    att::Blk cur{Qd + (size_t)(rho + dl * qb * 256) * 128, Kd + (size_t)rho * 128, Vd + (size_t)rho * 128, qb * 256, 128 * dl};
    att::Aux ax{F.tb + (size_t)(8 + h) * SEQ, dl, (const GA float*)nullptr, (const GA u64*)nullptr, 0.f};
    f32x16 o[4]; float m_, l_;
    att::attn_block<3, 8>(cur, SEQ / dl, 129, 0, ax, (LAS char*)F.lds, o, m_, l_);
    const int tid = tid_l(), wid = tid >> 6, lane = tid & 63, r32 = lane & 31, hi = lane >> 5;
    GA unsigned char* w2 = launder(F.ws);
    GA bf16_t* od = (GA bf16_t*)(w2 + WS_OD) + (size_t)cfg * MT * 512;
#pragma unroll
    for (int r = 0; r < 16; ++r) { const size_t row = (size_t)b * SEQ + rho + (size_t)dl * (qb * 256 + wid * 32 + att::crow(r, hi));
#pragma unroll
        for (int d0 = 0; d0 < 4; ++d0) od[row * 512 + h * 128 + d0 * 32 + r32] = (bf16_t)(cvt_pk_bf16(o[d0][r], 0.f) & 0xffffu); }
    if (hi == 0) { const size_t row = (size_t)b * SEQ + rho + (size_t)dl * (qb * 256 + wid * 32 + r32);
        ((GA float*)(w2 + WS_LSE))[((size_t)cfg * MT + row) * 4 + h] = m_ + __builtin_amdgcn_logf(l_); }
}
__device__ __forceinline__ void dil_merge_unit(const Frame& F, int u) {
    const int tid = tid_l(), row = u * 32 + (tid >> 4), cg = tid & 15, h = cg >> 2, col = cg * 32;
    const float l0 = F.LSE[((size_t)0 * MT + row) * 4 + h], l1 = F.LSE[((size_t)1 * MT + row) * 4 + h], l2 = F.LSE[((size_t)2 * MT + row) * 4 + h];
    const float mx = fmaxf(l0, fmaxf(l1, l2)); float w0 = ex2(l0 - mx), w1 = ex2(l1 - mx), w2 = ex2(l2 - mx); const float inv = 1.0f / (w0 + w1 + w2); w0 *= inv; w1 *= inv; w2 *= inv;
    const GA bf16_t* odb = (const GA bf16_t*)F.OD;
    const GA bf16_t* p0 = odb + ((size_t)0 * MT + row) * 512 + col; const GA bf16_t* p1 = odb + ((size_t)1 * MT + row) * 512 + col; const GA bf16_t* p2 = odb + ((size_t)2 * MT + row) * 512 + col;
    const size_t yo = (size_t)row * DM + 3 * 512 + col;
#pragma unroll
    for (int i = 0; i < 4; ++i) {
        const u32x4 A_ = *(const GA u32x4*)(p0 + 8 * i), B_ = *(const GA u32x4*)(p1 + 8 * i), C_ = *(const GA u32x4*)(p2 + 8 * i);
        const f32x4 a0 = {bf_lo(A_[0]), bf_hi(A_[0]), bf_lo(A_[1]), bf_hi(A_[1])}, a1 = {bf_lo(A_[2]), bf_hi(A_[2]), bf_lo(A_[3]), bf_hi(A_[3])}, b0 = {bf_lo(B_[0]), bf_hi(B_[0]), bf_lo(B_[1]), bf_hi(B_[1])}, b1 = {bf_lo(B_[2]), bf_hi(B_[2]), bf_lo(B_[3]), bf_hi(B_[3])},
                    c0 = {bf_lo(C_[0]), bf_hi(C_[0]), bf_lo(C_[1]), bf_hi(C_[1])}, c1 = {bf_lo(C_[2]), bf_hi(C_[2]), bf_lo(C_[3]), bf_hi(C_[3])};
        const u32x4 zw = *(const GA u32x4*)(F.Zs + yo + 8 * i);
        const f32x4 v0 = a0 * w0 + b0 * w1 + c0 * w2, v1 = a1 * w0 + b1 * w1 + c1 * w2;
        u32x4 w = {cvt_pk_bf16(v0[0] * bf_lo(zw[0]), v0[1] * bf_hi(zw[0])), cvt_pk_bf16(v0[2] * bf_lo(zw[1]), v0[3] * bf_hi(zw[1])),
                   cvt_pk_bf16(v1[0] * bf_lo(zw[2]), v1[1] * bf_hi(zw[2])), cvt_pk_bf16(v1[2] * bf_lo(zw[3]), v1[3] * bf_hi(zw[3]))};
        *(GA u32x4*)(F.Y + yo + 8 * i) = w; }
}

struct EpiMerged {
    static constexpr bool PERM = true, AFTER_DRAIN = false, MIDK = true, FP8 = false;
    const GA unsigned char* G; GA bf16_t* MG;
    static __device__ __forceinline__ float gq(unsigned w, int i) { return (float)((w >> (8 * i)) & 0xffu) + 0.5f; }
    __device__ __forceinline__ void mid(f32x4 (&acc)[2][2][4][2], const pg8::Unit& u, int bnext, int wr, int wc, int fr, int fq) const {
        const int row0 = u.pm * 256 + wr * 64 + fr, c0 = u.pn * 256 + wc * 32 + 8 * fq;
#pragma unroll
        for (int ai = 0; ai < 2; ++ai) {
            u32x2 num[4][2], den[4][2];
#pragma unroll
            for (int m = 0; m < 4; ++m) { const GA unsigned char* gp = G + (size_t)(row0 + ai * 128 + m * 16) * 8192 + c0;
#pragma unroll
                for (int bj = 0; bj < 2; ++bj) { num[m][bj] = *(const GA u32x2*)(gp + (bnext - 1) * DM + bj * 128); den[m][bj] = *(const GA u32x2*)(gp + bnext * DM + bj * 128); } }
#pragma unroll
            for (int m = 0; m < 4; ++m)
#pragma unroll
                for (int bj = 0; bj < 2; ++bj)
#pragma unroll
                    for (int j = 0; j < 4; ++j) {
                        acc[ai][bj][m][0][j] *= gq(num[m][bj][0], j) * __builtin_amdgcn_rcpf(gq(den[m][bj][0], j));
                        acc[ai][bj][m][1][j] *= gq(num[m][bj][1], j) * __builtin_amdgcn_rcpf(gq(den[m][bj][1], j)); }
            asm volatile("" ::: "memory");
        }
    }
    __device__ __forceinline__ void operator()(const f32x4 (&acc)[2][2][4][2], const pg8::Unit& u, int wr, int wc, int fr, int fq) const {
        const int row0 = u.pm * 256 + wr * 64 + fr, c0 = u.pn * 256 + wc * 32 + 8 * fq;
        u32x2 g3v[2][4][2];
#pragma unroll
        for (int ai = 0; ai < 2; ++ai)
#pragma unroll
            for (int m = 0; m < 4; ++m)
#pragma unroll
                for (int bj = 0; bj < 2; ++bj) g3v[ai][m][bj] = *(const GA u32x2*)(G + (size_t)(row0 + ai * 128 + m * 16) * 8192 + 3 * DM + c0 + bj * 128);
#pragma unroll
        for (int ai = 0; ai < 2; ++ai)
#pragma unroll
            for (int m = 0; m < 4; ++m) { const int r = row0 + ai * 128 + m * 16;
#pragma unroll
                for (int bj = 0; bj < 2; ++bj) { const u32x2 g3 = g3v[ai][m][bj];
                    const f32x4 v0 = acc[ai][bj][m][0] * (1.0f / 256.0f), v1 = acc[ai][bj][m][1] * (1.0f / 256.0f);
                    u32x4 w = {cvt_pk_bf16(v0[0] * gq(g3[0], 0), v0[1] * gq(g3[0], 1)), cvt_pk_bf16(v0[2] * gq(g3[0], 2), v0[3] * gq(g3[0], 3)),
                               cvt_pk_bf16(v1[0] * gq(g3[1], 0), v1[1] * gq(g3[1], 1)), cvt_pk_bf16(v1[2] * gq(g3[1], 2), v1[3] * gq(g3[1], 3))};
                    *(GA u32x4*)(MG + (size_t)r * DM + c0 + bj * 128) = w; } }
    }
};

struct EpiOut {
    static constexpr bool PERM = false, AFTER_DRAIN = false, MIDK = false, FP8 = false;
    GA float* xres; GA bf16_t* xb; GA float* ssq; GA unsigned char* xq; const GA float* xsrc; bool feed_next;
    __device__ __forceinline__ void operator()(const f32x4 (&acc)[2][2][4][2], const pg8::Unit& u, int wr, int wc, int fr, int fq) const {
        const int row0 = u.pm * 256 + wr * 64 + fr, col0 = u.pn * 256 + wc * 32 + 4 * fq;
#pragma unroll
        for (int h = 0; h < 4; ++h) {
            const int ai = h >> 1, mb = (h & 1) * 2;
            f32x4 xv[2][2][2];
#pragma unroll
            for (int m = 0; m < 2; ++m)
#pragma unroll
                for (int bj = 0; bj < 2; ++bj)
#pragma unroll
                    for (int n = 0; n < 2; ++n) { const size_t off_ = (size_t)(row0 + ai * 128 + (mb + m) * 16) * DM + col0 + bj * 128 + n * 16;
                        if (xsrc != nullptr) xv[m][bj][n] = *(const GA f32x4*)(xsrc + off_);
                        else { const u32x2 t_ = *(const GA u32x2*)(xb + off_); xv[m][bj][n] = (f32x4){bf_lo(t_[0]), bf_hi(t_[0]), bf_lo(t_[1]), bf_hi(t_[1])}; } }
#pragma unroll
            for (int m = 0; m < 2; ++m) { const int r = row0 + ai * 128 + (mb + m) * 16; float ss = 0.f;
#pragma unroll
                for (int bj = 0; bj < 2; ++bj)
#pragma unroll
                    for (int n = 0; n < 2; ++n) { const size_t off = (size_t)r * DM + col0 + bj * 128 + n * 16;
                        const f32x4 v = xv[m][bj][n] + acc[ai][bj][mb + m][n];
                        ss += v[0] * v[0] + v[1] * v[1] + v[2] * v[2] + v[3] * v[3];
                        { u32x2 w = {cvt_pk_bf16(v[0], v[1]), cvt_pk_bf16(v[2], v[3])}; *(GA u32x2*)(xb + off) = w; }
                        if (feed_next) *(GA unsigned*)(xq + off) = cvt4_fp8(v[0], v[1], v[2], v[3]); }
                ss += __shfl_xor(ss, 16); ss += __shfl_xor(ss, 32);
                if (fq == 0) ssq[(size_t)r * 32 + u.pn * 4 + wc] = ss; }
        }
    }
};

__device__ __forceinline__ void final_norm(const Frame& F) {
    const int tid = tid_l(), lane = tid & 63, wave = tid >> 6, G = gridDim.x, bid = blockIdx.x;
    for (int row = bid * 8 + wave; row < MT; row += G * 8) {
        float ss = (lane < 32) ? F.ssq[(size_t)row * 32 + lane] : 0.f; ss = wave_sum(ss);
        const float rs = rsqrtf(ss * (1.0f / DM) + RMS_EPS);
#pragma unroll
        for (int i = 0; i < 8; ++i) { const int c = (i * 64 + lane) * 4; const u32x2 t = *(const GA u32x2*)(F.xb + (size_t)row * DM + c); const f32x4 v = {bf_lo(t[0]), bf_hi(t[0]), bf_lo(t[1]), bf_hi(t[1])}, w = *(const GA f32x4*)(F.final_w + c);
            *(GA f32x4*)(F.out + (size_t)row * DM + c) = v * rs * w; }
    }
}

__device__ __forceinline__ Frame mkframe(const Args& args, GA unsigned char* ws, LAS unsigned char* lds) {
    Frame F;
    F.x = (const GA float*)args.in[0]; F.norm_w = (const GA float*)args.in[1]; F.w_in = (const GA float*)args.in[2]; F.fox_b = (const GA float*)args.in[3];
    F.lq1 = (const GA float*)args.in[4]; F.lk1 = (const GA float*)args.in[5]; F.lq2 = (const GA float*)args.in[6]; F.lk2 = (const GA float*)args.in[7];
    F.subln = (const GA float*)args.in[8]; F.w_branch = (const GA float*)args.in[9]; F.w_out = (const GA float*)args.in[10]; F.rel_bias = (const GA float*)args.in[11];
    F.final_w = (const GA float*)args.in[12]; F.out = (GA float*)args.out;
    F.ctl = (GA unsigned*)(ws + WS_CTL); F.WinT = (GA bf16_t*)(ws + WS_WIN); F.WbrT = (GA bf16_t*)(ws + WS_WBR); F.WoutT = (GA bf16_t*)(ws + WS_WOUT);
    F.xres = (GA float*)(ws + WS_XRES); F.xb = (GA bf16_t*)(ws + WS_XB); F.ssq = (GA float*)(ws + WS_SSQ); F.Zs = (GA bf16_t*)(ws + WS_ZS); F.G = (GA bf16_t*)(ws + WS_G);
    F.QKV = (GA bf16_t*)(ws + WS_QKV); F.IQ = (GA bf16_t*)(ws + WS_IQ); F.IK = (GA bf16_t*)(ws + WS_IK); F.IW = (GA float*)(ws + WS_IW); F.FF = (GA float*)(ws + WS_FF);
    F.cum = (GA float*)(ws + WS_CUM); F.tb = (GA float*)(ws + WS_TB); F.sc = (GA float*)(ws + WS_SC); F.mask = (GA u64*)(ws + WS_MASK); F.Y = (GA bf16_t*)(ws + WS_Y); F.MG = (GA bf16_t*)(ws + WS_MG);
    F.O1 = (GA float*)(ws + WS_O1); F.OD = (GA float*)(ws + WS_OD); F.LSE = (GA float*)(ws + WS_LSE); F.DP = (GA float*)(ws + WS_DP); F.ws = ws;
    F.lds = lds; F.misc = (volatile LAS unsigned*)(lds + LDS_MISC);
    return F;
}

constexpr unsigned WQ_L0 = 2u * WT_TB, WQ_TOTAL = WQ_L0 + 3u * WT_TL;
__device__ __forceinline__ void wq_tile(const Args& args, LAS unsigned char* ldsl, unsigned t) {
    const Frame F = mkframe(args, launder(args.ws), ldsl);
    if (t < WQ_L0) { weight_tile(F, 0, WT_TW + WT_TG + (int)t, (LAS float*)ldsl); return; }
    const unsigned t1 = t - WQ_L0, l1 = t1 / (unsigned)WT_TL;
    weight_tile(F, 1 + (int)l1, (int)(t1 - l1 * (unsigned)WT_TL), (LAS float*)ldsl);
}
__device__ __forceinline__ void wq_drain(const Args& args, LAS unsigned char* ldsl, unsigned bound) {
    volatile LAS unsigned* st = (volatile LAS unsigned*)(ldsl + LDS_MISC);
    GA unsigned* wq = (GA unsigned*)(args.ws + WS_CTL) + CW_WQ;
    for (;;) {
        __syncthreads();
        if (threadIdx.x == 0) st[11] = __hip_atomic_fetch_add(wq, 1u, __ATOMIC_RELAXED, __HIP_MEMORY_SCOPE_AGENT);
        __syncthreads();
        const unsigned t = st[11];
        if (t < WQ_TOTAL) wq_tile(args, ldsl, t);
        if (t + 1u >= bound) break;
    }
}
__device__ __forceinline__ void xcd_barrier_steal(const XcdBarrier& b, const Args& args, LAS unsigned char* ldsl) {
    asm volatile("s_waitcnt vmcnt(0)" ::: "memory");
    __syncthreads();
    volatile LAS unsigned* st = b.st;
    if (threadIdx.x == 0) {
        unsigned* bar = b.bar;
        __builtin_amdgcn_s_waitcnt(0);
        unsigned nloc = st[0], nx = st[1];
        if (nloc == 0u) { xcd_barrier_complete(bar, b.x, nloc, nx); st[0] = nloc; st[1] = nx; }
        const unsigned old = xb_add(&bar[XB_XSUB(b.x)], 1u);
        const unsigned gen = old / nloc;
        if (old + 1u == (gen + 1u) * nloc) {
            __builtin_amdgcn_fence(__ATOMIC_RELEASE, "agent");
            asm volatile("s_waitcnt vmcnt(0)" ::: "memory");
            const unsigned og = xb_add(&bar[XB_TOP], 1u);
            const unsigned tg = og / nx;
            if (og + 1u == (tg + 1u) * nx) xb_add(&bar[XB_TOPGEN], 1u);
            else XB_SPIN(xb_ld(&bar[XB_TOPGEN]) == tg, bar);
            __builtin_amdgcn_fence(__ATOMIC_ACQUIRE, "agent");
            xb_add(&bar[XB_XGEN(b.x)], 1u);
            asm volatile("s_waitcnt vmcnt(0)" ::: "memory");
            st[8] = 1u;
        } else { st[8] = 0u; st[9] = gen; }
    }
    __syncthreads();
    const unsigned leader_ = st[8];
    __syncthreads();
    if (leader_ == 0u) {
        unsigned sp = 0u;
        for (;;) {
            if (threadIdx.x == 0) {
                unsigned* bar = b.bar;
                unsigned done = (xb_ld(&bar[XB_XGEN(b.x)]) != st[9]) ? 1u : 0u, t = 0xffffffffu;
                if (!done) {
                    if (st[10] == 0u) { t = xb_add((unsigned*)(args.ws + WS_CTL) + CW_WQ, 1u); if (t >= WQ_TOTAL) { st[10] = 1u; t = 0xffffffffu; } }
                    if (t == 0xffffffffu) { __builtin_amdgcn_s_sleep(1);
                        if ((++sp & 255u) == 0u) { if (xb_ld(&bar[XB_TMO])) done = 1u; else if (sp > XB_SPIN_CAP) { atomicAdd(&bar[XB_TMO], 1u); done = 1u; } } }
                }
                st[8] = done; st[11] = t;
            }
            __syncthreads();
            const unsigned done = st[8], t = st[11];
            if (done) break;
            if (t != 0xffffffffu) wq_tile(args, ldsl, t);
            else __syncthreads();
        }
        if (threadIdx.x == 0) { __builtin_amdgcn_fence(__ATOMIC_ACQUIRE, "agent"); asm volatile("s_waitcnt vmcnt(0)" ::: "memory"); }
    }
    __syncthreads();
}

__global__ void __launch_bounds__(512, 2) fwd(Args args) {
    extern __shared__ __attribute__((aligned(16))) unsigned char lds[];
    LAS unsigned char* ldsl = (LAS unsigned char*)lds;
    if (threadIdx.x < 64) ((volatile LAS unsigned*)(ldsl + LDS_MISC))[threadIdx.x] = 0u;
    __syncthreads();
    const int lo = args.ph_lo, hi = args.ph_hi;
    const bool fused = (hi - lo) > 1;
    if (fused) (void)xcd_barrier_post((unsigned*)(args.ws + WS_CTL) + CW_BAR, (volatile LAS unsigned*)(ldsl + LDS_MISC));
#ifndef PH_EN
#define PH_EN 0xff
#endif
#define IN(k) (lo <= (k) && (k) < hi)
#if defined(BWPROBE)
#define BW_MATCH(k) (BWPROBE == 9 || ((k) == 0 ? 5 : ((k) - 1) % 5) == BWPROBE)
#define SEAM(k) do { if (IN((k) + 1)) { const unsigned long long bw0_ = __builtin_amdgcn_s_memrealtime(); XcdBarrier b_; b_.bar = (unsigned*)(args.ws + WS_CTL) + CW_BAR; b_.x = xb_xcc_id(); b_.st = (volatile LAS unsigned*)(ldsl + LDS_MISC); xcd_barrier(b_); \
    if (BW_MATCH(k) && threadIdx.x == 0) atomicAdd((unsigned*)(args.ws + WS_CTL) + 14336, (unsigned)(__builtin_amdgcn_s_memrealtime() - bw0_)); } } while (0)
#else
#define SEAM(k) do { if (IN((k) + 1)) { XcdBarrier b_; b_.bar = (unsigned*)(args.ws + WS_CTL) + CW_BAR; b_.x = xb_xcc_id(); b_.st = (volatile LAS unsigned*)(ldsl + LDS_MISC); xcd_barrier(b_); } } while (0)
#endif
#define SEAM_STEAL(k) do { if (IN((k) + 1)) { XcdBarrier b_; b_.bar = (unsigned*)(args.ws + WS_CTL) + CW_BAR; b_.x = xb_xcc_id(); b_.st = (volatile LAS unsigned*)(ldsl + LDS_MISC); xcd_barrier_steal(b_, args, ldsl); } } while (0)
    const int G = gridDim.x, bid = blockIdx.x;
#if defined(TPROBE)
    unsigned long long tp_acc = 0ull, tp_t0 = 0ull;
#define tp_acc_ref tp_acc
#define TP_BEGIN(k) do { if ((k) == TPROBE) tp_t0 = __builtin_amdgcn_s_memrealtime(); } while (0)
#define TP_END(k) do { if ((k) == TPROBE) tp_acc += __builtin_amdgcn_s_memrealtime() - tp_t0; } while (0)
#else
    unsigned long long tp_dummy = 0ull;
#define tp_acc_ref tp_dummy
#define TP_BEGIN(k) do { } while (0)
#define TP_END(k) do { } while (0)
#endif

    if ((PH_EN & 1) && IN(0)) { const Frame F = mkframe(args, launder(args.ws), ldsl); TP_BEGIN(0); p0_prologue(F);
#if defined(DUP) && DUP == 6
        __syncthreads(); p0_prologue(F);
#endif
        SEAM(0); TP_END(0); }

    for (int layer = 0; layer < DEPTH; ++layer) {
        const int pb = 1 + 5 * layer;
        if ((PH_EN & 2) && IN(pb)) { TP_BEGIN(1);
            GA unsigned char* ws = launder(args.ws);
            { pg8::Gemm g{(const GA bf16_t*)(ws + WS_XB), (const GA bf16_t*)(ws + WS_WIN) + (size_t)layer * NINP * DM, MT, NINP, DM}; pg8::StaticOrder S; S.init(MT, NINP, G, bid);
              EpiIn E{ws};
              pg8::gemm_phase<EpiIn, pg8::StaticOrder>(ldsl, g, S, E); }
            __syncthreads();
            { pg8::Gemm g{(const GA bf16_t*)(ws + WS_XQ), (const GA bf16_t*)(ws + WS_WG8 + (size_t)layer * N8 * DM), MT, N8, DM / 2}; pg8::StaticOrder S;
              if (G == 256) { if (bid < 192) S.init_part(MT, N8, 192, bid, 12); else S.init_part(MT, N8, 64, 2304 + (bid - 192), 14); } else S.init(MT, N8, G, (bid + 128) % G);
              EpiGate E{ws};
              pg8::gemm_phase<EpiGate, pg8::StaticOrder>(ldsl, g, S, E); }
            SEAM_STEAL(pb); TP_END(1);
        }
        if ((PH_EN & 4) && IN(pb + 1)) { TP_BEGIN(2);
            const Frame F = mkframe(args, launder(args.ws), ldsl);
            TP_BEGIN(20); if (bid < 8) fox_scan(F, layer, bid);
            fox_kmax(F, layer); TP_END(20);
            GA unsigned* ctr = F.ctl + CW_Q + 64 * (layer * 4 + 0);
            for (int u = q_next(ctr, F.misc + 4); u < 768 + 2048; u = q_next(ctr, F.misc + 4)) {
                if (u < 768) { TP_BEGIN(23); attn_dil_unit(F, u); TP_END(23); } else { TP_BEGIN(21); idxsel_unit(F, u - 768, tp_acc_ref); TP_END(21); }
            }
            SEAM_STEAL(pb + 1); TP_END(2);
        }
        if ((PH_EN & 16) && IN(pb + 2)) { TP_BEGIN(4);
            const Frame F = mkframe(args, launder(args.ws), ldsl);
            GA unsigned* ctr = F.ctl + CW_Q + 64 * (layer * 4 + 1);
            const int nunits = 1536;
            for (int u = q_next(ctr, F.misc + 4); u < nunits; u = q_next(ctr, F.misc + 4)) {
                if (u < 512) { const int qb = 31 - (u >> 4), r = u & 15; TP_BEGIN(40); TP_BEGIN(44 + (qb >= 16)); attn_diffmap_unit(F, layer, r & 1, (r >> 1) & 3, qb, r >> 3); TP_END(40); TP_END(44 + (qb >= 16)); }
                else if (u < 1024) { const int v = u - 512, qb = 31 - (v >> 4), r = v & 15, mode = r & 1, b = (r >> 1) & 1, h = r >> 2;
                    if (mode == 0) { TP_BEGIN(41); attn_fast_unit<0>(F, layer, b, h, qb); TP_END(41); } else { TP_BEGIN(42); attn_fast_unit<1>(F, layer, b, h, qb); TP_END(42); } }
                else { TP_BEGIN(43); dil_merge_unit(F, u - 1024); TP_END(43); }
            }
            if (layer == 0) { __syncthreads(); wq_drain(args, ldsl, WQ_L0); }
            SEAM_STEAL(pb + 2); TP_END(4);
        }
        if ((PH_EN & 32) && IN(pb + 3)) { TP_BEGIN(5);
            GA unsigned char* ws = launder(args.ws);
            pg8::Gemm g{(const GA bf16_t*)(ws + WS_Y), (const GA bf16_t*)(ws + WS_WBR) + (size_t)layer * DM * DM, MT, DM, DM}; pg8::StaticOrder S; S.init(MT, DM, G, bid);
            EpiMerged E{(const GA unsigned char*)(ws + WS_G), (GA bf16_t*)(ws + WS_MG)};
            pg8::gemm_phase<EpiMerged, pg8::StaticOrder>(ldsl, g, S, E);
#if defined(DUP) && DUP == 4
            __syncthreads(); pg8::gemm_phase<EpiMerged, pg8::StaticOrder>(ldsl, g, S, E);
#endif
            SEAM_STEAL(pb + 3); TP_END(5);
        }
        if ((PH_EN & 64) && IN(pb + 4)) { TP_BEGIN(6);
            GA unsigned char* ws = launder(args.ws);
            pg8::Gemm g{(const GA bf16_t*)(ws + WS_MG), (const GA bf16_t*)(ws + WS_WOUT) + (size_t)layer * DM * DM, MT, DM, DM}; pg8::StaticOrder S; S.init(MT, DM, G, bid);
            EpiOut E{(GA float*)(ws + WS_XRES), (GA bf16_t*)(ws + WS_XB), (GA float*)(ws + WS_SSQ), ws + WS_XQ, (layer == 0) ? (const GA float*)args.in[0] : (const GA float*)nullptr, layer + 1 < DEPTH};
            pg8::gemm_phase<EpiOut, pg8::StaticOrder>(ldsl, g, S, E);
            if (layer + 1 < DEPTH) { __syncthreads(); wq_drain(args, ldsl, WQ_L0 + (unsigned)(layer + 1) * WT_TL); }
            SEAM_STEAL(pb + 4); TP_END(6);
        }
    }
    if ((PH_EN & 128) && IN(21)) { TP_BEGIN(7); const Frame F = mkframe(args, launder(args.ws), ldsl); final_norm(F); TP_END(7); }
#if defined(BWPROBE)
    if (bid == 0) { __syncthreads(); const unsigned long long te = __builtin_amdgcn_s_memrealtime(); const unsigned long long tot = xb_ld((unsigned*)(args.ws + WS_CTL) + 14336);
        while ((__builtin_amdgcn_s_memrealtime() - te) * 32ull < tot) __builtin_amdgcn_s_sleep(8); }
#endif
#if defined(TPROBE)
    if (bid == 0) { const unsigned long long te = __builtin_amdgcn_s_memrealtime(); while (__builtin_amdgcn_s_memrealtime() - te < 8ull * tp_acc) __builtin_amdgcn_s_sleep(8); }
#endif
#undef IN
#undef SEAM
}

extern "C" void kernel_launch(void* const* d_in, const int* in_sizes, int n_in, void* d_out, int out_size, void* d_ws, size_t ws_size, hipStream_t stream) {
    static int grid = 0;
    if (grid == 0) {
        if (n_in != 13 || in_sizes[0] != MT * DM || out_size != MT * DM || ws_size < WS_END) {
            fprintf(stderr, "kernel_launch: unexpected shapes (n_in %d, in0 %d, out %d, ws %zu, need %zu)\n", n_in, n_in > 0 ? in_sizes[0] : -1, out_size, ws_size, (size_t)WS_END); grid = -1; return; }
        int dev = 0, cus = 0, per_cu = 0;
        if (hipGetDevice(&dev) != hipSuccess || hipDeviceGetAttribute(&cus, hipDeviceAttributeMultiprocessorCount, dev) != hipSuccess) { grid = -1; return; }
        if (hipFuncSetAttribute((const void*)fwd, hipFuncAttributeMaxDynamicSharedMemorySize, LDS_BYTES) != hipSuccess) { fprintf(stderr, "kernel_launch: hipFuncSetAttribute failed\n"); grid = -1; return; }
        if (hipOccupancyMaxActiveBlocksPerMultiprocessor(&per_cu, (const void*)fwd, 512, LDS_BYTES) != hipSuccess || per_cu < 1) fprintf(stderr, "kernel_launch: occupancy query reports %d\n", per_cu);
        (void)hipGetLastError();
        grid = cus;
    }
    if (grid < 0) return;
    if (hipMemsetAsync((char*)d_ws + WS_CTL, 0, CTL_BYTES, stream) != hipSuccess) return;
    Args a{};
    for (int i = 0; i < 13; ++i) a.in[i] = (const float*)d_in[i];
    a.out = (float*)d_out; a.ws = (unsigned char*)d_ws;
#if MK_LAUNCHES == 1
    a.ph_lo = 0; a.ph_hi = NPH;
    hipLaunchKernelGGL(fwd, dim3(grid), dim3(512), LDS_BYTES, stream, a);
#else
    for (int p = 0; p < NPH; ++p) { a.ph_lo = p; a.ph_hi = p + 1; hipLaunchKernelGGL(fwd, dim3(grid), dim3(512), LDS_BYTES, stream, a); }
#endif
}
```

```cpp
#include <hip/hip_runtime.h>
#include <stdint.h>
#include <stdio.h>

#ifndef MK_LAUNCHES
#define MK_LAUNCHES 1
#endif

#define LAS __attribute__((address_space(3)))
#define GA __attribute__((address_space(1)))
typedef unsigned short bf16_t;
typedef short bf16x8 __attribute__((ext_vector_type(8)));
typedef float f32x4 __attribute__((ext_vector_type(4)));
typedef float f32x16 __attribute__((ext_vector_type(16)));
typedef unsigned u32x4 __attribute__((ext_vector_type(4)));
typedef unsigned u32x2 __attribute__((ext_vector_type(2)));
typedef unsigned long long u64;

constexpr int DM = 2048, NB = 2, SEQ = 8192, DEPTH = 4, MT = NB * SEQ;
constexpr int NIN = 17492, NINP = 4864, N8 = 12800;
constexpr float W8SCALE = 512.f;
constexpr int NPH = 22;
constexpr float LOG2E = 1.4426950408889634f;
constexpr float QSC128 = 0.08838834764831845f * 1.4426950408889634f;
constexpr float QSC64 = 0.125f * 1.4426950408889634f;
constexpr float RMS_EPS = 1e-6f;
constexpr size_t QS = (size_t)NB * 4 * SEQ * 128;

constexpr size_t al256(size_t x) { return (x + 255) & ~(size_t)255; }
constexpr size_t WS_CTL = 0, CTL_BYTES = 65536;
constexpr size_t WS_WIN = WS_CTL + CTL_BYTES;
constexpr size_t WS_WBR = WS_WIN + (size_t)DEPTH * NINP * DM * 2;
constexpr size_t WS_WOUT = WS_WBR + (size_t)DEPTH * DM * DM * 2;
constexpr size_t WS_XRES = WS_WOUT + (size_t)DEPTH * DM * DM * 2;
constexpr size_t WS_XB = WS_XRES + (size_t)MT * DM * 4;
constexpr size_t WS_SSQ = WS_XB + (size_t)MT * DM * 2;
constexpr size_t WS_ZS = WS_SSQ + (size_t)MT * 32 * 4;
constexpr size_t WS_G = WS_ZS + (size_t)MT * DM * 2;
constexpr size_t WS_QKV = WS_G + (size_t)MT * 8192 * 2;
constexpr size_t WS_IQ = WS_QKV + 12 * QS * 2;
constexpr size_t WS_IK = WS_IQ + (size_t)MT * 1024 * 2;
constexpr size_t WS_IW = WS_IK + (size_t)MT * 64 * 2;
constexpr size_t WS_FF = WS_IW + (size_t)MT * 16 * 4;
constexpr size_t WS_CUM = WS_FF + (size_t)MT * 4 * 4;
constexpr size_t WS_TB = WS_CUM + (size_t)NB * 4 * SEQ * 4;
constexpr size_t WS_SC = WS_TB + (size_t)12 * SEQ * 4;
constexpr size_t WS_MASK = WS_SC + (size_t)NB * SEQ * SEQ * 4;
constexpr size_t WS_Y = WS_MASK + (size_t)NB * SEQ * 128 * 8;
constexpr size_t WS_MG = WS_Y + (size_t)MT * DM * 2;
constexpr size_t WS_O1 = WS_MG + (size_t)MT * DM * 2;
constexpr size_t WS_OD = WS_O1 + (size_t)2 * 256 * 64 * 512 * 4;
constexpr size_t WS_LSE = WS_OD + (size_t)3 * MT * 512 * 4;
constexpr size_t WS_DP = WS_LSE + (size_t)3 * MT * 4 * 4;
constexpr size_t WS_WG8 = WS_DP + 4 * 256 * 4;
constexpr size_t WS_XQ = WS_WG8 + (size_t)DEPTH * N8 * DM;
constexpr size_t WS_END = WS_XQ + (size_t)MT * DM;

constexpr int CW_BAR = 0;
constexpr int CW_Q = 4096;
constexpr int CW_DC = 8192;
constexpr int CW_WQ = 13312;
constexpr int CW_KM = 12288;

constexpr int LDS_STAGE = 131072;
constexpr int LDS_MISC = 131072;
constexpr int LDS_BYTES = 147456;

__device__ __forceinline__ unsigned cvt_pk_bf16(float lo, float hi) { unsigned r; asm volatile("v_cvt_pk_bf16_f32 %0, %1, %2" : "=v"(r) : "v"(lo), "v"(hi)); return r; }
__device__ __forceinline__ float bf_lo(unsigned w) { return __uint_as_float(w << 16); }
__device__ __forceinline__ float bf_hi(unsigned w) { return __uint_as_float(w & 0xffff0000u); }
__device__ __forceinline__ float bf2f(bf16_t b) { return __uint_as_float(((unsigned)b) << 16); }
__device__ __forceinline__ float ex2(float x) { return __builtin_amdgcn_exp2f(x); }
__device__ __forceinline__ float sigmoidf_(float x) { return __builtin_amdgcn_rcpf(1.0f + ex2(-x * LOG2E)); }
__device__ __forceinline__ int tid_l() { int t = threadIdx.x; asm volatile("" : "+v"(t)); return t; }
__device__ __forceinline__ GA unsigned char* launder(unsigned char* p) { asm volatile("" : "+s"(p)); return (GA unsigned char*)p; }
__device__ __forceinline__ GA unsigned char* launder(GA unsigned char* p) { asm volatile("" : "+s"(p)); return p; }
__device__ __forceinline__ float wave_sum(float v) {
#pragma unroll
    for (int o = 32; o > 0; o >>= 1) v += __shfl_xor(v, o);
    return v;
}

#define XB_TMO      128
#define XB_XCNT(j)  (256  + 64 * (j))
#define XB_XSUB(j)  (1280 + 64 * (j))
#define XB_XGEN(j)  (2304 + 64 * (j))
#define XB_TOP      3328
#define XB_TOPGEN   3392
#define XCD_BAR_WORDS 3456
#define XB_SPIN_CAP (1u << 18)

__device__ __forceinline__ unsigned xb_ld(unsigned* p)              { return __hip_atomic_load(p, __ATOMIC_RELAXED, __HIP_MEMORY_SCOPE_AGENT); }
__device__ __forceinline__ unsigned xb_add(unsigned* p, unsigned v) { return __hip_atomic_fetch_add(p, v, __ATOMIC_RELAXED, __HIP_MEMORY_SCOPE_AGENT); }
__device__ __forceinline__ unsigned xb_xcc_id() { return (unsigned)__builtin_amdgcn_s_getreg((3 << 11) | 20) & 0xFu; }
#define XB_SPIN(cond, bar) do { unsigned _sp = 0; while (cond) { __builtin_amdgcn_s_sleep(1); \
    if ((++_sp & 255u) == 0u) { if (xb_ld(&(bar)[XB_TMO])) break; if (_sp > XB_SPIN_CAP) { atomicAdd(&(bar)[XB_TMO], 1u); break; } } } } while (0)

struct XcdBarrier { unsigned* bar; unsigned x; volatile LAS unsigned* st; };

__device__ __forceinline__ XcdBarrier xcd_barrier_post(unsigned* bar, volatile LAS unsigned* st) {
    XcdBarrier b; b.bar = bar; b.x = xb_xcc_id(); b.st = st;
    if (threadIdx.x == 0) (void)xb_add(&bar[XB_XCNT(b.x)], 1u);
    return b;
}
__device__ __forceinline__ void xcd_barrier_complete(unsigned* bar, unsigned x, unsigned& nloc, unsigned& nx) {
    const unsigned G = gridDim.x * gridDim.y * gridDim.z;
    unsigned sum, cnt, mine, sp = 0u;
    for (;;) {
        sum = 0u; cnt = 0u; mine = 0u;
#pragma unroll
        for (unsigned j = 0; j < 16; ++j) { const unsigned c = xb_ld(&bar[XB_XCNT(j)]); sum += c; cnt += (c > 0u) ? 1u : 0u; mine = (j == x) ? c : mine; }
        if (sum == G) break;
        __builtin_amdgcn_s_sleep(1);
        if ((++sp & 255u) == 0u) { if (xb_ld(&bar[XB_TMO])) break; if (sp > XB_SPIN_CAP) { atomicAdd(&bar[XB_TMO], 1u); break; } }
    }
    nloc = mine > 0u ? mine : 1u; nx = cnt > 0u ? cnt : 1u;
}
__device__ __forceinline__ void xcd_barrier(const XcdBarrier& b) {
    asm volatile("s_waitcnt vmcnt(0)" ::: "memory");
    __syncthreads();
    if (threadIdx.x == 0) {
        unsigned* bar = b.bar;
        __builtin_amdgcn_s_waitcnt(0);
        unsigned nloc = b.st[0], nx = b.st[1];
        if (nloc == 0u) { xcd_barrier_complete(bar, b.x, nloc, nx); b.st[0] = nloc; b.st[1] = nx; }
        const unsigned old = xb_add(&bar[XB_XSUB(b.x)], 1u);
        const unsigned gen = old / nloc;
        if (old + 1u == (gen + 1u) * nloc) {
            __builtin_amdgcn_fence(__ATOMIC_RELEASE, "agent");
            asm volatile("s_waitcnt vmcnt(0)" ::: "memory");
            const unsigned og = xb_add(&bar[XB_TOP], 1u);
            const unsigned tg = og / nx;
            if (og + 1u == (tg + 1u) * nx) xb_add(&bar[XB_TOPGEN], 1u);
            else XB_SPIN(xb_ld(&bar[XB_TOPGEN]) == tg, bar);
            __builtin_amdgcn_fence(__ATOMIC_ACQUIRE, "agent");
            xb_add(&bar[XB_XGEN(b.x)], 1u);
            asm volatile("s_waitcnt vmcnt(0)" ::: "memory");
        } else {
            XB_SPIN(xb_ld(&bar[XB_XGEN(b.x)]) == gen, bar);
            __builtin_amdgcn_fence(__ATOMIC_ACQUIRE, "agent");
            asm volatile("s_waitcnt vmcnt(0)" ::: "memory");
        }
    }
    __syncthreads();
}

namespace pg8 {
constexpr int BM = 256, BK = 64, HALF = 128, HTB = HALF * BK * 2, STAGE_BYTES = 8 * HTB, NXCD = 8, WGM = 4;
__host__ __device__ __forceinline__ int lds_byte(int r, int c) { const int st = (r >> 4) * 2 + (c >> 5), rr = r & 15, cc = c & 31, ob = rr * 64 + cc * 2; return st * 1024 + (ob ^ (((ob >> 9) & 1) << 5)); }
__host__ __device__ __forceinline__ void stage_rc(int b, int& R, int& C) { const int st = b / 1024, sb = b % 1024, swz = sb ^ (((sb >> 9) & 1) << 5); R = (st >> 1) * 16 + swz / 64; C = (st & 1) * 32 + (swz % 64) / 2; }
__host__ __device__ __forceinline__ int perm32(int rho) { const int n = rho >> 4, i = rho & 15; return 8 * (i >> 2) + 4 * n + (i & 3); }
struct Unit { int pm, pn; };
struct Gemm { const GA bf16_t* A; const GA bf16_t* Bt; int M, N, K; };
struct StaticOrder {
    int nM, nN, nwg, G, c, cnt;
    __host__ __device__ void init(int M, int N, int G_, int c_) { nM = M / BM; nN = N / BM; nwg = nM * nN; G = G_; c = c_; cnt = 1 << 30; }
    __host__ __device__ void init_part(int M, int N, int stride, int first, int cnt_) { nM = M / BM; nN = N / BM; nwg = nM * nN; G = stride; c = first; cnt = cnt_; }
    __host__ __device__ bool next(int i, Unit& u) const {
        const long L = (long)i * G + c; if (L >= nwg || i >= cnt) return false;
        int wgid = (int)L; { const int q = nwg / NXCD, r = nwg % NXCD, xcd = wgid % NXCD, off = wgid / NXCD; wgid = (xcd < r ? xcd * (q + 1) : r * (q + 1) + (xcd - r) * q) + off; }
        const int nig = WGM * nN, gid = wgid / nig, fm = gid * WGM, gsz = (nM - fm) < WGM ? (nM - fm) : WGM;
        u.pm = fm + ((wgid % nig) % gsz); u.pn = (wgid % nig) / gsz; return true;
    }
    __device__ __forceinline__ void a_ready(const Unit&) const {}
    __device__ __forceinline__ void done(const Unit&) const {}
};

template <class Epi, class Sched>
__device__ __forceinline__ void gemm_phase(LAS unsigned char* lds, const Gemm g, const Sched& S, const Epi& E) {
    const int tid = tid_l(), wid = __builtin_amdgcn_readfirstlane(tid >> 6), lane = tid & 63, wr = wid >> 2, wc = wid & 3, fr = lane & 15, fq = lane >> 4;
    const int K = g.K, nt = K / BK;
    unsigned voffA[2], voffB[2];
#pragma unroll
    for (int i = 0; i < 2; ++i) { int R, C; stage_rc(tid * 16 + i * 8192, R, C); const int Rb = Epi::PERM ? ((R & ~31) + perm32(R & 31)) : R;
        voffA[i] = (unsigned)(R * K + C) * 2u; voffB[i] = (unsigned)(Rb * K + C) * 2u; }
    const size_t kstep = (size_t)(BK * 2);
    const size_t hstep = (size_t)HALF * K * 2;
    const size_t tstep = 2 * hstep;
    const unsigned ldsw = (unsigned)wid * 1024u;
    const int aoff = lds_byte(wr * 64 + fr, fq * 8), boff = lds_byte(wc * 32 + fr, fq * 8);
    typedef int v8i_t __attribute__((ext_vector_type(8)));
    const int aoff8 = lds_byte(wr * 64 + fr, (fq & 1) * 16) + (fq >> 1) * 1024, boff8 = lds_byte(wc * 32 + fr, (fq & 1) * 16) + (fq >> 1) * 1024;
#define PG8_SA(b, h) (((b) * 2 + (h)) * HTB)
#define PG8_SB(b, h) ((4 + (b) * 2 + (h)) * HTB)
#define PG8_STAGE(bufoff, gbase, voff) do { _Pragma("unroll") for (int _i = 0; _i < 2; ++_i) \
        __builtin_amdgcn_global_load_lds((const GA unsigned*)((const GA char*)(gbase) + (voff)[_i]), (LAS unsigned*)(lds + (bufoff) + ldsw + _i * 8192), 16, 0, 0); } while (0)
#define PG8_LDA(dst, b, h) do { if constexpr (Epi::FP8) { _Pragma("unroll") for (int m = 0; m < 4; ++m) { typedef int v4i_t_ __attribute__((ext_vector_type(4))); const LAS char* p_ = (const LAS char*)(lds + PG8_SA(b, h) + aoff8 + m * 2048); const v4i_t_ lo_ = *(const LAS v4i_t_*)p_, hi_ = *(const LAS v4i_t_*)(p_ + 16); dst##8[m] = __builtin_shufflevector(lo_, hi_, 0, 1, 2, 3, 4, 5, 6, 7); } } \
        else { _Pragma("unroll") for (int m = 0; m < 4; ++m) _Pragma("unroll") for (int k = 0; k < 2; ++k) dst[m][k] = *(const LAS bf16x8*)(lds + PG8_SA(b, h) + aoff + m * 2048 + k * 1024); } } while (0)
#define PG8_LDB(dst, b, h) do { if constexpr (Epi::FP8) { _Pragma("unroll") for (int n = 0; n < 2; ++n) { typedef int v4i_t_ __attribute__((ext_vector_type(4))); const LAS char* p_ = (const LAS char*)(lds + PG8_SB(b, h) + boff8 + n * 2048); const v4i_t_ lo_ = *(const LAS v4i_t_*)p_, hi_ = *(const LAS v4i_t_*)(p_ + 16); dst##8[n] = __builtin_shufflevector(lo_, hi_, 0, 1, 2, 3, 4, 5, 6, 7); } } \
        else { _Pragma("unroll") for (int n = 0; n < 2; ++n) _Pragma("unroll") for (int k = 0; k < 2; ++k) dst[n][k] = *(const LAS bf16x8*)(lds + PG8_SB(b, h) + boff + n * 2048 + k * 1024); } } while (0)
#define PG8_MMA(ai, bj, At, Bt) do { __builtin_amdgcn_s_setprio(1); _Pragma("unroll") for (int m = 0; m < 4; ++m) _Pragma("unroll") for (int n = 0; n < 2; ++n) { \
        if constexpr (Epi::FP8) asm volatile("v_mfma_scale_f32_16x16x128_f8f6f4 %0, %1, %2, %0, %3, %3 op_sel_hi:[0,0,0]" : "+v"(acc[ai][bj][m][n]) : "v"(Bt##8[n]), "v"(At##8[m]), "v"(sc127)); \
        else { _Pragma("unroll") for (int k = 0; k < 2; ++k) acc[ai][bj][m][n] = __builtin_amdgcn_mfma_f32_16x16x32_bf16(Bt[n][k], At[m][k], acc[ai][bj][m][n], 0, 0, 0); } } \
        __builtin_amdgcn_s_setprio(0); } while (0)
#define PG8_WAIT_V(n) asm volatile("s_waitcnt vmcnt(" #n ")" ::: "memory")
#define PG8_WAIT_L(n) asm volatile("s_waitcnt lgkmcnt(" #n ")" ::: "memory")
#define PG8_BAR __builtin_amdgcn_s_barrier()
#define PG8_SCHED __builtin_amdgcn_sched_barrier(0)
    Unit cur, nxt; int ui = 0;
    if (!S.next(0, cur)) return;
    f32x4 acc[2][2][4][2];
#pragma unroll
    for (int a = 0; a < 2; ++a)
#pragma unroll
        for (int b = 0; b < 2; ++b)
#pragma unroll
            for (int m = 0; m < 4; ++m)
#pragma unroll
                for (int n = 0; n < 2; ++n) acc[a][b][m][n] = (f32x4){0.f, 0.f, 0.f, 0.f};
    bf16x8 At[4][2], B0[2][2], B1[2][2]; v8i_t At8[4], B08[2], B18[2]; const int sc127 = 127;
    const GA char* cA = (const GA char*)g.A + (size_t)cur.pm * tstep; const GA char* cB = (const GA char*)g.Bt + (size_t)cur.pn * tstep;
    S.a_ready(cur);
    PG8_STAGE(PG8_SB(0, 0), cB, voffB); PG8_STAGE(PG8_SA(0, 0), cA, voffA); PG8_STAGE(PG8_SB(0, 1), cB + hstep, voffB); PG8_STAGE(PG8_SA(0, 1), cA + hstep, voffA);
    if (wr == 1) PG8_BAR;
    PG8_WAIT_V(4); PG8_BAR;
    PG8_STAGE(PG8_SB(1, 0), cB + kstep, voffB); PG8_STAGE(PG8_SA(1, 0), cA + kstep, voffA); PG8_STAGE(PG8_SB(1, 1), cB + hstep + kstep, voffB);
    PG8_WAIT_V(6); PG8_BAR;
    for (;;) {
        const bool has_next = S.next(ui + 1, nxt);
        const GA char* nA = has_next ? (const GA char*)g.A + (size_t)nxt.pm * tstep : cA; const GA char* nB = has_next ? (const GA char*)g.Bt + (size_t)nxt.pn * tstep : cB;
        for (int t = 0; t < nt; t += 2) {
            const bool last = (t == nt - 2);
            const GA char* a1 = cA + (size_t)(t + 1) * kstep;
            const GA char* a2 = last ? nA : cA + (size_t)(t + 2) * kstep; const GA char* b2 = last ? nB : cB + (size_t)(t + 2) * kstep;
            const GA char* a3 = a2 + kstep; const GA char* b3 = b2 + kstep;
            if (last && has_next) S.a_ready(nxt);
            if constexpr (Epi::MIDK) { if (t > 0 && (t & 7) == 0) E.mid(acc, cur, t >> 3, wr, wc, fr, fq); }
            PG8_LDB(B0, 0, 0); PG8_SCHED; PG8_LDA(At, 0, 0); PG8_STAGE(PG8_SA(1, 1), a1 + hstep, voffA);
            PG8_WAIT_L(8); PG8_BAR; PG8_WAIT_L(0); PG8_MMA(0, 0, At, B0); PG8_BAR; PG8_SCHED;
            PG8_LDB(B1, 0, 1); PG8_STAGE(PG8_SB(0, 0), b2, voffB);
            PG8_BAR; PG8_WAIT_L(0); PG8_MMA(0, 1, At, B1); PG8_BAR;
            PG8_LDA(At, 0, 1); PG8_STAGE(PG8_SA(0, 0), a2, voffA);
            PG8_BAR; PG8_WAIT_L(0); PG8_MMA(1, 0, At, B0); PG8_BAR; PG8_SCHED;
            PG8_STAGE(PG8_SB(0, 1), b2 + hstep, voffB);
            PG8_WAIT_V(6); PG8_BAR; PG8_MMA(1, 1, At, B1); PG8_BAR;
            PG8_LDB(B0, 1, 0); PG8_SCHED; PG8_LDA(At, 1, 0); PG8_STAGE(PG8_SA(0, 1), a2 + hstep, voffA);
            PG8_WAIT_L(8); PG8_BAR; PG8_WAIT_L(0); PG8_MMA(0, 0, At, B0); PG8_BAR; PG8_SCHED;
            PG8_LDB(B1, 1, 1); PG8_STAGE(PG8_SB(1, 0), b3, voffB);
            PG8_BAR; PG8_WAIT_L(0); PG8_MMA(0, 1, At, B1); PG8_BAR;
            PG8_LDA(At, 1, 1); PG8_STAGE(PG8_SA(1, 0), a3, voffA);
            PG8_BAR; PG8_WAIT_L(0); PG8_MMA(1, 0, At, B0); PG8_BAR; PG8_SCHED;
            PG8_STAGE(PG8_SB(1, 1), b3 + hstep, voffB);
            PG8_WAIT_V(6); PG8_BAR; PG8_MMA(1, 1, At, B1); PG8_BAR;
        }
        if constexpr (Epi::FP8) asm volatile("s_nop 15\n\ts_nop 15" ::: "memory");
        E(acc, cur, wr, wc, fr, fq); S.done(cur);
#if defined(DUP) && DUP == 7
        if constexpr (!Epi::MIDK && Epi::PERM) { asm volatile("s_waitcnt vmcnt(0)" ::: "memory"); E(acc, cur, wr, wc, fr, fq); E(acc, cur, wr, wc, fr, fq); }
#endif
        if (!has_next) break;
#pragma unroll
        for (int a = 0; a < 2; ++a)
#pragma unroll
            for (int b = 0; b < 2; ++b)
#pragma unroll
                for (int m = 0; m < 4; ++m)
#pragma unroll
                    for (int n = 0; n < 2; ++n) acc[a][b][m][n] = (f32x4){0.f, 0.f, 0.f, 0.f};
        cur = nxt; cA = nA; cB = nB; ++ui;
    }
    PG8_WAIT_V(0);
    if (wr == 0) PG8_BAR;
    PG8_BAR;
#undef PG8_SA
#undef PG8_SB
#undef PG8_STAGE
#undef PG8_LDA
#undef PG8_LDB
#undef PG8_MMA
#undef PG8_WAIT_V
#undef PG8_WAIT_L
#undef PG8_BAR
#undef PG8_SCHED
}
}

struct Args { const float* in[13]; float* out; unsigned char* ws; int ph_lo, ph_hi; };
struct Frame {
    const GA float* x; const GA float* norm_w; const GA float* w_in; const GA float* fox_b; const GA float* lq1; const GA float* lk1; const GA float* lq2; const GA float* lk2;
    const GA float* subln; const GA float* w_branch; const GA float* w_out; const GA float* rel_bias; const GA float* final_w; GA float* out;
    GA unsigned* ctl; GA bf16_t* WinT; GA bf16_t* WbrT; GA bf16_t* WoutT; GA float* xres; GA bf16_t* xb; GA float* ssq; GA bf16_t* Zs; GA bf16_t* G; GA bf16_t* QKV; GA bf16_t* IQ; GA bf16_t* IK;
    GA float* IW; GA float* FF; GA float* cum; GA float* tb; GA float* sc; GA u64* mask; GA bf16_t* Y; GA bf16_t* MG; GA float* O1; GA float* OD; GA float* LSE; GA float* DP; GA unsigned char* ws;
    LAS unsigned char* lds; volatile LAS unsigned* misc;
};

__device__ __forceinline__ int q_next(GA unsigned* ctr, volatile LAS unsigned* lw) {
    __syncthreads();
    if (threadIdx.x == 0) *lw = __hip_atomic_fetch_add(ctr, 1u, __ATOMIC_RELAXED, __HIP_MEMORY_SCOPE_AGENT);
    __syncthreads();
    return (int)*lw;
}

__device__ __forceinline__ int win_src_col(int n) {
    if (n < 2048) return n;
    if (n < 3072) return n - 2048 + 11776;
    if (n < 4608) return n - 3072 + 14420;
    if (n < 4672) return n - 4608 + 12800;
    if (n < 4688) return n - 4672 + 12864;
    if (n < 4692) return n - 4688 + 14416;
    return -1;
}
__device__ __forceinline__ int win8_src_col(int n) {
    if (n < 8192) return n + 2048;
    if (n < 9728) return n - 8192 + 10240;
    if (n < 11264) return n - 9728 + 12880;
    return n - 11264 + 15956;
}
__device__ __forceinline__ void transpose_tile(const GA float* src, int ld, int srccol4, const GA float* ksc, GA bf16_t* dst, int k0, int n0, LAS float* tile) {
    const int tid = tid_l(), tk = tid >> 5, tn4 = (tid & 31) * 4;
    f32x4 v[4];
#pragma unroll
    for (int i = 0; i < 4; ++i) { const int kk = tk + 16 * i; v[i] = (f32x4){0.f, 0.f, 0.f, 0.f};
        if (srccol4 >= 0) { v[i] = *(const GA f32x4*)(src + (size_t)(k0 + kk) * ld + srccol4); if (ksc) v[i] *= ksc[k0 + kk]; } }
#pragma unroll
    for (int i = 0; i < 4; ++i) { const int kk = tk + 16 * i;
#pragma unroll
        for (int j = 0; j < 4; ++j) tile[kk * 129 + tn4 + j] = v[i][j]; }
    __syncthreads();
    const int wn = tid >> 2, wk = tid & 3;
    float f[16];
#pragma unroll
    for (int j = 0; j < 16; ++j) f[j] = tile[(wk * 16 + j) * 129 + wn];
    u32x4 w0 = {cvt_pk_bf16(f[0], f[1]), cvt_pk_bf16(f[2], f[3]), cvt_pk_bf16(f[4], f[5]), cvt_pk_bf16(f[6], f[7])};
    u32x4 w1 = {cvt_pk_bf16(f[8], f[9]), cvt_pk_bf16(f[10], f[11]), cvt_pk_bf16(f[12], f[13]), cvt_pk_bf16(f[14], f[15])};
    GA u32x4* dp = (GA u32x4*)(dst + (size_t)(n0 + wn) * DM + k0 + wk * 16);
    dp[0] = w0; dp[1] = w1;
    __syncthreads();
}
__device__ __forceinline__ unsigned cvt4_fp8(float a, float b, float c, float d) {
    unsigned w = 0u; w = __builtin_amdgcn_cvt_pk_fp8_f32(a, b, w, false); w = __builtin_amdgcn_cvt_pk_fp8_f32(c, d, w, true); return w;
}
__device__ __forceinline__ void transpose_tile8(const GA float* src, int ld, int srccol4, const GA float* ksc, GA unsigned char* dst, int k0, int n0, LAS float* tile) {
    const int tid = tid_l(), tk = tid >> 5, tn4 = (tid & 31) * 4;
    f32x4 v[4];
#pragma unroll
    for (int i = 0; i < 4; ++i) { const int kk = tk + 16 * i; v[i] = *(const GA f32x4*)(src + (size_t)(k0 + kk) * ld + srccol4) * (ksc[k0 + kk] * W8SCALE); }
#pragma unroll
    for (int i = 0; i < 4; ++i) { const int kk = tk + 16 * i;
#pragma unroll
        for (int j = 0; j < 4; ++j) tile[kk * 129 + tn4 + j] = v[i][j]; }
    __syncthreads();
    const int wn = tid >> 2, wk = tid & 3;
    float f[16];
#pragma unroll
    for (int j = 0; j < 16; ++j) f[j] = tile[(wk * 16 + j) * 129 + wn];
    u32x4 w = {cvt4_fp8(f[0], f[1], f[2], f[3]), cvt4_fp8(f[4], f[5], f[6], f[7]), cvt4_fp8(f[8], f[9], f[10], f[11]), cvt4_fp8(f[12], f[13], f[14], f[15])};
    *(GA u32x4*)(dst + (size_t)(n0 + wn) * DM + k0 + wk * 16) = w;
    __syncthreads();
}
__device__ __forceinline__ int t5_bucket(int d) {
    if (d < 16) return d;
    const int th[15] = {22, 30, 40, 54, 73, 99, 134, 182, 246, 332, 450, 609, 825, 1117, 1513};
    int b = 16;
#pragma unroll
    for (int i = 0; i < 15; ++i) b += (d >= th[i]) ? 1 : 0;
    return b;
}
constexpr int WT_TW = 32 * 38, WT_TG = 32 * 100, WT_TB = 32 * 16, WT_TL = WT_TW + WT_TG + 2 * WT_TB;
__device__ __forceinline__ void weight_tile(const Frame& F, int l, int r, LAS float* tile) {
    const int tid = tid_l();
    if (r < WT_TW) { const int nt = r % 38, kt = r / 38; const int n = nt * 128 + (tid & 31) * 4;
        transpose_tile(F.w_in + (size_t)l * DM * NIN, NIN, win_src_col(n), F.norm_w + l * DM, F.WinT + (size_t)l * NINP * DM, kt * 64, nt * 128, tile); }
    else if (r < WT_TW + WT_TG) { const int q = r - WT_TW, nt = q % 100, kt = q / 100;
        transpose_tile8(F.w_in + (size_t)l * DM * NIN, NIN, win8_src_col(nt * 128 + (tid & 31) * 4), F.norm_w + l * DM, F.ws + WS_WG8 + (size_t)l * N8 * DM, kt * 64, nt * 128, tile); }
    else if (r < WT_TW + WT_TG + WT_TB) { const int q = r - WT_TW - WT_TG, nt = q % 16, kt = q / 16;
        transpose_tile(F.w_branch + (size_t)l * DM * DM, DM, nt * 128 + (tid & 31) * 4, (const GA float*)nullptr, F.WbrT + (size_t)l * DM * DM, kt * 64, nt * 128, tile); }
    else { const int q = r - WT_TW - WT_TG - WT_TB, nt = q % 16, kt = q / 16;
        transpose_tile(F.w_out + (size_t)l * DM * DM, DM, nt * 128 + (tid & 31) * 4, (const GA float*)nullptr, F.WoutT + (size_t)l * DM * DM, kt * 64, nt * 128, tile); }
}
__device__ __forceinline__ void p0_prologue(const Frame& F) {
    const int tid = tid_l(), lane = tid & 63, wave = tid >> 6, G = gridDim.x, bid = blockIdx.x;
    LAS float* tile = (LAS float*)F.lds;
    for (int j = bid; j < WT_TW + WT_TG; j += G) weight_tile(F, 0, j, tile);
    for (int row = bid * 8 + wave; row < MT; row += G * 8) {
        const GA float* xr = F.x + (size_t)row * DM; float ss = 0.f;
#pragma unroll
        for (int i = 0; i < 8; ++i) { const int c = (i * 64 + lane) * 4; const f32x4 v = *(const GA f32x4*)(xr + c);
            ss += v[0] * v[0] + v[1] * v[1] + v[2] * v[2] + v[3] * v[3];
            u32x2 w = {cvt_pk_bf16(v[0], v[1]), cvt_pk_bf16(v[2], v[3])}; *(GA u32x2*)(F.xb + (size_t)row * DM + c) = w;
            *(GA unsigned*)(F.ws + WS_XQ + (size_t)row * DM + c) = cvt4_fp8(v[0], v[1], v[2], v[3]); }
        ss = wave_sum(ss);
        if (lane < 32) F.ssq[(size_t)row * 32 + lane] = (lane == 0) ? ss : 0.f;
    }
    if (bid == 0 && tid < DEPTH * 128) { const int l = tid >> 7, i = tid & 127;
        const float lam_init = 0.8f - 0.6f * expf(-0.3f * (float)l);
        F.DP[l * 256 + 128 + i] = F.subln[l * 128 + i] * (1.0f - lam_init);
        if (i == 0) { float s1 = 0.f, s2 = 0.f;
            for (int k = 0; k < 64; ++k) { s1 = fmaf(F.lq1[l * 64 + k], F.lk1[l * 64 + k], s1); s2 = fmaf(F.lq2[l * 64 + k], F.lk2[l * 64 + k], s2); }
            F.DP[l * 256] = expf(s1) - expf(s2) + lam_init; F.DP[l * 256 + 1] = 1.0f - lam_init; } }
    for (int i = bid * 512 + tid; i < 12 * SEQ; i += G * 512) { const int hd = i / SEQ, d = i % SEQ; F.tb[i] = F.rel_bias[t5_bucket(d) * 12 + hd] * LOG2E; }
}

struct EpiIn {
    static constexpr bool PERM = true, AFTER_DRAIN = false, MIDK = false, FP8 = false;
    GA unsigned char* ws;
    template <int KIND>
    __device__ __forceinline__ void body(const f32x4 (&acc)[2][2][4][2], int row0_, int cl_, int fq, GA bf16_t* base, int ldc, float qscale, int headbase) const {
        int row0 = row0_, cl = cl_; asm volatile("" : "+v"(row0), "+v"(cl));
        const GA float* ssq = (const GA float*)(ws + WS_SSQ);
        float scv_[2][4];
#pragma unroll
        for (int ai = 0; ai < 2; ++ai) {
            f32x4 sq_[4][2];
#pragma unroll
            for (int m = 0; m < 4; ++m) { const GA float* sp = ssq + (size_t)(row0 + ai * 128 + m * 16) * 32 + fq * 8;
                sq_[m][0] = *(const GA f32x4*)sp; sq_[m][1] = *(const GA f32x4*)(sp + 4); }
#pragma unroll
            for (int m = 0; m < 4; ++m) { const f32x4 s4 = sq_[m][0] + sq_[m][1];
                float ssum = (s4[0] + s4[1]) + (s4[2] + s4[3]);
                ssum += __shfl_xor(ssum, 16); ssum += __shfl_xor(ssum, 32);
                scv_[ai][m] = __builtin_amdgcn_rsqf(ssum * (1.0f / DM) + RMS_EPS) * qscale; }
            asm volatile("" :: "v"(scv_[ai][0]), "v"(scv_[ai][1]), "v"(scv_[ai][2]), "v"(scv_[ai][3]));
        }
#pragma unroll
        for (int ai = 0; ai < 2; ++ai)
#pragma unroll
            for (int m = 0; m < 4; ++m) {
                const int r = row0 + ai * 128 + m * 16;
                const float sc = scv_[ai][m];
#pragma unroll
                for (int bj = 0; bj < 2; ++bj) {
                    f32x4 v0 = acc[ai][bj][m][0] * sc, v1 = acc[ai][bj][m][1] * sc;
                    if (KIND == 0) {
#pragma unroll
                        for (int j = 0; j < 4; ++j) { v0[j] = v0[j] * sigmoidf_(v0[j]); v1[j] = v1[j] * sigmoidf_(v1[j]); }
                    } else if (KIND == 1) {
#pragma unroll
                        for (int j = 0; j < 4; ++j) { v0[j] = sigmoidf_(v0[j]) * 256.0f; v1[j] = sigmoidf_(v1[j]) * 256.0f; }
                    }
                    if (KIND == 4) {
                        if (bj == 0) {
                            if (cl < 64) { u32x4 w = {cvt_pk_bf16(v0[0], v0[1]), cvt_pk_bf16(v0[2], v0[3]), cvt_pk_bf16(v1[0], v1[1]), cvt_pk_bf16(v1[2], v1[3])};
                                *(GA u32x4*)((GA bf16_t*)(ws + WS_IK) + (size_t)(r >> 5) * 2048 + (cl >> 4) * 512 + (((cl >> 3) & 1) * 32 + (r & 31)) * 8) = w; }
                            else if (cl < 80) { GA float* iw = (GA float*)(ws + WS_IW) + (size_t)r * 16 + (cl - 64); *(GA f32x4*)iw = v0; *(GA f32x4*)(iw + 4) = v1; }
                            else if (cl == 80) { *(GA f32x4*)((GA float*)(ws + WS_FF) + (size_t)r * 4) = v0; }
                        }
                    } else {
                        if (KIND == 1) {
                            u32x2 w;
                            { const unsigned a = __builtin_amdgcn_cvt_pk_u8_f32(v0[0], 0, 0u), b = __builtin_amdgcn_cvt_pk_u8_f32(v0[1], 1, a), c = __builtin_amdgcn_cvt_pk_u8_f32(v0[2], 2, b); w[0] = __builtin_amdgcn_cvt_pk_u8_f32(v0[3], 3, c); }
                            { const unsigned a = __builtin_amdgcn_cvt_pk_u8_f32(v1[0], 0, 0u), b = __builtin_amdgcn_cvt_pk_u8_f32(v1[1], 1, a), c = __builtin_amdgcn_cvt_pk_u8_f32(v1[2], 2, b); w[1] = __builtin_amdgcn_cvt_pk_u8_f32(v1[3], 3, c); }
                            *(GA u32x2*)((GA unsigned char*)base + (size_t)r * ldc + bj * 128 + cl) = w;
                            continue;
                        }
                        GA bf16_t* dst;
                        if (KIND == 2) { const int b = r >> 13, s = r & (SEQ - 1); dst = base + ((size_t)(b * 4 + headbase + bj) * SEQ + s) * 128 + cl; }
                        else dst = base + (size_t)r * ldc + bj * 128 + cl;
                        u32x4 w = {cvt_pk_bf16(v0[0], v0[1]), cvt_pk_bf16(v0[2], v0[3]), cvt_pk_bf16(v1[0], v1[1]), cvt_pk_bf16(v1[2], v1[3])};
                        *(GA u32x4*)dst = w;
                    }
                }
            }
    }
    __device__ __forceinline__ void operator()(const f32x4 (&acc)[2][2][4][2], const pg8::Unit& u, int wr, int wc, int fr, int fq) const {
        const int row0 = u.pm * 256 + wr * 64 + fr, pn = u.pn, cl = wc * 32 + 8 * fq;
        if (pn < 8) body<0>(acc, row0, cl, fq, (GA bf16_t*)(ws + WS_ZS) + pn * 256, DM, 1.f, 0);
        else if (pn < 12) body<3>(acc, row0, cl, fq, (GA bf16_t*)(ws + WS_IQ) + (pn - 8) * 256, 1024, 1.f, 0);
        else if (pn < 18) { const int t6 = pn - 12, which = t6 >> 1;
            body<2>(acc, row0, cl, fq, (GA bf16_t*)(ws + WS_QKV) + (size_t)(2 * 3 + which) * QS, 0, (which == 0) ? QSC64 : 1.f, (t6 & 1) * 2); }
        else body<4>(acc, row0, cl, fq, (GA bf16_t*)nullptr, 0, 1.f, 0);
    }
};

struct EpiGate {
    static constexpr bool PERM = true, AFTER_DRAIN = false, MIDK = false, FP8 = true;
    GA unsigned char* ws;
    __device__ __forceinline__ void operator()(const f32x4 (&acc)[2][2][4][2], const pg8::Unit& u, int wr, int wc, int fr, int fq) const {
        const int row0 = u.pm * 256 + wr * 64 + fr, cl = wc * 32 + 8 * fq, pn = u.pn;
        EpiIn e{ws};
        if (pn < 32) e.body<1>(acc, row0, cl, fq, (GA bf16_t*)(ws + WS_G + pn * 256), 8192, 1.0f / W8SCALE, 0);
        else { const int q = pn - 32, mixer = (q < 6) ? 0 : (q < 12 ? 1 : 3), t6 = q % 6, which = t6 >> 1;
            e.body<2>(acc, row0, cl, fq, (GA bf16_t*)(ws + WS_QKV) + (size_t)(mixer * 3 + which) * QS, 0, ((which == 0) ? QSC128 : 1.f) * (1.0f / W8SCALE), (t6 & 1) * 2); }
    }
};

__device__ __forceinline__ void fox_scan(const Frame& F, int layer, int seqid) {
    const int tid = tid_l(), lane = tid & 63, wave = tid >> 6, b = seqid >> 2, h = seqid & 3;
    LAS float* sm = (LAS float*)F.lds;
    const float bias = F.fox_b[layer * 4 + h];
    float v[16]; float run = 0.f;
#pragma unroll
    for (int i = 0; i < 16; ++i) { const int s = tid * 16 + i; const float x = F.FF[(size_t)(b * SEQ + s) * 4 + h] + bias;
        const float ls = fminf(x, 0.f) - log1pf(expf(-fabsf(x))); run += ls; v[i] = run; }
    float incl = run;
#pragma unroll
    for (int o = 1; o < 64; o <<= 1) { const float t = __shfl_up(incl, o); if (lane >= o) incl += t; }
    if (lane == 63) sm[wave] = incl;
    __syncthreads();
    float woff = 0.f;
    for (int w = 0; w < wave; ++w) woff += sm[w];
    const float excl = woff + incl - run;
#pragma unroll
    for (int i = 0; i < 16; ++i) F.cum[(size_t)(b * 4 + h) * SEQ + tid * 16 + i] = (excl + v[i]) * LOG2E;
    __syncthreads();
}
__device__ __forceinline__ void fox_kmax(const Frame& F, int layer) {
    const int tid = tid_l(), lane = tid & 63, wave = tid >> 6, G = gridDim.x, bid = blockIdx.x;
    const GA bf16_t* Kf = F.QKV + (size_t)(1 * 3 + 1) * QS;
    LAS float* sm = (LAS float*)F.lds;
    const int bh = bid & 7, part = bid >> 3, nparts = (G + 7 - bh) / 8;
    float mx = 0.f;
    for (int r4 = part * 8 + wave; r4 < SEQ / 4; r4 += nparts * 8) {
        const u32x4 w = *(const GA u32x4*)(Kf + ((size_t)bh * SEQ + r4 * 4 + (lane >> 4)) * 128 + (lane & 15) * 8); float ss = 0.f;
#pragma unroll
        for (int j = 0; j < 4; ++j) { const float a = bf_lo(w[j]), b = bf_hi(w[j]); ss = fmaf(a, a, ss); ss = fmaf(b, b, ss); }
        ss += __shfl_xor(ss, 1); ss += __shfl_xor(ss, 2); ss += __shfl_xor(ss, 4); ss += __shfl_xor(ss, 8);
        mx = fmaxf(mx, ss); }
#pragma unroll
    for (int o = 32; o > 0; o >>= 1) mx = fmaxf(mx, __shfl_xor(mx, o));
    __syncthreads();
    if (lane == 0) sm[wave] = mx;
    __syncthreads();
    if (tid == 0) { float m8 = sm[0];
#pragma unroll
        for (int w = 1; w < 8; ++w) m8 = fmaxf(m8, sm[w]);
        __hip_atomic_fetch_max(F.ctl + CW_KM + layer * 8 + bh, __float_as_uint(m8), __ATOMIC_RELAXED, __HIP_MEMORY_SCOPE_AGENT); }
    __syncthreads();
}
__device__ __forceinline__ void idx_unit(const Frame& F, int unit) {
    const int b = unit / 576; int id = unit % 576; int g = 0;
    while (8 * (g + 1) * (g + 2) <= id) ++g;
    const int rem = id - 8 * g * (g + 1), qb = 16 * g + rem / (g + 1), kc = rem % (g + 1);
    const int tid = tid_l(), lane = tid & 63, wave = __builtin_amdgcn_readfirstlane(tid >> 6), n32 = lane & 31, hi = lane >> 5;
    const int tq0 = qb * 64 + wave * 8;
    const int qa = (n32 >> 2) & 1, ha = (n32 & 3) + 4 * (n32 >> 3);
    bf16x8 Af[4][4]; float wr_[4][16];
#pragma unroll
    for (int p = 0; p < 4; ++p) {
        const GA bf16_t* qp = F.IQ + (size_t)(b * SEQ + tq0 + 2 * p + qa) * 1024 + ha * 64 + hi * 8;
#pragma unroll
        for (int ks = 0; ks < 4; ++ks) Af[p][ks] = *(const GA bf16x8*)(qp + ks * 16);
        const GA float* wp = F.IW + (size_t)(b * SEQ + tq0 + 2 * p + hi) * 16;
#pragma unroll
        for (int q4 = 0; q4 < 4; ++q4) { const f32x4 w4 = *(const GA f32x4*)(wp + 4 * q4); wr_[p][4 * q4] = w4[0]; wr_[p][4 * q4 + 1] = w4[1]; wr_[p][4 * q4 + 2] = w4[2]; wr_[p][4 * q4 + 3] = w4[3]; }
    }
    const int smax = tq0 + 7;
    int nj = (smax - kc * 1024) / 32 + 1; nj = nj > 32 ? 32 : nj;
    const GA bf16_t* kp0 = F.IK + (size_t)(b * SEQ + kc * 1024 + n32) * 64 + hi * 8;
    GA float* sp0 = F.sc + ((size_t)(b * SEQ + tq0 + hi)) * SEQ + kc * 1024 + n32;
    bf16x8 Bn[4];
#pragma unroll
    for (int ks = 0; ks < 4; ++ks) Bn[ks] = *(const GA bf16x8*)(kp0 + ks * 16);
    for (int j = 0; j < nj; ++j) {
        bf16x8 Bf[4];
#pragma unroll
        for (int ks = 0; ks < 4; ++ks) Bf[ks] = Bn[ks];
        if (j + 1 < nj) {
#pragma unroll
            for (int ks = 0; ks < 4; ++ks) Bn[ks] = *(const GA bf16x8*)(kp0 + (size_t)(j + 1) * 32 * 64 + ks * 16);
        }
#pragma unroll
        for (int p = 0; p < 4; ++p) {
            f32x16 c = {};
#pragma unroll
            for (int ks = 0; ks < 4; ++ks) c = __builtin_amdgcn_mfma_f32_32x32x16_bf16(Af[p][ks], Bf[ks], c, 0, 0, 0);
            float sc = 0.f;
#pragma unroll
            for (int r = 0; r < 16; ++r) sc = fmaf(wr_[p][r], fmaxf(c[r], 0.f), sc);
            sp0[(size_t)(2 * p) * SEQ + j * 32] = sc;
        }
    }
}

__device__ __forceinline__ unsigned sel_key(float f) { const unsigned u = __float_as_uint(f == 0.f ? 0.f : f); return (u >> 31) ? ~u : (u | 0x80000000u); }
__device__ __forceinline__ int wave_sum_i(int v) {
#pragma unroll
    for (int o = 32; o > 0; o >>= 1) v += __shfl_xor(v, o);
    return v;
}
__device__ __forceinline__ void select_row(const Frame& F, int row_) {
    const int row = __builtin_amdgcn_readfirstlane(row_);
    const int lane = tid_l() & 63, t = row & (SEQ - 1);
    GA u64* mrow = F.mask + (size_t)row * 128;
    if (t < 256) {
#pragma unroll
        for (int half = 0; half < 2; ++half) { const int j = half * 64 + lane; const int lo = j * 64; u64 w = 0ull;
            if (t >= lo + 63) w = ~0ull; else if (t >= lo) w = (~0ull) >> (63 - (t - lo));
            mrow[j] = w; }
        return;
    }
    const GA float* srow = F.sc + (size_t)row * SEQ + lane;
    const int nj = (t >> 6) + 1;
    unsigned key[128];
#pragma unroll
    for (int jj = 0; jj < 4; ++jj) {
        if (jj * 32 < nj) {
#pragma unroll
            for (int j = jj * 32; j < jj * 32 + 32; ++j) key[j] = __float_as_uint(srow[j * 64]);
        }
    }
#pragma unroll
    for (int jj = 0; jj < 4; ++jj) {
        if (jj * 32 < nj) {
#pragma unroll
            for (int j = jj * 32; j < jj * 32 + 32; ++j) key[j] = (j * 64 + lane <= t) ? sel_key(__uint_as_float(key[j])) : 0u;
        } else {
#pragma unroll
            for (int j = jj * 32; j < jj * 32 + 32; ++j) key[j] = 0u;
        }
    }
#define CNT8(j0) do { u64 b0 = __ballot(key[(j0)] >= cand), b1 = __ballot(key[(j0) + 1] >= cand), b2 = __ballot(key[(j0) + 2] >= cand), b3 = __ballot(key[(j0) + 3] >= cand), \
        b4 = __ballot(key[(j0) + 4] >= cand), b5 = __ballot(key[(j0) + 5] >= cand), b6 = __ballot(key[(j0) + 6] >= cand), b7 = __ballot(key[(j0) + 7] >= cand); \
        asm volatile("" : "+s"(b0), "+s"(b1), "+s"(b2), "+s"(b3), "+s"(b4), "+s"(b5), "+s"(b6), "+s"(b7)); \
        c += (__popcll(b0) + __popcll(b1)) + (__popcll(b2) + __popcll(b3)) + (__popcll(b4) + __popcll(b5)) + (__popcll(b6) + __popcll(b7)); } while (0)
#define COUNT_GE() do { c = 0; _Pragma("unroll") for (int jj = 0; jj < 4; ++jj) { if (jj * 32 < nj) { CNT8(jj * 32); CNT8(jj * 32 + 8); CNT8(jj * 32 + 16); CNT8(jj * 32 + 24); } } } while (0)
    unsigned mx = 0u;
#pragma unroll
    for (int j = 0; j < 128; ++j) mx = key[j] > mx ? key[j] : mx;
#pragma unroll
    for (int o = 32; o > 0; o >>= 1) { const unsigned t2 = (unsigned)__shfl_xor((int)mx, o); mx = t2 > mx ? t2 : mx; }
    unsigned prefix = 0u; int cge = 1 << 30, c, bit = 31;
    { const unsigned e9 = mx >> 23;
      for (unsigned k = 0; k < 6u && k <= e9; ++k) { const unsigned cand = (e9 - k) << 23; COUNT_GE();
          if (c >= 256) { prefix = cand; cge = c; bit = 22; break; } } }
    if (cge != 256) {
        for (; bit >= 0; --bit) {
            const unsigned cand = prefix | (1u << bit); COUNT_GE();
            if (c >= 256) { prefix = cand; cge = c; if (c == 256) break; }
        }
    }
#undef CNT8
#undef COUNT_GE
    if (cge == 256) {
        unsigned w0l = 0u, w0h = 0u, w1l = 0u, w1h = 0u;
#pragma unroll
        for (int j = 0; j < 64; ++j) { const u64 word = __ballot(key[j] >= prefix);
            asm volatile("s_nop 1\n\tv_writelane_b32 %0, %1, %2" : "+v"(w0l) : "s"((unsigned)word), "n"(j)); asm volatile("v_writelane_b32 %0, %1, %2" : "+v"(w0h) : "s"((unsigned)(word >> 32)), "n"(j)); }
        if (nj > 64) {
#pragma unroll
            for (int j = 64; j < 128; ++j) { const u64 word = __ballot(key[j] >= prefix);
                asm volatile("s_nop 1\n\tv_writelane_b32 %0, %1, %2" : "+v"(w1l) : "s"((unsigned)word), "n"(j - 64)); asm volatile("v_writelane_b32 %0, %1, %2" : "+v"(w1h) : "s"((unsigned)(word >> 32)), "n"(j - 64)); }
        }
        mrow[lane] = ((u64)w0h << 32) | w0l; mrow[64 + lane] = ((u64)w1h << 32) | w1l;
    } else {
        int cgt = 0;
        for (int j = 0; j < nj; ++j) { const int s = j * 64 + lane; const float v_ = srow[j * 64]; const unsigned k = (s <= t) ? sel_key(v_) : 0u; cgt += __popcll(__ballot(k > prefix)); }
        int need = 256 - cgt;
        for (int j = 0; j < nj; ++j) { const int s = j * 64 + lane; const float v_ = srow[j * 64]; const unsigned k = (s <= t) ? sel_key(v_) : 0u;
            u64 word = __ballot(k > prefix); u64 tm = __ballot(k == prefix);
            if (tm != 0ull && need > 0) { const int c = __popcll(tm);
                if (c <= need) { word |= tm; need -= c; }
                else { u64 selb = 0ull; for (int i = 0; i < need; ++i) { const u64 low = tm & (~tm + 1ull); selb |= low; tm ^= low; } word |= selb; need = 0; } }
            if (lane == 0) mrow[j] = word; }
        for (int j = nj + lane; j < 128; j += 64) mrow[j] = 0ull;
    }
}

#if defined(TPROBE)
#define IS_T0(k) do { if ((k) == TPROBE) is_t0 = __builtin_amdgcn_s_memrealtime(); } while (0)
#define IS_T1(k) do { if ((k) == TPROBE) tpacc += __builtin_amdgcn_s_memrealtime() - is_t0; } while (0)
#else
#define IS_T0(k) do { } while (0)
#define IS_T1(k) do { } while (0)
#endif
__device__ __forceinline__ void idxsel_unit(const Frame& F, int unit, unsigned long long& tpacc) {
    unsigned long long is_t0 = 0ull; (void)is_t0;
    const int b = unit & 1, t0 = (SEQ / 8 - 1 - (unit >> 1)) * 8;
    const int tid = tid_l(), lane = tid & 63, wave = __builtin_amdgcn_readfirstlane(tid >> 6), n32 = lane & 31, hi = lane >> 5;
    LAS unsigned short* S = (LAS unsigned short*)F.lds;
    IS_T0(30);
    {
        const int qa = (n32 >> 2) & 1, ha = (n32 & 3) + 4 * (n32 >> 3);
        typedef float f32x2_ __attribute__((ext_vector_type(2)));
        bf16x8 Af[4][4]; f32x2_ wr2[4][8];
#pragma unroll
        for (int p = 0; p < 4; ++p) {
            const GA bf16_t* qp = F.IQ + (size_t)(b * SEQ + t0 + 2 * p + qa) * 1024 + ha * 64 + hi * 8;
#pragma unroll
            for (int ks = 0; ks < 4; ++ks) Af[p][ks] = *(const GA bf16x8*)(qp + ks * 16);
            const GA float* wp = F.IW + (size_t)(b * SEQ + t0 + 2 * p + hi) * 16;
#pragma unroll
            for (int q4 = 0; q4 < 4; ++q4) { const f32x4 w4 = *(const GA f32x4*)(wp + 4 * q4); wr2[p][2 * q4] = (f32x2_){w4[0], w4[1]}; wr2[p][2 * q4 + 1] = (f32x2_){w4[2], w4[3]}; }
        }
        asm volatile("s_waitcnt vmcnt(0)" ::: "memory"); IS_T1(30); IS_T0(31);
        const int ntile = (t0 + 7) / 32 + 1;
        const GA bf16_t* kp0 = F.IK + (size_t)b * SEQ * 64 + lane * 8;
        bf16x8 Bn[4];
        if (wave < ntile) {
#pragma unroll
            for (int ks = 0; ks < 4; ++ks) Bn[ks] = *(const GA bf16x8*)(kp0 + (size_t)wave * 2048 + ks * 512);
        }
        for (int j = wave; j < ntile; j += 8) {
            bf16x8 Bf[4];
#pragma unroll
            for (int ks = 0; ks < 4; ++ks) Bf[ks] = Bn[ks];
            if (j + 8 < ntile) {
#pragma unroll
                for (int ks = 0; ks < 4; ++ks) Bn[ks] = *(const GA bf16x8*)(kp0 + (size_t)(j + 8) * 2048 + ks * 512);
            }
            const int s = j * 32 + n32;
            LAS unsigned short* sp = S + ((s >> 7) * 64 + (s & 63)) * 2 + ((s >> 6) & 1);
#define IDX_MM(C, p) do { C = f32x16{}; _Pragma("unroll") for (int ks = 0; ks < 4; ++ks) C = __builtin_amdgcn_mfma_f32_32x32x16_bf16(Af[p][ks], Bf[ks], C, 0, 0, 0); } while (0)
#define IDX_RED(C, p) do { f32x2_ s2 = {0.f, 0.f}; _Pragma("unroll") for (int r2 = 0; r2 < 8; ++r2) { \
                    const float f0 = C[2 * r2], f1 = C[2 * r2 + 1]; const int i0 = __float_as_int(f0), i1 = __float_as_int(f1); \
                    const f32x2_ x2 = {__int_as_float(i0 > 0 ? i0 : 0), __int_as_float(i1 > 0 ? i1 : 0)}; s2 = __builtin_elementwise_fma(wr2[p][r2], x2, s2); } \
                float sc = s2[0] + s2[1]; sc = fminf(fmaxf(sc, -65504.f), 65504.f);       \
                sp[(2 * (p) + hi) * 8192] = __builtin_bit_cast(unsigned short, (_Float16)sc); } while (0)
            f32x16 c0, c1;
            IDX_MM(c0, 0); IDX_MM(c1, 1); __builtin_amdgcn_sched_barrier(0);
            IDX_RED(c0, 0); __builtin_amdgcn_sched_barrier(0); IDX_MM(c0, 2); __builtin_amdgcn_sched_barrier(0);
            IDX_RED(c1, 1); __builtin_amdgcn_sched_barrier(0); IDX_MM(c1, 3); __builtin_amdgcn_sched_barrier(0);
            IDX_RED(c0, 2); IDX_RED(c1, 3);
#undef IDX_MM
#undef IDX_RED
        }
    }
    IS_T1(31); IS_T0(32);
    __syncthreads();
    IS_T1(32);
    {
        const int t = t0 + wave;
        GA u64* mrow = F.mask + (size_t)(b * SEQ + t) * 128;
        if (t < 256) {
#pragma unroll
            for (int half = 0; half < 2; ++half) { const int jw = half * 64 + lane; const int lo = jw * 64; u64 w = 0ull;
                if (t >= lo + 63) w = ~0ull; else if (t >= lo) w = (~0ull) >> (63 - (t - lo));
                mrow[jw] = w; }
        } else {
            const LAS unsigned* row = (const LAS unsigned*)(S + wave * 8192) + lane;
            const int nj = (t >> 7) + 1;
            unsigned kw[64];
            IS_T0(33);
            { LAS unsigned short* rw = S + wave * 8192; const int sa = 128 * (nj - 1) + lane, sb = sa + 64;
              if (sa > t) rw[((sa >> 7) * 64 + (sa & 63)) * 2] = (unsigned short)0xffffu;
              if (sb > t) rw[((sb >> 7) * 64 + (sb & 63)) * 2 + 1] = (unsigned short)0xffffu;
              asm volatile("" ::: "memory"); }
            const unsigned sh15 = 0x000f000fu;
#pragma unroll
            for (int jj = 0; jj < 4; ++jj) {
                if (jj * 16 < nj) {
#pragma unroll
                    for (int j = jj * 16; j < jj * 16 + 16; ++j) { unsigned w = row[j * 64]; unsigned sg;
                        asm("v_pk_ashrrev_i16 %0, %1, %2" : "=v"(sg) : "v"(sh15), "v"(w));
                        w ^= (sg | 0x80008000u);
                        kw[j] = (j < nj) ? w : 0u; }
                } else {
#pragma unroll
                    for (int j = jj * 16; j < jj * 16 + 16; ++j) kw[j] = 0u;
                }
            }
#define CNT1(j) asm volatile("v_pk_sub_u16 %1, %2, %3 clamp\n\tv_pk_min_u16 %1, %1, %4\n\tv_pk_add_u16 %0, %0, %1" : "+v"(acc2), "=&v"(tmp2) : "v"(kw[(j)]), "v"(cm2), "v"(one2))
#define COUNT_GE16(cand) do { const unsigned cm2 = (((cand) - 1u) & 0xffffu) * 0x00010001u, one2 = 0x00010001u; unsigned acc2 = 0u, tmp2; \
            _Pragma("unroll") for (int jj = 0; jj < 4; ++jj) { if (jj * 16 < nj) { _Pragma("unroll") for (int j = jj * 16; j < jj * 16 + 16; ++j) CNT1(j); } } \
            int v_ = (int)((acc2 & 0xffffu) + (acc2 >> 16));                                                                                            \
            v_ += __builtin_amdgcn_update_dpp(0, v_, 0x111, 0xf, 0xf, true); v_ += __builtin_amdgcn_update_dpp(0, v_, 0x112, 0xf, 0xf, true);            \
            v_ += __builtin_amdgcn_update_dpp(0, v_, 0x114, 0xf, 0xf, true); v_ += __builtin_amdgcn_update_dpp(0, v_, 0x118, 0xf, 0xf, true);            \
            v_ += __builtin_amdgcn_update_dpp(0, v_, 0x142, 0xa, 0xf, true); v_ += __builtin_amdgcn_update_dpp(0, v_, 0x143, 0xc, 0xf, true);            \
            c = __builtin_amdgcn_readlane(v_, 63); } while (0)
            IS_T1(33); IS_T0(34);
            unsigned prefix = 0u; int cge = 1 << 30, c;
            unsigned lo = 0u, hi; int clo = t + 1, chi = 0;
            { unsigned mx = 0u;
#pragma unroll
              for (int j = 0; j < 64; ++j) asm("v_pk_max_u16 %0, %0, %1" : "+v"(mx) : "v"(kw[j]));
              mx = (mx & 0xffffu) > (mx >> 16) ? (mx & 0xffffu) : (mx >> 16);
#pragma unroll
              for (int o = 32; o > 0; o >>= 1) { const unsigned t2 = (unsigned)__shfl_xor((int)mx, o); mx = t2 > mx ? t2 : mx; }
              const unsigned e6 = (unsigned)__builtin_amdgcn_readfirstlane((int)mx) >> 10;
              hi = (e6 + 1u) << 10;
              for (unsigned k = 0; k < 5u && k < e6; ++k) { const unsigned cand = (e6 - k) << 10; COUNT_GE16(cand);
                  if (c >= 256) { lo = cand; clo = c; break; } else { hi = cand; chi = c; } } }
            for (int it = 0; clo != 256 && hi - lo > 1u; ++it) {
                const unsigned span = hi - lo; unsigned cand;
                if (it >= 3 && (it & 1)) cand = lo + (span >> 1);
                else { const float frac = (float)(256 - chi) / (float)(clo - chi); unsigned d = (unsigned)(frac * (float)span + 0.5f); d = d < 1u ? 1u : (d > span - 1u ? span - 1u : d); cand = hi - d; }
                COUNT_GE16(cand);
                if (c >= 256) { lo = cand; clo = c; } else { hi = cand; chi = c; }
            }
            prefix = lo; cge = clo;
#undef CNT1
#undef COUNT_GE16
            IS_T1(34); IS_T0(35);
            unsigned w0l = 0u, w0h = 0u, w1l = 0u, w1h = 0u;
            const unsigned short pl16 = (unsigned short)prefix; const unsigned ph16 = prefix << 16;
            if (cge == 256) {
#pragma unroll
                for (int j = 0; j < 32; ++j) { const u64 wa = __ballot((unsigned short)kw[j] >= pl16), wb = __ballot(kw[j] >= ph16);
                    asm volatile("s_nop 1\n\tv_writelane_b32 %0, %1, %2" : "+v"(w0l) : "s"((unsigned)wa), "n"(2 * j)); asm volatile("v_writelane_b32 %0, %1, %2" : "+v"(w0h) : "s"((unsigned)(wa >> 32)), "n"(2 * j));
                    asm volatile("s_nop 1\n\tv_writelane_b32 %0, %1, %2" : "+v"(w0l) : "s"((unsigned)wb), "n"(2 * j + 1)); asm volatile("v_writelane_b32 %0, %1, %2" : "+v"(w0h) : "s"((unsigned)(wb >> 32)), "n"(2 * j + 1)); }
                if (nj > 32) {
#pragma unroll
                    for (int j = 32; j < 64; ++j) { const u64 wa = __ballot((unsigned short)kw[j] >= pl16), wb = __ballot(kw[j] >= ph16);
                        asm volatile("s_nop 1\n\tv_writelane_b32 %0, %1, %2" : "+v"(w1l) : "s"((unsigned)wa), "n"(2 * j - 64)); asm volatile("v_writelane_b32 %0, %1, %2" : "+v"(w1h) : "s"((unsigned)(wa >> 32)), "n"(2 * j - 64));
                        asm volatile("s_nop 1\n\tv_writelane_b32 %0, %1, %2" : "+v"(w1l) : "s"((unsigned)wb), "n"(2 * j - 63)); asm volatile("v_writelane_b32 %0, %1, %2" : "+v"(w1h) : "s"((unsigned)(wb >> 32)), "n"(2 * j - 63)); }
                }
            } else {
                int need = 256 - chi;
#define TIE_WORD(GT, EQ, SETL, SETH, LN) do { u64 word = (GT); u64 tm = (EQ);                                                          \
                    if (tm != 0ull && need > 0) { const int ce = __popcll(tm);                                                       \
                        if (ce <= need) { word |= tm; need -= ce; }                                                                  \
                        else { u64 selb = 0ull; for (int i = 0; i < need; ++i) { const u64 low = tm & (~tm + 1ull); selb |= low; tm ^= low; } word |= selb; need = 0; } } \
                    asm volatile("s_nop 1\n\tv_writelane_b32 %0, %1, %2" : "+v"(SETL) : "s"((unsigned)word), "n"(LN)); asm volatile("v_writelane_b32 %0, %1, %2" : "+v"(SETH) : "s"((unsigned)(word >> 32)), "n"(LN)); } while (0)
#pragma unroll
                for (int j = 0; j < 32; ++j) {
                    TIE_WORD(__ballot((unsigned short)kw[j] > pl16), __ballot((unsigned short)kw[j] == pl16), w0l, w0h, 2 * j);
                    TIE_WORD(__ballot((kw[j] >> 16) > prefix), __ballot((kw[j] >> 16) == prefix), w0l, w0h, 2 * j + 1); }
#pragma unroll
                for (int j = 32; j < 64; ++j) {
                    TIE_WORD(__ballot((unsigned short)kw[j] > pl16), __ballot((unsigned short)kw[j] == pl16), w1l, w1h, 2 * j - 64);
                    TIE_WORD(__ballot((kw[j] >> 16) > prefix), __ballot((kw[j] >> 16) == prefix), w1l, w1h, 2 * j - 63); }
#undef TIE_WORD
            }
            mrow[lane] = ((u64)w0h << 32) | w0l; mrow[64 + lane] = ((u64)w1h << 32) | w1l;
            IS_T1(35);
        }
    }
}

namespace att {
typedef short s16x4 __attribute__((ext_vector_type(4)));
constexpr int D = 128, NW = 8, QBLK = 32, KVBLK = 64, QB = NW * QBLK;
constexpr int SHM_V = KVBLK * D * 2, SHM_K = KVBLK * D * 2;
constexpr int L_WS = 2 * SHM_V + 2 * SHM_K;
constexpr int L_AUX = L_WS + NW * 64 * 4;
constexpr int TB_PAD = 320, TB_N = TB_PAD + 1984;
constexpr int L_FLG = L_AUX + 8192 * 4;
constexpr int L_END = L_FLG + 64;
constexpr float SKIP_MARGIN = 40.f;
constexpr float THR2 = 11.5f;
constexpr int FAR_DIST = 1513;

#define KSWZ(row, colB) ((row) * 256 + ((colB) ^ (((row) & 7) << 4)))
#define SBAR() __builtin_amdgcn_sched_barrier(0)
__device__ __forceinline__ int v_st(int k, int c) { const int kk = (k & ~0xC) | ((k & 4) << 1) | ((k & 8) >> 1); return ((kk >> 3) * 4 + (c >> 5)) * 512 + ((kk & 7) * 32 + (c & 31)) * 2; }
__device__ __forceinline__ int v_rd_base(int lane) { return ((lane & 3) << 3) | (((lane >> 2) & 3) << 6) | (((lane >> 4) & 1) << 5) | (((lane >> 5) & 1) << 8); }
constexpr int v_rd_off(int d0, int ks, int half) { return d0 * 512 + ks * 4096 + half * 2048; }
__device__ __forceinline__ int crow(int r, int hi) { return (r & 3) + 8 * (r >> 2) + 4 * hi; }
__device__ __forceinline__ bf16x8 load8(const GA bf16_t* p) { return *(const GA bf16x8*)p; }

__device__ __forceinline__ void mask_tile(f32x16& p0, f32x16& p1, int dq, unsigned W) {
    const float NEG = -__builtin_inff();
#pragma unroll
    for (int r = 0; r < 16; ++r) {
        const int c = (r & 3) + 8 * (r >> 2);
        if ((unsigned)(dq - c) >= W) p0[r] = NEG;
        if ((unsigned)(dq - c - 32) >= W) p1[r] = NEG;
    }
}
__device__ __forceinline__ void mask_bits(f32x16& p0, f32x16& p1, u64 w, int hi) {
    const float NEG = -__builtin_inff();
    unsigned w0 = (unsigned)w, w1 = (unsigned)(w >> 32);
    if (hi == 0) { w0 <<= 4; w1 <<= 4; }
#define MB4(W, P, g) do { u64 c0_, c1_, c2_, c3_; asm volatile(                          \
        "v_add_co_u32 %[w], %[c0], %[w], %[w]\n\tv_add_co_u32 %[w], %[c1], %[w], %[w]\n\t"                     \
        "v_add_co_u32 %[w], %[c2], %[w], %[w]\n\tv_add_co_u32 %[w], %[c3], %[w], %[w]\n\t"                     \
        "v_cndmask_b32 %[e3], %[neg], %[e3], %[c0]\n\tv_cndmask_b32 %[e2], %[neg], %[e2], %[c1]\n\t"           \
        "v_cndmask_b32 %[e1], %[neg], %[e1], %[c2]\n\tv_cndmask_b32 %[e0], %[neg], %[e0], %[c3]"               \
        : [w] "+v"(W), [e0] "+v"(P[4 * (g)]), [e1] "+v"(P[4 * (g) + 1]), [e2] "+v"(P[4 * (g) + 2]), [e3] "+v"(P[4 * (g) + 3]),         \
          [c0] "=&s"(c0_), [c1] "=&s"(c1_), [c2] "=&s"(c2_), [c3] "=&s"(c3_) : [neg] "v"(NEG)); } while (0)
    MB4(w0, p0, 3); MB4(w1, p1, 3); w0 <<= 4; w1 <<= 4;
    MB4(w0, p0, 2); MB4(w1, p1, 2); w0 <<= 4; w1 <<= 4;
    MB4(w0, p0, 1); MB4(w1, p1, 1); w0 <<= 4; w1 <<= 4;
    MB4(w0, p0, 0); MB4(w1, p1, 0);
#undef MB4
}
__device__ __forceinline__ void partialSM(f32x16& p0, f32x16& p1, float& m_reg, float& mn, float& alpha, float cb) {
    float pmax = p0[0];
#pragma unroll
    for (int r = 1; r < 16; ++r) pmax = fmaxf(pmax, p0[r]);
#pragma unroll
    for (int r = 0; r < 16; ++r) pmax = fmaxf(pmax, p1[r]);
    { auto rr = __builtin_amdgcn_permlane32_swap(__float_as_uint(pmax), __float_as_uint(pmax), false, false);
      pmax = fmaxf(__uint_as_float(rr[0]), __uint_as_float(rr[1])); }
    pmax += cb;
    if (__builtin_expect(__all((pmax - m_reg) <= THR2), 1)) { mn = m_reg; alpha = 1.f; }
    else { mn = fmaxf(m_reg, pmax); alpha = __builtin_amdgcn_exp2f(m_reg - mn); m_reg = mn; }
    const float sh = mn - cb;
#pragma unroll
    for (int r = 0; r < 16; ++r) p0[r] = p0[r] - sh;
#pragma unroll
    for (int r = 0; r < 16; ++r) p1[r] = p1[r] - sh;
#pragma unroll
    for (int r = 0; r < 16; ++r) p0[r] = __builtin_amdgcn_exp2f(p0[r]);
}
__device__ __forceinline__ void finishSM(f32x16& p0, f32x16& p1, float alpha, float& l_reg, bf16x8& pa0, bf16x8& pa1, bf16x8& pa2, bf16x8& pa3) {
#pragma unroll
    for (int r = 0; r < 16; ++r) p1[r] = __builtin_amdgcn_exp2f(p1[r]);
    float ps = 0;
#pragma unroll
    for (int r = 0; r < 16; ++r) ps += p0[r];
#pragma unroll
    for (int r = 0; r < 16; ++r) ps += p1[r];
    { auto rr = __builtin_amdgcn_permlane32_swap(__float_as_uint(ps), __float_as_uint(ps), false, false);
      ps = __uint_as_float(rr[0]) + __uint_as_float(rr[1]); }
    l_reg = l_reg * alpha + ps;
#define PK4(P, B_, OUT) do { unsigned a0 = cvt_pk_bf16(P[B_+0], P[B_+1]), a1 = cvt_pk_bf16(P[B_+2], P[B_+3]);                          \
        unsigned b0 = cvt_pk_bf16(P[B_+4], P[B_+5]), b1 = cvt_pk_bf16(P[B_+6], P[B_+7]);                                             \
        auto r0 = __builtin_amdgcn_permlane32_swap(a0, b0, false, false); auto r1 = __builtin_amdgcn_permlane32_swap(a1, b1, false, false); \
        u32x4 w = {r0[0], r1[0], r0[1], r1[1]}; OUT = *reinterpret_cast<bf16x8*>(&w); } while (0)
    PK4(p0, 0, pa0); PK4(p0, 8, pa1); PK4(p1, 0, pa2); PK4(p1, 8, pa3);
#undef PK4
}
template <int KB, int NQ>
__device__ __forceinline__ void qkt(f32x16& p0, f32x16& p1, const LAS char* K_lds, int r32, int hi, const bf16x8* qr, int koff) {
    p0 = f32x16{}; p1 = f32x16{};
    const LAS char* kb[4];
#pragma unroll
    for (int dd = 0; dd < 4; ++dd) kb[dd] = K_lds + KB * SHM_K + KSWZ(r32, (dd * 16 + hi * 8) * 2) + koff;
#pragma unroll
    for (int d0 = 0; d0 < NQ; ++d0) { const LAS char* a = kb[d0 & 3] + (d0 >> 2) * 128;
        bf16x8 b0 = *(const LAS bf16x8*)a;
        bf16x8 b1 = *(const LAS bf16x8*)(a + 32 * 256);
        p0 = __builtin_amdgcn_mfma_f32_32x32x16_bf16(b0, qr[d0], p0, 0, 0, 0);
        p1 = __builtin_amdgcn_mfma_f32_32x32x16_bf16(b1, qr[d0], p1, 0, 0, 0); }
}
template <int VB>
__device__ __forceinline__ void pv_tile(f32x16* o, int vb0, bf16x8 pa0, bf16x8 pa1, bf16x8 pa2, bf16x8 pa3) {
#define TRRD(dst, off) asm volatile("ds_read_b64_tr_b16 %0, %1 offset:%2" : "=&v"(dst) : "v"(vb0), "i"(off) : "memory")
#define PV_D0(d0) do { s16x4 l0, l1, l2, l3, h0, h1, h2, h3; constexpr int b_ = VB * SHM_V + v_rd_off(d0, 0, 0); \
        TRRD(l0, b_); TRRD(h0, b_ + 2048); TRRD(l1, b_ + 4096); TRRD(h1, b_ + 6144); TRRD(l2, b_ + 8192); TRRD(h2, b_ + 10240); TRRD(l3, b_ + 12288); TRRD(h3, b_ + 14336); \
        asm volatile("s_waitcnt lgkmcnt(0)" ::: "memory"); SBAR();   \
        o[d0] = __builtin_amdgcn_mfma_f32_32x32x16_bf16(pa0, (bf16x8){l0[0], l0[1], l0[2], l0[3], h0[0], h0[1], h0[2], h0[3]}, o[d0], 0, 0, 0);   \
        o[d0] = __builtin_amdgcn_mfma_f32_32x32x16_bf16(pa1, (bf16x8){l1[0], l1[1], l1[2], l1[3], h1[0], h1[1], h1[2], h1[3]}, o[d0], 0, 0, 0);   \
        o[d0] = __builtin_amdgcn_mfma_f32_32x32x16_bf16(pa2, (bf16x8){l2[0], l2[1], l2[2], l2[3], h2[0], h2[1], h2[2], h2[3]}, o[d0], 0, 0, 0);   \
        o[d0] = __builtin_amdgcn_mfma_f32_32x32x16_bf16(pa3, (bf16x8){l3[0], l3[1], l3[2], l3[3], h3[0], h3[1], h3[2], h3[3]}, o[d0], 0, 0, 0); } while (0)
    PV_D0(0); PV_D0(1); PV_D0(2); PV_D0(3);
#undef PV_D0
#undef TRRD
}
__device__ __forceinline__ void bias_dist(f32x16& p0, f32x16& p1, const LAS char* tbase) {
#pragma unroll
    for (int r = 0; r < 16; ++r) { const int c = (r & 3) + 8 * (r >> 2);
        p0[r] += *(const LAS float*)(tbase + (59 - c) * 4);
        p1[r] += *(const LAS float*)(tbase + (27 - c) * 4); }
}
__device__ __forceinline__ void bias_const(f32x16& p0, f32x16& p1, float c) {
#pragma unroll
    for (int r = 0; r < 16; ++r) { p0[r] += c; p1[r] += c; }
}
__device__ __forceinline__ void bias_key(f32x16& p0, f32x16& p1, const LAS char* kbase) {
#pragma unroll
    for (int g = 0; g < 4; ++g) { const f32x4 a = *(const LAS f32x4*)(kbase + (8 * g) * 4), b = *(const LAS f32x4*)(kbase + (32 + 8 * g) * 4);
#pragma unroll
        for (int q = 0; q < 4; ++q) { p0[4 * g + q] -= a[q]; p1[4 * g + q] -= b[q]; } }
}

struct Blk { const GA bf16_t* Q; const GA bf16_t* K; const GA bf16_t* V; int P0; int rs; };
struct Aux { const GA float* tb; int dscale; const GA float* cum; const GA u64* mrow0; float kmax; };

__device__ __forceinline__ int swa_jlo(int P0, int W) { const int lowk = P0 - W + 1; return lowk > 0 ? lowk / KVBLK : 0; }

template <int MODE, int NQ>
__device__ __forceinline__ void attn_block(const Blk& cur, int skv, int W, int koff, const Aux& ax, LAS char* lds, f32x16 (&o)[4], float& m_out, float& l_out) {
    const int tid = tid_l(), wid = __builtin_amdgcn_readfirstlane(tid >> 6), lane = tid & 63, r32 = lane & 31, hi = lane >> 5;
    const int rs = cur.rs;
    const int j_lo = swa_jlo(cur.P0, W);
    int j_hi = (cur.P0 + QB - 1) / KVBLK + 1; if (j_hi > skv / KVBLK) j_hi = skv / KVBLK;
    int NT = j_hi - j_lo;
    const int qlo = cur.P0 + wid * QBLK, qm = qlo + r32 - 4 * hi;
    LAS char* V_lds = lds; LAS char* K_lds = lds + 2 * SHM_V;
    LAS float* ws = (LAS float*)(lds + L_WS) + wid * 64; LAS float* li_l = ws; LAS float* al_l = ws + 32;
    LAS float* auxl = (LAS float*)(lds + L_AUX);
    float m_reg = -1e30f, l_reg = 0;
#pragma unroll
    for (int d_ = 0; d_ < 4; ++d_) o[d_] = f32x16{};
    const int sr = tid >> 4, sc = (tid & 15) * 8, vst0 = v_st(sr, sc), vst1 = v_st(32 + sr, sc), kws = KSWZ(sr, sc * 2);
    const int vb0 = (int)(unsigned)(uintptr_t)V_lds + v_rd_base(lane);
    const GA bf16_t* Kh = cur.K; const GA bf16_t* Vh = cur.V;
    bf16x8 qr[NQ]; bf16x8 st_v0, st_v1, st_k0, st_k1;
#define ROW(p, k0, rr) ((p) + (size_t)((k0) + (rr)) * rs + sc)
#define VMW() asm volatile("s_waitcnt vmcnt(0)" ::: "memory")
#define SLOAD_H(Kp, Vp, k0) do { st_v0 = load8(ROW(Vp, k0, sr)); st_v1 = load8(ROW(Vp, k0, 32 + sr));              \
                                 st_k0 = load8(ROW(Kp, k0, sr)); st_k1 = load8(ROW(Kp, k0, 32 + sr)); } while (0)
#define SWRITE_HK(bf) do { *(LAS bf16x8*)(K_lds + (bf) * SHM_K + kws) = st_k0; *(LAS bf16x8*)(K_lds + (bf) * SHM_K + kws + 32 * 256) = st_k1; } while (0)
#define SWRITE_HV(bf) do { *(LAS bf16x8*)(V_lds + (bf) * SHM_V + vst0) = st_v0; *(LAS bf16x8*)(V_lds + (bf) * SHM_V + vst1) = st_v1; } while (0)
#define SWRITE_H(bf) do { SWRITE_HV(bf); SWRITE_HK(bf); } while (0)
#define RESC(a) do { if (__any((a) < 1.f)) { if (hi == 0) al_l[r32] = (a); asm volatile("s_waitcnt lgkmcnt(0)" ::: "memory");              \
                     for (int d_ = 0; d_ < 4; ++d_) for (int r = 0; r < 16; ++r) o[d_][r] *= al_l[crow(r, hi)]; } } while (0)
#define KBASE(t) ((MODE == 1 ? (j_hi - 1 - (t)) : (j_lo + (t))) * KVBLK)
    LAS unsigned* flg = (LAS unsigned*)(lds + L_FLG);
    {
        const int kb0 = KBASE(0);
        if (MODE == 1 && tid < 8) flg[tid] = 0u;
#pragma unroll
        for (int d0 = 0; d0 < NQ; ++d0) qr[d0] = load8(cur.Q + (size_t)(wid * QBLK + r32) * rs + d0 * 16 + hi * 8);
        SLOAD_H(Kh, Vh, kb0);
        if (MODE == 1) { for (int i = tid; i < cur.P0 + QB; i += 512) auxl[i] = ax.cum[i]; }
        else { for (int i = tid; i < TB_N; i += 512) { int d = i - TB_PAD; d = d < 0 ? 0 : d; auxl[i] = ax.tb[d * ax.dscale]; } }
        VMW(); SWRITE_HK(0); SWRITE_HV(0);
        __syncthreads();
    }
    const float cfar = (MODE == 0 || MODE == 2) ? ax.tb[FAR_DIST] : 0.f;
    float qbound = 0.f;
    if (MODE == 1) { float ss = 0.f;
#pragma unroll
        for (int d0 = 0; d0 < NQ; ++d0) { const u32x4 w = *reinterpret_cast<const u32x4*>(&qr[d0]);
#pragma unroll
            for (int j = 0; j < 4; ++j) { const float a = bf_lo(w[j]), b = bf_hi(w[j]); ss = fmaf(a, a, ss); ss = fmaf(b, b, ss); } }
        { auto rr = __builtin_amdgcn_permlane32_swap(__float_as_uint(ss), __float_as_uint(ss), false, false); ss = __uint_as_float(rr[0]) + __uint_as_float(rr[1]); }
        qbound = sqrtf(ss) * ax.kmax * 1.001f + 1e-3f; }
    float cbv = 0.f;
#define BIASMASK(P0_, P1_, t) do { const int kb_ = KBASE(t); cbv = 0.f;                                                                \
        if (MODE == 1) { bias_key(P0_, P1_, (const LAS char*)(auxl + kb_ + 4 * hi)); }                                                       \
        else if (MODE == 3) { bias_dist(P0_, P1_, (const LAS char*)(auxl + (qm - kb_ - 59 + TB_PAD))); }                                     \
        else { if (cur.P0 - kb_ - 63 >= FAR_DIST) cbv = cfar; else bias_dist(P0_, P1_, (const LAS char*)(auxl + (qm - kb_ - 59 + TB_PAD))); } \
        if (MODE == 0) { mask_bits(P0_, P1_, mw, hi); }                                                                                  \
        else if (kb_ + KVBLK - 1 > qlo || kb_ <= qlo + QBLK - 1 - W) mask_tile(P0_, P1_, qm - kb_, (unsigned)W); } while (0)
#define MLOAD(t) do { if (MODE == 0) mw = ax.mrow0[(size_t)(wid * QBLK + r32) * 128 + (KBASE(t) >> 6)]; } while (0)
    f32x16 pA0, pA1, pB0, pB1; float mnA, mnB, alA, alB; bf16x8 pa0, pa1, pa2, pa3; u64 mw = 0ull;
    if (NT > 1) SLOAD_H(Kh, Vh, KBASE(1));
    MLOAD(0);
    SBAR(); qkt<0, NQ>(pA0, pA1, K_lds, r32, hi, qr, koff);
    BIASMASK(pA0, pA1, 0); partialSM(pA0, pA1, m_reg, mnA, alA, cbv);
    if (NT > 1) { VMW(); SWRITE_H(1); }
    __syncthreads();
#define HALF_STEP(PX0, PX1, mnX, alX, PY0, PY1, alY, t, KB, VB, SB) do {                                                      \
        MLOAD(t);                                                                                                             \
        if ((t) + 1 < NT) { SLOAD_H(Kh, Vh, KBASE((t) + 1)); }        \
        SBAR(); qkt<KB, NQ>(PX0, PX1, K_lds, r32, hi, qr, koff);                                                              \
        finishSM(PY0, PY1, alY, l_reg, pa0, pa1, pa2, pa3); SBAR();                                                           \
        pv_tile<VB>(o, vb0, pa0, pa1, pa2, pa3); BIASMASK(PX0, PX1, (t)); partialSM(PX0, PX1, m_reg, mnX, alX, cbv);          \
        __syncthreads();                                                                                                      \
        if ((t) + 1 < NT) { VMW(); SWRITE_H(SB); }                                                                            \
        RESC(alX); __syncthreads(); } while (0)
    for (int t = 1; t + 1 < NT; t += 2) {
        if (MODE == 1) {
            const u32x4 f0 = *(const LAS u32x4*)flg, f1 = *(const LAS u32x4*)(flg + 4);
            if ((f0[0] & f0[1] & f0[2] & f0[3] & f1[0] & f1[1] & f1[2] & f1[3]) != 0u) { NT = t + 1; break; }
        }
        HALF_STEP(pB0, pB1, mnB, alB, pA0, pA1, alA, t, 1, 0, 0);
        if (MODE == 1) {
            unsigned ok = 0u;
            if (t + 3 < NT) { const float ub = qbound - auxl[KBASE(t + 3) + KVBLK - 1]; ok = __all(ub < m_reg - SKIP_MARGIN) ? 1u : 0u; }
            if (lane == 0) flg[wid] = ok;
        }
        HALF_STEP(pA0, pA1, mnA, alA, pB0, pB1, alB, t + 1, 0, 1, 1);
    }
    const bool even = (NT & 1) == 0;
    if (even) { MLOAD(NT - 1); SBAR(); qkt<1, NQ>(pB0, pB1, K_lds, r32, hi, qr, koff); SBAR(); }
    finishSM(pA0, pA1, alA, l_reg, pa0, pa1, pa2, pa3); SBAR();
    pv_tile<0>(o, vb0, pa0, pa1, pa2, pa3);
    if (even) { BIASMASK(pB0, pB1, NT - 1); partialSM(pB0, pB1, m_reg, mnB, alB, cbv); __syncthreads(); RESC(alB);
        finishSM(pB0, pB1, alB, l_reg, pa0, pa1, pa2, pa3); SBAR(); pv_tile<1>(o, vb0, pa0, pa1, pa2, pa3); }
    if (hi == 0) li_l[r32] = l_reg; asm volatile("s_waitcnt lgkmcnt(0)" ::: "memory");
#pragma unroll
    for (int r = 0; r < 16; ++r) { const float rl = __builtin_amdgcn_rcpf(li_l[crow(r, hi)]);
#pragma unroll
        for (int d0 = 0; d0 < 4; ++d0) o[d0][r] *= rl; }
    m_out = m_reg; l_out = l_reg;
    __syncthreads();
#undef ROW
#undef VMW
#undef SLOAD_H
#undef SWRITE_HK
#undef SWRITE_HV
#undef SWRITE_H
#undef RESC
#undef KBASE
#undef BIASMASK
#undef MLOAD
#undef HALF_STEP
}
#undef KSWZ
}

__device__ __forceinline__ void store_y(const GA bf16_t* Zs, GA bf16_t* Y, const f32x16 (&o)[4], int row0w, int colbase, int r32, int hi) {
    bf16_t zv[16][4];
#pragma unroll
    for (int r = 0; r < 16; ++r) { const size_t off = (size_t)(row0w + att::crow(r, hi)) * DM + colbase + r32;
#pragma unroll
        for (int d0 = 0; d0 < 4; ++d0) zv[r][d0] = Zs[off + d0 * 32]; }
#pragma unroll
    for (int r = 0; r < 16; ++r) { const size_t off = (size_t)(row0w + att::crow(r, hi)) * DM + colbase + r32;
#pragma unroll
        for (int d0 = 0; d0 < 4; ++d0) { const float v = o[d0][r] * bf2f(zv[r][d0]); const float vn = __shfl_xor(v, 1);
            if ((r32 & 1) == 0) *(GA unsigned*)(Y + off + d0 * 32) = cvt_pk_bf16(v, vn); } }
}
template <int MODE>
__device__ __forceinline__ void attn_fast_unit(const Frame& F, int layer, int b, int h, int qb) {
    const int mixer = MODE;
    const size_t hb = ((size_t)(b * 4 + h) * SEQ) * 128;
    att::Blk cur{F.QKV + (size_t)(mixer * 3 + 0) * QS + hb + (size_t)qb * 256 * 128, F.QKV + (size_t)(mixer * 3 + 1) * QS + hb, F.QKV + (size_t)(mixer * 3 + 2) * QS + hb, qb * 256, 128};
    att::Aux ax{F.tb + (size_t)h * SEQ, 1, F.cum + (size_t)(b * 4 + h) * SEQ, F.mask + (size_t)(b * SEQ + qb * 256) * 128, 0.f};
    if (MODE == 1) ax.kmax = sqrtf(__uint_as_float(F.ctl[CW_KM + layer * 8 + b * 4 + h]));
    f32x16 o[4]; float m_, l_;
    att::attn_block<MODE, 8>(cur, SEQ, SEQ, 0, ax, (LAS char*)F.lds, o, m_, l_);
    const int tid = tid_l(), wid = tid >> 6, lane = tid & 63;
    GA unsigned char* w2 = launder(F.ws);
    store_y((const GA bf16_t*)(w2 + WS_ZS), (GA bf16_t*)(w2 + WS_Y), o, b * SEQ + qb * 256 + wid * 32, mixer * 512 + h * 128, lane & 31, lane >> 5);
}

__device__ __forceinline__ void attn_diffmap_unit(const Frame& F, int layer, int b, int h, int qb, int c) {
    const size_t hb = ((size_t)(b * 4 + h) * SEQ) * 128;
    const GA bf16_t* Qc = F.QKV + (size_t)(2 * 3 + 0) * QS + hb + (size_t)qb * 256 * 128; const GA bf16_t* Kc = F.QKV + (size_t)(2 * 3 + 1) * QS + hb; const GA bf16_t* Vc = F.QKV + (size_t)(2 * 3 + 2) * QS + hb;
    att::Aux ax{F.tb + (size_t)(4 + h) * SEQ, 1, (const GA float*)nullptr, (const GA u64*)nullptr, 0.f};
    f32x16 o[4]; float m_, l_;
    { att::Blk cur{Qc + c * 64, Kc, Vc, qb * 256, 128};
      att::attn_block<2, 4>(cur, SEQ, SEQ, c * 128, ax, (LAS char*)F.lds, o, m_, l_); }
    const int tid = tid_l(), wid = tid >> 6, lane = tid & 63, r32 = lane & 31, hi = lane >> 5;
    const int pair = (b * 4 + h) * 32 + qb;
    GA unsigned char* w2 = launder(F.ws);
    { GA f32x4* mine = (GA f32x4*)(w2 + WS_O1) + ((size_t)(c * 256 + pair) * 16) * 512 + tid;
#pragma unroll
      for (int d0 = 0; d0 < 4; ++d0)
#pragma unroll
          for (int g = 0; g < 4; ++g) { const f32x4 v = {o[d0][4 * g], o[d0][4 * g + 1], o[d0][4 * g + 2], o[d0][4 * g + 3]};
              asm volatile("global_store_dwordx4 %0, %1, off sc1" :: "v"(mine + (d0 * 4 + g) * 512), "v"(v) : "memory"); } }
    asm volatile("s_waitcnt vmcnt(0)" ::: "memory");
    __syncthreads();
    volatile LAS unsigned* lw = F.misc + 5;
    if (tid == 0) *lw = __hip_atomic_fetch_add((GA unsigned*)(w2 + WS_CTL) + CW_DC + layer * 256 + pair, 1u, __ATOMIC_RELAXED, __HIP_MEMORY_SCOPE_AGENT);
    __syncthreads();
    if (*lw == 0u) return;
    __builtin_amdgcn_fence(__ATOMIC_ACQUIRE, "agent");
    asm volatile("s_waitcnt vmcnt(0)" ::: "memory");
    const GA f32x4* other = (const GA f32x4*)(w2 + WS_O1) + ((size_t)((1 - c) * 256 + pair) * 16) * 512 + tid;
    const GA float* dp = (const GA float*)(w2 + WS_DP) + layer * 256;
    const float lam = dp[0];
#pragma unroll
    for (int g = 0; g < 4; ++g) {
        f32x4 ot[4];
#pragma unroll
        for (int d0 = 0; d0 < 4; ++d0) ot[d0] = other[(d0 * 4 + g) * 512];
#pragma unroll
        for (int q = 0; q < 4; ++q) { const int r = 4 * g + q;
            float ss = 0.f;
#pragma unroll
            for (int d0 = 0; d0 < 4; ++d0) { const float mo = o[d0][r], oth = ot[d0][q];
                const float a0 = (c == 0) ? mo : oth, a1 = (c == 0) ? oth : mo; const float v = fmaf(-lam, a1, a0); o[d0][r] = v; ss = fmaf(v, v, ss); }
            ss += __shfl_xor(ss, 1); ss += __shfl_xor(ss, 2); ss += __shfl_xor(ss, 4); ss += __shfl_xor(ss, 8); ss += __shfl_xor(ss, 16);
            const float rn = rsqrtf(ss * (1.0f / 128.0f) + RMS_EPS);
#pragma unroll
            for (int d0 = 0; d0 < 4; ++d0) o[d0][r] = o[d0][r] * rn;
        }
        asm volatile("" ::: "memory");
    }
#pragma unroll
    for (int d0 = 0; d0 < 4; ++d0) { const float sw = dp[128 + d0 * 32 + r32];
#pragma unroll
        for (int r = 0; r < 16; ++r) o[d0][r] *= sw; }
    store_y((const GA bf16_t*)(w2 + WS_ZS), (GA bf16_t*)(w2 + WS_Y), o, b * SEQ + qb * 256 + wid * 32, 2 * 512 + h * 128, r32, hi);
}
__device__ __forceinline__ void attn_dil_unit(const Frame& F, int u) {
    const int cfg = u >> 8, v = u & 255, b = v & 1, h = (v >> 1) & 3, x = v >> 3;
    const int dl = (cfg == 0) ? 1 : (cfg == 1 ? 4 : 16);
    const int rho = (cfg == 0) ? 0 : (cfg == 1 ? (x & 3) : (x & 15)), qb = (cfg == 0) ? x : (cfg == 1 ? (x >> 2) : (x >> 4));
    const size_t hb = ((size_t)(b * 4 + h) * SEQ) * 128;
    const GA bf16_t* Qd = F.QKV + (size_t)(3 * 3 + 0) * QS + hb; const GA bf16_t* Kd = F.QKV + (size_t)(3 * 3 + 1) * QS + hb; const GA bf16_t* Vd = F.QKV + (size_t)(3 * 3 + 2) * QS + hb;
    att::Blk cur{Qd + (size_t)(rho + dl * qb * 256) * 128, Kd + (size_t)rho * 128, Vd + (size_t)rho * 128, qb * 256, 128 * dl};
    att::Aux ax{F.tb + (size_t)(8 + h) * SEQ, dl, (const GA float*)nullptr, (const GA u64*)nullptr, 0.f};
    f32x16 o[4]; float m_, l_;
    att::attn_block<3, 8>(cur, SEQ / dl, 129, 0, ax, (LAS char*)F.lds, o, m_, l_);
    const int tid = tid_l(), wid = tid >> 6, lane = tid & 63, r32 = lane & 31, hi = lane >> 5;
    GA unsigned char* w2 = launder(F.ws);
    GA bf16_t* od = (GA bf16_t*)(w2 + WS_OD) + (size_t)cfg * MT * 512;
#pragma unroll
    for (int r = 0; r < 16; ++r) { const size_t row = (size_t)b * SEQ + rho + (size_t)dl * (qb * 256 + wid * 32 + att::crow(r, hi));
#pragma unroll
        for (int d0 = 0; d0 < 4; ++d0) od[row * 512 + h * 128 + d0 * 32 + r32] = (bf16_t)(cvt_pk_bf16(o[d0][r], 0.f) & 0xffffu); }
    if (hi == 0) { const size_t row = (size_t)b * SEQ + rho + (size_t)dl * (qb * 256 + wid * 32 + r32);
        ((GA float*)(w2 + WS_LSE))[((size_t)cfg * MT + row) * 4 + h] = m_ + __builtin_amdgcn_logf(l_); }
}
__device__ __forceinline__ void dil_merge_unit(const Frame& F, int u) {
    const int tid = tid_l(), row = u * 32 + (tid >> 4), cg = tid & 15, h = cg >> 2, col = cg * 32;
    const float l0 = F.LSE[((size_t)0 * MT + row) * 4 + h], l1 = F.LSE[((size_t)1 * MT + row) * 4 + h], l2 = F.LSE[((size_t)2 * MT + row) * 4 + h];
    const float mx = fmaxf(l0, fmaxf(l1, l2)); float w0 = ex2(l0 - mx), w1 = ex2(l1 - mx), w2 = ex2(l2 - mx); const float inv = 1.0f / (w0 + w1 + w2); w0 *= inv; w1 *= inv; w2 *= inv;
    const GA bf16_t* odb = (const GA bf16_t*)F.OD;
    const GA bf16_t* p0 = odb + ((size_t)0 * MT + row) * 512 + col; const GA bf16_t* p1 = odb + ((size_t)1 * MT + row) * 512 + col; const GA bf16_t* p2 = odb + ((size_t)2 * MT + row) * 512 + col;
    const size_t yo = (size_t)row * DM + 3 * 512 + col;
#pragma unroll
    for (int i = 0; i < 4; ++i) {
        const u32x4 A_ = *(const GA u32x4*)(p0 + 8 * i), B_ = *(const GA u32x4*)(p1 + 8 * i), C_ = *(const GA u32x4*)(p2 + 8 * i);
        const f32x4 a0 = {bf_lo(A_[0]), bf_hi(A_[0]), bf_lo(A_[1]), bf_hi(A_[1])}, a1 = {bf_lo(A_[2]), bf_hi(A_[2]), bf_lo(A_[3]), bf_hi(A_[3])}, b0 = {bf_lo(B_[0]), bf_hi(B_[0]), bf_lo(B_[1]), bf_hi(B_[1])}, b1 = {bf_lo(B_[2]), bf_hi(B_[2]), bf_lo(B_[3]), bf_hi(B_[3])},
                    c0 = {bf_lo(C_[0]), bf_hi(C_[0]), bf_lo(C_[1]), bf_hi(C_[1])}, c1 = {bf_lo(C_[2]), bf_hi(C_[2]), bf_lo(C_[3]), bf_hi(C_[3])};
        const u32x4 zw = *(const GA u32x4*)(F.Zs + yo + 8 * i);
        const f32x4 v0 = a0 * w0 + b0 * w1 + c0 * w2, v1 = a1 * w0 + b1 * w1 + c1 * w2;
        u32x4 w = {cvt_pk_bf16(v0[0] * bf_lo(zw[0]), v0[1] * bf_hi(zw[0])), cvt_pk_bf16(v0[2] * bf_lo(zw[1]), v0[3] * bf_hi(zw[1])),
                   cvt_pk_bf16(v1[0] * bf_lo(zw[2]), v1[1] * bf_hi(zw[2])), cvt_pk_bf16(v1[2] * bf_lo(zw[3]), v1[3] * bf_hi(zw[3]))};
        *(GA u32x4*)(F.Y + yo + 8 * i) = w; }
}

struct EpiMerged {
    static constexpr bool PERM = true, AFTER_DRAIN = false, MIDK = true, FP8 = false;
    const GA unsigned char* G; GA bf16_t* MG;
    static __device__ __forceinline__ float gq(unsigned w, int i) { return (float)((w >> (8 * i)) & 0xffu) + 0.5f; }
    __device__ __forceinline__ void mid(f32x4 (&acc)[2][2][4][2], const pg8::Unit& u, int bnext, int wr, int wc, int fr, int fq) const {
        const int row0 = u.pm * 256 + wr * 64 + fr, c0 = u.pn * 256 + wc * 32 + 8 * fq;
#pragma unroll
        for (int ai = 0; ai < 2; ++ai) {
            u32x2 num[4][2], den[4][2];
#pragma unroll
            for (int m = 0; m < 4; ++m) { const GA unsigned char* gp = G + (size_t)(row0 + ai * 128 + m * 16) * 8192 + c0;
#pragma unroll
                for (int bj = 0; bj < 2; ++bj) { num[m][bj] = *(const GA u32x2*)(gp + (bnext - 1) * DM + bj * 128); den[m][bj] = *(const GA u32x2*)(gp + bnext * DM + bj * 128); } }
#pragma unroll
            for (int m = 0; m < 4; ++m)
#pragma unroll
                for (int bj = 0; bj < 2; ++bj)
#pragma unroll
                    for (int j = 0; j < 4; ++j) {
                        acc[ai][bj][m][0][j] *= gq(num[m][bj][0], j) * __builtin_amdgcn_rcpf(gq(den[m][bj][0], j));
                        acc[ai][bj][m][1][j] *= gq(num[m][bj][1], j) * __builtin_amdgcn_rcpf(gq(den[m][bj][1], j)); }
            asm volatile("" ::: "memory");
        }
    }
    __device__ __forceinline__ void operator()(const f32x4 (&acc)[2][2][4][2], const pg8::Unit& u, int wr, int wc, int fr, int fq) const {
        const int row0 = u.pm * 256 + wr * 64 + fr, c0 = u.pn * 256 + wc * 32 + 8 * fq;
        u32x2 g3v[2][4][2];
#pragma unroll
        for (int ai = 0; ai < 2; ++ai)
#pragma unroll
            for (int m = 0; m < 4; ++m)
#pragma unroll
                for (int bj = 0; bj < 2; ++bj) g3v[ai][m][bj] = *(const GA u32x2*)(G + (size_t)(row0 + ai * 128 + m * 16) * 8192 + 3 * DM + c0 + bj * 128);
#pragma unroll
        for (int ai = 0; ai < 2; ++ai)
#pragma unroll
            for (int m = 0; m < 4; ++m) { const int r = row0 + ai * 128 + m * 16;
#pragma unroll
                for (int bj = 0; bj < 2; ++bj) { const u32x2 g3 = g3v[ai][m][bj];
                    const f32x4 v0 = acc[ai][bj][m][0] * (1.0f / 256.0f), v1 = acc[ai][bj][m][1] * (1.0f / 256.0f);
                    u32x4 w = {cvt_pk_bf16(v0[0] * gq(g3[0], 0), v0[1] * gq(g3[0], 1)), cvt_pk_bf16(v0[2] * gq(g3[0], 2), v0[3] * gq(g3[0], 3)),
                               cvt_pk_bf16(v1[0] * gq(g3[1], 0), v1[1] * gq(g3[1], 1)), cvt_pk_bf16(v1[2] * gq(g3[1], 2), v1[3] * gq(g3[1], 3))};
                    *(GA u32x4*)(MG + (size_t)r * DM + c0 + bj * 128) = w; } }
    }
};

struct EpiOut {
    static constexpr bool PERM = false, AFTER_DRAIN = false, MIDK = false, FP8 = false;
    GA float* xres; GA bf16_t* xb; GA float* ssq; GA unsigned char* xq; const GA float* xsrc; bool feed_next;
    __device__ __forceinline__ void operator()(const f32x4 (&acc)[2][2][4][2], const pg8::Unit& u, int wr, int wc, int fr, int fq) const {
        const int row0 = u.pm * 256 + wr * 64 + fr, col0 = u.pn * 256 + wc * 32 + 4 * fq;
#pragma unroll
        for (int h = 0; h < 4; ++h) {
            const int ai = h >> 1, mb = (h & 1) * 2;
            f32x4 xv[2][2][2];
#pragma unroll
            for (int m = 0; m < 2; ++m)
#pragma unroll
                for (int bj = 0; bj < 2; ++bj)
#pragma unroll
                    for (int n = 0; n < 2; ++n) { const size_t off_ = (size_t)(row0 + ai * 128 + (mb + m) * 16) * DM + col0 + bj * 128 + n * 16;
                        if (xsrc != nullptr) xv[m][bj][n] = *(const GA f32x4*)(xsrc + off_);
                        else { const u32x2 t_ = *(const GA u32x2*)(xb + off_); xv[m][bj][n] = (f32x4){bf_lo(t_[0]), bf_hi(t_[0]), bf_lo(t_[1]), bf_hi(t_[1])}; } }
#pragma unroll
            for (int m = 0; m < 2; ++m) { const int r = row0 + ai * 128 + (mb + m) * 16; float ss = 0.f;
#pragma unroll
                for (int bj = 0; bj < 2; ++bj)
#pragma unroll
                    for (int n = 0; n < 2; ++n) { const size_t off = (size_t)r * DM + col0 + bj * 128 + n * 16;
                        const f32x4 v = xv[m][bj][n] + acc[ai][bj][mb + m][n];
                        ss += v[0] * v[0] + v[1] * v[1] + v[2] * v[2] + v[3] * v[3];
                        { u32x2 w = {cvt_pk_bf16(v[0], v[1]), cvt_pk_bf16(v[2], v[3])}; *(GA u32x2*)(xb + off) = w; }
                        if (feed_next) *(GA unsigned*)(xq + off) = cvt4_fp8(v[0], v[1], v[2], v[3]); }
                ss += __shfl_xor(ss, 16); ss += __shfl_xor(ss, 32);
                if (fq == 0) ssq[(size_t)r * 32 + u.pn * 4 + wc] = ss; }
        }
    }
};

__device__ __forceinline__ void final_norm(const Frame& F) {
    const int tid = tid_l(), lane = tid & 63, wave = tid >> 6, G = gridDim.x, bid = blockIdx.x;
    for (int row = bid * 8 + wave; row < MT; row += G * 8) {
        float ss = (lane < 32) ? F.ssq[(size_t)row * 32 + lane] : 0.f; ss = wave_sum(ss);
        const float rs = rsqrtf(ss * (1.0f / DM) + RMS_EPS);
#pragma unroll
        for (int i = 0; i < 8; ++i) { const int c = (i * 64 + lane) * 4; const u32x2 t = *(const GA u32x2*)(F.xb + (size_t)row * DM + c); const f32x4 v = {bf_lo(t[0]), bf_hi(t[0]), bf_lo(t[1]), bf_hi(t[1])}, w = *(const GA f32x4*)(F.final_w + c);
            *(GA f32x4*)(F.out + (size_t)row * DM + c) = v * rs * w; }
    }
}

__device__ __forceinline__ Frame mkframe(const Args& args, GA unsigned char* ws, LAS unsigned char* lds) {
    Frame F;
    F.x = (const GA float*)args.in[0]; F.norm_w = (const GA float*)args.in[1]; F.w_in = (const GA float*)args.in[2]; F.fox_b = (const GA float*)args.in[3];
    F.lq1 = (const GA float*)args.in[4]; F.lk1 = (const GA float*)args.in[5]; F.lq2 = (const GA float*)args.in[6]; F.lk2 = (const GA float*)args.in[7];
    F.subln = (const GA float*)args.in[8]; F.w_branch = (const GA float*)args.in[9]; F.w_out = (const GA float*)args.in[10]; F.rel_bias = (const GA float*)args.in[11];
    F.final_w = (const GA float*)args.in[12]; F.out = (GA float*)args.out;
    F.ctl = (GA unsigned*)(ws + WS_CTL); F.WinT = (GA bf16_t*)(ws + WS_WIN); F.WbrT = (GA bf16_t*)(ws + WS_WBR); F.WoutT = (GA bf16_t*)(ws + WS_WOUT);
    F.xres = (GA float*)(ws + WS_XRES); F.xb = (GA bf16_t*)(ws + WS_XB); F.ssq = (GA float*)(ws + WS_SSQ); F.Zs = (GA bf16_t*)(ws + WS_ZS); F.G = (GA bf16_t*)(ws + WS_G);
    F.QKV = (GA bf16_t*)(ws + WS_QKV); F.IQ = (GA bf16_t*)(ws + WS_IQ); F.IK = (GA bf16_t*)(ws + WS_IK); F.IW = (GA float*)(ws + WS_IW); F.FF = (GA float*)(ws + WS_FF);
    F.cum = (GA float*)(ws + WS_CUM); F.tb = (GA float*)(ws + WS_TB); F.sc = (GA float*)(ws + WS_SC); F.mask = (GA u64*)(ws + WS_MASK); F.Y = (GA bf16_t*)(ws + WS_Y); F.MG = (GA bf16_t*)(ws + WS_MG);
    F.O1 = (GA float*)(ws + WS_O1); F.OD = (GA float*)(ws + WS_OD); F.LSE = (GA float*)(ws + WS_LSE); F.DP = (GA float*)(ws + WS_DP); F.ws = ws;
    F.lds = lds; F.misc = (volatile LAS unsigned*)(lds + LDS_MISC);
    return F;
}

constexpr unsigned WQ_L0 = 2u * WT_TB, WQ_TOTAL = WQ_L0 + 3u * WT_TL;
__device__ __forceinline__ void wq_tile(const Args& args, LAS unsigned char* ldsl, unsigned t) {
    const Frame F = mkframe(args, launder(args.ws), ldsl);
    if (t < WQ_L0) { weight_tile(F, 0, WT_TW + WT_TG + (int)t, (LAS float*)ldsl); return; }
    const unsigned t1 = t - WQ_L0, l1 = t1 / (unsigned)WT_TL;
    weight_tile(F, 1 + (int)l1, (int)(t1 - l1 * (unsigned)WT_TL), (LAS float*)ldsl);
}
__device__ __forceinline__ void wq_drain(const Args& args, LAS unsigned char* ldsl, unsigned bound) {
    volatile LAS unsigned* st = (volatile LAS unsigned*)(ldsl + LDS_MISC);
    GA unsigned* wq = (GA unsigned*)(args.ws + WS_CTL) + CW_WQ;
    for (;;) {
        __syncthreads();
        if (threadIdx.x == 0) st[11] = __hip_atomic_fetch_add(wq, 1u, __ATOMIC_RELAXED, __HIP_MEMORY_SCOPE_AGENT);
        __syncthreads();
        const unsigned t = st[11];
        if (t < WQ_TOTAL) wq_tile(args, ldsl, t);
        if (t + 1u >= bound) break;
    }
}
__device__ __forceinline__ void xcd_barrier_steal(const XcdBarrier& b, const Args& args, LAS unsigned char* ldsl) {
    asm volatile("s_waitcnt vmcnt(0)" ::: "memory");
    __syncthreads();
    volatile LAS unsigned* st = b.st;
    if (threadIdx.x == 0) {
        unsigned* bar = b.bar;
        __builtin_amdgcn_s_waitcnt(0);
        unsigned nloc = st[0], nx = st[1];
        if (nloc == 0u) { xcd_barrier_complete(bar, b.x, nloc, nx); st[0] = nloc; st[1] = nx; }
        const unsigned old = xb_add(&bar[XB_XSUB(b.x)], 1u);
        const unsigned gen = old / nloc;
        if (old + 1u == (gen + 1u) * nloc) {
            __builtin_amdgcn_fence(__ATOMIC_RELEASE, "agent");
            asm volatile("s_waitcnt vmcnt(0)" ::: "memory");
            const unsigned og = xb_add(&bar[XB_TOP], 1u);
            const unsigned tg = og / nx;
            if (og + 1u == (tg + 1u) * nx) xb_add(&bar[XB_TOPGEN], 1u);
            else XB_SPIN(xb_ld(&bar[XB_TOPGEN]) == tg, bar);
            __builtin_amdgcn_fence(__ATOMIC_ACQUIRE, "agent");
            xb_add(&bar[XB_XGEN(b.x)], 1u);
            asm volatile("s_waitcnt vmcnt(0)" ::: "memory");
            st[8] = 1u;
        } else { st[8] = 0u; st[9] = gen; }
    }
    __syncthreads();
    const unsigned leader_ = st[8];
    __syncthreads();
    if (leader_ == 0u) {
        unsigned sp = 0u;
        for (;;) {
            if (threadIdx.x == 0) {
                unsigned* bar = b.bar;
                unsigned done = (xb_ld(&bar[XB_XGEN(b.x)]) != st[9]) ? 1u : 0u, t = 0xffffffffu;
                if (!done) {
                    if (st[10] == 0u) { t = xb_add((unsigned*)(args.ws + WS_CTL) + CW_WQ, 1u); if (t >= WQ_TOTAL) { st[10] = 1u; t = 0xffffffffu; } }
                    if (t == 0xffffffffu) { __builtin_amdgcn_s_sleep(1);
                        if ((++sp & 255u) == 0u) { if (xb_ld(&bar[XB_TMO])) done = 1u; else if (sp > XB_SPIN_CAP) { atomicAdd(&bar[XB_TMO], 1u); done = 1u; } } }
                }
                st[8] = done; st[11] = t;
            }
            __syncthreads();
            const unsigned done = st[8], t = st[11];
            if (done) break;
            if (t != 0xffffffffu) wq_tile(args, ldsl, t);
            else __syncthreads();
        }
        if (threadIdx.x == 0) { __builtin_amdgcn_fence(__ATOMIC_ACQUIRE, "agent"); asm volatile("s_waitcnt vmcnt(0)" ::: "memory"); }
    }
    __syncthreads();
}

__global__ void __launch_bounds__(512, 2) fwd(Args args) {
    extern __shared__ __attribute__((aligned(16))) unsigned char lds[];
    LAS unsigned char* ldsl = (LAS unsigned char*)lds;
    if (threadIdx.x < 64) ((volatile LAS unsigned*)(ldsl + LDS_MISC))[threadIdx.x] = 0u;
    __syncthreads();
    const int lo = args.ph_lo, hi = args.ph_hi;
    const bool fused = (hi - lo) > 1;
    if (fused) (void)xcd_barrier_post((unsigned*)(args.ws + WS_CTL) + CW_BAR, (volatile LAS unsigned*)(ldsl + LDS_MISC));
#ifndef PH_EN
#define PH_EN 0xff
#endif
#define IN(k) (lo <= (k) && (k) < hi)
#if defined(BWPROBE)
#define BW_MATCH(k) (BWPROBE == 9 || ((k) == 0 ? 5 : ((k) - 1) % 5) == BWPROBE)
#define SEAM(k) do { if (IN((k) + 1)) { const unsigned long long bw0_ = __builtin_amdgcn_s_memrealtime(); XcdBarrier b_; b_.bar = (unsigned*)(args.ws + WS_CTL) + CW_BAR; b_.x = xb_xcc_id(); b_.st = (volatile LAS unsigned*)(ldsl + LDS_MISC); xcd_barrier(b_); \
    if (BW_MATCH(k) && threadIdx.x == 0) atomicAdd((unsigned*)(args.ws + WS_CTL) + 14336, (unsigned)(__builtin_amdgcn_s_memrealtime() - bw0_)); } } while (0)
#else
#define SEAM(k) do { if (IN((k) + 1)) { XcdBarrier b_; b_.bar = (unsigned*)(args.ws + WS_CTL) + CW_BAR; b_.x = xb_xcc_id(); b_.st = (volatile LAS unsigned*)(ldsl + LDS_MISC); xcd_barrier(b_); } } while (0)
#endif
#define SEAM_STEAL(k) do { if (IN((k) + 1)) { XcdBarrier b_; b_.bar = (unsigned*)(args.ws + WS_CTL) + CW_BAR; b_.x = xb_xcc_id(); b_.st = (volatile LAS unsigned*)(ldsl + LDS_MISC); xcd_barrier_steal(b_, args, ldsl); } } while (0)
    const int G = gridDim.x, bid = blockIdx.x;
#if defined(TPROBE)
    unsigned long long tp_acc = 0ull, tp_t0 = 0ull;
#define tp_acc_ref tp_acc
#define TP_BEGIN(k) do { if ((k) == TPROBE) tp_t0 = __builtin_amdgcn_s_memrealtime(); } while (0)
#define TP_END(k) do { if ((k) == TPROBE) tp_acc += __builtin_amdgcn_s_memrealtime() - tp_t0; } while (0)
#else
    unsigned long long tp_dummy = 0ull;
#define tp_acc_ref tp_dummy
#define TP_BEGIN(k) do { } while (0)
#define TP_END(k) do { } while (0)
#endif

    if ((PH_EN & 1) && IN(0)) { const Frame F = mkframe(args, launder(args.ws), ldsl); TP_BEGIN(0); p0_prologue(F);
#if defined(DUP) && DUP == 6
        __syncthreads(); p0_prologue(F);
#endif
        SEAM(0); TP_END(0); }

    for (int layer = 0; layer < DEPTH; ++layer) {
        const int pb = 1 + 5 * layer;
        if ((PH_EN & 2) && IN(pb)) { TP_BEGIN(1);
            GA unsigned char* ws = launder(args.ws);
            { pg8::Gemm g{(const GA bf16_t*)(ws + WS_XB), (const GA bf16_t*)(ws + WS_WIN) + (size_t)layer * NINP * DM, MT, NINP, DM}; pg8::StaticOrder S; S.init(MT, NINP, G, bid);
              EpiIn E{ws};
              pg8::gemm_phase<EpiIn, pg8::StaticOrder>(ldsl, g, S, E); }
            __syncthreads();
            { pg8::Gemm g{(const GA bf16_t*)(ws + WS_XQ), (const GA bf16_t*)(ws + WS_WG8 + (size_t)layer * N8 * DM), MT, N8, DM / 2}; pg8::StaticOrder S;
              if (G == 256) { if (bid < 192) S.init_part(MT, N8, 192, bid, 12); else S.init_part(MT, N8, 64, 2304 + (bid - 192), 14); } else S.init(MT, N8, G, (bid + 128) % G);
              EpiGate E{ws};
              pg8::gemm_phase<EpiGate, pg8::StaticOrder>(ldsl, g, S, E); }
            SEAM_STEAL(pb); TP_END(1);
        }
        if ((PH_EN & 4) && IN(pb + 1)) { TP_BEGIN(2);
            const Frame F = mkframe(args, launder(args.ws), ldsl);
            TP_BEGIN(20); if (bid < 8) fox_scan(F, layer, bid);
            fox_kmax(F, layer); TP_END(20);
            GA unsigned* ctr = F.ctl + CW_Q + 64 * (layer * 4 + 0);
            for (int u = q_next(ctr, F.misc + 4); u < 768 + 2048; u = q_next(ctr, F.misc + 4)) {
                if (u < 768) { TP_BEGIN(23); attn_dil_unit(F, u); TP_END(23); } else { TP_BEGIN(21); idxsel_unit(F, u - 768, tp_acc_ref); TP_END(21); }
            }
            SEAM_STEAL(pb + 1); TP_END(2);
        }
        if ((PH_EN & 16) && IN(pb + 2)) { TP_BEGIN(4);
            const Frame F = mkframe(args, launder(args.ws), ldsl);
            GA unsigned* ctr = F.ctl + CW_Q + 64 * (layer * 4 + 1);
            const int nunits = 1536;
            for (int u = q_next(ctr, F.misc + 4); u < nunits; u = q_next(ctr, F.misc + 4)) {
                if (u < 512) { const int qb = 31 - (u >> 4), r = u & 15; TP_BEGIN(40); TP_BEGIN(44 + (qb >= 16)); attn_diffmap_unit(F, layer, r & 1, (r >> 1) & 3, qb, r >> 3); TP_END(40); TP_END(44 + (qb >= 16)); }
                else if (u < 1024) { const int v = u - 512, qb = 31 - (v >> 4), r = v & 15, mode = r & 1, b = (r >> 1) & 1, h = r >> 2;
                    if (mode == 0) { TP_BEGIN(41); attn_fast_unit<0>(F, layer, b, h, qb); TP_END(41); } else { TP_BEGIN(42); attn_fast_unit<1>(F, layer, b, h, qb); TP_END(42); } }
                else { TP_BEGIN(43); dil_merge_unit(F, u - 1024); TP_END(43); }
            }
            if (layer == 0) { __syncthreads(); wq_drain(args, ldsl, WQ_L0); }
            SEAM_STEAL(pb + 2); TP_END(4);
        }
        if ((PH_EN & 32) && IN(pb + 3)) { TP_BEGIN(5);
            GA unsigned char* ws = launder(args.ws);
            pg8::Gemm g{(const GA bf16_t*)(ws + WS_Y), (const GA bf16_t*)(ws + WS_WBR) + (size_t)layer * DM * DM, MT, DM, DM}; pg8::StaticOrder S; S.init(MT, DM, G, bid);
            EpiMerged E{(const GA unsigned char*)(ws + WS_G), (GA bf16_t*)(ws + WS_MG)};
            pg8::gemm_phase<EpiMerged, pg8::StaticOrder>(ldsl, g, S, E);
#if defined(DUP) && DUP == 4
            __syncthreads(); pg8::gemm_phase<EpiMerged, pg8::StaticOrder>(ldsl, g, S, E);
#endif
            SEAM_STEAL(pb + 3); TP_END(5);
        }
        if ((PH_EN & 64) && IN(pb + 4)) { TP_BEGIN(6);
            GA unsigned char* ws = launder(args.ws);
            pg8::Gemm g{(const GA bf16_t*)(ws + WS_MG), (const GA bf16_t*)(ws + WS_WOUT) + (size_t)layer * DM * DM, MT, DM, DM}; pg8::StaticOrder S; S.init(MT, DM, G, bid);
            EpiOut E{(GA float*)(ws + WS_XRES), (GA bf16_t*)(ws + WS_XB), (GA float*)(ws + WS_SSQ), ws + WS_XQ, (layer == 0) ? (const GA float*)args.in[0] : (const GA float*)nullptr, layer + 1 < DEPTH};
            pg8::gemm_phase<EpiOut, pg8::StaticOrder>(ldsl, g, S, E);
            if (layer + 1 < DEPTH) { __syncthreads(); wq_drain(args, ldsl, WQ_L0 + (unsigned)(layer + 1) * WT_TL); }
            SEAM_STEAL(pb + 4); TP_END(6);
        }
    }
    if ((PH_EN & 128) && IN(21)) { TP_BEGIN(7); const Frame F = mkframe(args, launder(args.ws), ldsl); final_norm(F); TP_END(7); }
#if defined(BWPROBE)
    if (bid == 0) { __syncthreads(); const unsigned long long te = __builtin_amdgcn_s_memrealtime(); const unsigned long long tot = xb_ld((unsigned*)(args.ws + WS_CTL) + 14336);
        while ((__builtin_amdgcn_s_memrealtime() - te) * 32ull < tot) __builtin_amdgcn_s_sleep(8); }
#endif
#if defined(TPROBE)
    if (bid == 0) { const unsigned long long te = __builtin_amdgcn_s_memrealtime(); while (__builtin_amdgcn_s_memrealtime() - te < 8ull * tp_acc) __builtin_amdgcn_s_sleep(8); }
#endif
#undef IN
#undef SEAM
}

extern "C" void kernel_launch(void* const* d_in, const int* in_sizes, int n_in, void* d_out, int out_size, void* d_ws, size_t ws_size, hipStream_t stream) {
    static int grid = 0;
    if (grid == 0) {
        if (n_in != 13 || in_sizes[0] != MT * DM || out_size != MT * DM || ws_size < WS_END) {
            fprintf(stderr, "kernel_launch: unexpected shapes (n_in %d, in0 %d, out %d, ws %zu, need %zu)\n", n_in, n_in > 0 ? in_sizes[0] : -1, out_size, ws_size, (size_t)WS_END); grid = -1; return; }
        int dev = 0, cus = 0, per_cu = 0;
        if (hipGetDevice(&dev) != hipSuccess || hipDeviceGetAttribute(&cus, hipDeviceAttributeMultiprocessorCount, dev) != hipSuccess) { grid = -1; return; }
        if (hipFuncSetAttribute((const void*)fwd, hipFuncAttributeMaxDynamicSharedMemorySize, LDS_BYTES) != hipSuccess) { fprintf(stderr, "kernel_launch: hipFuncSetAttribute failed\n"); grid = -1; return; }
        if (hipOccupancyMaxActiveBlocksPerMultiprocessor(&per_cu, (const void*)fwd, 512, LDS_BYTES) != hipSuccess || per_cu < 1) fprintf(stderr, "kernel_launch: occupancy query reports %d\n", per_cu);
        (void)hipGetLastError();
        grid = cus;
    }
    if (grid < 0) return;
    if (hipMemsetAsync((char*)d_ws + WS_CTL, 0, CTL_BYTES, stream) != hipSuccess) return;
    Args a{};
    for (int i = 0; i < 13; ++i) a.in[i] = (const float*)d_in[i];
    a.out = (float*)d_out; a.ws = (unsigned char*)d_ws;
#if MK_LAUNCHES == 1
    a.ph_lo = 0; a.ph_hi = NPH;
    hipLaunchKernelGGL(fwd, dim3(grid), dim3(512), LDS_BYTES, stream, a);
#else
    for (int p = 0; p < NPH; ++p) { a.ph_lo = p; a.ph_hi = p + 1; hipLaunchKernelGGL(fwd, dim3(grid), dim3(512), LDS_BYTES, stream, a); }
#endif
}
```

```cpp
#include <hip/hip_runtime.h>
#include <stdint.h>
#include <stdio.h>

#ifndef MK_LAUNCHES
#define MK_LAUNCHES 1
#endif

#define LAS __attribute__((address_space(3)))
#define GA __attribute__((address_space(1)))
typedef unsigned short bf16_t;
typedef short bf16x8 __attribute__((ext_vector_type(8)));
typedef float f32x4 __attribute__((ext_vector_type(4)));
typedef float f32x16 __attribute__((ext_vector_type(16)));
typedef unsigned u32x4 __attribute__((ext_vector_type(4)));
typedef unsigned u32x2 __attribute__((ext_vector_type(2)));
typedef unsigned long long u64;

constexpr int DM = 2048, NB = 2, SEQ = 8192, DEPTH = 4, MT = NB * SEQ;
constexpr int NIN = 17492, NINP = 4864, N8 = 12800;
constexpr float W8SCALE = 512.f;
constexpr int NPH = 22;
constexpr float LOG2E = 1.4426950408889634f;
constexpr float QSC128 = 0.08838834764831845f * 1.4426950408889634f;
constexpr float QSC64 = 0.125f * 1.4426950408889634f;
constexpr float RMS_EPS = 1e-6f;
constexpr size_t QS = (size_t)NB * 4 * SEQ * 128;

constexpr size_t al256(size_t x) { return (x + 255) & ~(size_t)255; }
constexpr size_t WS_CTL = 0, CTL_BYTES = 65536;
constexpr size_t WS_WIN = WS_CTL + CTL_BYTES;
constexpr size_t WS_WBR = WS_WIN + (size_t)DEPTH * NINP * DM * 2;
constexpr size_t WS_WOUT = WS_WBR + (size_t)DEPTH * DM * DM * 2;
constexpr size_t WS_XRES = WS_WOUT + (size_t)DEPTH * DM * DM * 2;
constexpr size_t WS_XB = WS_XRES + (size_t)MT * DM * 4;
constexpr size_t WS_SSQ = WS_XB + (size_t)MT * DM * 2;
constexpr size_t WS_ZS = WS_SSQ + (size_t)MT * 32 * 4;
constexpr size_t WS_G = WS_ZS + (size_t)MT * DM * 2;
constexpr size_t WS_QKV = WS_G + (size_t)MT * 8192 * 2;
constexpr size_t WS_IQ = WS_QKV + 12 * QS * 2;
constexpr size_t WS_IK = WS_IQ + (size_t)MT * 1024 * 2;
constexpr size_t WS_IW = WS_IK + (size_t)MT * 64 * 2;
constexpr size_t WS_FF = WS_IW + (size_t)MT * 16 * 4;
constexpr size_t WS_CUM = WS_FF + (size_t)MT * 4 * 4;
constexpr size_t WS_TB = WS_CUM + (size_t)NB * 4 * SEQ * 4;
constexpr size_t WS_SC = WS_TB + (size_t)12 * SEQ * 4;
constexpr size_t WS_MASK = WS_SC + (size_t)NB * SEQ * SEQ * 4;
constexpr size_t WS_Y = WS_MASK + (size_t)NB * SEQ * 128 * 8;
constexpr size_t WS_MG = WS_Y + (size_t)MT * DM * 2;
constexpr size_t WS_O1 = WS_MG + (size_t)MT * DM * 2;
constexpr size_t WS_OD = WS_O1 + (size_t)2 * 256 * 64 * 512 * 4;
constexpr size_t WS_LSE = WS_OD + (size_t)3 * MT * 512 * 4;
constexpr size_t WS_DP = WS_LSE + (size_t)3 * MT * 4 * 4;
constexpr size_t WS_WG8 = WS_DP + 4 * 256 * 4;
constexpr size_t WS_XQ = WS_WG8 + (size_t)DEPTH * N8 * DM;
constexpr size_t WS_END = WS_XQ + (size_t)MT * DM;

constexpr int CW_BAR = 0;
constexpr int CW_Q = 4096;
constexpr int CW_DC = 8192;
constexpr int CW_WQ = 13312;
constexpr int CW_PC = 15360;
constexpr int CW_KM = 12288;

constexpr int LDS_STAGE = 131072;
constexpr int LDS_MISC = 131072;
constexpr int LDS_BYTES = 147456;

__device__ __forceinline__ unsigned cvt_pk_bf16(float lo, float hi) { unsigned r; asm volatile("v_cvt_pk_bf16_f32 %0, %1, %2" : "=v"(r) : "v"(lo), "v"(hi)); return r; }
__device__ __forceinline__ float bf_lo(unsigned w) { return __uint_as_float(w << 16); }
__device__ __forceinline__ float bf_hi(unsigned w) { return __uint_as_float(w & 0xffff0000u); }
__device__ __forceinline__ float bf2f(bf16_t b) { return __uint_as_float(((unsigned)b) << 16); }
__device__ __forceinline__ float ex2(float x) { return __builtin_amdgcn_exp2f(x); }
__device__ __forceinline__ float sigmoidf_(float x) { return __builtin_amdgcn_rcpf(1.0f + ex2(-x * LOG2E)); }
__device__ __forceinline__ int tid_l() { int t = threadIdx.x; asm volatile("" : "+v"(t)); return t; }
__device__ __forceinline__ GA unsigned char* launder(unsigned char* p) { asm volatile("" : "+s"(p)); return (GA unsigned char*)p; }
__device__ __forceinline__ GA unsigned char* launder(GA unsigned char* p) { asm volatile("" : "+s"(p)); return p; }
__device__ __forceinline__ float wave_sum(float v) {
#pragma unroll
    for (int o = 32; o > 0; o >>= 1) v += __shfl_xor(v, o);
    return v;
}

#define XB_TMO      128
#define XB_XCNT(j)  (256  + 64 * (j))
#define XB_XSUB(j)  (1280 + 64 * (j))
#define XB_XGEN(j)  (2304 + 64 * (j))
#define XB_TOP      3328
#define XB_TOPGEN   3392
#define XCD_BAR_WORDS 3456
#define XB_SPIN_CAP (1u << 18)

__device__ __forceinline__ unsigned xb_ld(unsigned* p)              { return __hip_atomic_load(p, __ATOMIC_RELAXED, __HIP_MEMORY_SCOPE_AGENT); }
__device__ __forceinline__ unsigned xb_add(unsigned* p, unsigned v) { return __hip_atomic_fetch_add(p, v, __ATOMIC_RELAXED, __HIP_MEMORY_SCOPE_AGENT); }
__device__ __forceinline__ unsigned xb_xcc_id() { return (unsigned)__builtin_amdgcn_s_getreg((3 << 11) | 20) & 0xFu; }
#define XB_SPIN(cond, bar) do { unsigned _sp = 0; while (cond) { __builtin_amdgcn_s_sleep(1); \
    if ((++_sp & 255u) == 0u) { if (xb_ld(&(bar)[XB_TMO])) break; if (_sp > XB_SPIN_CAP) { atomicAdd(&(bar)[XB_TMO], 1u); break; } } } } while (0)

struct XcdBarrier { unsigned* bar; unsigned x; volatile LAS unsigned* st; };

__device__ __forceinline__ XcdBarrier xcd_barrier_post(unsigned* bar, volatile LAS unsigned* st) {
    XcdBarrier b; b.bar = bar; b.x = xb_xcc_id(); b.st = st;
    if (threadIdx.x == 0) (void)xb_add(&bar[XB_XCNT(b.x)], 1u);
    return b;
}
__device__ __forceinline__ void xcd_barrier_complete(unsigned* bar, unsigned x, unsigned& nloc, unsigned& nx) {
    const unsigned G = gridDim.x * gridDim.y * gridDim.z;
    unsigned sum, cnt, mine, sp = 0u;
    for (;;) {
        sum = 0u; cnt = 0u; mine = 0u;
#pragma unroll
        for (unsigned j = 0; j < 16; ++j) { const unsigned c = xb_ld(&bar[XB_XCNT(j)]); sum += c; cnt += (c > 0u) ? 1u : 0u; mine = (j == x) ? c : mine; }
        if (sum == G) break;
        __builtin_amdgcn_s_sleep(1);
        if ((++sp & 255u) == 0u) { if (xb_ld(&bar[XB_TMO])) break; if (sp > XB_SPIN_CAP) { atomicAdd(&bar[XB_TMO], 1u); break; } }
    }
    nloc = mine > 0u ? mine : 1u; nx = cnt > 0u ? cnt : 1u;
}
__device__ __forceinline__ void xcd_barrier(const XcdBarrier& b) {
    asm volatile("s_waitcnt vmcnt(0)" ::: "memory");
    __syncthreads();
    if (threadIdx.x == 0) {
        unsigned* bar = b.bar;
        __builtin_amdgcn_s_waitcnt(0);
        unsigned nloc = b.st[0], nx = b.st[1];
        if (nloc == 0u) { xcd_barrier_complete(bar, b.x, nloc, nx); b.st[0] = nloc; b.st[1] = nx; }
        const unsigned old = xb_add(&bar[XB_XSUB(b.x)], 1u);
        const unsigned gen = old / nloc;
        if (old + 1u == (gen + 1u) * nloc) {
            __builtin_amdgcn_fence(__ATOMIC_RELEASE, "agent");
            asm volatile("s_waitcnt vmcnt(0)" ::: "memory");
            const unsigned og = xb_add(&bar[XB_TOP], 1u);
            const unsigned tg = og / nx;
            if (og + 1u == (tg + 1u) * nx) xb_add(&bar[XB_TOPGEN], 1u);
            else XB_SPIN(xb_ld(&bar[XB_TOPGEN]) == tg, bar);
            __builtin_amdgcn_fence(__ATOMIC_ACQUIRE, "agent");
            xb_add(&bar[XB_XGEN(b.x)], 1u);
            asm volatile("s_waitcnt vmcnt(0)" ::: "memory");
        } else {
            XB_SPIN(xb_ld(&bar[XB_XGEN(b.x)]) == gen, bar);
            __builtin_amdgcn_fence(__ATOMIC_ACQUIRE, "agent");
            asm volatile("s_waitcnt vmcnt(0)" ::: "memory");
        }
    }
    __syncthreads();
}

namespace pg8 {
constexpr int BM = 256, BK = 64, HALF = 128, HTB = HALF * BK * 2, STAGE_BYTES = 8 * HTB, NXCD = 8, WGM = 4;
__host__ __device__ __forceinline__ int lds_byte(int r, int c) { const int st = (r >> 4) * 2 + (c >> 5), rr = r & 15, cc = c & 31, ob = rr * 64 + cc * 2; return st * 1024 + (ob ^ (((ob >> 9) & 1) << 5)); }
__host__ __device__ __forceinline__ void stage_rc(int b, int& R, int& C) { const int st = b / 1024, sb = b % 1024, swz = sb ^ (((sb >> 9) & 1) << 5); R = (st >> 1) * 16 + swz / 64; C = (st & 1) * 32 + (swz % 64) / 2; }
__host__ __device__ __forceinline__ int perm32(int rho) { const int n = rho >> 4, i = rho & 15; return 8 * (i >> 2) + 4 * n + (i & 3); }
struct Unit { int pm, pn; };
struct Gemm { const GA bf16_t* A; const GA bf16_t* Bt; int M, N, K; };
struct StaticOrder {
    int nM, nN, nwg, G, c, cnt;
    __host__ __device__ void init(int M, int N, int G_, int c_) { nM = M / BM; nN = N / BM; nwg = nM * nN; G = G_; c = c_; cnt = 1 << 30; }
    __host__ __device__ void init_part(int M, int N, int stride, int first, int cnt_) { nM = M / BM; nN = N / BM; nwg = nM * nN; G = stride; c = first; cnt = cnt_; }
    __host__ __device__ bool next(int i, Unit& u) const {
        const long L = (long)i * G + c; if (L >= nwg || i >= cnt) return false;
        int wgid = (int)L; { const int q = nwg / NXCD, r = nwg % NXCD, xcd = wgid % NXCD, off = wgid / NXCD; wgid = (xcd < r ? xcd * (q + 1) : r * (q + 1) + (xcd - r) * q) + off; }
        const int nig = WGM * nN, gid = wgid / nig, fm = gid * WGM, gsz = (nM - fm) < WGM ? (nM - fm) : WGM;
        u.pm = fm + ((wgid % nig) % gsz); u.pn = (wgid % nig) / gsz; return true;
    }
    __device__ __forceinline__ void a_ready(const Unit&) const {}
    __device__ __forceinline__ void done(const Unit&) const {}
};

template <class Epi, class Sched>
__device__ __forceinline__ void gemm_phase(LAS unsigned char* lds, const Gemm g, const Sched& S, const Epi& E) {
    const int tid = tid_l(), wid = __builtin_amdgcn_readfirstlane(tid >> 6), lane = tid & 63, wr = wid >> 2, wc = wid & 3, fr = lane & 15, fq = lane >> 4;
    const int K = g.K, nt = K / BK;
    unsigned voffA[2], voffB[2];
#pragma unroll
    for (int i = 0; i < 2; ++i) { int R, C; stage_rc(tid * 16 + i * 8192, R, C); const int Rb = Epi::PERM ? ((R & ~31) + perm32(R & 31)) : R;
        voffA[i] = (unsigned)(R * K + C) * 2u; voffB[i] = (unsigned)(Rb * K + C) * 2u; }
    const size_t kstep = (size_t)(BK * 2);
    const size_t hstep = (size_t)HALF * K * 2;
    const size_t tstep = 2 * hstep;
    const unsigned ldsw = (unsigned)wid * 1024u;
    const int aoff = lds_byte(wr * 64 + fr, fq * 8), boff = lds_byte(wc * 32 + fr, fq * 8);
    typedef int v8i_t __attribute__((ext_vector_type(8)));
    const int aoff8 = lds_byte(wr * 64 + fr, (fq & 1) * 16) + (fq >> 1) * 1024, boff8 = lds_byte(wc * 32 + fr, (fq & 1) * 16) + (fq >> 1) * 1024;
#define PG8_SA(b, h) (((b) * 2 + (h)) * HTB)
#define PG8_SB(b, h) ((4 + (b) * 2 + (h)) * HTB)
#define PG8_STAGE(bufoff, gbase, voff) do { _Pragma("unroll") for (int _i = 0; _i < 2; ++_i) \
        __builtin_amdgcn_global_load_lds((const GA unsigned*)((const GA char*)(gbase) + (voff)[_i]), (LAS unsigned*)(lds + (bufoff) + ldsw + _i * 8192), 16, 0, 0); } while (0)
#define PG8_LDA(dst, b, h) do { if constexpr (Epi::FP8) { _Pragma("unroll") for (int m = 0; m < 4; ++m) { typedef int v4i_t_ __attribute__((ext_vector_type(4))); const LAS char* p_ = (const LAS char*)(lds + PG8_SA(b, h) + aoff8 + m * 2048); const v4i_t_ lo_ = *(const LAS v4i_t_*)p_, hi_ = *(const LAS v4i_t_*)(p_ + 16); dst##8[m] = __builtin_shufflevector(lo_, hi_, 0, 1, 2, 3, 4, 5, 6, 7); } } \
        else { _Pragma("unroll") for (int m = 0; m < 4; ++m) _Pragma("unroll") for (int k = 0; k < 2; ++k) dst[m][k] = *(const LAS bf16x8*)(lds + PG8_SA(b, h) + aoff + m * 2048 + k * 1024); } } while (0)
#define PG8_LDB(dst, b, h) do { if constexpr (Epi::FP8) { _Pragma("unroll") for (int n = 0; n < 2; ++n) { typedef int v4i_t_ __attribute__((ext_vector_type(4))); const LAS char* p_ = (const LAS char*)(lds + PG8_SB(b, h) + boff8 + n * 2048); const v4i_t_ lo_ = *(const LAS v4i_t_*)p_, hi_ = *(const LAS v4i_t_*)(p_ + 16); dst##8[n] = __builtin_shufflevector(lo_, hi_, 0, 1, 2, 3, 4, 5, 6, 7); } } \
        else { _Pragma("unroll") for (int n = 0; n < 2; ++n) _Pragma("unroll") for (int k = 0; k < 2; ++k) dst[n][k] = *(const LAS bf16x8*)(lds + PG8_SB(b, h) + boff + n * 2048 + k * 1024); } } while (0)
#define PG8_MMA(ai, bj, At, Bt) do { __builtin_amdgcn_s_setprio(1); _Pragma("unroll") for (int m = 0; m < 4; ++m) _Pragma("unroll") for (int n = 0; n < 2; ++n) { \
        if constexpr (Epi::FP8) asm volatile("v_mfma_scale_f32_16x16x128_f8f6f4 %0, %1, %2, %0, %3, %3 op_sel_hi:[0,0,0]" : "+v"(acc[ai][bj][m][n]) : "v"(Bt##8[n]), "v"(At##8[m]), "v"(sc127)); \
        else { _Pragma("unroll") for (int k = 0; k < 2; ++k) acc[ai][bj][m][n] = __builtin_amdgcn_mfma_f32_16x16x32_bf16(Bt[n][k], At[m][k], acc[ai][bj][m][n], 0, 0, 0); } } \
        __builtin_amdgcn_s_setprio(0); } while (0)
#define PG8_WAIT_V(n) asm volatile("s_waitcnt vmcnt(" #n ")" ::: "memory")
#define PG8_WAIT_L(n) asm volatile("s_waitcnt lgkmcnt(" #n ")" ::: "memory")
#define PG8_BAR __builtin_amdgcn_s_barrier()
#define PG8_SCHED __builtin_amdgcn_sched_barrier(0)
    Unit cur, nxt; int ui = 0;
    if (!S.next(0, cur)) return;
    f32x4 acc[2][2][4][2];
#pragma unroll
    for (int a = 0; a < 2; ++a)
#pragma unroll
        for (int b = 0; b < 2; ++b)
#pragma unroll
            for (int m = 0; m < 4; ++m)
#pragma unroll
                for (int n = 0; n < 2; ++n) acc[a][b][m][n] = (f32x4){0.f, 0.f, 0.f, 0.f};
    bf16x8 At[4][2], B0[2][2], B1[2][2]; v8i_t At8[4], B08[2], B18[2]; const int sc127 = 127;
    const GA char* cA = (const GA char*)g.A + (size_t)cur.pm * tstep; const GA char* cB = (const GA char*)g.Bt + (size_t)cur.pn * tstep;
    S.a_ready(cur);
    PG8_STAGE(PG8_SB(0, 0), cB, voffB); PG8_STAGE(PG8_SA(0, 0), cA, voffA); PG8_STAGE(PG8_SB(0, 1), cB + hstep, voffB); PG8_STAGE(PG8_SA(0, 1), cA + hstep, voffA);
    if (wr == 1) PG8_BAR;
    PG8_WAIT_V(4); PG8_BAR;
    PG8_STAGE(PG8_SB(1, 0), cB + kstep, voffB); PG8_STAGE(PG8_SA(1, 0), cA + kstep, voffA); PG8_STAGE(PG8_SB(1, 1), cB + hstep + kstep, voffB);
    PG8_WAIT_V(6); PG8_BAR;
    for (;;) {
        const bool has_next = S.next(ui + 1, nxt);
        const GA char* nA = has_next ? (const GA char*)g.A + (size_t)nxt.pm * tstep : cA; const GA char* nB = has_next ? (const GA char*)g.Bt + (size_t)nxt.pn * tstep : cB;
        for (int t = 0; t < nt; t += 2) {
            const bool last = (t == nt - 2);
            const GA char* a1 = cA + (size_t)(t + 1) * kstep;
            const GA char* a2 = last ? nA : cA + (size_t)(t + 2) * kstep; const GA char* b2 = last ? nB : cB + (size_t)(t + 2) * kstep;
            const GA char* a3 = a2 + kstep; const GA char* b3 = b2 + kstep;
            if (last && has_next) S.a_ready(nxt);
            if constexpr (Epi::MIDK) { if (t > 0 && (t & 7) == 0) E.mid(acc, cur, t >> 3, wr, wc, fr, fq); }
            PG8_LDB(B0, 0, 0); PG8_SCHED; PG8_LDA(At, 0, 0); PG8_STAGE(PG8_SA(1, 1), a1 + hstep, voffA);
            PG8_WAIT_L(8); PG8_BAR; PG8_WAIT_L(0); PG8_MMA(0, 0, At, B0); PG8_BAR; PG8_SCHED;
            PG8_LDB(B1, 0, 1); PG8_STAGE(PG8_SB(0, 0), b2, voffB);
            PG8_BAR; PG8_WAIT_L(0); PG8_MMA(0, 1, At, B1); PG8_BAR;
            PG8_LDA(At, 0, 1); PG8_STAGE(PG8_SA(0, 0), a2, voffA);
            PG8_BAR; PG8_WAIT_L(0); PG8_MMA(1, 0, At, B0); PG8_BAR; PG8_SCHED;
            PG8_STAGE(PG8_SB(0, 1), b2 + hstep, voffB);
            PG8_WAIT_V(6); PG8_BAR; PG8_MMA(1, 1, At, B1); PG8_BAR;
            PG8_LDB(B0, 1, 0); PG8_SCHED; PG8_LDA(At, 1, 0); PG8_STAGE(PG8_SA(0, 1), a2 + hstep, voffA);
            PG8_WAIT_L(8); PG8_BAR; PG8_WAIT_L(0); PG8_MMA(0, 0, At, B0); PG8_BAR; PG8_SCHED;
            PG8_LDB(B1, 1, 1); PG8_STAGE(PG8_SB(1, 0), b3, voffB);
            PG8_BAR; PG8_WAIT_L(0); PG8_MMA(0, 1, At, B1); PG8_BAR;
            PG8_LDA(At, 1, 1); PG8_STAGE(PG8_SA(1, 0), a3, voffA);
            PG8_BAR; PG8_WAIT_L(0); PG8_MMA(1, 0, At, B0); PG8_BAR; PG8_SCHED;
            PG8_STAGE(PG8_SB(1, 1), b3 + hstep, voffB);
            PG8_WAIT_V(6); PG8_BAR; PG8_MMA(1, 1, At, B1); PG8_BAR;
        }
        if constexpr (Epi::FP8) asm volatile("s_nop 15\n\ts_nop 15" ::: "memory");
        E(acc, cur, wr, wc, fr, fq); S.done(cur);
#if defined(DUP) && DUP == 7
        if constexpr (!Epi::MIDK && Epi::PERM) { asm volatile("s_waitcnt vmcnt(0)" ::: "memory"); E(acc, cur, wr, wc, fr, fq); E(acc, cur, wr, wc, fr, fq); }
#endif
        if (!has_next) break;
#pragma unroll
        for (int a = 0; a < 2; ++a)
#pragma unroll
            for (int b = 0; b < 2; ++b)
#pragma unroll
                for (int m = 0; m < 4; ++m)
#pragma unroll
                    for (int n = 0; n < 2; ++n) acc[a][b][m][n] = (f32x4){0.f, 0.f, 0.f, 0.f};
        cur = nxt; cA = nA; cB = nB; ++ui;
    }
    PG8_WAIT_V(0);
    if (wr == 0) PG8_BAR;
    PG8_BAR;
#undef PG8_SA
#undef PG8_SB
#undef PG8_STAGE
#undef PG8_LDA
#undef PG8_LDB
#undef PG8_MMA
#undef PG8_WAIT_V
#undef PG8_WAIT_L
#undef PG8_BAR
#undef PG8_SCHED
}
}

struct Args { const float* in[13]; float* out; unsigned char* ws; int ph_lo, ph_hi; };
struct Frame {
    const GA float* x; const GA float* norm_w; const GA float* w_in; const GA float* fox_b; const GA float* lq1; const GA float* lk1; const GA float* lq2; const GA float* lk2;
    const GA float* subln; const GA float* w_branch; const GA float* w_out; const GA float* rel_bias; const GA float* final_w; GA float* out;
    GA unsigned* ctl; GA bf16_t* WinT; GA bf16_t* WbrT; GA bf16_t* WoutT; GA float* xres; GA bf16_t* xb; GA float* ssq; GA bf16_t* Zs; GA bf16_t* G; GA bf16_t* QKV; GA bf16_t* IQ; GA bf16_t* IK;
    GA float* IW; GA float* FF; GA float* cum; GA float* tb; GA float* sc; GA u64* mask; GA bf16_t* Y; GA bf16_t* MG; GA float* O1; GA float* OD; GA float* LSE; GA float* DP; GA unsigned char* ws;
    LAS unsigned char* lds; volatile LAS unsigned* misc;
};

__device__ __forceinline__ unsigned q_issue(GA unsigned* ctr) { unsigned pf = 0u; int z = 0; asm volatile("" : "+v"(z)); if (threadIdx.x == 0) pf = __hip_atomic_fetch_add(ctr + z, 1u, __ATOMIC_RELAXED, __HIP_MEMORY_SCOPE_AGENT); return pf; }
__device__ __forceinline__ int q_commit(volatile LAS unsigned* lw, unsigned pf) { __syncthreads(); if (threadIdx.x == 0) *lw = pf; __syncthreads(); return (int)*lw; }
__device__ __forceinline__ int q_next(GA unsigned* ctr, volatile LAS unsigned* lw) {
    __syncthreads();
    if (threadIdx.x == 0) *lw = __hip_atomic_fetch_add(ctr, 1u, __ATOMIC_RELAXED, __HIP_MEMORY_SCOPE_AGENT);
    __syncthreads();
    return (int)*lw;
}

__device__ __forceinline__ int win_src_col(int n) {
    if (n < 2048) return n;
    if (n < 3072) return n - 2048 + 11776;
    if (n < 4608) return n - 3072 + 14420;
    if (n < 4672) return n - 4608 + 12800;
    if (n < 4688) return n - 4672 + 12864;
    if (n < 4692) return n - 4688 + 14416;
    return -1;
}
__device__ __forceinline__ int win8_src_col(int n) {
    if (n < 8192) return n + 2048;
    if (n < 9728) return n - 8192 + 10240;
    if (n < 11264) return n - 9728 + 12880;
    return n - 11264 + 15956;
}
__device__ __forceinline__ void transpose_tile(const GA float* src, int ld, int srccol4, const GA float* ksc, GA bf16_t* dst, int k0, int n0, LAS float* tile) {
    const int tid = tid_l(), tk = tid >> 5, tn4 = (tid & 31) * 4;
    f32x4 v[4];
#pragma unroll
    for (int i = 0; i < 4; ++i) { const int kk = tk + 16 * i; v[i] = (f32x4){0.f, 0.f, 0.f, 0.f};
        if (srccol4 >= 0) { v[i] = *(const GA f32x4*)(src + (size_t)(k0 + kk) * ld + srccol4); if (ksc) v[i] *= ksc[k0 + kk]; } }
#pragma unroll
    for (int i = 0; i < 4; ++i) { const int kk = tk + 16 * i;
#pragma unroll
        for (int j = 0; j < 4; ++j) tile[kk * 129 + tn4 + j] = v[i][j]; }
    __syncthreads();
    const int wn = tid >> 2, wk = tid & 3;
    float f[16];
#pragma unroll
    for (int j = 0; j < 16; ++j) f[j] = tile[(wk * 16 + j) * 129 + wn];
    u32x4 w0 = {cvt_pk_bf16(f[0], f[1]), cvt_pk_bf16(f[2], f[3]), cvt_pk_bf16(f[4], f[5]), cvt_pk_bf16(f[6], f[7])};
    u32x4 w1 = {cvt_pk_bf16(f[8], f[9]), cvt_pk_bf16(f[10], f[11]), cvt_pk_bf16(f[12], f[13]), cvt_pk_bf16(f[14], f[15])};
    GA u32x4* dp = (GA u32x4*)(dst + (size_t)(n0 + wn) * DM + k0 + wk * 16);
    dp[0] = w0; dp[1] = w1;
    __syncthreads();
}
__device__ __forceinline__ unsigned cvt4_fp8(float a, float b, float c, float d) {
    unsigned w = 0u; w = __builtin_amdgcn_cvt_pk_fp8_f32(a, b, w, false); w = __builtin_amdgcn_cvt_pk_fp8_f32(c, d, w, true); return w;
}
__device__ __forceinline__ void transpose_tile8(const GA float* src, int ld, int srccol4, const GA float* ksc, GA unsigned char* dst, int k0, int n0, LAS float* tile) {
    const int tid = tid_l(), tk = tid >> 5, tn4 = (tid & 31) * 4;
    f32x4 v[4];
#pragma unroll
    for (int i = 0; i < 4; ++i) { const int kk = tk + 16 * i; v[i] = *(const GA f32x4*)(src + (size_t)(k0 + kk) * ld + srccol4) * (ksc[k0 + kk] * W8SCALE); }
#pragma unroll
    for (int i = 0; i < 4; ++i) { const int kk = tk + 16 * i;
#pragma unroll
        for (int j = 0; j < 4; ++j) tile[kk * 129 + tn4 + j] = v[i][j]; }
    __syncthreads();
    const int wn = tid >> 2, wk = tid & 3;
    float f[16];
#pragma unroll
    for (int j = 0; j < 16; ++j) f[j] = tile[(wk * 16 + j) * 129 + wn];
    u32x4 w = {cvt4_fp8(f[0], f[1], f[2], f[3]), cvt4_fp8(f[4], f[5], f[6], f[7]), cvt4_fp8(f[8], f[9], f[10], f[11]), cvt4_fp8(f[12], f[13], f[14], f[15])};
    *(GA u32x4*)(dst + (size_t)(n0 + wn) * DM + k0 + wk * 16) = w;
    __syncthreads();
}
__device__ __forceinline__ int t5_bucket(int d) {
    if (d < 16) return d;
    const int th[15] = {22, 30, 40, 54, 73, 99, 134, 182, 246, 332, 450, 609, 825, 1117, 1513};
    int b = 16;
#pragma unroll
    for (int i = 0; i < 15; ++i) b += (d >= th[i]) ? 1 : 0;
    return b;
}
constexpr int WT_TW = 32 * 38, WT_TG = 32 * 100, WT_TB = 32 * 16, WT_TL = WT_TW + WT_TG + 2 * WT_TB;
__device__ __forceinline__ void weight_tile(const Frame& F, int l, int r, LAS float* tile) {
    const int tid = tid_l();
    if (r < WT_TW) { const int nt = r % 38, kt = r / 38; const int n = nt * 128 + (tid & 31) * 4;
        transpose_tile(F.w_in + (size_t)l * DM * NIN, NIN, win_src_col(n), F.norm_w + l * DM, F.WinT + (size_t)l * NINP * DM, kt * 64, nt * 128, tile); }
    else if (r < WT_TW + WT_TG) { const int q = r - WT_TW, nt = q % 100, kt = q / 100;
        transpose_tile8(F.w_in + (size_t)l * DM * NIN, NIN, win8_src_col(nt * 128 + (tid & 31) * 4), F.norm_w + l * DM, F.ws + WS_WG8 + (size_t)l * N8 * DM, kt * 64, nt * 128, tile); }
    else if (r < WT_TW + WT_TG + WT_TB) { const int q = r - WT_TW - WT_TG, nt = q % 16, kt = q / 16;
        transpose_tile(F.w_branch + (size_t)l * DM * DM, DM, nt * 128 + (tid & 31) * 4, (const GA float*)nullptr, F.WbrT + (size_t)l * DM * DM, kt * 64, nt * 128, tile); }
    else { const int q = r - WT_TW - WT_TG - WT_TB, nt = q % 16, kt = q / 16;
        transpose_tile(F.w_out + (size_t)l * DM * DM, DM, nt * 128 + (tid & 31) * 4, (const GA float*)nullptr, F.WoutT + (size_t)l * DM * DM, kt * 64, nt * 128, tile); }
}
__device__ __forceinline__ void p0_prologue(const Frame& F) {
    const int tid = tid_l(), lane = tid & 63, wave = tid >> 6, G = gridDim.x, bid = blockIdx.x;
    LAS float* tile = (LAS float*)F.lds;
    for (int j = bid; j < WT_TW + WT_TG; j += G) weight_tile(F, 0, j, tile);
    for (int row = bid * 8 + wave; row < MT; row += G * 8) {
        const GA float* xr = F.x + (size_t)row * DM; float ss = 0.f;
#pragma unroll
        for (int i = 0; i < 8; ++i) { const int c = (i * 64 + lane) * 4; const f32x4 v = *(const GA f32x4*)(xr + c);
            ss += v[0] * v[0] + v[1] * v[1] + v[2] * v[2] + v[3] * v[3];
            u32x2 w = {cvt_pk_bf16(v[0], v[1]), cvt_pk_bf16(v[2], v[3])}; *(GA u32x2*)(F.xb + (size_t)row * DM + c) = w;
            *(GA unsigned*)(F.ws + WS_XQ + (size_t)row * DM + c) = cvt4_fp8(v[0], v[1], v[2], v[3]); }
        ss = wave_sum(ss);
        if (lane == 0) F.sc[row] = __builtin_amdgcn_rsqf(ss * (1.0f / DM) + RMS_EPS);
    }
    if (bid == 0 && tid < DEPTH * 128) { const int l = tid >> 7, i = tid & 127;
        const float lam_init = 0.8f - 0.6f * expf(-0.3f * (float)l);
        F.DP[l * 256 + 128 + i] = F.subln[l * 128 + i] * (1.0f - lam_init);
        if (i == 0) { float s1 = 0.f, s2 = 0.f;
            for (int k = 0; k < 64; ++k) { s1 = fmaf(F.lq1[l * 64 + k], F.lk1[l * 64 + k], s1); s2 = fmaf(F.lq2[l * 64 + k], F.lk2[l * 64 + k], s2); }
            F.DP[l * 256] = expf(s1) - expf(s2) + lam_init; F.DP[l * 256 + 1] = 1.0f - lam_init; } }
    for (int i = bid * 512 + tid; i < 12 * SEQ; i += G * 512) { const int hd = i / SEQ, d = i % SEQ; F.tb[i] = F.rel_bias[t5_bucket(d) * 12 + hd] * LOG2E; }
}

struct EpiIn {
    static constexpr bool PERM = true, AFTER_DRAIN = false, MIDK = false, FP8 = false;
    GA unsigned char* ws;
    template <int KIND>
    __device__ __forceinline__ void body(const f32x4 (&acc)[2][2][4][2], int row0_, int cl_, int fq, GA bf16_t* base, int ldc, float qscale, int headbase) const {
        int row0 = row0_, cl = cl_; asm volatile("" : "+v"(row0), "+v"(cl));
        const GA float* rsarr = (const GA float*)(ws + WS_SC);
        float scv_[2][4];
#pragma unroll
        for (int ai = 0; ai < 2; ++ai)
#pragma unroll
            for (int m = 0; m < 4; ++m) scv_[ai][m] = rsarr[row0 + ai * 128 + m * 16];
#pragma unroll
        for (int ai = 0; ai < 2; ++ai)
#pragma unroll
            for (int m = 0; m < 4; ++m) scv_[ai][m] *= qscale;
#pragma unroll
        for (int ai = 0; ai < 2; ++ai)
#pragma unroll
            for (int m = 0; m < 4; ++m) {
                const int r = row0 + ai * 128 + m * 16;
                const float sc = scv_[ai][m];
#pragma unroll
                for (int bj = 0; bj < 2; ++bj) {
                    f32x4 v0 = acc[ai][bj][m][0] * sc, v1 = acc[ai][bj][m][1] * sc;
                    if (KIND == 1) {
                        const float k_ = sc * (-LOG2E);
#pragma unroll
                        for (int j = 0; j < 4; ++j) { v0[j] = __builtin_amdgcn_rcpf(ex2(fmaf(acc[ai][bj][m][0][j], k_, -8.0f)) + 0.00390625f); v1[j] = __builtin_amdgcn_rcpf(ex2(fmaf(acc[ai][bj][m][1][j], k_, -8.0f)) + 0.00390625f); }
                    }
                    if (KIND == 0) {
#pragma unroll
                        for (int j = 0; j < 4; ++j) { v0[j] = v0[j] * sigmoidf_(v0[j]); v1[j] = v1[j] * sigmoidf_(v1[j]); }
                    }
                    if (KIND == 4) {
                        if (bj == 0) {
                            if (cl < 64) { u32x4 w = {cvt_pk_bf16(v0[0], v0[1]), cvt_pk_bf16(v0[2], v0[3]), cvt_pk_bf16(v1[0], v1[1]), cvt_pk_bf16(v1[2], v1[3])};
                                *(GA u32x4*)((GA bf16_t*)(ws + WS_IK) + (size_t)(r >> 5) * 2048 + (cl >> 4) * 512 + (((cl >> 3) & 1) * 32 + (r & 31)) * 8) = w; }
                            else if (cl < 80) { GA float* iw = (GA float*)(ws + WS_IW) + (size_t)r * 16 + (cl - 64); *(GA f32x4*)iw = v0; *(GA f32x4*)(iw + 4) = v1; }
                            else if (cl == 80) { *(GA f32x4*)((GA float*)(ws + WS_FF) + (size_t)r * 4) = v0; }
                        }
                    } else {
                        if (KIND == 1) {
                            u32x2 w;
                            { const unsigned a = __builtin_amdgcn_cvt_pk_u8_f32(v0[0], 0, 0u), b = __builtin_amdgcn_cvt_pk_u8_f32(v0[1], 1, a), c = __builtin_amdgcn_cvt_pk_u8_f32(v0[2], 2, b); w[0] = __builtin_amdgcn_cvt_pk_u8_f32(v0[3], 3, c); }
                            { const unsigned a = __builtin_amdgcn_cvt_pk_u8_f32(v1[0], 0, 0u), b = __builtin_amdgcn_cvt_pk_u8_f32(v1[1], 1, a), c = __builtin_amdgcn_cvt_pk_u8_f32(v1[2], 2, b); w[1] = __builtin_amdgcn_cvt_pk_u8_f32(v1[3], 3, c); }
                            *(GA u32x2*)((GA unsigned char*)base + (size_t)r * ldc + bj * 128 + cl) = w;
                            continue;
                        }
                        GA bf16_t* dst;
                        if (KIND == 2) { const int b = r >> 13, s = r & (SEQ - 1); dst = base + ((size_t)(b * 4 + headbase + bj) * SEQ + s) * 128 + cl; }
                        else if (KIND == 3) { const int c = headbase + bj * 128 + cl, head = c >> 6, dim = c & 63;
                            dst = base + (size_t)(r >> 1) * 2048 + (dim >> 4) * 512 + ((dim >> 3) & 1) * 256 + ((head & 3) + 4 * (r & 1) + 8 * (head >> 2)) * 8; }
                        else dst = base + (size_t)r * ldc + bj * 128 + cl;
                        u32x4 w = {cvt_pk_bf16(v0[0], v0[1]), cvt_pk_bf16(v0[2], v0[3]), cvt_pk_bf16(v1[0], v1[1]), cvt_pk_bf16(v1[2], v1[3])};
                        *(GA u32x4*)dst = w;
                    }
                }
            }
    }
    __device__ __forceinline__ void operator()(const f32x4 (&acc)[2][2][4][2], const pg8::Unit& u, int wr, int wc, int fr, int fq) const {
        const int row0 = u.pm * 256 + wr * 64 + fr, pn = u.pn, cl = wc * 32 + 8 * fq;
        if (pn < 8) body<0>(acc, row0, cl, fq, (GA bf16_t*)(ws + WS_ZS) + pn * 256, DM, 1.f, 0);
        else if (pn < 12) body<3>(acc, row0, cl, fq, (GA bf16_t*)(ws + WS_IQ), 1024, 1.f, (pn - 8) * 256);
        else if (pn < 18) { const int t6 = pn - 12, which = t6 >> 1;
            body<2>(acc, row0, cl, fq, (GA bf16_t*)(ws + WS_QKV) + (size_t)(2 * 3 + which) * QS, 0, (which == 0) ? QSC64 : 1.f, (t6 & 1) * 2); }
        else body<4>(acc, row0, cl, fq, (GA bf16_t*)nullptr, 0, 1.f, 0);
    }
};

struct EpiGate {
    static constexpr bool PERM = true, AFTER_DRAIN = false, MIDK = false, FP8 = true;
    GA unsigned char* ws;
    __device__ __forceinline__ void operator()(const f32x4 (&acc)[2][2][4][2], const pg8::Unit& u, int wr, int wc, int fr, int fq) const {
        const int row0 = u.pm * 256 + wr * 64 + fr, cl = wc * 32 + 8 * fq, pn = u.pn;
        EpiIn e{ws};
        if (pn < 32) e.body<1>(acc, row0, cl, fq, (GA bf16_t*)(ws + WS_G + pn * 256), 8192, 1.0f / W8SCALE, 0);
        else { const int q = pn - 32, mixer = (q < 6) ? 0 : (q < 12 ? 1 : 3), t6 = q % 6, which = t6 >> 1;
            e.body<2>(acc, row0, cl, fq, (GA bf16_t*)(ws + WS_QKV) + (size_t)(mixer * 3 + which) * QS, 0, ((which == 0) ? QSC128 : 1.f) * (1.0f / W8SCALE), (t6 & 1) * 2); }
    }
};

__device__ __forceinline__ void fox_scan(const Frame& F, int layer, int seqid) {
    const int tid = tid_l(), lane = tid & 63, wave = tid >> 6, b = seqid >> 2, h = seqid & 3;
    LAS float* sm = (LAS float*)F.lds;
    const float bias = F.fox_b[layer * 4 + h];
    float v[16]; float run = 0.f;
#pragma unroll
    for (int i = 0; i < 16; ++i) { const int s = tid * 16 + i; const float x = F.FF[(size_t)(b * SEQ + s) * 4 + h] + bias;
        const float ls = fminf(x, 0.f) - log1pf(expf(-fabsf(x))); run += ls; v[i] = run; }
    float incl = run;
#pragma unroll
    for (int o = 1; o < 64; o <<= 1) { const float t = __shfl_up(incl, o); if (lane >= o) incl += t; }
    if (lane == 63) sm[wave] = incl;
    __syncthreads();
    float woff = 0.f;
    for (int w = 0; w < wave; ++w) woff += sm[w];
    const float excl = woff + incl - run;
#pragma unroll
    for (int i = 0; i < 16; ++i) F.cum[(size_t)(b * 4 + h) * SEQ + tid * 16 + i] = (excl + v[i]) * LOG2E;
    __syncthreads();
}
__device__ __forceinline__ void fox_kmax(const Frame& F, int layer) {
    const int tid = tid_l(), lane = tid & 63, wave = tid >> 6, G = gridDim.x, bid = blockIdx.x;
    const GA bf16_t* Kf = F.QKV + (size_t)(1 * 3 + 1) * QS;
    LAS float* sm = (LAS float*)F.lds;
    const int bh = bid & 7, part = bid >> 3, nparts = (G + 7 - bh) / 8;
    float mx = 0.f;
    int r4 = part * 8 + wave; const int r4s = nparts * 8;
    { u32x4 wv[8];
#pragma unroll
      for (int k = 0; k < 8; ++k) { const int rr = r4 + k * r4s; wv[k] = (u32x4){0u, 0u, 0u, 0u}; if (rr < SEQ / 4) wv[k] = *(const GA u32x4*)(Kf + ((size_t)bh * SEQ + rr * 4 + (lane >> 4)) * 128 + (lane & 15) * 8); }
#pragma unroll
      for (int k = 0; k < 8; ++k) { float ss = 0.f;
#pragma unroll
          for (int j = 0; j < 4; ++j) { const float a = bf_lo(wv[k][j]), b = bf_hi(wv[k][j]); ss = fmaf(a, a, ss); ss = fmaf(b, b, ss); }
          ss += __shfl_xor(ss, 1); ss += __shfl_xor(ss, 2); ss += __shfl_xor(ss, 4); ss += __shfl_xor(ss, 8);
          mx = fmaxf(mx, ss); }
      r4 += 8 * r4s; }
    for (; r4 < SEQ / 4; r4 += r4s) {
        const u32x4 w = *(const GA u32x4*)(Kf + ((size_t)bh * SEQ + r4 * 4 + (lane >> 4)) * 128 + (lane & 15) * 8); float ss = 0.f;
#pragma unroll
        for (int j = 0; j < 4; ++j) { const float a = bf_lo(w[j]), b = bf_hi(w[j]); ss = fmaf(a, a, ss); ss = fmaf(b, b, ss); }
        ss += __shfl_xor(ss, 1); ss += __shfl_xor(ss, 2); ss += __shfl_xor(ss, 4); ss += __shfl_xor(ss, 8);
        mx = fmaxf(mx, ss); }
#pragma unroll
    for (int o = 32; o > 0; o >>= 1) mx = fmaxf(mx, __shfl_xor(mx, o));
    __syncthreads();
    if (lane == 0) sm[wave] = mx;
    __syncthreads();
    if (tid == 0) { float m8 = sm[0];
#pragma unroll
        for (int w = 1; w < 8; ++w) m8 = fmaxf(m8, sm[w]);
        __hip_atomic_fetch_max(F.ctl + CW_KM + layer * 8 + bh, __float_as_uint(m8), __ATOMIC_RELAXED, __HIP_MEMORY_SCOPE_AGENT); }
    __syncthreads();
}
__device__ __forceinline__ void idx_unit(const Frame& F, int unit) {
    const int b = unit / 576; int id = unit % 576; int g = 0;
    while (8 * (g + 1) * (g + 2) <= id) ++g;
    const int rem = id - 8 * g * (g + 1), qb = 16 * g + rem / (g + 1), kc = rem % (g + 1);
    const int tid = tid_l(), lane = tid & 63, wave = __builtin_amdgcn_readfirstlane(tid >> 6), n32 = lane & 31, hi = lane >> 5;
    const int tq0 = qb * 64 + wave * 8;
    const int qa = (n32 >> 2) & 1, ha = (n32 & 3) + 4 * (n32 >> 3);
    bf16x8 Af[4][4]; float wr_[4][16];
#pragma unroll
    for (int p = 0; p < 4; ++p) {
        const GA bf16_t* qp = F.IQ + (size_t)(b * SEQ + tq0 + 2 * p + qa) * 1024 + ha * 64 + hi * 8;
#pragma unroll
        for (int ks = 0; ks < 4; ++ks) Af[p][ks] = *(const GA bf16x8*)(qp + ks * 16);
        const GA float* wp = F.IW + (size_t)(b * SEQ + tq0 + 2 * p + hi) * 16;
#pragma unroll
        for (int q4 = 0; q4 < 4; ++q4) { const f32x4 w4 = *(const GA f32x4*)(wp + 4 * q4); wr_[p][4 * q4] = w4[0]; wr_[p][4 * q4 + 1] = w4[1]; wr_[p][4 * q4 + 2] = w4[2]; wr_[p][4 * q4 + 3] = w4[3]; }
    }
    const int smax = tq0 + 7;
    int nj = (smax - kc * 1024) / 32 + 1; nj = nj > 32 ? 32 : nj;
    const GA bf16_t* kp0 = F.IK + (size_t)(b * SEQ + kc * 1024 + n32) * 64 + hi * 8;
    GA float* sp0 = F.sc + ((size_t)(b * SEQ + tq0 + hi)) * SEQ + kc * 1024 + n32;
    bf16x8 Bn[4];
#pragma unroll
    for (int ks = 0; ks < 4; ++ks) Bn[ks] = *(const GA bf16x8*)(kp0 + ks * 16);
    for (int j = 0; j < nj; ++j) {
        bf16x8 Bf[4];
#pragma unroll
        for (int ks = 0; ks < 4; ++ks) Bf[ks] = Bn[ks];
        if (j + 1 < nj) {
#pragma unroll
            for (int ks = 0; ks < 4; ++ks) Bn[ks] = *(const GA bf16x8*)(kp0 + (size_t)(j + 1) * 32 * 64 + ks * 16);
        }
#pragma unroll
        for (int p = 0; p < 4; ++p) {
            f32x16 c = {};
#pragma unroll
            for (int ks = 0; ks < 4; ++ks) c = __builtin_amdgcn_mfma_f32_32x32x16_bf16(Af[p][ks], Bf[ks], c, 0, 0, 0);
            float sc = 0.f;
#pragma unroll
            for (int r = 0; r < 16; ++r) sc = fmaf(wr_[p][r], fmaxf(c[r], 0.f), sc);
            sp0[(size_t)(2 * p) * SEQ + j * 32] = sc;
        }
    }
}

__device__ __forceinline__ unsigned sel_key(float f) { const unsigned u = __float_as_uint(f == 0.f ? 0.f : f); return (u >> 31) ? ~u : (u | 0x80000000u); }
__device__ __forceinline__ int wave_sum_i(int v) {
#pragma unroll
    for (int o = 32; o > 0; o >>= 1) v += __shfl_xor(v, o);
    return v;
}
__device__ __forceinline__ void select_row(const Frame& F, int row_) {
    const int row = __builtin_amdgcn_readfirstlane(row_);
    const int lane = tid_l() & 63, t = row & (SEQ - 1);
    GA u64* mrow = F.mask + (size_t)row * 128;
    if (t < 256) {
#pragma unroll
        for (int half = 0; half < 2; ++half) { const int j = half * 64 + lane; const int lo = j * 64; u64 w = 0ull;
            if (t >= lo + 63) w = ~0ull; else if (t >= lo) w = (~0ull) >> (63 - (t - lo));
            mrow[j] = w; }
        return;
    }
    const GA float* srow = F.sc + (size_t)row * SEQ + lane;
    const int nj = (t >> 6) + 1;
    unsigned key[128];
#pragma unroll
    for (int jj = 0; jj < 4; ++jj) {
        if (jj * 32 < nj) {
#pragma unroll
            for (int j = jj * 32; j < jj * 32 + 32; ++j) key[j] = __float_as_uint(srow[j * 64]);
        }
    }
#pragma unroll
    for (int jj = 0; jj < 4; ++jj) {
        if (jj * 32 < nj) {
#pragma unroll
            for (int j = jj * 32; j < jj * 32 + 32; ++j) key[j] = (j * 64 + lane <= t) ? sel_key(__uint_as_float(key[j])) : 0u;
        } else {
#pragma unroll
            for (int j = jj * 32; j < jj * 32 + 32; ++j) key[j] = 0u;
        }
    }
#define CNT8(j0) do { u64 b0 = __ballot(key[(j0)] >= cand), b1 = __ballot(key[(j0) + 1] >= cand), b2 = __ballot(key[(j0) + 2] >= cand), b3 = __ballot(key[(j0) + 3] >= cand), \
        b4 = __ballot(key[(j0) + 4] >= cand), b5 = __ballot(key[(j0) + 5] >= cand), b6 = __ballot(key[(j0) + 6] >= cand), b7 = __ballot(key[(j0) + 7] >= cand); \
        asm volatile("" : "+s"(b0), "+s"(b1), "+s"(b2), "+s"(b3), "+s"(b4), "+s"(b5), "+s"(b6), "+s"(b7)); \
        c += (__popcll(b0) + __popcll(b1)) + (__popcll(b2) + __popcll(b3)) + (__popcll(b4) + __popcll(b5)) + (__popcll(b6) + __popcll(b7)); } while (0)
#define COUNT_GE() do { c = 0; _Pragma("unroll") for (int jj = 0; jj < 4; ++jj) { if (jj * 32 < nj) { CNT8(jj * 32); CNT8(jj * 32 + 8); CNT8(jj * 32 + 16); CNT8(jj * 32 + 24); } } } while (0)
    unsigned mx = 0u;
#pragma unroll
    for (int j = 0; j < 128; ++j) mx = key[j] > mx ? key[j] : mx;
#pragma unroll
    for (int o = 32; o > 0; o >>= 1) { const unsigned t2 = (unsigned)__shfl_xor((int)mx, o); mx = t2 > mx ? t2 : mx; }
    unsigned prefix = 0u; int cge = 1 << 30, c, bit = 31;
    { const unsigned e9 = mx >> 23;
      for (unsigned k = 0; k < 6u && k <= e9; ++k) { const unsigned cand = (e9 - k) << 23; COUNT_GE();
          if (c >= 256) { prefix = cand; cge = c; bit = 22; break; } } }
    if (cge != 256) {
        for (; bit >= 0; --bit) {
            const unsigned cand = prefix | (1u << bit); COUNT_GE();
            if (c >= 256) { prefix = cand; cge = c; if (c == 256) break; }
        }
    }
#undef CNT8
#undef COUNT_GE
    if (cge == 256) {
        unsigned w0l = 0u, w0h = 0u, w1l = 0u, w1h = 0u;
#pragma unroll
        for (int j = 0; j < 64; ++j) { const u64 word = __ballot(key[j] >= prefix);
            asm volatile("s_nop 1\n\tv_writelane_b32 %0, %1, %2" : "+v"(w0l) : "s"((unsigned)word), "n"(j)); asm volatile("v_writelane_b32 %0, %1, %2" : "+v"(w0h) : "s"((unsigned)(word >> 32)), "n"(j)); }
        if (nj > 64) {
#pragma unroll
            for (int j = 64; j < 128; ++j) { const u64 word = __ballot(key[j] >= prefix);
                asm volatile("s_nop 1\n\tv_writelane_b32 %0, %1, %2" : "+v"(w1l) : "s"((unsigned)word), "n"(j - 64)); asm volatile("v_writelane_b32 %0, %1, %2" : "+v"(w1h) : "s"((unsigned)(word >> 32)), "n"(j - 64)); }
        }
        mrow[lane] = ((u64)w0h << 32) | w0l; mrow[64 + lane] = ((u64)w1h << 32) | w1l;
    } else {
        int cgt = 0;
        for (int j = 0; j < nj; ++j) { const int s = j * 64 + lane; const float v_ = srow[j * 64]; const unsigned k = (s <= t) ? sel_key(v_) : 0u; cgt += __popcll(__ballot(k > prefix)); }
        int need = 256 - cgt;
        for (int j = 0; j < nj; ++j) { const int s = j * 64 + lane; const float v_ = srow[j * 64]; const unsigned k = (s <= t) ? sel_key(v_) : 0u;
            u64 word = __ballot(k > prefix); u64 tm = __ballot(k == prefix);
            if (tm != 0ull && need > 0) { const int c = __popcll(tm);
                if (c <= need) { word |= tm; need -= c; }
                else { u64 selb = 0ull; for (int i = 0; i < need; ++i) { const u64 low = tm & (~tm + 1ull); selb |= low; tm ^= low; } word |= selb; need = 0; } }
            if (lane == 0) mrow[j] = word; }
        for (int j = nj + lane; j < 128; j += 64) mrow[j] = 0ull;
    }
}

#if defined(TPROBE)
#define IS_T0(k) do { if ((k) == TPROBE) is_t0 = __builtin_amdgcn_s_memrealtime(); } while (0)
#define IS_T1(k) do { if ((k) == TPROBE) tpacc += __builtin_amdgcn_s_memrealtime() - is_t0; } while (0)
#else
#define IS_T0(k) do { } while (0)
#define IS_T1(k) do { } while (0)
#endif
__device__ __forceinline__ int idxsel_unit(const Frame& F, int unit, unsigned long long& tpacc, GA unsigned* qctr) {
    unsigned long long is_t0 = 0ull; (void)is_t0;
    const int b = unit & 1, t0 = (SEQ / 8 - 1 - (unit >> 1)) * 8;
    const int tid = tid_l(), lane = tid & 63, wave = __builtin_amdgcn_readfirstlane(tid >> 6), n32 = lane & 31, hi = lane >> 5;
    LAS unsigned short* S = (LAS unsigned short*)F.lds;
    IS_T0(30);
    {
        const int qa = (n32 >> 2) & 1, ha = (n32 & 3) + 4 * (n32 >> 3);
        typedef float f32x2_ __attribute__((ext_vector_type(2)));
        bf16x8 Af[4][4]; f32x2_ wr2[4][8];
#pragma unroll
        for (int p = 0; p < 4; ++p) {
            const GA bf16_t* qp = F.IQ + (size_t)((b * SEQ + t0) / 2 + p) * 2048 + lane * 8;
#pragma unroll
            for (int ks = 0; ks < 4; ++ks) Af[p][ks] = *(const GA bf16x8*)(qp + ks * 512);
            const GA float* wp = F.IW + (size_t)(b * SEQ + t0 + 2 * p + hi) * 16;
#pragma unroll
            for (int q4 = 0; q4 < 4; ++q4) { const f32x4 w4 = *(const GA f32x4*)(wp + 4 * q4); wr2[p][2 * q4] = (f32x2_){w4[0], w4[1]}; wr2[p][2 * q4 + 1] = (f32x2_){w4[2], w4[3]}; }
        }
        asm volatile("s_waitcnt vmcnt(0)" ::: "memory"); IS_T1(30); IS_T0(31);
        const int ntile = (t0 + 7) / 32 + 1;
        const GA bf16_t* kp0 = F.IK + (size_t)b * SEQ * 64 + lane * 8;
        bf16x8 Bn[4];
        if (wave < ntile) {
#pragma unroll
            for (int ks = 0; ks < 4; ++ks) Bn[ks] = *(const GA bf16x8*)(kp0 + (size_t)wave * 2048 + ks * 512);
        }
        for (int j = wave; j < ntile; j += 8) {
            bf16x8 Bf[4];
#pragma unroll
            for (int ks = 0; ks < 4; ++ks) Bf[ks] = Bn[ks];
            if (j + 8 < ntile) {
#pragma unroll
                for (int ks = 0; ks < 4; ++ks) Bn[ks] = *(const GA bf16x8*)(kp0 + (size_t)(j + 8) * 2048 + ks * 512);
            }
            const int s = j * 32 + n32;
            LAS unsigned short* sp = S + ((s >> 7) * 64 + (s & 63)) * 2 + ((s >> 6) & 1);
#define IDX_MM(C, p) do { C = f32x16{}; _Pragma("unroll") for (int ks = 0; ks < 4; ++ks) C = __builtin_amdgcn_mfma_f32_32x32x16_bf16(Af[p][ks], Bf[ks], C, 0, 0, 0); } while (0)
#define IDX_RED(C, p) do { f32x2_ s2 = {0.f, 0.f}; _Pragma("unroll") for (int r2 = 0; r2 < 8; ++r2) { \
                    const float f0 = C[2 * r2], f1 = C[2 * r2 + 1]; const int i0 = __float_as_int(f0), i1 = __float_as_int(f1); \
                    const f32x2_ x2 = {__int_as_float(i0 > 0 ? i0 : 0), __int_as_float(i1 > 0 ? i1 : 0)}; s2 = __builtin_elementwise_fma(wr2[p][r2], x2, s2); } \
                float sc = s2[0] + s2[1]; sc = fminf(fmaxf(sc, -65504.f), 65504.f);       \
                sp[(2 * (p) + hi) * 8192] = __builtin_bit_cast(unsigned short, (_Float16)sc); } while (0)
            f32x16 c0, c1;
            IDX_MM(c0, 0); IDX_MM(c1, 1); __builtin_amdgcn_sched_barrier(0);
            IDX_RED(c0, 0); __builtin_amdgcn_sched_barrier(0); IDX_MM(c0, 2); __builtin_amdgcn_sched_barrier(0);
            IDX_RED(c1, 1); __builtin_amdgcn_sched_barrier(0); IDX_MM(c1, 3); __builtin_amdgcn_sched_barrier(0);
            IDX_RED(c0, 2); IDX_RED(c1, 3);
#undef IDX_MM
#undef IDX_RED
        }
    }
    IS_T1(31); IS_T0(32);
    __syncthreads();
    IS_T1(32);
    unsigned pf = 0u;
    { int z = 0; asm volatile("" : "+v"(z));
      if (tid == 0) pf = __hip_atomic_fetch_add(qctr + z, 1u, __ATOMIC_RELAXED, __HIP_MEMORY_SCOPE_AGENT); }
    {
        const int t = t0 + wave;
        GA u64* mrow = F.mask + (size_t)(b * SEQ + t) * 128;
        if (t < 256) {
#pragma unroll
            for (int half = 0; half < 2; ++half) { const int jw = half * 64 + lane; const int lo = jw * 64; u64 w = 0ull;
                if (t >= lo + 63) w = ~0ull; else if (t >= lo) w = (~0ull) >> (63 - (t - lo));
                mrow[jw] = w; }
        } else {
            const LAS unsigned* row = (const LAS unsigned*)(S + wave * 8192) + lane;
            const int nj = (t >> 7) + 1;
            unsigned kw[64];
            IS_T0(33);
            { LAS unsigned short* rw = S + wave * 8192; const int sa = 128 * (nj - 1) + lane, sb = sa + 64;
              if (sa > t) rw[((sa >> 7) * 64 + (sa & 63)) * 2] = (unsigned short)0xffffu;
              if (sb > t) rw[((sb >> 7) * 64 + (sb & 63)) * 2 + 1] = (unsigned short)0xffffu;
              asm volatile("" ::: "memory"); }
            const unsigned sh15 = 0x000f000fu;
#pragma unroll
            for (int jj = 0; jj < 4; ++jj) {
                if (jj * 16 < nj) {
#pragma unroll
                    for (int j = jj * 16; j < jj * 16 + 16; ++j) { unsigned w = row[j * 64]; unsigned sg;
                        asm("v_pk_ashrrev_i16 %0, %1, %2" : "=v"(sg) : "v"(sh15), "v"(w));
                        w ^= (sg | 0x80008000u);
                        kw[j] = (j < nj) ? w : 0u; }
                } else {
#pragma unroll
                    for (int j = jj * 16; j < jj * 16 + 16; ++j) kw[j] = 0u;
                }
            }
#define CNT1(j) asm volatile("v_pk_sub_u16 %1, %2, %3 clamp\n\tv_pk_min_u16 %1, %1, %4\n\tv_pk_add_u16 %0, %0, %1" : "+v"(acc2), "=&v"(tmp2) : "v"(kw[(j)]), "v"(cm2), "v"(one2))
#define COUNT_GE16(cand) do { const unsigned cm2 = (((cand) - 1u) & 0xffffu) * 0x00010001u, one2 = 0x00010001u; unsigned acc2 = 0u, tmp2; \
            _Pragma("unroll") for (int jj = 0; jj < 4; ++jj) { if (jj * 16 < nj) { _Pragma("unroll") for (int j = jj * 16; j < jj * 16 + 16; ++j) CNT1(j); } } \
            int v_ = (int)((acc2 & 0xffffu) + (acc2 >> 16));                                                                                            \
            v_ += __builtin_amdgcn_update_dpp(0, v_, 0x111, 0xf, 0xf, true); v_ += __builtin_amdgcn_update_dpp(0, v_, 0x112, 0xf, 0xf, true);            \
            v_ += __builtin_amdgcn_update_dpp(0, v_, 0x114, 0xf, 0xf, true); v_ += __builtin_amdgcn_update_dpp(0, v_, 0x118, 0xf, 0xf, true);            \
            v_ += __builtin_amdgcn_update_dpp(0, v_, 0x142, 0xa, 0xf, true); v_ += __builtin_amdgcn_update_dpp(0, v_, 0x143, 0xc, 0xf, true);            \
            c = __builtin_amdgcn_readlane(v_, 63); } while (0)
            IS_T1(33); IS_T0(34);
            unsigned prefix = 0u; int cge = 1 << 30, c;
            unsigned lo = 0u, hi; int clo = t + 1, chi = 0;
            { unsigned mx = 0u;
#pragma unroll
              for (int j = 0; j < 64; ++j) asm("v_pk_max_u16 %0, %0, %1" : "+v"(mx) : "v"(kw[j]));
              mx = (mx & 0xffffu) > (mx >> 16) ? (mx & 0xffffu) : (mx >> 16);
#pragma unroll
              for (int o = 32; o > 0; o >>= 1) { const unsigned t2 = (unsigned)__shfl_xor((int)mx, o); mx = t2 > mx ? t2 : mx; }
              const unsigned e6 = (unsigned)__builtin_amdgcn_readfirstlane((int)mx) >> 10;
              hi = (e6 + 1u) << 10;
              for (unsigned k = 0; k < 5u && k < e6; ++k) { const unsigned cand = (e6 - k) << 10; COUNT_GE16(cand);
                  if (c >= 256) { lo = cand; clo = c; break; } else { hi = cand; chi = c; } } }
            for (int it = 0; clo != 256 && hi - lo > 1u; ++it) {
                const unsigned span = hi - lo; unsigned cand;
                if (it >= 3 && (it & 1)) cand = lo + (span >> 1);
                else { const float frac = (float)(256 - chi) / (float)(clo - chi); unsigned d = (unsigned)(frac * (float)span + 0.5f); d = d < 1u ? 1u : (d > span - 1u ? span - 1u : d); cand = hi - d; }
                COUNT_GE16(cand);
                if (c >= 256) { lo = cand; clo = c; } else { hi = cand; chi = c; }
            }
            prefix = lo; cge = clo;
#undef CNT1
#undef COUNT_GE16
            IS_T1(34); IS_T0(35);
            unsigned w0l = 0u, w0h = 0u, w1l = 0u, w1h = 0u;
            const unsigned short pl16 = (unsigned short)prefix; const unsigned ph16 = prefix << 16;
            if (cge == 256) {
#pragma unroll
                for (int j = 0; j < 32; ++j) { const u64 wa = __ballot((unsigned short)kw[j] >= pl16), wb = __ballot(kw[j] >= ph16);
                    asm volatile("s_nop 1\n\tv_writelane_b32 %0, %1, %2" : "+v"(w0l) : "s"((unsigned)wa), "n"(2 * j)); asm volatile("v_writelane_b32 %0, %1, %2" : "+v"(w0h) : "s"((unsigned)(wa >> 32)), "n"(2 * j));
                    asm volatile("s_nop 1\n\tv_writelane_b32 %0, %1, %2" : "+v"(w0l) : "s"((unsigned)wb), "n"(2 * j + 1)); asm volatile("v_writelane_b32 %0, %1, %2" : "+v"(w0h) : "s"((unsigned)(wb >> 32)), "n"(2 * j + 1)); }
                if (nj > 32) {
#pragma unroll
                    for (int j = 32; j < 64; ++j) { const u64 wa = __ballot((unsigned short)kw[j] >= pl16), wb = __ballot(kw[j] >= ph16);
                        asm volatile("s_nop 1\n\tv_writelane_b32 %0, %1, %2" : "+v"(w1l) : "s"((unsigned)wa), "n"(2 * j - 64)); asm volatile("v_writelane_b32 %0, %1, %2" : "+v"(w1h) : "s"((unsigned)(wa >> 32)), "n"(2 * j - 64));
                        asm volatile("s_nop 1\n\tv_writelane_b32 %0, %1, %2" : "+v"(w1l) : "s"((unsigned)wb), "n"(2 * j - 63)); asm volatile("v_writelane_b32 %0, %1, %2" : "+v"(w1h) : "s"((unsigned)(wb >> 32)), "n"(2 * j - 63)); }
                }
            } else {
                int need = 256 - chi;
#define TIE_WORD(GT, EQ, SETL, SETH, LN) do { u64 word = (GT); u64 tm = (EQ);                                                          \
                    if (tm != 0ull && need > 0) { const int ce = __popcll(tm);                                                       \
                        if (ce <= need) { word |= tm; need -= ce; }                                                                  \
                        else { u64 selb = 0ull; for (int i = 0; i < need; ++i) { const u64 low = tm & (~tm + 1ull); selb |= low; tm ^= low; } word |= selb; need = 0; } } \
                    asm volatile("s_nop 1\n\tv_writelane_b32 %0, %1, %2" : "+v"(SETL) : "s"((unsigned)word), "n"(LN)); asm volatile("v_writelane_b32 %0, %1, %2" : "+v"(SETH) : "s"((unsigned)(word >> 32)), "n"(LN)); } while (0)
#pragma unroll
                for (int j = 0; j < 32; ++j) {
                    TIE_WORD(__ballot((unsigned short)kw[j] > pl16), __ballot((unsigned short)kw[j] == pl16), w0l, w0h, 2 * j);
                    TIE_WORD(__ballot((kw[j] >> 16) > prefix), __ballot((kw[j] >> 16) == prefix), w0l, w0h, 2 * j + 1); }
#pragma unroll
                for (int j = 32; j < 64; ++j) {
                    TIE_WORD(__ballot((unsigned short)kw[j] > pl16), __ballot((unsigned short)kw[j] == pl16), w1l, w1h, 2 * j - 64);
                    TIE_WORD(__ballot((kw[j] >> 16) > prefix), __ballot((kw[j] >> 16) == prefix), w1l, w1h, 2 * j - 63); }
#undef TIE_WORD
            }
            mrow[lane] = ((u64)w0h << 32) | w0l; mrow[64 + lane] = ((u64)w1h << 32) | w1l;
            IS_T1(35);
        }
    }
    __syncthreads();
    if (tid == 0) F.misc[4] = pf;
    __syncthreads();
    return (int)F.misc[4];
}

namespace att {
typedef short s16x4 __attribute__((ext_vector_type(4)));
constexpr int D = 128, NW = 8, QBLK = 32, KVBLK = 64, QB = NW * QBLK;
constexpr int SHM_V = KVBLK * D * 2, SHM_K = KVBLK * D * 2;
constexpr int L_WS = 2 * SHM_V + 2 * SHM_K;
constexpr int L_AUX = L_WS + NW * 64 * 4;
constexpr int TB_PAD = 320, TB_N = TB_PAD + 1984;
constexpr int L_FLG = L_AUX + 8192 * 4;
constexpr int L_END = L_FLG + 64;
constexpr float SKIP_MARGIN = 40.f;
constexpr float THR2 = 11.5f;
constexpr int FAR_DIST = 1513;

#define KSWZ(row, colB) ((row) * 256 + ((colB) ^ (((row) & 7) << 4)))
#define SBAR() __builtin_amdgcn_sched_barrier(0)
__device__ __forceinline__ int v_st(int k, int c) { const int kk = (k & ~0xC) | ((k & 4) << 1) | ((k & 8) >> 1); return ((kk >> 3) * 4 + (c >> 5)) * 512 + ((kk & 7) * 32 + (c & 31)) * 2; }
__device__ __forceinline__ int v_rd_base(int lane) { return ((lane & 3) << 3) | (((lane >> 2) & 3) << 6) | (((lane >> 4) & 1) << 5) | (((lane >> 5) & 1) << 8); }
constexpr int v_rd_off(int d0, int ks, int half) { return d0 * 512 + ks * 4096 + half * 2048; }
__device__ __forceinline__ int crow(int r, int hi) { return (r & 3) + 8 * (r >> 2) + 4 * hi; }
__device__ __forceinline__ bf16x8 load8(const GA bf16_t* p) { return *(const GA bf16x8*)p; }

__device__ __forceinline__ void mask_tile(f32x16& p0, f32x16& p1, int dq, unsigned W) {
    const float NEG = -__builtin_inff();
#pragma unroll
    for (int r = 0; r < 16; ++r) {
        const int c = (r & 3) + 8 * (r >> 2);
        if ((unsigned)(dq - c) >= W) p0[r] = NEG;
        if ((unsigned)(dq - c - 32) >= W) p1[r] = NEG;
    }
}
__device__ __forceinline__ void mask_bits(f32x16& p0, f32x16& p1, u64 w, int hi) {
    const float NEG = -__builtin_inff();
    unsigned w0 = (unsigned)w, w1 = (unsigned)(w >> 32);
    if (hi == 0) { w0 <<= 4; w1 <<= 4; }
#define MB4(W, P, g) do { u64 c0_, c1_, c2_, c3_; asm volatile(                          \
        "v_add_co_u32 %[w], %[c0], %[w], %[w]\n\tv_add_co_u32 %[w], %[c1], %[w], %[w]\n\t"                     \
        "v_add_co_u32 %[w], %[c2], %[w], %[w]\n\tv_add_co_u32 %[w], %[c3], %[w], %[w]\n\t"                     \
        "v_cndmask_b32 %[e3], %[neg], %[e3], %[c0]\n\tv_cndmask_b32 %[e2], %[neg], %[e2], %[c1]\n\t"           \
        "v_cndmask_b32 %[e1], %[neg], %[e1], %[c2]\n\tv_cndmask_b32 %[e0], %[neg], %[e0], %[c3]"               \
        : [w] "+v"(W), [e0] "+v"(P[4 * (g)]), [e1] "+v"(P[4 * (g) + 1]), [e2] "+v"(P[4 * (g) + 2]), [e3] "+v"(P[4 * (g) + 3]),         \
          [c0] "=&s"(c0_), [c1] "=&s"(c1_), [c2] "=&s"(c2_), [c3] "=&s"(c3_) : [neg] "v"(NEG)); } while (0)
    MB4(w0, p0, 3); MB4(w1, p1, 3); w0 <<= 4; w1 <<= 4;
    MB4(w0, p0, 2); MB4(w1, p1, 2); w0 <<= 4; w1 <<= 4;
    MB4(w0, p0, 1); MB4(w1, p1, 1); w0 <<= 4; w1 <<= 4;
    MB4(w0, p0, 0); MB4(w1, p1, 0);
#undef MB4
}
__device__ __forceinline__ void partialSM(f32x16& p0, f32x16& p1, float& m_reg, float& mn, float& alpha, float cb) {
    float pmax = p0[0];
#pragma unroll
    for (int r = 1; r < 16; ++r) pmax = fmaxf(pmax, p0[r]);
#pragma unroll
    for (int r = 0; r < 16; ++r) pmax = fmaxf(pmax, p1[r]);
    { auto rr = __builtin_amdgcn_permlane32_swap(__float_as_uint(pmax), __float_as_uint(pmax), false, false);
      pmax = fmaxf(__uint_as_float(rr[0]), __uint_as_float(rr[1])); }
    pmax += cb;
    if (__builtin_expect(__all((pmax - m_reg) <= THR2), 1)) { mn = m_reg; alpha = 1.f; }
    else { mn = fmaxf(m_reg, pmax); alpha = __builtin_amdgcn_exp2f(m_reg - mn); m_reg = mn; }
    const float sh = mn - cb;
#pragma unroll
    for (int r = 0; r < 16; ++r) p0[r] = p0[r] - sh;
#pragma unroll
    for (int r = 0; r < 16; ++r) p1[r] = p1[r] - sh;
#pragma unroll
    for (int r = 0; r < 16; ++r) p0[r] = __builtin_amdgcn_exp2f(p0[r]);
}
__device__ __forceinline__ void finishSM(f32x16& p0, f32x16& p1, float alpha, float& l_reg, bf16x8& pa0, bf16x8& pa1, bf16x8& pa2, bf16x8& pa3) {
#pragma unroll
    for (int r = 0; r < 16; ++r) p1[r] = __builtin_amdgcn_exp2f(p1[r]);
    float ps = 0;
#pragma unroll
    for (int r = 0; r < 16; ++r) ps += p0[r];
#pragma unroll
    for (int r = 0; r < 16; ++r) ps += p1[r];
    { auto rr = __builtin_amdgcn_permlane32_swap(__float_as_uint(ps), __float_as_uint(ps), false, false);
      ps = __uint_as_float(rr[0]) + __uint_as_float(rr[1]); }
    l_reg = l_reg * alpha + ps;
#define PK4(P, B_, OUT) do { unsigned a0 = cvt_pk_bf16(P[B_+0], P[B_+1]), a1 = cvt_pk_bf16(P[B_+2], P[B_+3]);                          \
        unsigned b0 = cvt_pk_bf16(P[B_+4], P[B_+5]), b1 = cvt_pk_bf16(P[B_+6], P[B_+7]);                                             \
        auto r0 = __builtin_amdgcn_permlane32_swap(a0, b0, false, false); auto r1 = __builtin_amdgcn_permlane32_swap(a1, b1, false, false); \
        u32x4 w = {r0[0], r1[0], r0[1], r1[1]}; OUT = *reinterpret_cast<bf16x8*>(&w); } while (0)
    PK4(p0, 0, pa0); PK4(p0, 8, pa1); PK4(p1, 0, pa2); PK4(p1, 8, pa3);
#undef PK4
}
template <int KB, int NQ>
__device__ __forceinline__ void qkt(f32x16& p0, f32x16& p1, const LAS char* K_lds, int r32, int hi, const bf16x8* qr, int koff) {
    p0 = f32x16{}; p1 = f32x16{};
    const LAS char* kb[4];
#pragma unroll
    for (int dd = 0; dd < 4; ++dd) kb[dd] = K_lds + KB * SHM_K + KSWZ(r32, (dd * 16 + hi * 8) * 2) + koff;
#pragma unroll
    for (int d0 = 0; d0 < NQ; ++d0) { const LAS char* a = kb[d0 & 3] + (d0 >> 2) * 128;
        bf16x8 b0 = *(const LAS bf16x8*)a;
        bf16x8 b1 = *(const LAS bf16x8*)(a + 32 * 256);
        p0 = __builtin_amdgcn_mfma_f32_32x32x16_bf16(b0, qr[d0], p0, 0, 0, 0);
        p1 = __builtin_amdgcn_mfma_f32_32x32x16_bf16(b1, qr[d0], p1, 0, 0, 0); }
}
template <int VB>
__device__ __forceinline__ void pv_tile(f32x16* o, int vb0, bf16x8 pa0, bf16x8 pa1, bf16x8 pa2, bf16x8 pa3) {
#define TRRD(dst, off) asm volatile("ds_read_b64_tr_b16 %0, %1 offset:%2" : "=&v"(dst) : "v"(vb0), "i"(off) : "memory")
#define PV_D0(d0) do { s16x4 l0, l1, l2, l3, h0, h1, h2, h3; constexpr int b_ = VB * SHM_V + v_rd_off(d0, 0, 0); \
        TRRD(l0, b_); TRRD(h0, b_ + 2048); TRRD(l1, b_ + 4096); TRRD(h1, b_ + 6144); TRRD(l2, b_ + 8192); TRRD(h2, b_ + 10240); TRRD(l3, b_ + 12288); TRRD(h3, b_ + 14336); \
        asm volatile("s_waitcnt lgkmcnt(0)" ::: "memory"); SBAR();   \
        o[d0] = __builtin_amdgcn_mfma_f32_32x32x16_bf16(pa0, (bf16x8){l0[0], l0[1], l0[2], l0[3], h0[0], h0[1], h0[2], h0[3]}, o[d0], 0, 0, 0);   \
        o[d0] = __builtin_amdgcn_mfma_f32_32x32x16_bf16(pa1, (bf16x8){l1[0], l1[1], l1[2], l1[3], h1[0], h1[1], h1[2], h1[3]}, o[d0], 0, 0, 0);   \
        o[d0] = __builtin_amdgcn_mfma_f32_32x32x16_bf16(pa2, (bf16x8){l2[0], l2[1], l2[2], l2[3], h2[0], h2[1], h2[2], h2[3]}, o[d0], 0, 0, 0);   \
        o[d0] = __builtin_amdgcn_mfma_f32_32x32x16_bf16(pa3, (bf16x8){l3[0], l3[1], l3[2], l3[3], h3[0], h3[1], h3[2], h3[3]}, o[d0], 0, 0, 0); } while (0)
    PV_D0(0); PV_D0(1); PV_D0(2); PV_D0(3);
#undef PV_D0
#undef TRRD
}
__device__ __forceinline__ void bias_dist(f32x16& p0, f32x16& p1, const LAS char* tbase) {
#pragma unroll
    for (int r = 0; r < 16; ++r) { const int c = (r & 3) + 8 * (r >> 2);
        p0[r] += *(const LAS float*)(tbase + (59 - c) * 4);
        p1[r] += *(const LAS float*)(tbase + (27 - c) * 4); }
}
__device__ __forceinline__ void bias_const(f32x16& p0, f32x16& p1, float c) {
#pragma unroll
    for (int r = 0; r < 16; ++r) { p0[r] += c; p1[r] += c; }
}
__device__ __forceinline__ void bias_key(f32x16& p0, f32x16& p1, const LAS char* kbase) {
#pragma unroll
    for (int g = 0; g < 4; ++g) { const f32x4 a = *(const LAS f32x4*)(kbase + (8 * g) * 4), b = *(const LAS f32x4*)(kbase + (32 + 8 * g) * 4);
#pragma unroll
        for (int q = 0; q < 4; ++q) { p0[4 * g + q] -= a[q]; p1[4 * g + q] -= b[q]; } }
}

struct Blk { const GA bf16_t* Q; const GA bf16_t* K; const GA bf16_t* V; int P0; int rs; };
struct Aux { const GA float* tb; int dscale; const GA float* cum; const GA u64* mrow0; float kmax; };

__device__ __forceinline__ int swa_jlo(int P0, int W) { const int lowk = P0 - W + 1; return lowk > 0 ? lowk / KVBLK : 0; }

template <int MODE, int NQ>
__device__ __forceinline__ void attn_block(const Blk& cur, int skv, int W, int koff, const Aux& ax, LAS char* lds, f32x16 (&o)[4], float& m_out, float& l_out) {
    const int tid = tid_l(), wid = __builtin_amdgcn_readfirstlane(tid >> 6), lane = tid & 63, r32 = lane & 31, hi = lane >> 5;
    const int rs = cur.rs;
    const int j_lo = swa_jlo(cur.P0, W);
    int j_hi = (cur.P0 + QB - 1) / KVBLK + 1; if (j_hi > skv / KVBLK) j_hi = skv / KVBLK;
    int NT = j_hi - j_lo;
    const int qlo = cur.P0 + wid * QBLK, qm = qlo + r32 - 4 * hi;
    LAS char* V_lds = lds; LAS char* K_lds = lds + 2 * SHM_V;
    LAS float* ws = (LAS float*)(lds + L_WS) + wid * 64; LAS float* li_l = ws; LAS float* al_l = ws + 32;
    LAS float* auxl = (LAS float*)(lds + L_AUX);
    float m_reg = -1e30f, l_reg = 0;
#pragma unroll
    for (int d_ = 0; d_ < 4; ++d_) o[d_] = f32x16{};
    const int sr = tid >> 4, sc = (tid & 15) * 8, vst0 = v_st(sr, sc), vst1 = v_st(32 + sr, sc), kws = KSWZ(sr, sc * 2);
    const int vb0 = (int)(unsigned)(uintptr_t)V_lds + v_rd_base(lane);
    const GA bf16_t* Kh = cur.K; const GA bf16_t* Vh = cur.V;
    bf16x8 qr[NQ]; bf16x8 st_v0, st_v1, st_k0, st_k1;
#define ROW(p, k0, rr) ((p) + (size_t)((k0) + (rr)) * rs + sc)
#define VMW() asm volatile("s_waitcnt vmcnt(0)" ::: "memory")
#define SLOAD_H(Kp, Vp, k0) do { st_v0 = load8(ROW(Vp, k0, sr)); st_v1 = load8(ROW(Vp, k0, 32 + sr));              \
                                 st_k0 = load8(ROW(Kp, k0, sr)); st_k1 = load8(ROW(Kp, k0, 32 + sr)); } while (0)
#define SWRITE_HK(bf) do { *(LAS bf16x8*)(K_lds + (bf) * SHM_K + kws) = st_k0; *(LAS bf16x8*)(K_lds + (bf) * SHM_K + kws + 32 * 256) = st_k1; } while (0)
#define SWRITE_HV(bf) do { *(LAS bf16x8*)(V_lds + (bf) * SHM_V + vst0) = st_v0; *(LAS bf16x8*)(V_lds + (bf) * SHM_V + vst1) = st_v1; } while (0)
#define SWRITE_H(bf) do { SWRITE_HV(bf); SWRITE_HK(bf); } while (0)
#define RESC(a) do { if (__any((a) < 1.f)) { if (hi == 0) al_l[r32] = (a); asm volatile("s_waitcnt lgkmcnt(0)" ::: "memory");              \
                     for (int d_ = 0; d_ < 4; ++d_) for (int r = 0; r < 16; ++r) o[d_][r] *= al_l[crow(r, hi)]; } } while (0)
#define KBASE(t) ((MODE == 1 ? (j_hi - 1 - (t)) : (j_lo + (t))) * KVBLK)
    LAS unsigned* flg = (LAS unsigned*)(lds + L_FLG);
    {
        const int kb0 = KBASE(0);
        if (MODE == 1 && tid < 8) flg[tid] = 0u;
#pragma unroll
        for (int d0 = 0; d0 < NQ; ++d0) qr[d0] = load8(cur.Q + (size_t)(wid * QBLK + r32) * rs + d0 * 16 + hi * 8);
        SLOAD_H(Kh, Vh, kb0);
        if (MODE == 1) { const int n_ = cur.P0 + QB; float tv[16];
#pragma unroll
            for (int k = 0; k < 16; ++k) { const int i = tid + 512 * k; tv[k] = (i < n_) ? ax.cum[i] : 0.f; }
#pragma unroll
            for (int k = 0; k < 16; ++k) { const int i = tid + 512 * k; if (i < n_) auxl[i] = tv[k]; } }
        else { float tv[5];
#pragma unroll
            for (int k = 0; k < 5; ++k) { const int i = tid + 512 * k; int d = i - TB_PAD; d = d < 0 ? 0 : d; tv[k] = (i < TB_N) ? ax.tb[d * ax.dscale] : 0.f; }
#pragma unroll
            for (int k = 0; k < 5; ++k) { const int i = tid + 512 * k; if (i < TB_N) auxl[i] = tv[k]; } }
        VMW(); SWRITE_HK(0); SWRITE_HV(0);
        __syncthreads();
    }
    const float cfar = (MODE == 0 || MODE == 2) ? ax.tb[FAR_DIST] : 0.f;
    float qbound = 0.f;
    if (MODE == 1) { float ss = 0.f;
#pragma unroll
        for (int d0 = 0; d0 < NQ; ++d0) { const u32x4 w = *reinterpret_cast<const u32x4*>(&qr[d0]);
#pragma unroll
            for (int j = 0; j < 4; ++j) { const float a = bf_lo(w[j]), b = bf_hi(w[j]); ss = fmaf(a, a, ss); ss = fmaf(b, b, ss); } }
        { auto rr = __builtin_amdgcn_permlane32_swap(__float_as_uint(ss), __float_as_uint(ss), false, false); ss = __uint_as_float(rr[0]) + __uint_as_float(rr[1]); }
        qbound = sqrtf(ss) * ax.kmax * 1.001f + 1e-3f; }
    float cbv = 0.f;
#define BIASMASK(P0_, P1_, t) do { const int kb_ = KBASE(t); cbv = 0.f;                                                                \
        if (MODE == 1) { bias_key(P0_, P1_, (const LAS char*)(auxl + kb_ + 4 * hi)); }                                                       \
        else if (MODE == 3) { bias_dist(P0_, P1_, (const LAS char*)(auxl + (qm - kb_ - 59 + TB_PAD))); }                                     \
        else { if (cur.P0 - kb_ - 63 >= FAR_DIST) cbv = cfar; else bias_dist(P0_, P1_, (const LAS char*)(auxl + (qm - kb_ - 59 + TB_PAD))); } \
        if (MODE == 0) { mask_bits(P0_, P1_, mw, hi); }                                                                                  \
        else if (kb_ + KVBLK - 1 > qlo || kb_ <= qlo + QBLK - 1 - W) mask_tile(P0_, P1_, qm - kb_, (unsigned)W); } while (0)
#define MLOAD(t) do { if (MODE == 0) mw = ax.mrow0[(size_t)(wid * QBLK + r32) * 128 + (KBASE(t) >> 6)]; } while (0)
    f32x16 pA0, pA1, pB0, pB1; float mnA, mnB, alA, alB; bf16x8 pa0, pa1, pa2, pa3; u64 mw = 0ull;
    if (NT > 1) SLOAD_H(Kh, Vh, KBASE(1));
    MLOAD(0);
    SBAR(); qkt<0, NQ>(pA0, pA1, K_lds, r32, hi, qr, koff);
    BIASMASK(pA0, pA1, 0); partialSM(pA0, pA1, m_reg, mnA, alA, cbv);
    if (NT > 1) { VMW(); SWRITE_H(1); }
    __syncthreads();
#define HALF_STEP(PX0, PX1, mnX, alX, PY0, PY1, alY, t, KB, VB, SB) do {                                                      \
        MLOAD(t);                                                                                                             \
        if ((t) + 1 < NT) { SLOAD_H(Kh, Vh, KBASE((t) + 1)); }        \
        SBAR(); qkt<KB, NQ>(PX0, PX1, K_lds, r32, hi, qr, koff);                                                              \
        finishSM(PY0, PY1, alY, l_reg, pa0, pa1, pa2, pa3); SBAR();                                                           \
        pv_tile<VB>(o, vb0, pa0, pa1, pa2, pa3); BIASMASK(PX0, PX1, (t)); partialSM(PX0, PX1, m_reg, mnX, alX, cbv);          \
        __syncthreads();                                                                                                      \
        if ((t) + 1 < NT) { VMW(); SWRITE_H(SB); }                                                                            \
        RESC(alX); __syncthreads(); } while (0)
    for (int t = 1; t + 1 < NT; t += 2) {
        if (MODE == 1) {
            const u32x4 f0 = *(const LAS u32x4*)flg, f1 = *(const LAS u32x4*)(flg + 4);
            if ((f0[0] & f0[1] & f0[2] & f0[3] & f1[0] & f1[1] & f1[2] & f1[3]) != 0u) { NT = t + 1; break; }
        }
        HALF_STEP(pB0, pB1, mnB, alB, pA0, pA1, alA, t, 1, 0, 0);
        if (MODE == 1) {
            unsigned ok = 0u;
            if (t + 3 < NT) { const float ub = qbound - auxl[KBASE(t + 3) + KVBLK - 1]; ok = __all(ub < m_reg - SKIP_MARGIN) ? 1u : 0u; }
            if (lane == 0) flg[wid] = ok;
        }
        HALF_STEP(pA0, pA1, mnA, alA, pB0, pB1, alB, t + 1, 0, 1, 1);
    }
    const bool even = (NT & 1) == 0;
    if (even) { MLOAD(NT - 1); SBAR(); qkt<1, NQ>(pB0, pB1, K_lds, r32, hi, qr, koff); SBAR(); }
    finishSM(pA0, pA1, alA, l_reg, pa0, pa1, pa2, pa3); SBAR();
    pv_tile<0>(o, vb0, pa0, pa1, pa2, pa3);
    if (even) { BIASMASK(pB0, pB1, NT - 1); partialSM(pB0, pB1, m_reg, mnB, alB, cbv); __syncthreads(); RESC(alB);
        finishSM(pB0, pB1, alB, l_reg, pa0, pa1, pa2, pa3); SBAR(); pv_tile<1>(o, vb0, pa0, pa1, pa2, pa3); }
    if (hi == 0) li_l[r32] = l_reg; asm volatile("s_waitcnt lgkmcnt(0)" ::: "memory");
#pragma unroll
    for (int r = 0; r < 16; ++r) { const float rl = __builtin_amdgcn_rcpf(li_l[crow(r, hi)]);
#pragma unroll
        for (int d0 = 0; d0 < 4; ++d0) o[d0][r] *= rl; }
    m_out = m_reg; l_out = l_reg;
    __syncthreads();
#undef ROW
#undef VMW
#undef SLOAD_H
#undef SWRITE_HK
#undef SWRITE_HV
#undef SWRITE_H
#undef RESC
#undef KBASE
#undef BIASMASK
#undef MLOAD
#undef HALF_STEP
}
#undef KSWZ
}

__device__ __forceinline__ void store_y(const GA bf16_t* Zs, GA bf16_t* Y, const f32x16 (&o)[4], int row0w, int colbase, int r32, int hi) {
    bf16_t zv[16][4];
#pragma unroll
    for (int r = 0; r < 16; ++r) { const size_t off = (size_t)(row0w + att::crow(r, hi)) * DM + colbase + r32;
#pragma unroll
        for (int d0 = 0; d0 < 4; ++d0) zv[r][d0] = Zs[off + d0 * 32]; }
#pragma unroll
    for (int r = 0; r < 16; ++r) { const size_t off = (size_t)(row0w + att::crow(r, hi)) * DM + colbase + r32;
#pragma unroll
        for (int d0 = 0; d0 < 4; ++d0) { const float v = o[d0][r] * bf2f(zv[r][d0]); const float vn = __shfl_xor(v, 1);
            if ((r32 & 1) == 0) *(GA unsigned*)(Y + off + d0 * 32) = cvt_pk_bf16(v, vn); } }
}
template <int MODE>
__device__ __forceinline__ int attn_fast_unit(const Frame& F, int layer, int b, int h, int qb, GA unsigned* qctr) {
    const int mixer = MODE;
    const size_t hb = ((size_t)(b * 4 + h) * SEQ) * 128;
    att::Blk cur{F.QKV + (size_t)(mixer * 3 + 0) * QS + hb + (size_t)qb * 256 * 128, F.QKV + (size_t)(mixer * 3 + 1) * QS + hb, F.QKV + (size_t)(mixer * 3 + 2) * QS + hb, qb * 256, 128};
    att::Aux ax{F.tb + (size_t)h * SEQ, 1, F.cum + (size_t)(b * 4 + h) * SEQ, F.mask + (size_t)(b * SEQ + qb * 256) * 128, 0.f};
    if (MODE == 1) ax.kmax = sqrtf(__uint_as_float(F.ctl[CW_KM + layer * 8 + b * 4 + h]));
    f32x16 o[4]; float m_, l_;
    att::attn_block<MODE, 8>(cur, SEQ, SEQ, 0, ax, (LAS char*)F.lds, o, m_, l_);
    const unsigned pf = q_issue(qctr);
    const int tid = tid_l(), wid = tid >> 6, lane = tid & 63;
    GA unsigned char* w2 = launder(F.ws);
    store_y((const GA bf16_t*)(w2 + WS_ZS), (GA bf16_t*)(w2 + WS_Y), o, b * SEQ + qb * 256 + wid * 32, mixer * 512 + h * 128, lane & 31, lane >> 5);
    return q_commit(F.misc + 4, pf);
}

__device__ __forceinline__ int attn_diffmap_unit(const Frame& F, int layer, int b, int h, int qb, int c, GA unsigned* qctr) {
    const size_t hb = ((size_t)(b * 4 + h) * SEQ) * 128;
    const GA bf16_t* Qc = F.QKV + (size_t)(2 * 3 + 0) * QS + hb + (size_t)qb * 256 * 128; const GA bf16_t* Kc = F.QKV + (size_t)(2 * 3 + 1) * QS + hb; const GA bf16_t* Vc = F.QKV + (size_t)(2 * 3 + 2) * QS + hb;
    att::Aux ax{F.tb + (size_t)(4 + h) * SEQ, 1, (const GA float*)nullptr, (const GA u64*)nullptr, 0.f};
    f32x16 o[4]; float m_, l_;
    { att::Blk cur{Qc + c * 64, Kc, Vc, qb * 256, 128};
      att::attn_block<2, 4>(cur, SEQ, SEQ, c * 128, ax, (LAS char*)F.lds, o, m_, l_); }
    const unsigned pf = q_issue(qctr);
    const int tid = tid_l(), wid = tid >> 6, lane = tid & 63, r32 = lane & 31, hi = lane >> 5;
    const int pair = (b * 4 + h) * 32 + qb;
    GA unsigned char* w2 = launder(F.ws);
    { GA f32x4* mine = (GA f32x4*)(w2 + WS_O1) + ((size_t)(c * 256 + pair) * 16) * 512 + tid;
#pragma unroll
      for (int d0 = 0; d0 < 4; ++d0)
#pragma unroll
          for (int g = 0; g < 4; ++g) { const f32x4 v = {o[d0][4 * g], o[d0][4 * g + 1], o[d0][4 * g + 2], o[d0][4 * g + 3]};
              asm volatile("global_store_dwordx4 %0, %1, off sc1" :: "v"(mine + (d0 * 4 + g) * 512), "v"(v) : "memory"); } }
    asm volatile("s_waitcnt vmcnt(0)" ::: "memory");
    __syncthreads();
    volatile LAS unsigned* lw = F.misc + 5;
    if (tid == 0) *lw = __hip_atomic_fetch_add((GA unsigned*)(w2 + WS_CTL) + CW_DC + layer * 256 + pair, 1u, __ATOMIC_RELAXED, __HIP_MEMORY_SCOPE_AGENT);
    __syncthreads();
    if (*lw == 0u) return q_commit(F.misc + 4, pf);
    __builtin_amdgcn_fence(__ATOMIC_ACQUIRE, "agent");
    asm volatile("s_waitcnt vmcnt(0)" ::: "memory");
    const GA f32x4* other = (const GA f32x4*)(w2 + WS_O1) + ((size_t)((1 - c) * 256 + pair) * 16) * 512 + tid;
    const GA float* dp = (const GA float*)(w2 + WS_DP) + layer * 256;
    const float lam = dp[0];
    f32x4 otall[4][4];
#pragma unroll
    for (int g = 0; g < 4; ++g)
#pragma unroll
        for (int d0 = 0; d0 < 4; ++d0) otall[g][d0] = other[(d0 * 4 + g) * 512];
    float swv[4];
#pragma unroll
    for (int d0 = 0; d0 < 4; ++d0) swv[d0] = dp[128 + d0 * 32 + r32];
#pragma unroll
    for (int g = 0; g < 4; ++g) {
#pragma unroll
        for (int q = 0; q < 4; ++q) { const int r = 4 * g + q;
            float ss = 0.f;
#pragma unroll
            for (int d0 = 0; d0 < 4; ++d0) { const float mo = o[d0][r], oth = otall[g][d0][q];
                const float a0 = (c == 0) ? mo : oth, a1 = (c == 0) ? oth : mo; const float v = fmaf(-lam, a1, a0); o[d0][r] = v; ss = fmaf(v, v, ss); }
            ss += __shfl_xor(ss, 1); ss += __shfl_xor(ss, 2); ss += __shfl_xor(ss, 4); ss += __shfl_xor(ss, 8); ss += __shfl_xor(ss, 16);
            const float rn = rsqrtf(ss * (1.0f / 128.0f) + RMS_EPS);
#pragma unroll
            for (int d0 = 0; d0 < 4; ++d0) o[d0][r] = o[d0][r] * rn;
        }
    }
#pragma unroll
    for (int d0 = 0; d0 < 4; ++d0) { const float sw = swv[d0];
#pragma unroll
        for (int r = 0; r < 16; ++r) o[d0][r] *= sw; }
    store_y((const GA bf16_t*)(w2 + WS_ZS), (GA bf16_t*)(w2 + WS_Y), o, b * SEQ + qb * 256 + wid * 32, 2 * 512 + h * 128, r32, hi);
    return q_commit(F.misc + 4, pf);
}
__device__ __forceinline__ int attn_dil_unit(const Frame& F, int u, GA unsigned* qctr) {
    const int cfg = u >> 8, v = u & 255, b = v & 1, h = (v >> 1) & 3, x = v >> 3;
    const int dl = (cfg == 0) ? 1 : (cfg == 1 ? 4 : 16);
    const int rho = (cfg == 0) ? 0 : (cfg == 1 ? (x & 3) : (x & 15)), qb = (cfg == 0) ? x : (cfg == 1 ? (x >> 2) : (x >> 4));
    const size_t hb = ((size_t)(b * 4 + h) * SEQ) * 128;
    const GA bf16_t* Qd = F.QKV + (size_t)(3 * 3 + 0) * QS + hb; const GA bf16_t* Kd = F.QKV + (size_t)(3 * 3 + 1) * QS + hb; const GA bf16_t* Vd = F.QKV + (size_t)(3 * 3 + 2) * QS + hb;
    att::Blk cur{Qd + (size_t)(rho + dl * qb * 256) * 128, Kd + (size_t)rho * 128, Vd + (size_t)rho * 128, qb * 256, 128 * dl};
    att::Aux ax{F.tb + (size_t)(8 + h) * SEQ, dl, (const GA float*)nullptr, (const GA u64*)nullptr, 0.f};
    f32x16 o[4]; float m_, l_;
    att::attn_block<3, 8>(cur, SEQ / dl, 129, 0, ax, (LAS char*)F.lds, o, m_, l_);
    const unsigned pf = q_issue(qctr);
    const int tid = tid_l(), wid = tid >> 6, lane = tid & 63, r32 = lane & 31, hi = lane >> 5;
    GA unsigned char* w2 = launder(F.ws);
    GA bf16_t* od = (GA bf16_t*)(w2 + WS_OD) + (size_t)cfg * MT * 512;
#pragma unroll
    for (int r = 0; r < 16; ++r) { const size_t row = (size_t)b * SEQ + rho + (size_t)dl * (qb * 256 + wid * 32 + att::crow(r, hi));
#pragma unroll
        for (int d0 = 0; d0 < 4; ++d0) od[row * 512 + h * 128 + d0 * 32 + r32] = (bf16_t)(cvt_pk_bf16(o[d0][r], 0.f) & 0xffffu); }
    if (hi == 0) { const size_t row = (size_t)b * SEQ + rho + (size_t)dl * (qb * 256 + wid * 32 + r32);
        ((GA float*)(w2 + WS_LSE))[((size_t)cfg * MT + row) * 4 + h] = m_ + __builtin_amdgcn_logf(l_); }
    return q_commit(F.misc + 4, pf);
}
__device__ __forceinline__ int dil_merge_unit(const Frame& F, int u, GA unsigned* qctr) {
    const unsigned pf = q_issue(qctr);
    const int tid = tid_l(), row = u * 32 + (tid >> 4), cg = tid & 15, h = cg >> 2, col = cg * 32;
    const float l0 = F.LSE[((size_t)0 * MT + row) * 4 + h], l1 = F.LSE[((size_t)1 * MT + row) * 4 + h], l2 = F.LSE[((size_t)2 * MT + row) * 4 + h];
    const float mx = fmaxf(l0, fmaxf(l1, l2)); float w0 = ex2(l0 - mx), w1 = ex2(l1 - mx), w2 = ex2(l2 - mx); const float inv = 1.0f / (w0 + w1 + w2); w0 *= inv; w1 *= inv; w2 *= inv;
    const GA bf16_t* odb = (const GA bf16_t*)F.OD;
    const GA bf16_t* p0 = odb + ((size_t)0 * MT + row) * 512 + col; const GA bf16_t* p1 = odb + ((size_t)1 * MT + row) * 512 + col; const GA bf16_t* p2 = odb + ((size_t)2 * MT + row) * 512 + col;
    const size_t yo = (size_t)row * DM + 3 * 512 + col;
    u32x4 Av[4], Bv[4], Cv[4], Zv[4];
#pragma unroll
    for (int i = 0; i < 4; ++i) { Av[i] = *(const GA u32x4*)(p0 + 8 * i); Bv[i] = *(const GA u32x4*)(p1 + 8 * i); Cv[i] = *(const GA u32x4*)(p2 + 8 * i); Zv[i] = *(const GA u32x4*)(F.Zs + yo + 8 * i); }
#pragma unroll
    for (int i = 0; i < 4; ++i) {
        const u32x4 A_ = Av[i], B_ = Bv[i], C_ = Cv[i];
        const f32x4 a0 = {bf_lo(A_[0]), bf_hi(A_[0]), bf_lo(A_[1]), bf_hi(A_[1])}, a1 = {bf_lo(A_[2]), bf_hi(A_[2]), bf_lo(A_[3]), bf_hi(A_[3])}, b0 = {bf_lo(B_[0]), bf_hi(B_[0]), bf_lo(B_[1]), bf_hi(B_[1])}, b1 = {bf_lo(B_[2]), bf_hi(B_[2]), bf_lo(B_[3]), bf_hi(B_[3])},
                    c0 = {bf_lo(C_[0]), bf_hi(C_[0]), bf_lo(C_[1]), bf_hi(C_[1])}, c1 = {bf_lo(C_[2]), bf_hi(C_[2]), bf_lo(C_[3]), bf_hi(C_[3])};
        const u32x4 zw = Zv[i];
        const f32x4 v0 = a0 * w0 + b0 * w1 + c0 * w2, v1 = a1 * w0 + b1 * w1 + c1 * w2;
        u32x4 w = {cvt_pk_bf16(v0[0] * bf_lo(zw[0]), v0[1] * bf_hi(zw[0])), cvt_pk_bf16(v0[2] * bf_lo(zw[1]), v0[3] * bf_hi(zw[1])),
                   cvt_pk_bf16(v1[0] * bf_lo(zw[2]), v1[1] * bf_hi(zw[2])), cvt_pk_bf16(v1[2] * bf_lo(zw[3]), v1[3] * bf_hi(zw[3]))};
        *(GA u32x4*)(F.Y + yo + 8 * i) = w; }
    return q_commit(F.misc + 4, pf);
}

struct EpiMerged {
    static constexpr bool PERM = true, AFTER_DRAIN = false, MIDK = true, FP8 = false;
    const GA unsigned char* G; GA bf16_t* MG;
    static __device__ __forceinline__ float gq(unsigned w, int i) { return (float)((w >> (8 * i)) & 0xffu) + 0.5f; }
    __device__ __forceinline__ void mid(f32x4 (&acc)[2][2][4][2], const pg8::Unit& u, int bnext, int wr, int wc, int fr, int fq) const {
        const int row0 = u.pm * 256 + wr * 64 + fr, c0 = u.pn * 256 + wc * 32 + 8 * fq;
#pragma unroll
        for (int ai = 0; ai < 2; ++ai) {
            u32x2 num[4][2], den[4][2];
#pragma unroll
            for (int m = 0; m < 4; ++m) { const GA unsigned char* gp = G + (size_t)(row0 + ai * 128 + m * 16) * 8192 + c0;
#pragma unroll
                for (int bj = 0; bj < 2; ++bj) { num[m][bj] = *(const GA u32x2*)(gp + (bnext - 1) * DM + bj * 128); den[m][bj] = *(const GA u32x2*)(gp + bnext * DM + bj * 128); } }
#pragma unroll
            for (int m = 0; m < 4; ++m)
#pragma unroll
                for (int bj = 0; bj < 2; ++bj)
#pragma unroll
                    for (int j = 0; j < 4; ++j) {
                        acc[ai][bj][m][0][j] *= gq(num[m][bj][0], j) * __builtin_amdgcn_rcpf(gq(den[m][bj][0], j));
                        acc[ai][bj][m][1][j] *= gq(num[m][bj][1], j) * __builtin_amdgcn_rcpf(gq(den[m][bj][1], j)); }
            asm volatile("" ::: "memory");
        }
    }
    __device__ __forceinline__ void operator()(const f32x4 (&acc)[2][2][4][2], const pg8::Unit& u, int wr, int wc, int fr, int fq) const {
        const int row0 = u.pm * 256 + wr * 64 + fr, c0 = u.pn * 256 + wc * 32 + 8 * fq;
        u32x2 g3v[2][4][2];
#pragma unroll
        for (int ai = 0; ai < 2; ++ai)
#pragma unroll
            for (int m = 0; m < 4; ++m)
#pragma unroll
                for (int bj = 0; bj < 2; ++bj) g3v[ai][m][bj] = *(const GA u32x2*)(G + (size_t)(row0 + ai * 128 + m * 16) * 8192 + 3 * DM + c0 + bj * 128);
#pragma unroll
        for (int ai = 0; ai < 2; ++ai)
#pragma unroll
            for (int m = 0; m < 4; ++m) { const int r = row0 + ai * 128 + m * 16;
#pragma unroll
                for (int bj = 0; bj < 2; ++bj) { const u32x2 g3 = g3v[ai][m][bj];
                    const f32x4 v0 = acc[ai][bj][m][0] * (1.0f / 256.0f), v1 = acc[ai][bj][m][1] * (1.0f / 256.0f);
                    u32x4 w = {cvt_pk_bf16(v0[0] * gq(g3[0], 0), v0[1] * gq(g3[0], 1)), cvt_pk_bf16(v0[2] * gq(g3[0], 2), v0[3] * gq(g3[0], 3)),
                               cvt_pk_bf16(v1[0] * gq(g3[1], 0), v1[1] * gq(g3[1], 1)), cvt_pk_bf16(v1[2] * gq(g3[1], 2), v1[3] * gq(g3[1], 3))};
                    *(GA u32x4*)(MG + (size_t)r * DM + c0 + bj * 128) = w; } }
    }
};

struct EpiOut {
    static constexpr bool PERM = false, AFTER_DRAIN = false, MIDK = false, FP8 = false;
    GA float* xres; GA bf16_t* xb; GA float* ssq; GA unsigned char* xq; const GA float* xsrc; bool feed_next; GA float* rsarr; GA unsigned* pcnt;
    template <int GM, bool F32SRC>
    __device__ __forceinline__ void group(const f32x4 (&acc)[2][2][4][2], const pg8::Unit& u, int row0, int col0, int wc, int fq, int ai, int mb) const {
        f32x4 xv[GM][2][2];
#pragma unroll
        for (int m = 0; m < GM; ++m)
#pragma unroll
            for (int bj = 0; bj < 2; ++bj)
#pragma unroll
                for (int n = 0; n < 2; ++n) { const size_t off_ = (size_t)(row0 + ai * 128 + (mb + m) * 16) * DM + col0 + bj * 128 + n * 16;
                    if (F32SRC) xv[m][bj][n] = *(const GA f32x4*)(xsrc + off_);
                    else { const u32x2 t_ = *(const GA u32x2*)(xb + off_); xv[m][bj][n] = (f32x4){bf_lo(t_[0]), bf_hi(t_[0]), bf_lo(t_[1]), bf_hi(t_[1])}; } }
#pragma unroll
        for (int m = 0; m < GM; ++m) { const int r = row0 + ai * 128 + (mb + m) * 16; float ss = 0.f;
#pragma unroll
            for (int bj = 0; bj < 2; ++bj)
#pragma unroll
                for (int n = 0; n < 2; ++n) { const size_t off = (size_t)r * DM + col0 + bj * 128 + n * 16;
                    const f32x4 v = xv[m][bj][n] + acc[ai][bj][mb + m][n];
                    ss += v[0] * v[0] + v[1] * v[1] + v[2] * v[2] + v[3] * v[3];
                    { u32x2 w = {cvt_pk_bf16(v[0], v[1]), cvt_pk_bf16(v[2], v[3])}; *(GA u32x2*)(xb + off) = w; }
                    if (feed_next) *(GA unsigned*)(xq + off) = cvt4_fp8(v[0], v[1], v[2], v[3]); }
            ss += __shfl_xor(ss, 16); ss += __shfl_xor(ss, 32);
            if (fq == 0) asm volatile("global_store_dword %0, %1, off sc1" :: "v"(ssq + (size_t)r * 32 + u.pn * 4 + wc), "v"(ss) : "memory"); }
    }
    __device__ __forceinline__ void operator()(const f32x4 (&acc)[2][2][4][2], const pg8::Unit& u, int wr, int wc, int fr, int fq) const {
        const int row0 = u.pm * 256 + wr * 64 + fr, col0 = u.pn * 256 + wc * 32 + 4 * fq;
        if (xsrc != nullptr) {
#pragma unroll
            for (int h = 0; h < 4; ++h) group<2, true>(acc, u, row0, col0, wc, fq, h >> 1, (h & 1) * 2);
        } else {
            u32x2 xr[2][4][2][2];
#pragma unroll
            for (int ai = 0; ai < 2; ++ai)
#pragma unroll
                for (int m = 0; m < 4; ++m)
#pragma unroll
                    for (int bj = 0; bj < 2; ++bj)
#pragma unroll
                        for (int n = 0; n < 2; ++n) xr[ai][m][bj][n] = *(const GA u32x2*)(xb + (size_t)(row0 + ai * 128 + m * 16) * DM + col0 + bj * 128 + n * 16);
#pragma unroll
            for (int ai = 0; ai < 2; ++ai)
#pragma unroll
                for (int m = 0; m < 4; ++m) { const int r = row0 + ai * 128 + m * 16; float ss = 0.f;
#pragma unroll
                    for (int bj = 0; bj < 2; ++bj)
#pragma unroll
                        for (int n = 0; n < 2; ++n) { const size_t off = (size_t)r * DM + col0 + bj * 128 + n * 16; const u32x2 t_ = xr[ai][m][bj][n];
                            const f32x4 v = (f32x4){bf_lo(t_[0]), bf_hi(t_[0]), bf_lo(t_[1]), bf_hi(t_[1])} + acc[ai][bj][m][n];
                            ss += v[0] * v[0] + v[1] * v[1] + v[2] * v[2] + v[3] * v[3];
                            { u32x2 w = {cvt_pk_bf16(v[0], v[1]), cvt_pk_bf16(v[2], v[3])}; *(GA u32x2*)(xb + off) = w; }
                            if (feed_next) *(GA unsigned*)(xq + off) = cvt4_fp8(v[0], v[1], v[2], v[3]); }
                    ss += __shfl_xor(ss, 16); ss += __shfl_xor(ss, 32);
                    if (fq == 0) asm volatile("global_store_dword %0, %1, off sc1" :: "v"(ssq + (size_t)r * 32 + u.pn * 4 + wc), "v"(ss) : "memory"); }
        }
        asm volatile("s_waitcnt vmcnt(0)" ::: "memory");
        unsigned old = 0u;
        if (fr == 0 && fq == 0) old = __hip_atomic_fetch_add(pcnt + u.pm, 1u, __ATOMIC_RELAXED, __HIP_MEMORY_SCOPE_AGENT);
        old = (unsigned)__builtin_amdgcn_readfirstlane((int)old);
        if (old == 63u) {
            __builtin_amdgcn_fence(__ATOMIC_ACQUIRE, "agent"); asm volatile("s_waitcnt vmcnt(0)" ::: "memory");
            const int lane_ = fr + 16 * fq;
#pragma unroll
            for (int k = 0; k < 4; ++k) { const int r = u.pm * 256 + lane_ * 4 + k; const GA f32x4* sp = (const GA f32x4*)(ssq + (size_t)r * 32);
                f32x4 a = sp[0];
#pragma unroll
                for (int j = 1; j < 8; ++j) a += sp[j];
                rsarr[r] = __builtin_amdgcn_rsqf(((a[0] + a[1]) + (a[2] + a[3])) * (1.0f / DM) + RMS_EPS); }
        }
    }
};

__device__ __forceinline__ void final_norm(const Frame& F) {
    const int tid = tid_l(), lane = tid & 63, wave = tid >> 6, G = gridDim.x, bid = blockIdx.x;
    for (int row = bid * 8 + wave; row < MT; row += G * 8) {
        const float rs = F.sc[row];
#pragma unroll
        for (int i = 0; i < 8; ++i) { const int c = (i * 64 + lane) * 4; const u32x2 t = *(const GA u32x2*)(F.xb + (size_t)row * DM + c); const f32x4 v = {bf_lo(t[0]), bf_hi(t[0]), bf_lo(t[1]), bf_hi(t[1])}, w = *(const GA f32x4*)(F.final_w + c);
            *(GA f32x4*)(F.out + (size_t)row * DM + c) = v * rs * w; }
    }
}

__device__ __forceinline__ Frame mkframe(const Args& args, GA unsigned char* ws, LAS unsigned char* lds) {
    Frame F;
    F.x = (const GA float*)args.in[0]; F.norm_w = (const GA float*)args.in[1]; F.w_in = (const GA float*)args.in[2]; F.fox_b = (const GA float*)args.in[3];
    F.lq1 = (const GA float*)args.in[4]; F.lk1 = (const GA float*)args.in[5]; F.lq2 = (const GA float*)args.in[6]; F.lk2 = (const GA float*)args.in[7];
    F.subln = (const GA float*)args.in[8]; F.w_branch = (const GA float*)args.in[9]; F.w_out = (const GA float*)args.in[10]; F.rel_bias = (const GA float*)args.in[11];
    F.final_w = (const GA float*)args.in[12]; F.out = (GA float*)args.out;
    F.ctl = (GA unsigned*)(ws + WS_CTL); F.WinT = (GA bf16_t*)(ws + WS_WIN); F.WbrT = (GA bf16_t*)(ws + WS_WBR); F.WoutT = (GA bf16_t*)(ws + WS_WOUT);
    F.xres = (GA float*)(ws + WS_XRES); F.xb = (GA bf16_t*)(ws + WS_XB); F.ssq = (GA float*)(ws + WS_SSQ); F.Zs = (GA bf16_t*)(ws + WS_ZS); F.G = (GA bf16_t*)(ws + WS_G);
    F.QKV = (GA bf16_t*)(ws + WS_QKV); F.IQ = (GA bf16_t*)(ws + WS_IQ); F.IK = (GA bf16_t*)(ws + WS_IK); F.IW = (GA float*)(ws + WS_IW); F.FF = (GA float*)(ws + WS_FF);
    F.cum = (GA float*)(ws + WS_CUM); F.tb = (GA float*)(ws + WS_TB); F.sc = (GA float*)(ws + WS_SC); F.mask = (GA u64*)(ws + WS_MASK); F.Y = (GA bf16_t*)(ws + WS_Y); F.MG = (GA bf16_t*)(ws + WS_MG);
    F.O1 = (GA float*)(ws + WS_O1); F.OD = (GA float*)(ws + WS_OD); F.LSE = (GA float*)(ws + WS_LSE); F.DP = (GA float*)(ws + WS_DP); F.ws = ws;
    F.lds = lds; F.misc = (volatile LAS unsigned*)(lds + LDS_MISC);
    return F;
}

constexpr unsigned WQ_L0 = 2u * WT_TB, WQ_TOTAL = WQ_L0 + 3u * WT_TL;
__device__ __forceinline__ void wq_tile(const Args& args, LAS unsigned char* ldsl, unsigned t) {
    const Frame F = mkframe(args, launder(args.ws), ldsl);
    if (t < WQ_L0) { weight_tile(F, 0, WT_TW + WT_TG + (int)t, (LAS float*)ldsl); return; }
    const unsigned t1 = t - WQ_L0, l1 = t1 / (unsigned)WT_TL;
    weight_tile(F, 1 + (int)l1, (int)(t1 - l1 * (unsigned)WT_TL), (LAS float*)ldsl);
}
__device__ __forceinline__ void wq_drain(const Args& args, LAS unsigned char* ldsl, unsigned bound) {
    volatile LAS unsigned* st = (volatile LAS unsigned*)(ldsl + LDS_MISC);
    GA unsigned* wq = (GA unsigned*)(args.ws + WS_CTL) + CW_WQ;
    for (;;) {
        __syncthreads();
        if (threadIdx.x == 0) st[11] = __hip_atomic_fetch_add(wq, 1u, __ATOMIC_RELAXED, __HIP_MEMORY_SCOPE_AGENT);
        __syncthreads();
        const unsigned t = st[11];
        if (t < WQ_TOTAL) wq_tile(args, ldsl, t);
        if (t + 1u >= bound) break;
    }
}
__device__ __forceinline__ void xcd_barrier_steal(const XcdBarrier& b, const Args& args, LAS unsigned char* ldsl) {
    asm volatile("s_waitcnt vmcnt(0)" ::: "memory");
    __syncthreads();
    volatile LAS unsigned* st = b.st;
    if (threadIdx.x == 0) {
        unsigned* bar = b.bar;
        __builtin_amdgcn_s_waitcnt(0);
        unsigned nloc = st[0], nx = st[1];
        if (nloc == 0u) { xcd_barrier_complete(bar, b.x, nloc, nx); st[0] = nloc; st[1] = nx; }
        const unsigned old = xb_add(&bar[XB_XSUB(b.x)], 1u);
        const unsigned gen = old / nloc;
        if (old + 1u == (gen + 1u) * nloc) {
            __builtin_amdgcn_fence(__ATOMIC_RELEASE, "agent");
            asm volatile("s_waitcnt vmcnt(0)" ::: "memory");
            const unsigned og = xb_add(&bar[XB_TOP], 1u);
            const unsigned tg = og / nx;
            if (og + 1u == (tg + 1u) * nx) xb_add(&bar[XB_TOPGEN], 1u);
            else XB_SPIN(xb_ld(&bar[XB_TOPGEN]) == tg, bar);
            __builtin_amdgcn_fence(__ATOMIC_ACQUIRE, "agent");
            xb_add(&bar[XB_XGEN(b.x)], 1u);
            asm volatile("s_waitcnt vmcnt(0)" ::: "memory");
            st[8] = 1u;
        } else { st[8] = 0u; st[9] = gen; }
    }
    __syncthreads();
    const unsigned leader_ = st[8];
    __syncthreads();
    if (leader_ == 0u) {
        unsigned sp = 0u;
        for (;;) {
            if (threadIdx.x == 0) {
                unsigned* bar = b.bar;
                unsigned done = (xb_ld(&bar[XB_XGEN(b.x)]) != st[9]) ? 1u : 0u, t = 0xffffffffu;
                if (!done) {
                    if (st[10] == 0u) { t = xb_add((unsigned*)(args.ws + WS_CTL) + CW_WQ, 1u); if (t >= WQ_TOTAL) { st[10] = 1u; t = 0xffffffffu; } }
                    if (t == 0xffffffffu) { __builtin_amdgcn_s_sleep(1);
                        if ((++sp & 255u) == 0u) { if (xb_ld(&bar[XB_TMO])) done = 1u; else if (sp > XB_SPIN_CAP) { atomicAdd(&bar[XB_TMO], 1u); done = 1u; } } }
                }
                st[8] = done; st[11] = t;
            }
            __syncthreads();
            const unsigned done = st[8], t = st[11];
            if (done) break;
            if (t != 0xffffffffu) wq_tile(args, ldsl, t);
            else __syncthreads();
        }
        if (threadIdx.x == 0) { __builtin_amdgcn_fence(__ATOMIC_ACQUIRE, "agent"); asm volatile("s_waitcnt vmcnt(0)" ::: "memory"); }
    }
    __syncthreads();
}

__global__ void __launch_bounds__(512, 2) fwd(Args args) {
    extern __shared__ __attribute__((aligned(16))) unsigned char lds[];
    LAS unsigned char* ldsl = (LAS unsigned char*)lds;
    if (threadIdx.x < 64) ((volatile LAS unsigned*)(ldsl + LDS_MISC))[threadIdx.x] = 0u;
    __syncthreads();
    const int lo = args.ph_lo, hi = args.ph_hi;
    const bool fused = (hi - lo) > 1;
    if (fused) (void)xcd_barrier_post((unsigned*)(args.ws + WS_CTL) + CW_BAR, (volatile LAS unsigned*)(ldsl + LDS_MISC));
#ifndef PH_EN
#define PH_EN 0xff
#endif
#define IN(k) (lo <= (k) && (k) < hi)
#if defined(BWPROBE)
#define BW_MATCH(k) (BWPROBE == 9 || ((k) == 0 ? 5 : ((k) - 1) % 5) == BWPROBE)
#define SEAM(k) do { if (IN((k) + 1)) { const unsigned long long bw0_ = __builtin_amdgcn_s_memrealtime(); XcdBarrier b_; b_.bar = (unsigned*)(args.ws + WS_CTL) + CW_BAR; b_.x = xb_xcc_id(); b_.st = (volatile LAS unsigned*)(ldsl + LDS_MISC); xcd_barrier(b_); \
    if (BW_MATCH(k) && threadIdx.x == 0) atomicAdd((unsigned*)(args.ws + WS_CTL) + 14336, (unsigned)(__builtin_amdgcn_s_memrealtime() - bw0_)); } } while (0)
#else
#define SEAM(k) do { if (IN((k) + 1)) { XcdBarrier b_; b_.bar = (unsigned*)(args.ws + WS_CTL) + CW_BAR; b_.x = xb_xcc_id(); b_.st = (volatile LAS unsigned*)(ldsl + LDS_MISC); xcd_barrier(b_); } } while (0)
#endif
#define SEAM_STEAL(k) do { if (IN((k) + 1)) { XcdBarrier b_; b_.bar = (unsigned*)(args.ws + WS_CTL) + CW_BAR; b_.x = xb_xcc_id(); b_.st = (volatile LAS unsigned*)(ldsl + LDS_MISC); xcd_barrier_steal(b_, args, ldsl); } } while (0)
    const int G = gridDim.x, bid = blockIdx.x;
#if defined(TPROBE)
    unsigned long long tp_acc = 0ull, tp_t0 = 0ull;
#define tp_acc_ref tp_acc
#define TP_BEGIN(k) do { if ((k) == TPROBE) tp_t0 = __builtin_amdgcn_s_memrealtime(); } while (0)
#define TP_END(k) do { if ((k) == TPROBE) tp_acc += __builtin_amdgcn_s_memrealtime() - tp_t0; } while (0)
#else
    unsigned long long tp_dummy = 0ull;
#define tp_acc_ref tp_dummy
#define TP_BEGIN(k) do { } while (0)
#define TP_END(k) do { } while (0)
#endif

    if ((PH_EN & 1) && IN(0)) { const Frame F = mkframe(args, launder(args.ws), ldsl); TP_BEGIN(0); p0_prologue(F);
#if defined(DUP) && DUP == 6
        __syncthreads(); p0_prologue(F);
#endif
        SEAM(0); TP_END(0); }

    for (int layer = 0; layer < DEPTH; ++layer) {
        const int pb = 1 + 5 * layer;
        if ((PH_EN & 2) && IN(pb)) { TP_BEGIN(1);
            GA unsigned char* ws = launder(args.ws);
            { pg8::Gemm g{(const GA bf16_t*)(ws + WS_XB), (const GA bf16_t*)(ws + WS_WIN) + (size_t)layer * NINP * DM, MT, NINP, DM}; pg8::StaticOrder S; S.init(MT, NINP, G, bid);
              EpiIn E{ws};
              pg8::gemm_phase<EpiIn, pg8::StaticOrder>(ldsl, g, S, E); }
            __syncthreads();
            { pg8::Gemm g{(const GA bf16_t*)(ws + WS_XQ), (const GA bf16_t*)(ws + WS_WG8 + (size_t)layer * N8 * DM), MT, N8, DM / 2}; pg8::StaticOrder S;
              if (G == 256) { if (bid < 192) S.init_part(MT, N8, 192, bid, 12); else S.init_part(MT, N8, 64, 2304 + (bid - 192), 14); } else S.init(MT, N8, G, (bid + 128) % G);
              EpiGate E{ws};
              pg8::gemm_phase<EpiGate, pg8::StaticOrder>(ldsl, g, S, E); }
            SEAM_STEAL(pb); TP_END(1);
        }
        if ((PH_EN & 4) && IN(pb + 1)) { TP_BEGIN(2);
            const Frame F = mkframe(args, launder(args.ws), ldsl);
            TP_BEGIN(20); if (bid < 8) fox_scan(F, layer, bid);
            fox_kmax(F, layer); TP_END(20);
            GA unsigned* ctr = F.ctl + CW_Q + 64 * (layer * 4 + 0);
            for (int u = q_next(ctr, F.misc + 4); u < 768 + 2048; ) {
                if (u < 768) { TP_BEGIN(23); u = attn_dil_unit(F, u, ctr); TP_END(23); }
                else { TP_BEGIN(21); u = idxsel_unit(F, u - 768, tp_acc_ref, ctr); TP_END(21); }
            }
            SEAM_STEAL(pb + 1); TP_END(2);
        }
        if ((PH_EN & 16) && IN(pb + 2)) { TP_BEGIN(4);
            const Frame F = mkframe(args, launder(args.ws), ldsl);
            GA unsigned* ctr = F.ctl + CW_Q + 64 * (layer * 4 + 1);
            const int nunits = 1536;
            for (int u = q_next(ctr, F.misc + 4); u < nunits; ) {
                if (u < 512) { const int qb = 31 - (u >> 4), r = u & 15; TP_BEGIN(40); TP_BEGIN(44 + (qb >= 16)); u = attn_diffmap_unit(F, layer, r & 1, (r >> 1) & 3, qb, r >> 3, ctr); TP_END(40); TP_END(44 + (qb >= 16)); }
                else if (u < 1024) { const int v = u - 512, qb = 31 - (v >> 4), r = v & 15, mode = r & 1, b = (r >> 1) & 1, h = r >> 2;
                    if (mode == 0) { TP_BEGIN(41); u = attn_fast_unit<0>(F, layer, b, h, qb, ctr); TP_END(41); } else { TP_BEGIN(42); u = attn_fast_unit<1>(F, layer, b, h, qb, ctr); TP_END(42); } }
                else { TP_BEGIN(43); u = dil_merge_unit(F, u - 1024, ctr); TP_END(43); }
            }
            if (layer == 0) { __syncthreads(); wq_drain(args, ldsl, WQ_L0); }
            SEAM_STEAL(pb + 2); TP_END(4);
        }
        if ((PH_EN & 32) && IN(pb + 3)) { TP_BEGIN(5);
            GA unsigned char* ws = launder(args.ws);
            pg8::Gemm g{(const GA bf16_t*)(ws + WS_Y), (const GA bf16_t*)(ws + WS_WBR) + (size_t)layer * DM * DM, MT, DM, DM}; pg8::StaticOrder S; S.init(MT, DM, G, bid);
            EpiMerged E{(const GA unsigned char*)(ws + WS_G), (GA bf16_t*)(ws + WS_MG)};
            pg8::gemm_phase<EpiMerged, pg8::StaticOrder>(ldsl, g, S, E);
#if defined(DUP) && DUP == 4
            __syncthreads(); pg8::gemm_phase<EpiMerged, pg8::StaticOrder>(ldsl, g, S, E);
#endif
            SEAM_STEAL(pb + 3); TP_END(5);
        }
        if ((PH_EN & 64) && IN(pb + 4)) { TP_BEGIN(6);
            GA unsigned char* ws = launder(args.ws);
            pg8::Gemm g{(const GA bf16_t*)(ws + WS_MG), (const GA bf16_t*)(ws + WS_WOUT) + (size_t)layer * DM * DM, MT, DM, DM}; pg8::StaticOrder S; S.init(MT, DM, G, bid);
            EpiOut E{(GA float*)(ws + WS_XRES), (GA bf16_t*)(ws + WS_XB), (GA float*)(ws + WS_SSQ), ws + WS_XQ, (layer == 0) ? (const GA float*)args.in[0] : (const GA float*)nullptr, layer + 1 < DEPTH, (GA float*)(ws + WS_SC), (GA unsigned*)(ws + WS_CTL) + CW_PC + layer * 64};
            pg8::gemm_phase<EpiOut, pg8::StaticOrder>(ldsl, g, S, E);
            if (layer + 1 < DEPTH) { __syncthreads(); wq_drain(args, ldsl, WQ_L0 + (unsigned)(layer + 1) * WT_TL); }
            SEAM_STEAL(pb + 4); TP_END(6);
        }
    }
    if ((PH_EN & 128) && IN(21)) { TP_BEGIN(7); const Frame F = mkframe(args, launder(args.ws), ldsl); final_norm(F); TP_END(7); }
#if defined(BWPROBE)
    if (bid == 0) { __syncthreads(); const unsigned long long te = __builtin_amdgcn_s_memrealtime(); const unsigned long long tot = xb_ld((unsigned*)(args.ws + WS_CTL) + 14336);
        while ((__builtin_amdgcn_s_memrealtime() - te) * 32ull < tot) __builtin_amdgcn_s_sleep(8); }
#endif
#if defined(TPROBE)
    if (bid == 0) { const unsigned long long te = __builtin_amdgcn_s_memrealtime(); while (__builtin_amdgcn_s_memrealtime() - te < 8ull * tp_acc) __builtin_amdgcn_s_sleep(8); }
#endif
#undef IN
#undef SEAM
}

extern "C" void kernel_launch(void* const* d_in, const int* in_sizes, int n_in, void* d_out, int out_size, void* d_ws, size_t ws_size, hipStream_t stream) {
    static int grid = 0;
    if (grid == 0) {
        if (n_in != 13 || in_sizes[0] != MT * DM || out_size != MT * DM || ws_size < WS_END) {
            fprintf(stderr, "kernel_launch: unexpected shapes (n_in %d, in0 %d, out %d, ws %zu, need %zu)\n", n_in, n_in > 0 ? in_sizes[0] : -1, out_size, ws_size, (size_t)WS_END); grid = -1; return; }
        int dev = 0, cus = 0, per_cu = 0;
        if (hipGetDevice(&dev) != hipSuccess || hipDeviceGetAttribute(&cus, hipDeviceAttributeMultiprocessorCount, dev) != hipSuccess) { grid = -1; return; }
        if (hipFuncSetAttribute((const void*)fwd, hipFuncAttributeMaxDynamicSharedMemorySize, LDS_BYTES) != hipSuccess) { fprintf(stderr, "kernel_launch: hipFuncSetAttribute failed\n"); grid = -1; return; }
        if (hipOccupancyMaxActiveBlocksPerMultiprocessor(&per_cu, (const void*)fwd, 512, LDS_BYTES) != hipSuccess || per_cu < 1) fprintf(stderr, "kernel_launch: occupancy query reports %d\n", per_cu);
        (void)hipGetLastError();
        grid = cus;
    }
    if (grid < 0) return;
    if (hipMemsetAsync((char*)d_ws + WS_CTL, 0, CTL_BYTES, stream) != hipSuccess) return;
    Args a{};
    for (int i = 0; i < 13; ++i) a.in[i] = (const float*)d_in[i];
    a.out = (float*)d_out; a.ws = (unsigned char*)d_ws;
#if MK_LAUNCHES == 1
    a.ph_lo = 0; a.ph_hi = NPH;
    hipLaunchKernelGGL(fwd, dim3(grid), dim3(512), LDS_BYTES, stream, a);
#else
    for (int p = 0; p < NPH; ++p) { a.ph_lo = p; a.ph_hi = p + 1; hipLaunchKernelGGL(fwd, dim3(grid), dim3(512), LDS_BYTES, stream, a); }
#endif
}
```
